# Optimizing an MI355X kernel written in HIP

```python
import math
import jax, jax.numpy as jnp
from jax import lax
import numpy as np

D_MODEL = 1024
BATCH = 4
SEQ = 4096
DEPTH = 2

CHUNK = 64
EPS = 1e-6
D_MIX = D_MODEL
CONV_K = 4

SSD_HEADS = 8
SSD_HEAD_DIM = 64
SSD_DIM = SSD_HEADS * SSD_HEAD_DIM
SSD_GROUPS = 2
SSD_STATE = 128
SSD_CONV_DIM = SSD_DIM + 2 * SSD_GROUPS * SSD_STATE

ATT_HEADS = 4
ATT_KV_HEADS = 2
ATT_HEAD_DIM = 64
ATT_DIM = ATT_HEADS * ATT_HEAD_DIM
ATT_KV_DIM = ATT_KV_HEADS * ATT_HEAD_DIM
WINDOW = 128
WIN_CHUNKS = WINDOW // CHUNK

GDN_HEADS = 4
GDN_HEAD_K = 64
GDN_HEAD_V = 64
GDN_KDIM = GDN_HEADS * GDN_HEAD_K
GDN_DIM = GDN_HEADS * GDN_HEAD_V
GDN_CONV_DIM = 2 * GDN_KDIM + GDN_DIM

FF = ((8 * D_MODEL // 3 + 255) // 256) * 256

IN_SIZES = (ATT_DIM, ATT_KV_DIM, ATT_KV_DIM,
            SSD_DIM, SSD_CONV_DIM, SSD_HEADS,
            GDN_CONV_DIM, GDN_DIM, GDN_HEADS, GDN_HEADS)
IN_COLS = sum(IN_SIZES)

kernel_name = "hybrid_ssd_swa_gdn_sandwich_block"


def _offsets(sizes):
    out, acc = [], 0
    for s in sizes[:-1]:
        acc += s
        out.append(acc)
    return out


def rmsnorm(x, w):
    xf = x.astype(jnp.float32)
    y = xf * lax.rsqrt(jnp.mean(xf * xf, axis=-1, keepdims=True) + EPS)
    return (y * w.astype(jnp.float32)).astype(x.dtype)


def l2norm(x):
    return x * lax.rsqrt(jnp.sum(x * x, axis=-1, keepdims=True) + EPS)


def causal_dwconv(x, w, b=None):
    k = w.shape[0]
    t = x.shape[1]
    xp = jnp.pad(x, ((0, 0), (k - 1, 0), (0, 0)))
    y = xp[:, 0:t] * w[0]
    for i in range(1, k):
        y = y + xp[:, i:i + t] * w[i]
    if b is not None:
        y = y + b
    return y


def alibi_slopes(n):
    return 2.0 ** (-8.0 * jnp.arange(1, n + 1, dtype=jnp.float32) / n)


def lower_exp_diff(cs):
    n = cs.shape[-1]
    tril = jnp.tril(jnp.ones((n, n), dtype=bool))
    diff = cs[..., :, None] - cs[..., None, :]
    return jnp.where(tril, jnp.exp(jnp.where(tril, diff, 0.0)), 0.0)


def swa_sink_alibi(q, k, v, sinks):
    bsz, t = q.shape[0], q.shape[1]
    nc = t // CHUNK
    grp = ATT_HEADS // ATT_KV_HEADS
    band = (WIN_CHUNKS + 1) * CHUNK
    qc = q.reshape(bsz, nc, CHUNK, ATT_KV_HEADS, grp, ATT_HEAD_DIM)
    padw = ((0, 0), (WIN_CHUNKS * CHUNK, 0), (0, 0))
    kp = jnp.pad(k, padw).reshape(bsz, nc + WIN_CHUNKS, CHUNK, ATT_KV_HEADS, ATT_HEAD_DIM)
    vp = jnp.pad(v, padw).reshape(bsz, nc + WIN_CHUNKS, CHUNK, ATT_KV_HEADS, ATT_HEAD_DIM)
    kb = jnp.concatenate([kp[:, j:j + nc] for j in range(WIN_CHUNKS + 1)], axis=2)
    vb = jnp.concatenate([vp[:, j:j + nc] for j in range(WIN_CHUNKS + 1)], axis=2)
    s = jnp.einsum('bcikgd,bcjkd->bckgij', qc, kb).astype(jnp.float32) * (ATT_HEAD_DIM ** -0.5)
    qi = jnp.arange(CHUNK)[:, None]
    kj = jnp.arange(band)[None, :]
    dist = jnp.abs(qi + WIN_CHUNKS * CHUNK - kj).astype(jnp.float32)
    slopes = alibi_slopes(ATT_HEADS).reshape(ATT_KV_HEADS, grp)
    s = s - slopes[:, :, None, None] * dist
    key_chunk = jnp.arange(nc)[:, None] - WIN_CHUNKS + (jnp.arange(band) // CHUNK)[None, :]
    valid = key_chunk >= 0
    s = jnp.where(valid[None, :, None, None, None, :], s, -jnp.inf)
    sink = jnp.broadcast_to(sinks.astype(jnp.float32).reshape(1, 1, ATT_KV_HEADS, grp, 1, 1),
                            s.shape[:-1] + (1,))
    p = jax.nn.softmax(jnp.concatenate([s, sink], axis=-1), axis=-1)[..., :band]
    o = jnp.einsum('bckgij,bcjkd->bcikgd', p.astype(v.dtype), vb)
    return o.reshape(bsz, t, ATT_DIM)


def ssd_mixer(z, xbc, dt, conv_w, conv_b, dt_bias, a_log, d_skip, norm_w):
    bsz, t = xbc.shape[0], xbc.shape[1]
    nc = t // CHUNK
    hpg = SSD_HEADS // SSD_GROUPS
    xbc = jax.nn.silu(causal_dwconv(xbc, conv_w, conv_b)).astype(jnp.float32)
    xs, bm, cm = jnp.split(xbc, [SSD_DIM, SSD_DIM + SSD_GROUPS * SSD_STATE], axis=-1)
    xs = xs.reshape(bsz, t, SSD_HEADS, SSD_HEAD_DIM)
    bm = jnp.repeat(bm.reshape(bsz, t, SSD_GROUPS, SSD_STATE), hpg, axis=2)
    cm = jnp.repeat(cm.reshape(bsz, t, SSD_GROUPS, SSD_STATE), hpg, axis=2)
    dt = jax.nn.softplus(dt.astype(jnp.float32) + dt_bias.astype(jnp.float32))
    a = -jnp.exp(a_log.astype(jnp.float32))
    xc = (xs * dt[..., None]).reshape(bsz, nc, CHUNK, SSD_HEADS, SSD_HEAD_DIM)
    bc = bm.reshape(bsz, nc, CHUNK, SSD_HEADS, SSD_STATE)
    cc = cm.reshape(bsz, nc, CHUNK, SSD_HEADS, SSD_STATE)
    da = (dt * a).reshape(bsz, nc, CHUNK, SSD_HEADS).transpose(0, 3, 1, 2)
    a_cs = jnp.cumsum(da, axis=-1)
    lmat = lower_exp_diff(a_cs)
    scores = jnp.einsum('bclhn,bcshn->bhcls', cc, bc) * lmat
    y_diag = jnp.einsum('bhcls,bcshp->bclhp', scores, xc)
    decay_states = jnp.exp(a_cs[..., -1:] - a_cs)
    chunk_states = jnp.einsum('bclhn,bhcl,bclhp->bchpn', bc, decay_states, xc)
    chunk_decay = jnp.exp(a_cs[..., -1])

    def step(state, inp):
        new, dec = inp
        return state * dec[..., None, None] + new, state

    init = jnp.zeros((bsz, SSD_HEADS, SSD_HEAD_DIM, SSD_STATE), jnp.float32)
    _, prev = lax.scan(step, init, (chunk_states.transpose(1, 0, 2, 3, 4),
                                    chunk_decay.transpose(2, 0, 1)))
    prev = prev.transpose(1, 0, 2, 3, 4)
    y_off = jnp.einsum('bclhn,bchpn,bhcl->bclhp', cc, prev, jnp.exp(a_cs))
    y = (y_diag + y_off).reshape(bsz, t, SSD_HEADS, SSD_HEAD_DIM) + xs * d_skip.astype(jnp.float32)[:, None]
    g = y.reshape(bsz, t, SSD_DIM) * jax.nn.silu(z.astype(jnp.float32))
    g = g.reshape(bsz, t, SSD_GROUPS, SSD_DIM // SSD_GROUPS)
    g = g * lax.rsqrt(jnp.mean(g * g, axis=-1, keepdims=True) + EPS)
    return (g.reshape(bsz, t, SSD_DIM) * norm_w.astype(jnp.float32)).astype(z.dtype)


def gdn_mixer(qkv, z, b, a, conv_w, dt_bias, a_log, norm_w):
    bsz, t = qkv.shape[0], qkv.shape[1]
    nc = t // CHUNK
    qkv = jax.nn.silu(causal_dwconv(qkv, conv_w)).astype(jnp.float32)
    q, k, v = jnp.split(qkv, [GDN_KDIM, 2 * GDN_KDIM], axis=-1)
    q = l2norm(q.reshape(bsz, t, GDN_HEADS, GDN_HEAD_K)) * (GDN_HEAD_K ** -0.5)
    k = l2norm(k.reshape(bsz, t, GDN_HEADS, GDN_HEAD_K))
    v = v.reshape(bsz, t, GDN_HEADS, GDN_HEAD_V)
    beta = jax.nn.sigmoid(b.astype(jnp.float32))
    g = -jnp.exp(a_log.astype(jnp.float32)) * jax.nn.softplus(a.astype(jnp.float32) + dt_bias.astype(jnp.float32))

    def chunks(u):
        return u.reshape(bsz, nc, CHUNK, GDN_HEADS, u.shape[-1]).transpose(0, 3, 1, 2, 4)

    qc, kc, vc = chunks(q), chunks(k), chunks(v)
    betac = beta.reshape(bsz, nc, CHUNK, GDN_HEADS).transpose(0, 3, 1, 2)
    gc = jnp.cumsum(g.reshape(bsz, nc, CHUNK, GDN_HEADS).transpose(0, 3, 1, 2), axis=-1)
    decay = lower_exp_diff(gc)
    kbeta = kc * betac[..., None]
    strict = jnp.tril(jnp.einsum('bhcid,bhcjd->bhcij', kbeta, kc) * decay, -1)
    rhs = jnp.concatenate([vc * betac[..., None], kbeta * jnp.exp(gc)[..., None]], axis=-1)
    sol = lax.linalg.triangular_solve(strict, rhs, left_side=True, lower=True, unit_diagonal=True)
    u, w = jnp.split(sol, [GDN_HEAD_V], axis=-1)
    qk = jnp.einsum('bhcid,bhcjd->bhcij', qc, kc) * decay

    def step(state, inp):
        q_i, k_i, u_i, w_i, qk_i, g_i = inp
        v_new = u_i - jnp.einsum('bhld,bhde->bhle', w_i, state)
        o = (jnp.einsum('bhld,bhde->bhle', q_i * jnp.exp(g_i)[..., None], state)
             + jnp.einsum('bhls,bhse->bhle', qk_i, v_new))
        g_last = g_i[..., -1]
        state = (state * jnp.exp(g_last)[..., None, None]
                 + jnp.einsum('bhld,bhle->bhde', k_i * jnp.exp(g_last[..., None] - g_i)[..., None], v_new))
        return state, o

    xs = tuple(jnp.moveaxis(u_, 2, 0) for u_ in (qc, kc, u, w, qk, gc))
    init = jnp.zeros((bsz, GDN_HEADS, GDN_HEAD_K, GDN_HEAD_V), jnp.float32)
    _, o = lax.scan(step, init, xs)
    o = o.transpose(1, 0, 3, 2, 4).reshape(bsz, t, GDN_HEADS, GDN_HEAD_V)
    o = o * lax.rsqrt(jnp.mean(o * o, axis=-1, keepdims=True) + EPS) * norm_w.astype(jnp.float32)
    o = o * jax.nn.silu(z.astype(jnp.float32).reshape(bsz, t, GDN_HEADS, GDN_HEAD_V))
    return o.reshape(bsz, t, GDN_DIM).astype(z.dtype)


def setup_inputs(seed: int = 0) -> dict:
    key = jax.random.key(seed)
    ks = jax.random.split(key, 24)
    L = DEPTH

    def nrm(k, shape, scale):
        return jax.random.normal(k, shape, jnp.float32) * scale

    def gain(k, shape):
        return 1.0 + 0.05 * jax.random.normal(k, shape, jnp.float32)

    def dt_bias_init(k, shape):
        u = jax.random.uniform(k, shape, jnp.float32, math.log(1e-3), math.log(1e-1))
        dtv = jnp.exp(u)
        return dtv + jnp.log(-jnp.expm1(-dtv))

    def a_log_init(k, shape):
        return jnp.log(jax.random.uniform(k, shape, jnp.float32, 1.0, 16.0))

    return {
        "x": nrm(ks[0], (BATCH, SEQ, D_MODEL), 1.0),
        "pre_mix_norm": gain(ks[1], (L, D_MODEL)),
        "post_mix_norm": gain(ks[2], (L, D_MODEL)),
        "pre_ffn_norm": gain(ks[3], (L, D_MODEL)),
        "post_ffn_norm": gain(ks[4], (L, D_MODEL)),
        "w_in": nrm(ks[5], (L, D_MODEL, IN_COLS), D_MODEL ** -0.5),
        "w_out": nrm(ks[6], (L, D_MIX, D_MODEL), D_MIX ** -0.5),
        "attn_sinks": nrm(ks[7], (L, ATT_HEADS), 0.5),
        "ssd_conv_w": nrm(ks[8], (L, CONV_K, SSD_CONV_DIM), CONV_K ** -0.5),
        "ssd_conv_b": nrm(ks[9], (L, SSD_CONV_DIM), 0.01),
        "ssd_dt_bias": dt_bias_init(ks[10], (L, SSD_HEADS)),
        "ssd_A_log": a_log_init(ks[11], (L, SSD_HEADS)),
        "ssd_D": 1.0 + 0.1 * jax.random.normal(ks[12], (L, SSD_HEADS), jnp.float32),
        "ssd_norm_w": gain(ks[13], (L, SSD_DIM)),
        "gdn_conv_w": nrm(ks[14], (L, CONV_K, GDN_CONV_DIM), CONV_K ** -0.5),
        "gdn_dt_bias": dt_bias_init(ks[15], (L, GDN_HEADS)),
        "gdn_A_log": a_log_init(ks[16], (L, GDN_HEADS)),
        "gdn_norm_w": gain(ks[17], (L, GDN_HEAD_V)),
        "ffn_w_gate": nrm(ks[18], (L, D_MODEL, FF), D_MODEL ** -0.5),
        "ffn_w_up": nrm(ks[19], (L, D_MODEL, FF), D_MODEL ** -0.5),
        "ffn_w_down": nrm(ks[20], (L, FF, D_MODEL), FF ** -0.5),
    }


def reference(x, pre_mix_norm, post_mix_norm, pre_ffn_norm, post_ffn_norm, w_in, w_out,
              attn_sinks, ssd_conv_w, ssd_conv_b, ssd_dt_bias, ssd_A_log, ssd_D, ssd_norm_w,
              gdn_conv_w, gdn_dt_bias, gdn_A_log, gdn_norm_w, ffn_w_gate, ffn_w_up, ffn_w_down):
    offs = _offsets(IN_SIZES)
    for l in range(DEPTH):
        h = rmsnorm(x, pre_mix_norm[l])
        proj = h @ w_in[l]
        (a_q, a_k, a_v, s_z, s_xbc, s_dt, g_qkv, g_z, g_b, g_a) = jnp.split(proj, offs, axis=-1)
        att = swa_sink_alibi(a_q, a_k, a_v, attn_sinks[l])
        ssd = ssd_mixer(s_z, s_xbc, s_dt, ssd_conv_w[l], ssd_conv_b[l], ssd_dt_bias[l],
                        ssd_A_log[l], ssd_D[l], ssd_norm_w[l])
        gdn = gdn_mixer(g_qkv, g_z, g_b, g_a, gdn_conv_w[l], gdn_dt_bias[l], gdn_A_log[l], gdn_norm_w[l])
        mix = jnp.concatenate([att, ssd, gdn], axis=-1) @ w_out[l]
        x = x + rmsnorm(mix, post_mix_norm[l])
        h = rmsnorm(x, pre_ffn_norm[l])
        f = (jax.nn.silu(h @ ffn_w_gate[l]) * (h @ ffn_w_up[l])) @ ffn_w_down[l]
        x = x + rmsnorm(f, post_ffn_norm[l])
    return x
```

```cpp
#include <hip/hip_runtime.h>
#include <hip/hip_cooperative_groups.h>
#include <cstdio>
#include <cstdint>
namespace cg = cooperative_groups;
namespace pg8 {
#define PG8_LAS __attribute__((address_space(3)))
typedef unsigned short bf16_t;
typedef short bf16x8 __attribute__((ext_vector_type(8)));
typedef float f32x4 __attribute__((ext_vector_type(4)));
typedef unsigned u32x4 __attribute__((ext_vector_type(4)));
constexpr int BM = 256, BK = 64, HALF = 128, HTB = HALF * BK * 2  , STAGE_BYTES = 8 * HTB, NXCD = 8, WGM = 8;

__host__ __device__ __forceinline__ int lds_byte(int r, int c) { const int st = (r >> 4) * 2 + (c >> 5), rr = r & 15, cc = c & 31, ob = rr * 64 + cc * 2; return st * 1024 + (ob ^ (((ob >> 9) & 1) << 5)); }
__host__ __device__ __forceinline__ void stage_rc(int b, int& R, int& C) { const int st = b / 1024, sb = b % 1024, swz = sb ^ (((sb >> 9) & 1) << 5); R = (st >> 1) * 16 + swz / 64; C = (st & 1) * 32 + (swz % 64) / 2; }
__host__ __device__ __forceinline__ int perm32(int rho) { const int n = rho >> 4, i = rho & 15; return 8 * (i >> 2) + 4 * n + (i & 3); }

struct Unit { int pm, pn; };
struct Gemm { const bf16_t* A; const bf16_t* Bt; int M, N, K; };

struct StaticOrder {
    int nM, nN, nwg, G, c;
    __host__ __device__ void init(int M, int N, int G_, int c_) { nM = M / BM; nN = N / BM; nwg = nM * nN; G = G_; c = c_; }
    __host__ __device__ bool next(int i, Unit& u) const {
        const long L = (long)i * G + c; if (L >= nwg) return false;
        int wgid = (int)L; { const int q = nwg / NXCD, r = nwg % NXCD, xcd = wgid % NXCD, off = wgid / NXCD; wgid = (xcd < r ? xcd * (q + 1) : r * (q + 1) + (xcd - r) * q) + off; }
        const int nig = WGM * nN, gid = wgid / nig, fm = gid * WGM, gsz = (nM - fm) < WGM ? (nM - fm) : WGM;
        u.pm = fm + ((wgid % nig) % gsz); u.pn = (wgid % nig) / gsz; return true;
    }
    __device__ __forceinline__ void a_ready(const Unit&) const {}
    __device__ __forceinline__ void done(const Unit&) const {}
};

__device__ __forceinline__ unsigned cvt_pk_bf16(float lo, float hi) { unsigned r; asm volatile("v_cvt_pk_bf16_f32 %0, %1, %2" : "=v"(r) : "v"(lo), "v"(hi)); return r; }
typedef float f32x2 __attribute__((ext_vector_type(2)));
typedef unsigned u32x2 __attribute__((ext_vector_type(2)));
__device__ __forceinline__ float silu_f(float x) { return x * __builtin_amdgcn_rcpf(1.0f + __expf(-x)); }
struct EpiStoreBf16 {
    static constexpr bool PERM = true, AFTER_DRAIN = false;
    bf16_t* O; int ldc;
    __device__ __forceinline__ void operator()(const f32x4 (&acc)[2][2][4][2], const Unit& u, int wr, int wc, int fr, int fq) const {
        const int row0 = u.pm * BM + wr * 64 + fr, col0 = u.pn * BM + wc * 32 + 8 * fq;
#pragma unroll
        for (int ai = 0; ai < 2; ++ai)
#pragma unroll
            for (int m = 0; m < 4; ++m) { bf16_t* rowp = O + (size_t)(row0 + ai * HALF + m * 16) * ldc + col0;
#pragma unroll
                for (int bj = 0; bj < 2; ++bj) { const f32x4 v0 = acc[ai][bj][m][0], v1 = acc[ai][bj][m][1];
                    u32x4 w; w.x = cvt_pk_bf16(v0[0], v0[1]); w.y = cvt_pk_bf16(v0[2], v0[3]); w.z = cvt_pk_bf16(v1[0], v1[1]); w.w = cvt_pk_bf16(v1[2], v1[3]);
                    *(u32x4*)(rowp + bj * HALF) = w; } }
    }
};
struct EpiStoreF32 {
    static constexpr bool PERM = true, AFTER_DRAIN = false;
    float* O; int ldc;
    __device__ __forceinline__ void operator()(const f32x4 (&acc)[2][2][4][2], const Unit& u, int wr, int wc, int fr, int fq) const {
        const int row0 = u.pm * BM + wr * 64 + fr, col0 = u.pn * BM + wc * 32 + 8 * fq;
#pragma unroll
        for (int ai = 0; ai < 2; ++ai)
#pragma unroll
            for (int m = 0; m < 4; ++m) { float* rowp = O + (size_t)(row0 + ai * HALF + m * 16) * ldc + col0;
#pragma unroll
                for (int bj = 0; bj < 2; ++bj) { *(f32x4*)(rowp + bj * HALF) = acc[ai][bj][m][0]; *(f32x4*)(rowp + bj * HALF + 4) = acc[ai][bj][m][1]; } }
    }
};
struct EpiSwiGLU {
    static constexpr bool PERM = true, AFTER_DRAIN = false;
    bf16_t* H; int ldh;
    __device__ __forceinline__ void operator()(const f32x4 (&acc)[2][2][4][2], const Unit& u, int wr, int wc, int fr, int fq) const {
        const int row0 = u.pm * BM + wr * 64 + fr, col0 = u.pn * (BM / 2) + wc * 16 + 4 * fq;
#pragma unroll
        for (int ai = 0; ai < 2; ++ai)
#pragma unroll
            for (int m = 0; m < 4; ++m) { bf16_t* rowp = H + (size_t)(row0 + ai * HALF + m * 16) * ldh + col0;
#pragma unroll
                for (int bj = 0; bj < 2; ++bj) { const f32x4 v0 = acc[ai][bj][m][0], v1 = acc[ai][bj][m][1];
                    u32x2 w; w.x = cvt_pk_bf16(silu_f(v0[0]) * v0[1], silu_f(v0[2]) * v0[3]); w.y = cvt_pk_bf16(silu_f(v1[0]) * v1[1], silu_f(v1[2]) * v1[3]);
                    *(u32x2*)(rowp + bj * (HALF / 2)) = w; } }
    }
};
template <class Epi, class Sched, bool ALIGN_EPI = false, bool SP2 = false>
__device__ __forceinline__ void gemm_phase(PG8_LAS unsigned char* lds, const Gemm g, const Sched& S, const Epi& E) {
    int tid_l = threadIdx.x; asm volatile("" : "+v"(tid_l));
    const int tid = tid_l, wid = __builtin_amdgcn_readfirstlane(tid >> 6), lane = tid & 63, wr = wid >> 2, wc = wid & 3, fr = lane & 15, fq = lane >> 4;
    const int K = g.K, nt = K / BK;
    unsigned voffA[2], voffB[2];
#pragma unroll
    for (int i = 0; i < 2; ++i) { int R, C; stage_rc(tid * 16 + i * 8192, R, C); const int Rb = Epi::PERM ? ((R & ~31) + perm32(R & 31)) : R;
        voffA[i] = (unsigned)(R * K + C) * 2u; voffB[i] = (unsigned)(Rb * K + C) * 2u; }
    const size_t kstep = (size_t)(BK * 2);
    const size_t hstep = (size_t)HALF * K * 2;
    const size_t tstep = 2 * hstep;
    const unsigned ldsw = (unsigned)wid * 1024u;
    const int aoff = lds_byte(wr * 64 + fr, fq * 8), boff = lds_byte(wc * 32 + fr, fq * 8);
#define PG8_SA(b, h) (((b) * 2 + (h)) * HTB)
#define PG8_SB(b, h) ((4 + (b) * 2 + (h)) * HTB)
#define PG8_STAGE(bufoff, gbase, voff) do { _Pragma("unroll") for (int _i = 0; _i < 2; ++_i) \
        __builtin_amdgcn_global_load_lds((const unsigned*)((const char*)(gbase) + (voff)[_i]), (PG8_LAS unsigned*)(lds + (bufoff) + ldsw + _i * 8192), 16, 0, 0); } while (0)
#define PG8_LDA(dst, b, h) do { _Pragma("unroll") for (int m = 0; m < 4; ++m) _Pragma("unroll") for (int k = 0; k < 2; ++k) dst[m][k] = *(const PG8_LAS bf16x8*)(lds + PG8_SA(b, h) + aoff + m * 2048 + k * 1024); } while (0)
#define PG8_LDB(dst, b, h) do { _Pragma("unroll") for (int n = 0; n < 2; ++n) _Pragma("unroll") for (int k = 0; k < 2; ++k) dst[n][k] = *(const PG8_LAS bf16x8*)(lds + PG8_SB(b, h) + boff + n * 2048 + k * 1024); } while (0)
#define PG8_MMA(ai, bj, At, Bt) do { __builtin_amdgcn_s_setprio(1); _Pragma("unroll") for (int m = 0; m < 4; ++m) _Pragma("unroll") for (int n = 0; n < 2; ++n) _Pragma("unroll") for (int k = 0; k < 2; ++k) \
        acc[ai][bj][m][n] = __builtin_amdgcn_mfma_f32_16x16x32_bf16(Bt[n][k], At[m][k], acc[ai][bj][m][n], 0, 0, 0); __builtin_amdgcn_s_setprio(0); } while (0)
#define PG8_WAIT_V(n) asm volatile("s_waitcnt vmcnt(" #n ")" ::: "memory")
#define PG8_WAIT_L(n) asm volatile("s_waitcnt lgkmcnt(" #n ")" ::: "memory")
#define PG8_BAR __builtin_amdgcn_s_barrier()
#define PG8_SCHED __builtin_amdgcn_sched_barrier(0)
    Unit cur, nxt; int ui = 0;
    if (!S.next(0, cur)) return;
    f32x4 acc[2][2][4][2];
#pragma unroll
    for (int a = 0; a < 2; ++a)
#pragma unroll
        for (int b = 0; b < 2; ++b)
#pragma unroll
            for (int m = 0; m < 4; ++m)
#pragma unroll
                for (int n = 0; n < 2; ++n) acc[a][b][m][n] = (f32x4){0.f, 0.f, 0.f, 0.f};
    bf16x8 At[4][2], B0[2][2], B1[2][2];
    const char* cA = (const char*)g.A + (size_t)cur.pm * tstep; const char* cB = (const char*)g.Bt + (size_t)cur.pn * tstep;
    S.a_ready(cur);
    if constexpr (SP2) {
        PG8_STAGE(PG8_SB(0, 0), cB, voffB); PG8_STAGE(PG8_SB(0, 1), cB + hstep, voffB); PG8_STAGE(PG8_SA(0, 0), cA, voffA); PG8_STAGE(PG8_SA(0, 1), cA + hstep, voffA);
        if (wr == 1) PG8_BAR;
        PG8_WAIT_V(2); PG8_BAR;
        PG8_STAGE(PG8_SB(1, 0), cB + kstep, voffB); PG8_STAGE(PG8_SA(1, 0), cA + kstep, voffA); PG8_STAGE(PG8_SB(1, 1), cB + hstep + kstep, voffB);
        PG8_WAIT_V(6); PG8_BAR;
    } else {
        PG8_STAGE(PG8_SB(0, 0), cB, voffB); PG8_STAGE(PG8_SA(0, 0), cA, voffA); PG8_STAGE(PG8_SB(0, 1), cB + hstep, voffB); PG8_STAGE(PG8_SA(0, 1), cA + hstep, voffA);
        if (wr == 1) PG8_BAR;
        PG8_WAIT_V(4); PG8_BAR;
        PG8_STAGE(PG8_SB(1, 0), cB + kstep, voffB); PG8_STAGE(PG8_SA(1, 0), cA + kstep, voffA); PG8_STAGE(PG8_SB(1, 1), cB + hstep + kstep, voffB);
        PG8_WAIT_V(6); PG8_BAR;
    }
    for (;;) {
        const bool has_next = S.next(ui + 1, nxt);
        const char* nA = has_next ? (const char*)g.A + (size_t)nxt.pm * tstep : cA; const char* nB = has_next ? (const char*)g.Bt + (size_t)nxt.pn * tstep : cB;
        for (int t = 0; t < nt; t += 2) {
            const bool last = (t == nt - 2);
            const char* a1 = cA + (size_t)(t + 1) * kstep;
            const char* a2 = last ? nA : cA + (size_t)(t + 2) * kstep; const char* b2 = last ? nB : cB + (size_t)(t + 2) * kstep;
            const char* a3 = a2 + kstep; const char* b3 = b2 + kstep;
            if (last && has_next) S.a_ready(nxt);
            if constexpr (SP2) {
            PG8_LDB(B0, 0, 0); PG8_LDB(B1, 0, 1); PG8_SCHED; PG8_LDA(At, 0, 0); PG8_STAGE(PG8_SA(1, 1), a1 + hstep, voffA);
            PG8_WAIT_V(8); PG8_WAIT_L(0); PG8_BAR; PG8_MMA(0, 0, At, B0); PG8_MMA(0, 1, At, B1); PG8_BAR; PG8_SCHED;
            PG8_LDA(At, 0, 1); PG8_STAGE(PG8_SB(0, 0), b2, voffB); PG8_STAGE(PG8_SB(0, 1), b2 + hstep, voffB); PG8_STAGE(PG8_SA(0, 0), a2, voffA);
            PG8_WAIT_V(8); PG8_WAIT_L(0); PG8_BAR; PG8_MMA(1, 0, At, B0); PG8_MMA(1, 1, At, B1); PG8_BAR; PG8_SCHED;
            PG8_LDB(B0, 1, 0); PG8_LDB(B1, 1, 1); PG8_SCHED; PG8_LDA(At, 1, 0); PG8_STAGE(PG8_SA(0, 1), a2 + hstep, voffA);
            PG8_WAIT_V(8); PG8_WAIT_L(0); PG8_BAR; PG8_MMA(0, 0, At, B0); PG8_MMA(0, 1, At, B1); PG8_BAR; PG8_SCHED;
            PG8_LDA(At, 1, 1); PG8_STAGE(PG8_SB(1, 0), b3, voffB); PG8_STAGE(PG8_SB(1, 1), b3 + hstep, voffB); PG8_STAGE(PG8_SA(1, 0), a3, voffA);
            PG8_WAIT_V(8); PG8_WAIT_L(0); PG8_BAR; PG8_MMA(1, 0, At, B0); PG8_MMA(1, 1, At, B1); PG8_BAR; PG8_SCHED;
            } else {
            PG8_LDB(B0, 0, 0); PG8_SCHED; PG8_LDA(At, 0, 0); PG8_STAGE(PG8_SA(1, 1), a1 + hstep, voffA);
            PG8_WAIT_L(8); PG8_BAR; PG8_WAIT_L(0); PG8_MMA(0, 0, At, B0); PG8_BAR; PG8_SCHED;
            PG8_LDB(B1, 0, 1); PG8_STAGE(PG8_SB(0, 0), b2, voffB);
            PG8_BAR; PG8_WAIT_L(0); PG8_MMA(0, 1, At, B1); PG8_BAR;
            PG8_LDA(At, 0, 1); PG8_STAGE(PG8_SA(0, 0), a2, voffA);
            PG8_BAR; PG8_WAIT_L(0); PG8_MMA(1, 0, At, B0); PG8_BAR; PG8_SCHED;
            PG8_STAGE(PG8_SB(0, 1), b2 + hstep, voffB);
            PG8_WAIT_V(6); PG8_BAR; PG8_MMA(1, 1, At, B1); PG8_BAR;
            PG8_LDB(B0, 1, 0); PG8_SCHED; PG8_LDA(At, 1, 0); PG8_STAGE(PG8_SA(0, 1), a2 + hstep, voffA);
            PG8_WAIT_L(8); PG8_BAR; PG8_WAIT_L(0); PG8_MMA(0, 0, At, B0); PG8_BAR; PG8_SCHED;
            PG8_LDB(B1, 1, 1); PG8_STAGE(PG8_SB(1, 0), b3, voffB);
            PG8_BAR; PG8_WAIT_L(0); PG8_MMA(0, 1, At, B1); PG8_BAR;
            PG8_LDA(At, 1, 1); PG8_STAGE(PG8_SA(1, 0), a3, voffA);
            PG8_BAR; PG8_WAIT_L(0); PG8_MMA(1, 0, At, B0); PG8_BAR; PG8_SCHED;
            PG8_STAGE(PG8_SB(1, 1), b3 + hstep, voffB);
            PG8_WAIT_V(6); PG8_BAR; PG8_MMA(1, 1, At, B1); PG8_BAR;
            }
        }
        if constexpr (ALIGN_EPI) { if (wr == 0) PG8_BAR; }
        if constexpr (!Epi::AFTER_DRAIN) { E(acc, cur, wr, wc, fr, fq); S.done(cur); }
        if (!has_next) break;
#pragma unroll
        for (int a = 0; a < 2; ++a)
#pragma unroll
            for (int b = 0; b < 2; ++b)
#pragma unroll
                for (int m = 0; m < 4; ++m)
#pragma unroll
                    for (int n = 0; n < 2; ++n) acc[a][b][m][n] = (f32x4){0.f, 0.f, 0.f, 0.f};
        cur = nxt; cA = nA; cB = nB; ++ui;
        if constexpr (ALIGN_EPI) { if (wr == 1) PG8_BAR; }
    }
    PG8_WAIT_V(0);
    if constexpr (!ALIGN_EPI) { if (wr == 0) PG8_BAR; }
    PG8_BAR;
    if constexpr (Epi::AFTER_DRAIN) { E.fused(acc, cur, wr, wc, fr, fq, lds, wid, lane); S.done(cur); }
#undef PG8_SA
#undef PG8_SB
#undef PG8_STAGE
#undef PG8_LDA
#undef PG8_LDB
#undef PG8_MMA
#undef PG8_WAIT_V
#undef PG8_WAIT_L
#undef PG8_BAR
#undef PG8_SCHED
}
}
constexpr int BATCH = 4, SEQ = 4096, DM = 1024, NCH = 64, CH = 64, MTOK = BATCH * SEQ, DEPTH = 2;
constexpr int NPROJ = 3072, IN_COLS = 3088, FF = 2816;
constexpr float EPS = 1e-6f;
constexpr size_t MiB = 1u << 20;
constexpr size_t WS_SMALL = 1 * MiB, WS_ACS = 2 * MiB, WS_CDEC = 2 * MiB + 512 * 1024, WS_EGL = 2 * MiB + 768 * 1024;
constexpr size_t WS_WIN = 3 * MiB, WS_WOUT = 9 * MiB, WS_WGU = 11 * MiB, WS_WDN = 22 * MiB;
constexpr size_t WS_XN = 28 * MiB;
constexpr size_t WS_GU = 28 * MiB, WS_GW = 36 * MiB, WS_GQE = 44 * MiB, WS_GQK = 52 * MiB, WS_GKDT = 244 * MiB;
constexpr size_t WS_PROJ = 60 * MiB, WS_H = 60 * MiB;
constexpr size_t WS_MIX = 156 * MiB;
constexpr size_t WS_STATES = 188 * MiB, WS_YPART = 220 * MiB, WS_CCONV = 236 * MiB, WS_TMP = 188 * MiB;
constexpr size_t WS_END = 252 * MiB;
constexpr int LDS_BYTES = 147456;

#define LAS __attribute__((address_space(3)))
#define DEV __device__ __forceinline__
typedef unsigned short bf16;
typedef short bf16x8 __attribute__((ext_vector_type(8)));
typedef float f32x4 __attribute__((ext_vector_type(4)));
typedef unsigned u32x4 __attribute__((ext_vector_type(4)));
typedef unsigned u32x2 __attribute__((ext_vector_type(2)));

DEV unsigned f2bf(float f) { unsigned u = __builtin_bit_cast(unsigned, f); return (u + 0x7fffu + ((u >> 16) & 1u)) >> 16; }
DEV unsigned pk2(float lo, float hi) { return f2bf(lo) | (f2bf(hi) << 16); }
DEV float bf2f(unsigned b) { return __builtin_bit_cast(float, b << 16); }
DEV float bflo(unsigned w) { return __builtin_bit_cast(float, w << 16); }
DEV float bfhi(unsigned w) { return __builtin_bit_cast(float, w & 0xffff0000u); }
DEV float silu(float x) { return x / (1.0f + __expf(-x)); }
DEV float softplus(float x) { return fmaxf(x, 0.f) + log1pf(expf(-fabsf(x))); }
DEV float wave_sum(float v) {
#pragma unroll
    for (int o = 1; o < 64; o <<= 1) v += __shfl_xor(v, o);
    return v;
}
DEV float wave_incl_scan(float v, int lane) {
#pragma unroll
    for (int o = 1; o < 64; o <<= 1) { const float t = __shfl_up(v, o); if (lane >= o) v += t; }
    return v;
}
DEV f32x4 mma_tile(const LAS bf16* A, int lda, const LAS bf16* B, int ldb, int K, int lane, f32x4 acc) {
    const LAS bf16* ap = A + (lane & 15) * lda + (lane >> 4) * 8;
    const LAS bf16* bp = B + (lane & 15) * ldb + (lane >> 4) * 8;
    for (int k = 0; k < K; k += 32) {
        const bf16x8 a = *(const LAS bf16x8*)(ap + k), b = *(const LAS bf16x8*)(bp + k);
        acc = __builtin_amdgcn_mfma_f32_16x16x32_bf16(a, b, acc, 0, 0, 0);
    }
    return acc;
}

struct Params {
    const float *x, *pre_mix, *post_mix, *pre_ffn, *post_ffn, *w_in, *w_out, *sinks, *sconv_w, *sconv_b, *sdt_bias, *sA_log, *sD, *snorm_w,
                *gconv_w, *gdt_bias, *gA_log, *gnorm_w, *w_gate, *w_up, *w_down;
    float* out; unsigned char* ws;
};

DEV void tr_item(const float* W, int ldw, int col0, bf16* WT, int K, int drow0, int rs, LAS float* scr, int kb, int nb, int lane) {
    const int k0 = 64 * kb, n0 = 32 * nb;
#pragma unroll 8
    for (int i = 0; i < 32; ++i) { const int kk = 2 * i + (lane >> 5); scr[kk * 33 + (lane & 31)] = W[(size_t)(k0 + kk) * ldw + col0 + n0 + (lane & 31)]; }
    asm volatile("s_waitcnt lgkmcnt(0)" ::: "memory");
    const int c = lane & 7;
#pragma unroll
    for (int j = 0; j < 4; ++j) { const int n = (lane >> 3) + 8 * j; const LAS float* s = scr + (8 * c) * 33 + n;
        u32x4 o; o.x = pk2(s[0 * 33], s[1 * 33]); o.y = pk2(s[2 * 33], s[3 * 33]); o.z = pk2(s[4 * 33], s[5 * 33]); o.w = pk2(s[6 * 33], s[7 * 33]);
        *(u32x4*)(WT + (size_t)(drow0 + (n0 + n) * rs) * K + k0 + 8 * c) = o; }
    asm volatile("s_waitcnt lgkmcnt(0)" ::: "memory");
}
DEV void convert_weights(const Params& p, int l, LAS unsigned char* lds, int gw, int NGW, int wave, int lane) {
    LAS float* scr = (LAS float*)(lds + wave * 8448);
    const float* win = p.w_in + (size_t)l * DM * IN_COLS; const float* wout = p.w_out + (size_t)l * DM * DM;
    const float* wg = p.w_gate + (size_t)l * DM * FF; const float* wu = p.w_up + (size_t)l * DM * FF; const float* wd = p.w_down + (size_t)l * FF * DM;
    bf16* WIN = (bf16*)(p.ws + WS_WIN); bf16* WOUT = (bf16*)(p.ws + WS_WOUT); bf16* WGU = (bf16*)(p.ws + WS_WGU); bf16* WDN = (bf16*)(p.ws + WS_WDN);
    constexpr int I_IN = 16 * 96, I_OUT = 16 * 32, I_G = 16 * 88, I_D = 44 * 32;
    constexpr int NIT = I_IN + I_OUT + 2 * I_G + I_D;
    for (int it = gw; it < NIT; it += NGW) {
        int r = it;
        if (r < I_IN) { const int kb = r / 96, nb = r % 96;
            if (nb < 64) tr_item(win, IN_COLS, 0, WIN, DM, 0, 1, scr, kb, nb, lane); else tr_item(win, IN_COLS, 2056, WIN, DM, 2048, 1, scr, kb, nb - 64, lane);
            continue; } r -= I_IN;
        if (r < I_OUT) { tr_item(wout, DM, 0, WOUT, DM, 0, 1, scr, r / 32, r % 32, lane); continue; } r -= I_OUT;
        if (r < I_G) { tr_item(wg, FF, 0, WGU, DM, 0, 2, scr, r / 88, r % 88, lane); continue; } r -= I_G;
        if (r < I_G) { tr_item(wu, FF, 0, WGU, DM, 1, 2, scr, r / 88, r % 88, lane); continue; } r -= I_G;
        tr_item(wd, DM, 0, WDN, FF, 0, 1, scr, r / 32, r % 32, lane);
    }
}
DEV void stage_small(const Params& p, int l, LAS float* wsT, int tid) {
    const float* win = p.w_in + (size_t)l * DM * IN_COLS;
    for (int idx = tid; idx < 16 * DM; idx += 512) { const int k = idx >> 4, c = idx & 15; const int sc = c < 8 ? 2048 + c : 3072 + c; wsT[c * DM + k] = win[(size_t)k * IN_COLS + sc]; }
}
template <int MODE>
DEV void rowpass(const float* res, const float* tmp, const float* wpost, const float* wnext, float* xout, bf16* XN, float* SMALL, const LAS float* wsT, int gw, int NGW, int lane) {
    f32x4 wp[4], wn[4];
#pragma unroll
    for (int j = 0; j < 4; ++j) {
        if (MODE != 0) wp[j] = *((const f32x4*)wpost + lane + 64 * j);
        if (MODE != 3) wn[j] = *((const f32x4*)wnext + lane + 64 * j);
    }
    for (int m = gw; m < MTOK; m += NGW) {
        f32x4 v[4];
#pragma unroll
        for (int j = 0; j < 4; ++j) v[j] = *((const f32x4*)(res + (size_t)m * DM) + lane + 64 * j);
        if (MODE != 0) {
            f32x4 t[4]; float ss = 0.f;
#pragma unroll
            for (int j = 0; j < 4; ++j) { t[j] = *((const f32x4*)(tmp + (size_t)m * DM) + lane + 64 * j); ss += (t[j].x * t[j].x + t[j].y * t[j].y) + (t[j].z * t[j].z + t[j].w * t[j].w); }
            const float rstd = rsqrtf(wave_sum(ss) * (1.0f / DM) + EPS);
#pragma unroll
            for (int j = 0; j < 4; ++j) { v[j] = v[j] + t[j] * rstd * wp[j]; *((f32x4*)(xout + (size_t)m * DM) + lane + 64 * j) = v[j]; }
        }
        if (MODE != 3) {
            float ss = 0.f;
#pragma unroll
            for (int j = 0; j < 4; ++j) ss += (v[j].x * v[j].x + v[j].y * v[j].y) + (v[j].z * v[j].z + v[j].w * v[j].w);
            const float rstd = rsqrtf(wave_sum(ss) * (1.0f / DM) + EPS);
#pragma unroll
            for (int j = 0; j < 4; ++j) { v[j] = v[j] * rstd * wn[j];
                u32x2 o; o.x = pk2(v[j].x, v[j].y); o.y = pk2(v[j].z, v[j].w); *((u32x2*)(XN + (size_t)m * DM) + lane + 64 * j) = o; }
            if (MODE == 0 || MODE == 2) {
                float part[16];
#pragma unroll
                for (int c = 0; c < 16; ++c) { float s = 0.f; asm volatile("" ::: "memory");
#pragma unroll
                    for (int j = 0; j < 4; ++j) { const f32x4 w = *((const LAS f32x4*)(wsT + c * DM) + lane + 64 * j); s += (v[j].x * w.x + v[j].y * w.y) + (v[j].z * w.z + v[j].w * w.w); }
                    part[c] = wave_sum(s); }
                float mine = 0.f;
#pragma unroll
                for (int c = 0; c < 16; ++c) mine = (lane == c) ? part[c] : mine;
                if (lane < 16) SMALL[(size_t)m * 16 + lane] = mine;
            }
        }
    }
}

DEV void attn_unit(const Params& p, int l, int u, LAS unsigned char* lds, int tid) {
    const int b = u >> 7, c = (u >> 1) & 63, kvh = u & 1, wave = tid >> 6, lane = tid & 63;
    const bf16* PROJ = (const bf16*)(p.ws + WS_PROJ); bf16* MIX = (bf16*)(p.ws + WS_MIX);
    LAS bf16* Qs = (LAS bf16*)lds;
    LAS bf16* Ks = Qs + 128 * 72;
    LAS bf16* Vt = Ks + 192 * 72;
    LAS bf16* Ps = Vt + 64 * 200;
    const size_t t0 = (size_t)b * SEQ + (size_t)c * CH;
    for (int idx = tid; idx < 1024; idx += 512) { const int r = idx >> 3, v = idx & 7, g = r >> 6, i = r & 63;
        *(LAS u32x4*)(Qs + r * 72 + v * 8) = *(const u32x4*)(PROJ + (t0 + i) * NPROJ + kvh * 128 + g * 64 + v * 8); }
    for (int idx = tid; idx < 1536; idx += 512) { const int j = idx >> 3, v = idx & 7; const bool valid = (c - 2 + (j >> 6)) >= 0;
        u32x4 kv = (u32x4){0u, 0u, 0u, 0u}, vv = kv;
        if (valid) { const bf16* rowp = PROJ + (size_t)((long)t0 - 128 + j) * NPROJ; kv = *(const u32x4*)(rowp + 256 + kvh * 64 + v * 8); vv = *(const u32x4*)(rowp + 384 + kvh * 64 + v * 8); }
        *(LAS u32x4*)(Ks + j * 72 + v * 8) = kv;
        LAS bf16* vt = Vt + (v * 8) * 200 + j;
        vt[0 * 200] = (bf16)(vv.x & 0xffffu); vt[1 * 200] = (bf16)(vv.x >> 16); vt[2 * 200] = (bf16)(vv.y & 0xffffu); vt[3 * 200] = (bf16)(vv.y >> 16);
        vt[4 * 200] = (bf16)(vv.z & 0xffffu); vt[5 * 200] = (bf16)(vv.z >> 16); vt[6 * 200] = (bf16)(vv.w & 0xffffu); vt[7 * 200] = (bf16)(vv.w >> 16); }
    __syncthreads();
    {
        const int g = wave >> 2, h = kvh * 2 + g;
        const float slope = exp2f(-2.0f * (float)(h + 1)), sink = p.sinks[l * 4 + h];
        f32x4 s[12];
#pragma unroll
        for (int nt = 0; nt < 12; ++nt) s[nt] = mma_tile(Qs + wave * 16 * 72, 72, Ks + nt * 16 * 72, 72, 64, lane, (f32x4){0.f, 0.f, 0.f, 0.f});
#pragma unroll
        for (int j = 0; j < 4; ++j) {
            const int r = wave * 16 + (lane >> 4) * 4 + j, i = r & 63;
            float mx = sink;
#pragma unroll
            for (int nt = 0; nt < 12; ++nt) { const int jj = nt * 16 + (lane & 15);
                float val = s[nt][j] * 0.125f - slope * fabsf((float)(i + 128 - jj));
                if (c - 2 + (nt >> 2) < 0) val = -INFINITY;
                s[nt][j] = val; mx = fmaxf(mx, val); }
            mx = fmaxf(mx, __shfl_xor(mx, 1)); mx = fmaxf(mx, __shfl_xor(mx, 2)); mx = fmaxf(mx, __shfl_xor(mx, 4)); mx = fmaxf(mx, __shfl_xor(mx, 8));
            float sum = 0.f;
#pragma unroll
            for (int nt = 0; nt < 12; ++nt) { const float e = __expf(s[nt][j] - mx); s[nt][j] = e; sum += e; }
            sum += __shfl_xor(sum, 1); sum += __shfl_xor(sum, 2); sum += __shfl_xor(sum, 4); sum += __shfl_xor(sum, 8);
            sum += __expf(sink - mx);
            const float inv = 1.0f / sum;
#pragma unroll
            for (int nt = 0; nt < 12; ++nt) Ps[r * 200 + nt * 16 + (lane & 15)] = (bf16)f2bf(s[nt][j] * inv);
        }
    }
    __syncthreads();
#pragma unroll
    for (int nt = 0; nt < 4; ++nt) {
        const f32x4 acc = mma_tile(Vt + nt * 16 * 200, 200, Ps + wave * 16 * 200, 200, 192, lane, (f32x4){0.f, 0.f, 0.f, 0.f});
        const int r = wave * 16 + (lane & 15), g = r >> 6, i = r & 63, d0 = nt * 16 + (lane >> 4) * 4;
        u32x2 o; o.x = pk2(acc[0], acc[1]); o.y = pk2(acc[2], acc[3]);
        *(u32x2*)(MIX + (t0 + i) * DM + (kvh * 2 + g) * 64 + d0) = o;
    }
    __syncthreads();
}

DEV void load_raw(const bf16* PROJ, size_t t0, int c, int col0, int ncols, LAS bf16* Raw, int rawld, int dcol0, int tid) {
    const int vpr = ncols >> 3;
    for (int idx = tid; idx < 67 * vpr; idx += 512) { const int r = idx / vpr, v = idx % vpr;
        u32x4 val = (u32x4){0u, 0u, 0u, 0u};
        if (c > 0 || r >= 3) val = *(const u32x4*)(PROJ + (size_t)((long)t0 - 3 + r) * NPROJ + col0 + v * 8);
        *(LAS u32x4*)(Raw + r * rawld + dcol0 + v * 8) = val; }
}
DEV void ssd_p1_unit(const Params& p, int l, int u, LAS unsigned char* lds, int tid) {
    const int b = u >> 7, c = (u >> 1) & 63, g = u & 1, wave = tid >> 6, lane = tid & 63;
    const bf16* PROJ = (const bf16*)(p.ws + WS_PROJ);
    const float* SMALL = (const float*)(p.ws + WS_SMALL);
    float* ACS = (float*)(p.ws + WS_ACS); float* CDEC = (float*)(p.ws + WS_CDEC);
    bf16* STATES = (bf16*)(p.ws + WS_STATES); bf16* YPART = (bf16*)(p.ws + WS_YPART); bf16* CCONV = (bf16*)(p.ws + WS_CCONV);
    LAS bf16* XsT = (LAS bf16*)lds;
    LAS bf16* Bm = XsT + 4 * 64 * 72;
    LAS bf16* Cm = Bm + 64 * 136;
    LAS bf16* BmT = Cm + 64 * 136;
    LAS bf16* Sc = BmT + 128 * 72;
    LAS bf16* Raw = Sc;
    LAS float* dtS = (LAS float*)(Sc + 4 * 64 * 72);
    LAS float* acsS = dtS + 256;
    LAS float* fS = acsS + 256;
    const size_t t0 = (size_t)b * SEQ + (size_t)c * CH;
    if (tid < 256) {
        const int h = tid >> 6, hh = g * 4 + h;
        const float dt = softplus(SMALL[(t0 + lane) * 16 + hh] + p.sdt_bias[l * 8 + hh]);
        const float a = -expf(p.sA_log[l * 8 + hh]);
        const float acs = wave_incl_scan(dt * a, lane);
        const float alast = __shfl(acs, 63);
        dtS[tid] = dt; acsS[tid] = acs; fS[tid] = dt * expf(alast - acs);
        ACS[(t0 + lane) * 8 + hh] = acs;
        if (lane == 63) CDEC[((size_t)b * NCH + c) * 8 + hh] = expf(acs);
    }
    load_raw(PROJ, t0, c, 1024 + g * 256, 256, Raw, 256, 0, tid);
    __syncthreads();
    {
        const int ch = tid & 255, half = tid >> 8, chg = g * 256 + ch, h = ch >> 6, pp = ch & 63;
        const float* cw = p.sconv_w + (size_t)l * 4096 + chg; const float w0 = cw[0], w1 = cw[1024], w2 = cw[2048], w3 = cw[3072], bias = p.sconv_b[l * 1024 + chg];
        const int r0 = half * 32;
        float x0 = bf2f(Raw[(r0 + 0) * 256 + ch]), x1 = bf2f(Raw[(r0 + 1) * 256 + ch]), x2 = bf2f(Raw[(r0 + 2) * 256 + ch]);
        LAS bf16* dst = XsT + h * 64 * 72 + pp * 72 + r0;
        for (int r = 0; r < 32; ++r) { const float x3 = bf2f(Raw[(r0 + r + 3) * 256 + ch]);
            const float y = silu(w0 * x0 + w1 * x1 + w2 * x2 + w3 * x3 + bias);
            dst[r] = (bf16)f2bf(y); x0 = x1; x1 = x2; x2 = x3; }
    }
    __syncthreads();
    load_raw(PROJ, t0, c, 1024 + 512 + g * 128, 128, Raw, 256, 0, tid);
    load_raw(PROJ, t0, c, 1024 + 768 + g * 128, 128, Raw, 256, 128, tid);
    __syncthreads();
    {
        const int ch = tid & 255, half = tid >> 8, isC = ch >> 7, n = ch & 127, chg = 512 + isC * 256 + g * 128 + n;
        const float* cw = p.sconv_w + (size_t)l * 4096 + chg; const float w0 = cw[0], w1 = cw[1024], w2 = cw[2048], w3 = cw[3072], bias = p.sconv_b[l * 1024 + chg];
        const int r0 = half * 32;
        float x0 = bf2f(Raw[(r0 + 0) * 256 + ch]), x1 = bf2f(Raw[(r0 + 1) * 256 + ch]), x2 = bf2f(Raw[(r0 + 2) * 256 + ch]);
        for (int r = 0; r < 32; ++r) { const float x3 = bf2f(Raw[(r0 + r + 3) * 256 + ch]);
            const bf16 y = (bf16)f2bf(silu(w0 * x0 + w1 * x1 + w2 * x2 + w3 * x3 + bias));
            if (isC) Cm[(r0 + r) * 136 + n] = y; else { Bm[(r0 + r) * 136 + n] = y; BmT[n * 72 + r0 + r] = y; }
            x0 = x1; x1 = x2; x2 = x3; }
    }
    __syncthreads();
    for (int idx = tid; idx < 1024; idx += 512) { const int r = idx >> 4, v = idx & 15; *(u32x4*)(CCONV + (t0 + r) * 256 + g * 128 + v * 8) = *(const LAS u32x4*)(Cm + r * 136 + v * 8); }
#pragma unroll
    for (int ti = 0; ti < 2; ++ti) {
        const int tt = wave * 2 + ti, mt = tt >> 2, nt = tt & 3;
        f32x4 acc = (f32x4){0.f, 0.f, 0.f, 0.f};
        if (nt <= mt) acc = mma_tile(Cm + mt * 16 * 136, 136, Bm + nt * 16 * 136, 136, 128, lane, acc);
        const int s = nt * 16 + (lane & 15);
#pragma unroll
        for (int h = 0; h < 4; ++h) { const float as = acsS[h * 64 + s], ds = dtS[h * 64 + s];
#pragma unroll
            for (int j = 0; j < 4; ++j) { const int lr = mt * 16 + (lane >> 4) * 4 + j;
                const float val = (s <= lr) ? acc[j] * expf(acsS[h * 64 + lr] - as) * ds : 0.f;
                Sc[h * 64 * 72 + lr * 72 + s] = (bf16)f2bf(val); } }
    }
    __syncthreads();
    {
        const int h = wave >> 1, hh = g * 4 + h; const float Dh = p.sD[l * 8 + hh];
        for (int ti = 0; ti < 8; ++ti) { const int tt = (wave & 1) * 8 + ti, mt = tt >> 2, nt = tt & 3;
            const f32x4 acc = mma_tile(Sc + h * 64 * 72 + mt * 16 * 72, 72, XsT + h * 64 * 72 + nt * 16 * 72, 72, 64, lane, (f32x4){0.f, 0.f, 0.f, 0.f});
            const int pp = nt * 16 + (lane & 15), lr0 = mt * 16 + (lane >> 4) * 4;
            const u32x2 xw = *(const LAS u32x2*)(XsT + h * 64 * 72 + pp * 72 + lr0);
            const float xs[4] = {bflo(xw.x), bfhi(xw.x), bflo(xw.y), bfhi(xw.y)};
#pragma unroll
            for (int j = 0; j < 4; ++j) YPART[(t0 + lr0 + j) * 512 + hh * 64 + pp] = (bf16)f2bf(acc[j] + Dh * xs[j]); }
#pragma unroll
        for (int pi = 0; pi < 2; ++pi) { const int pt = (wave & 1) * 2 + pi;
            bf16x8 xf[2];
#pragma unroll
            for (int k = 0; k < 2; ++k) { const int l0 = k * 32 + (lane >> 4) * 8;
                const u32x4 xw = *(const LAS u32x4*)(XsT + h * 64 * 72 + (pt * 16 + (lane & 15)) * 72 + l0);
                const f32x4 f0 = *(const LAS f32x4*)(fS + h * 64 + l0), f1 = *(const LAS f32x4*)(fS + h * 64 + l0 + 4);
                u32x4 o; o.x = pk2(bflo(xw.x) * f0.x, bfhi(xw.x) * f0.y); o.y = pk2(bflo(xw.y) * f0.z, bfhi(xw.y) * f0.w);
                o.z = pk2(bflo(xw.z) * f1.x, bfhi(xw.z) * f1.y); o.w = pk2(bflo(xw.w) * f1.z, bfhi(xw.w) * f1.w);
                xf[k] = __builtin_bit_cast(bf16x8, o); }
            for (int nt = 0; nt < 8; ++nt) {
                f32x4 acc = (f32x4){0.f, 0.f, 0.f, 0.f};
#pragma unroll
                for (int k = 0; k < 2; ++k) { const bf16x8 bfr = *(const LAS bf16x8*)(BmT + (nt * 16 + (lane & 15)) * 72 + k * 32 + (lane >> 4) * 8);
                    acc = __builtin_amdgcn_mfma_f32_16x16x32_bf16(bfr, xf[k], acc, 0, 0, 0); }
                u32x2 o; o.x = pk2(acc[0], acc[1]); o.y = pk2(acc[2], acc[3]);
                *(u32x2*)(STATES + ((((size_t)b * NCH + c) * 8 + hh) * 64 + pt * 16 + (lane & 15)) * 128 + nt * 16 + (lane >> 4) * 4) = o; } }
    }
    __syncthreads();
}
DEV void ssd_scan_unit(const Params& p, int u, int tid) {
    bf16* STATES = (bf16*)(p.ws + WS_STATES); const float* CDEC = (const float*)(p.ws + WS_CDEC);
    const int idx = u * 512 + tid, b = idx >> 14, rem = idx & 16383, hh = rem >> 11, pn = rem & 2047;
    bf16* base = STATES + ((size_t)b * NCH * 8 + hh) * 8192 + (size_t)pn * 4;
    const float* dec = CDEC + (size_t)b * NCH * 8 + hh;
    float s0 = 0.f, s1 = 0.f, s2 = 0.f, s3 = 0.f;
    for (int c0 = 0; c0 < NCH; c0 += 8) {
        u32x2 nw[8]; float d[8];
#pragma unroll
        for (int k = 0; k < 8; ++k) { nw[k] = *(const u32x2*)(base + (size_t)(c0 + k) * 8 * 8192); d[k] = dec[(c0 + k) * 8]; }
#pragma unroll
        for (int k = 0; k < 8; ++k) { u32x2 o; o.x = pk2(s0, s1); o.y = pk2(s2, s3); *(u32x2*)(base + (size_t)(c0 + k) * 8 * 8192) = o;
            s0 = s0 * d[k] + bflo(nw[k].x); s1 = s1 * d[k] + bfhi(nw[k].x); s2 = s2 * d[k] + bflo(nw[k].y); s3 = s3 * d[k] + bfhi(nw[k].y); }
    }
}
DEV void ssd_p3_unit(const Params& p, int l, int u, LAS unsigned char* lds, int tid) {
    const int b = u >> 7, c = (u >> 1) & 63, g = u & 1, wave = tid >> 6, lane = tid & 63;
    const bf16* PROJ = (const bf16*)(p.ws + WS_PROJ); const float* ACS = (const float*)(p.ws + WS_ACS);
    const bf16* STATES = (const bf16*)(p.ws + WS_STATES); const bf16* YPART = (const bf16*)(p.ws + WS_YPART); const bf16* CCONV = (const bf16*)(p.ws + WS_CCONV);
    bf16* MIX = (bf16*)(p.ws + WS_MIX);
    LAS bf16* Cm = (LAS bf16*)lds;
    LAS bf16* Prev = Cm + 64 * 136;
    LAS float* Gb = (LAS float*)Prev;
    LAS float* acsS = (LAS float*)(Prev + 4 * 64 * 136);
    const size_t t0 = (size_t)b * SEQ + (size_t)c * CH;
    for (int idx = tid; idx < 1024; idx += 512) { const int r = idx >> 4, v = idx & 15; *(LAS u32x4*)(Cm + r * 136 + v * 8) = *(const u32x4*)(CCONV + (t0 + r) * 256 + g * 128 + v * 8); }
    for (int idx = tid; idx < 4096; idx += 512) { const int h = idx >> 10, r = (idx >> 4) & 63, v = idx & 15;
        *(LAS u32x4*)(Prev + h * 64 * 136 + r * 136 + v * 8) = *(const u32x4*)(STATES + ((((size_t)b * NCH + c) * 8 + g * 4 + h) * 64 + r) * 128 + v * 8); }
    if (tid < 256) acsS[tid] = ACS[(t0 + (tid & 63)) * 8 + g * 4 + (tid >> 6)];
    __syncthreads();
    const int h = wave >> 1, hh = g * 4 + h;
    f32x4 acc[8];
#pragma unroll
    for (int ti = 0; ti < 8; ++ti) { const int tt = (wave & 1) * 8 + ti, mt = tt >> 2, nt = tt & 3;
        acc[ti] = mma_tile(Cm + mt * 16 * 136, 136, Prev + h * 64 * 136 + nt * 16 * 136, 136, 128, lane, (f32x4){0.f, 0.f, 0.f, 0.f}); }
    __syncthreads();
#pragma unroll
    for (int ti = 0; ti < 8; ++ti) { const int tt = (wave & 1) * 8 + ti, mt = tt >> 2, nt = tt & 3, pp = nt * 16 + (lane & 15);
#pragma unroll
        for (int j = 0; j < 4; ++j) { const int lr = mt * 16 + (lane >> 4) * 4 + j;
            const float y = bf2f(YPART[(t0 + lr) * 512 + hh * 64 + pp]) + expf(acsS[h * 64 + lr]) * acc[ti][j];
            const float z = bf2f(PROJ[(t0 + lr) * NPROJ + 512 + hh * 64 + pp]);
            Gb[lr * 260 + h * 64 + pp] = y * silu(z); } }
    __syncthreads();
    {
        const int lr = tid >> 3, part = tid & 7;
        float v[32]; float ss = 0.f;
#pragma unroll
        for (int k = 0; k < 8; ++k) { const f32x4 q = *(const LAS f32x4*)(Gb + lr * 260 + part * 32 + k * 4); v[4 * k] = q.x; v[4 * k + 1] = q.y; v[4 * k + 2] = q.z; v[4 * k + 3] = q.w;
            ss += (q.x * q.x + q.y * q.y) + (q.z * q.z + q.w * q.w); }
        ss += __shfl_xor(ss, 1); ss += __shfl_xor(ss, 2); ss += __shfl_xor(ss, 4);
        const float rstd = rsqrtf(ss * (1.0f / 256.0f) + EPS);
        const float* nw = p.snorm_w + (size_t)l * 512 + g * 256 + part * 32;
        bf16* dst = MIX + (t0 + lr) * DM + 256 + g * 256 + part * 32;
#pragma unroll
        for (int k = 0; k < 4; ++k) { u32x4 o;
            o.x = pk2(v[8 * k] * rstd * nw[8 * k], v[8 * k + 1] * rstd * nw[8 * k + 1]); o.y = pk2(v[8 * k + 2] * rstd * nw[8 * k + 2], v[8 * k + 3] * rstd * nw[8 * k + 3]);
            o.z = pk2(v[8 * k + 4] * rstd * nw[8 * k + 4], v[8 * k + 5] * rstd * nw[8 * k + 5]); o.w = pk2(v[8 * k + 6] * rstd * nw[8 * k + 6], v[8 * k + 7] * rstd * nw[8 * k + 7]);
            *(u32x4*)(dst + 8 * k) = o; }
    }
    __syncthreads();
}

DEV void gdn_pre_unit(const Params& p, int l, int u, LAS unsigned char* lds, int tid) {
    const int b = u >> 8, c = (u >> 2) & 63, hg = u & 3, wave = tid >> 6, lane = tid & 63;
    const int ub = (b * 4 + hg) * 64 + c;
    const bf16* PROJ = (const bf16*)(p.ws + WS_PROJ); const float* SMALL = (const float*)(p.ws + WS_SMALL);
    bf16* GU = (bf16*)(p.ws + WS_GU) + (size_t)ub * 4096; bf16* GW = (bf16*)(p.ws + WS_GW) + (size_t)ub * 4096; bf16* GQE = (bf16*)(p.ws + WS_GQE) + (size_t)ub * 4096;
    bf16* GQK = (bf16*)(p.ws + WS_GQK) + (size_t)ub * 4096; bf16* GKDT = (bf16*)(p.ws + WS_GKDT) + (size_t)ub * 4096; float* EGL = (float*)(p.ws + WS_EGL);
    LAS bf16* Raw = (LAS bf16*)lds;
    LAS float* Qs = (LAS float*)(lds + 25728);
    LAS float* Ks = Qs + 64 * 65;
    LAS float* Vs = Ks + 64 * 65;
    LAS float* Am = Vs + 64 * 65;
    LAS float* betaS = Am + 64 * 64;
    LAS float* gcS = betaS + 64;
    LAS float* Xs = gcS + 64;
    const size_t t0 = (size_t)b * SEQ + (size_t)c * CH;
    if (wave == 0) {
        const float beta = 1.0f / (1.0f + expf(-SMALL[(t0 + lane) * 16 + 8 + hg]));
        const float gg = -expf(p.gA_log[l * 4 + hg]) * softplus(SMALL[(t0 + lane) * 16 + 12 + hg] + p.gdt_bias[l * 4 + hg]);
        const float gc = wave_incl_scan(gg, lane);
        betaS[lane] = beta; gcS[lane] = gc;
        if (lane == 63) EGL[ub] = expf(gc);
    }
    load_raw(PROJ, t0, c, 2048 + hg * 64, 64, Raw, 192, 0, tid);
    load_raw(PROJ, t0, c, 2048 + 256 + hg * 64, 64, Raw, 192, 64, tid);
    load_raw(PROJ, t0, c, 2048 + 512 + hg * 64, 64, Raw, 192, 128, tid);
    __syncthreads();
#pragma unroll
    for (int seg = 0; seg < 3; ++seg) {
        const float* cw = p.gconv_w + (size_t)l * 3072 + seg * 256 + hg * 64 + lane; const float w0 = cw[0], w1 = cw[768], w2 = cw[1536], w3 = cw[2304];
        LAS float* dst = seg == 0 ? Qs : (seg == 1 ? Ks : Vs);
        const int r0 = wave * 8;
        float x0 = bf2f(Raw[(r0 + 0) * 192 + seg * 64 + lane]), x1 = bf2f(Raw[(r0 + 1) * 192 + seg * 64 + lane]), x2 = bf2f(Raw[(r0 + 2) * 192 + seg * 64 + lane]);
#pragma unroll
        for (int r = 0; r < 8; ++r) { const float x3 = bf2f(Raw[(r0 + r + 3) * 192 + seg * 64 + lane]);
            float y = silu(w0 * x0 + w1 * x1 + w2 * x2 + w3 * x3);
            if (seg < 2) { const float ss = wave_sum(y * y); y *= rsqrtf(ss + EPS); if (seg == 0) y *= 0.125f; }
            dst[(r0 + r) * 65 + lane] = y; x0 = x1; x1 = x2; x2 = x3; }
    }
    __syncthreads();
    {
        const int i = tid >> 3, j0 = (tid & 7) * 8;
        float kk[8], qk[8];
#pragma unroll
        for (int jj = 0; jj < 8; ++jj) { kk[jj] = 0.f; qk[jj] = 0.f; }
        if (j0 <= i) {
            for (int d = 0; d < 64; ++d) { const float ki = Ks[i * 65 + d], qi = Qs[i * 65 + d];
#pragma unroll
                for (int jj = 0; jj < 8; ++jj) { const float kj = Ks[(j0 + jj) * 65 + d]; kk[jj] += ki * kj; qk[jj] += qi * kj; } }
        }
        const float gi = gcS[i], bi = betaS[i];
        float qv[8];
#pragma unroll
        for (int jj = 0; jj < 8; ++jj) { const int j = j0 + jj; const float dec = (j <= i) ? expf(gi - gcS[j]) : 0.f;
            Am[i * 64 + j] = (j < i) ? bi * kk[jj] * dec : 0.f; qv[jj] = (j <= i) ? qk[jj] * dec : 0.f; }
        u32x4 o; o.x = pk2(qv[0], qv[1]); o.y = pk2(qv[2], qv[3]); o.z = pk2(qv[4], qv[5]); o.w = pk2(qv[6], qv[7]);
        *(u32x4*)(GQK + i * 64 + j0) = o;
    }
    __syncthreads();
    if (tid < 128) {
        const int col = tid & 63; const bool isw = tid >= 64;
        LAS float* X = Xs + tid;
        bf16* dst = (isw ? GW : GU) + col;
        for (int i = 0; i < 64; ++i) {
            const float bi = betaS[i];
            float acc = isw ? Ks[i * 65 + col] * bi * expf(gcS[i]) : Vs[i * 65 + col] * bi;
            const LAS float* arow = Am + i * 64;
            for (int j = 0; j < i; ++j) acc -= arow[j] * X[j * 128];
            X[i * 128] = acc;
            dst[i * 64] = (bf16)f2bf(acc);
        }
    } else {
        const float glast = gcS[63];
        for (int idx = tid - 128; idx < 4096; idx += 384) { const int r = idx >> 6, d = idx & 63;
            GQE[idx] = (bf16)f2bf(Qs[r * 65 + d] * expf(gcS[r]));
            const int dd = idx >> 6, ll = idx & 63;
            GKDT[idx] = (bf16)f2bf(Ks[ll * 65 + dd] * expf(glast - gcS[ll])); }
    }
    __syncthreads();
}
DEV void gdn_scan_block(const Params& p, int bh, LAS unsigned char* lds, int tid) {
    const int b = bh >> 2, hg = bh & 3, wave = tid >> 6, lane = tid & 63;
    const size_t ub0 = (size_t)bh * 64;
    const bf16* GM[5] = {(const bf16*)(p.ws + WS_GW) + ub0 * 4096, (const bf16*)(p.ws + WS_GQE) + ub0 * 4096, (const bf16*)(p.ws + WS_GQK) + ub0 * 4096,
                         (const bf16*)(p.ws + WS_GKDT) + ub0 * 4096, (const bf16*)(p.ws + WS_GU) + ub0 * 4096};
    const float* EGL = (const float*)(p.ws + WS_EGL) + ub0;
    bf16* MIX = (bf16*)(p.ws + WS_MIX);
    LAS bf16* OPS = (LAS bf16*)lds;
    LAS bf16* St = OPS + 2 * 5 * 4608;
    LAS bf16* VnT = St + 2 * 4608;
    const int row = tid >> 3, vv = tid & 7;
    for (int idx = tid; idx < 4608; idx += 512) St[idx] = 0;
#pragma unroll
    for (int m = 0; m < 5; ++m) *(LAS u32x4*)(OPS + m * 4608 + row * 72 + vv * 8) = *(const u32x4*)(GM[m] + row * 64 + vv * 8);
    f32x4 Sacc[2] = {(f32x4){0.f, 0.f, 0.f, 0.f}, (f32x4){0.f, 0.f, 0.f, 0.f}};
    __syncthreads();
    for (int c = 0; c < NCH; ++c) {
        const LAS bf16* Wb = OPS + (c & 1) * 5 * 4608; const LAS bf16* QEb = Wb + 4608; const LAS bf16* QKb = Wb + 2 * 4608; const LAS bf16* KDTb = Wb + 3 * 4608; const LAS bf16* Ub = Wb + 4 * 4608;
        const LAS bf16* Sc = St + (c & 1) * 4608; LAS bf16* Sn = St + ((c + 1) & 1) * 4608;
        u32x4 nx[5];
        if (c + 1 < NCH) {
#pragma unroll
            for (int m = 0; m < 5; ++m) nx[m] = *(const u32x4*)(GM[m] + (size_t)(c + 1) * 4096 + row * 64 + vv * 8);
        }
        const float egl = EGL[c];
#pragma unroll
        for (int ti = 0; ti < 2; ++ti) { const int tt = wave * 2 + ti, mt = tt >> 2, nt = tt & 3;
            const f32x4 acc = mma_tile(Wb + mt * 16 * 72, 72, Sc + nt * 16 * 72, 72, 64, lane, (f32x4){0.f, 0.f, 0.f, 0.f});
            const int e = nt * 16 + (lane & 15), l0 = mt * 16 + (lane >> 4) * 4;
            float vn[4];
#pragma unroll
            for (int j = 0; j < 4; ++j) vn[j] = bf2f(Ub[(l0 + j) * 72 + e]) - acc[j];
            u32x2 o; o.x = pk2(vn[0], vn[1]); o.y = pk2(vn[2], vn[3]);
            *(LAS u32x2*)(VnT + e * 72 + l0) = o; }
        __syncthreads();
#pragma unroll
        for (int ti = 0; ti < 2; ++ti) { const int tt = wave * 2 + ti, mt = tt >> 2, nt = tt & 3;
            f32x4 acc = mma_tile(QEb + mt * 16 * 72, 72, Sc + nt * 16 * 72, 72, 64, lane, (f32x4){0.f, 0.f, 0.f, 0.f});
            acc = mma_tile(QKb + mt * 16 * 72, 72, VnT + nt * 16 * 72, 72, 64, lane, acc);
            const int e = nt * 16 + (lane & 15), l0 = mt * 16 + (lane >> 4) * 4;
            bf16* dst = MIX + ((size_t)b * SEQ + (size_t)c * CH + l0) * DM + 768 + hg * 64 + e;
#pragma unroll
            for (int j = 0; j < 4; ++j) dst[(size_t)j * DM] = (bf16)f2bf(acc[j]);
            Sacc[ti] = Sacc[ti] * egl;
            Sacc[ti] = mma_tile(KDTb + mt * 16 * 72, 72, VnT + nt * 16 * 72, 72, 64, lane, Sacc[ti]);
            u32x2 o; o.x = pk2(Sacc[ti][0], Sacc[ti][1]); o.y = pk2(Sacc[ti][2], Sacc[ti][3]);
            *(LAS u32x2*)(Sn + e * 72 + l0) = o; }
        if (c + 1 < NCH) {
            LAS bf16* nb = OPS + ((c + 1) & 1) * 5 * 4608;
#pragma unroll
            for (int m = 0; m < 5; ++m) *(LAS u32x4*)(nb + m * 4608 + row * 72 + vv * 8) = nx[m];
        }
        __syncthreads();
    }
}
DEV void gdn_post(const Params& p, int l, int gw, int NGW, int lane) {
    bf16* MIX = (bf16*)(p.ws + WS_MIX); const bf16* PROJ = (const bf16*)(p.ws + WS_PROJ);
    const f32x4 nw = *((const f32x4*)(p.gnorm_w + (size_t)l * 64) + (lane & 15));
    for (int m = gw; m < MTOK; m += NGW) {
        bf16* op = MIX + (size_t)m * DM + 768 + lane * 4;
        const u32x2 ow = *(const u32x2*)op; const u32x2 zw = *(const u32x2*)(PROJ + (size_t)m * NPROJ + 2816 + lane * 4);
        const float o0 = bflo(ow.x), o1 = bfhi(ow.x), o2 = bflo(ow.y), o3 = bfhi(ow.y);
        float ss = (o0 * o0 + o1 * o1) + (o2 * o2 + o3 * o3);
        ss += __shfl_xor(ss, 1); ss += __shfl_xor(ss, 2); ss += __shfl_xor(ss, 4); ss += __shfl_xor(ss, 8);
        const float rstd = rsqrtf(ss * (1.0f / 64.0f) + EPS);
        u32x2 r; r.x = pk2(o0 * rstd * nw.x * silu(bflo(zw.x)), o1 * rstd * nw.y * silu(bfhi(zw.x))); r.y = pk2(o2 * rstd * nw.z * silu(bflo(zw.y)), o3 * rstd * nw.w * silu(bfhi(zw.y)));
        *(u32x2*)op = r;
    }
}

__global__ void __launch_bounds__(512, 2) fwd_megakernel(Params p) {
    extern __shared__ __attribute__((aligned(16))) unsigned char lds_raw[];
    cg::grid_group grid = cg::this_grid();
    LAS unsigned char* lds = (LAS unsigned char*)lds_raw;
    const int tid = threadIdx.x, lane = tid & 63, wave = __builtin_amdgcn_readfirstlane(tid >> 6);
    const int G = gridDim.x, bx = blockIdx.x, gw = bx * 8 + wave, NGW = G * 8;
    bf16* XN = (bf16*)(p.ws + WS_XN); float* SMALL = (float*)(p.ws + WS_SMALL); float* TMP = (float*)(p.ws + WS_TMP);
    bf16* PROJ = (bf16*)(p.ws + WS_PROJ); bf16* MIX = (bf16*)(p.ws + WS_MIX); bf16* HB = (bf16*)(p.ws + WS_H);
    LAS float* wsT = (LAS float*)(lds + 69632);

#define PHASE_IDS() int tidp = threadIdx.x; int lq = l; asm volatile("" : "+v"(tidp), "+s"(lq)); const int lanep = tidp & 63; const int wavep = __builtin_amdgcn_readfirstlane(tidp >> 6); const int gwp = bx * 8 + wavep; (void)lanep; (void)gwp; (void)lq
#pragma unroll 1
    for (int l = 0; l < DEPTH; ++l) {
        {
            PHASE_IDS();
            convert_weights(p, lq, lds, gwp, NGW, wavep, lanep);
            if (lq == 0) {
                stage_small(p, 0, wsT, tidp);
                __syncthreads();
                rowpass<0>(p.x, nullptr, nullptr, p.pre_mix, nullptr, XN, SMALL, wsT, gwp, NGW, lanep);
            }
        }
        grid.sync();
        {
            pg8::Gemm g{XN, (const bf16*)(p.ws + WS_WIN), MTOK, NPROJ, DM}; pg8::StaticOrder S; S.init(MTOK, NPROJ, G, bx);
            pg8::EpiStoreBf16 E{PROJ, NPROJ};
            pg8::gemm_phase<pg8::EpiStoreBf16, pg8::StaticOrder, true, true>(lds, g, S, E);
        }
        grid.sync();
        {
            PHASE_IDS();
            for (int u = bx; u < 1536; u += G) { if (u < 1024) gdn_pre_unit(p, lq, u, lds, tidp); else ssd_p1_unit(p, lq, u - 1024, lds, tidp); }
        }
        grid.sync();
        {
            PHASE_IDS();
            if (bx < 16) gdn_scan_block(p, bx, lds, tidp);
            else { for (int u = bx - 16; u < 640; u += G - 16) { if (u < 128) ssd_scan_unit(p, u, tidp); else attn_unit(p, lq, u - 128, lds, tidp); } }
        }
        grid.sync();
        {
            PHASE_IDS();
            for (int u = bx; u < 512; u += G) ssd_p3_unit(p, lq, u, lds, tidp);
            gdn_post(p, lq, gwp, NGW, lanep);
        }
        grid.sync();
        {
            pg8::Gemm g{MIX, (const bf16*)(p.ws + WS_WOUT), MTOK, DM, DM}; pg8::StaticOrder S; S.init(MTOK, DM, G, bx);
            pg8::EpiStoreF32 E{TMP, DM};
            pg8::gemm_phase<pg8::EpiStoreF32, pg8::StaticOrder, true, true>(lds, g, S, E);
        }
        grid.sync();
        {
            PHASE_IDS();
            rowpass<1>(lq == 0 ? p.x : p.out, TMP, p.post_mix + (size_t)lq * DM, p.pre_ffn + (size_t)lq * DM, p.out, XN, nullptr, wsT, gwp, NGW, lanep);
        }
        grid.sync();
        {
            pg8::Gemm g{XN, (const bf16*)(p.ws + WS_WGU), MTOK, 2 * FF, DM}; pg8::StaticOrder S; S.init(MTOK, 2 * FF, G, bx);
            pg8::EpiSwiGLU E{HB, FF};
            pg8::gemm_phase<pg8::EpiSwiGLU, pg8::StaticOrder, true, true>(lds, g, S, E);
        }
        grid.sync();
        {
            pg8::Gemm g{HB, (const bf16*)(p.ws + WS_WDN), MTOK, DM, FF}; pg8::StaticOrder S; S.init(MTOK, DM, G, bx);
            pg8::EpiStoreF32 E{TMP, DM};
            pg8::gemm_phase<pg8::EpiStoreF32, pg8::StaticOrder, true, true>(lds, g, S, E);
        }
        grid.sync();
        {
            PHASE_IDS();
            if (lq + 1 < DEPTH) {
                stage_small(p, lq + 1, wsT, tidp);
                __syncthreads();
                rowpass<2>(p.out, TMP, p.post_ffn + (size_t)lq * DM, p.pre_mix + (size_t)(lq + 1) * DM, p.out, XN, SMALL, wsT, gwp, NGW, lanep);
                __syncthreads();
            } else {
                rowpass<3>(p.out, TMP, p.post_ffn + (size_t)lq * DM, nullptr, p.out, nullptr, nullptr, wsT, gwp, NGW, lanep);
            }
        }
    }
}

extern "C" void kernel_launch(void* const* d_in, const int* in_sizes, int n_in, void* d_out, int out_size, void* d_ws, size_t ws_size, hipStream_t stream) {
    static int grid = 0;
    if (grid == 0) {
        if (n_in != 21 || out_size != MTOK * DM || ws_size < WS_END) { fprintf(stderr, "kernel_launch: unexpected shapes (n_in %d out %d ws %zu)\n", n_in, out_size, ws_size); grid = -1; return; }
        int dev = 0, cus = 0, per_cu = 0;
        hipGetDevice(&dev); hipDeviceGetAttribute(&cus, hipDeviceAttributeMultiprocessorCount, dev);
        if (hipFuncSetAttribute((const void*)fwd_megakernel, hipFuncAttributeMaxDynamicSharedMemorySize, LDS_BYTES) != hipSuccess) { fprintf(stderr, "kernel_launch: hipFuncSetAttribute failed\n"); grid = -1; return; }
        hipOccupancyMaxActiveBlocksPerMultiprocessor(&per_cu, (const void*)fwd_megakernel, 512, LDS_BYTES);
        if (per_cu < 1) { fprintf(stderr, "kernel_launch: occupancy query says %d blocks per CU\n", per_cu); per_cu = 1; }
        (void)hipGetLastError();
        grid = cus;
    }
    if (grid < 0) return;
    Params p{};
    const float** pp = (const float**)&p;
    for (int i = 0; i < 21; ++i) pp[i] = (const float*)d_in[i];
    p.out = (float*)d_out; p.ws = (unsigned char*)d_ws;
    void* args[] = {&p};
    hipError_t e = hipLaunchCooperativeKernel((const void*)fwd_megakernel, dim3(grid), dim3(512), args, LDS_BYTES, stream);
    if (e != hipSuccess) fprintf(stderr, "cooperative launch failed: %s (grid %d)\n", hipGetErrorString(e), grid);
}
```

```cpp
#include <hip/hip_runtime.h>
#include <hip/hip_cooperative_groups.h>
#include <cstdio>
#include <cstdint>
namespace cg = cooperative_groups;
namespace pg8 {
#define PG8_LAS __attribute__((address_space(3)))
typedef unsigned short bf16_t;
typedef short bf16x8 __attribute__((ext_vector_type(8)));
typedef float f32x4 __attribute__((ext_vector_type(4)));
typedef unsigned u32x4 __attribute__((ext_vector_type(4)));
constexpr int BM = 256, BK = 64, HALF = 128, HTB = HALF * BK * 2  , STAGE_BYTES = 8 * HTB, NXCD = 8, WGM = 8;

__host__ __device__ __forceinline__ int lds_byte(int r, int c) { const int st = (r >> 4) * 2 + (c >> 5), rr = r & 15, cc = c & 31, ob = rr * 64 + cc * 2; return st * 1024 + (ob ^ (((ob >> 9) & 1) << 5)); }
__host__ __device__ __forceinline__ void stage_rc(int b, int& R, int& C) { const int st = b / 1024, sb = b % 1024, swz = sb ^ (((sb >> 9) & 1) << 5); R = (st >> 1) * 16 + swz / 64; C = (st & 1) * 32 + (swz % 64) / 2; }
__host__ __device__ __forceinline__ int perm32(int rho) { const int n = rho >> 4, i = rho & 15; return 8 * (i >> 2) + 4 * n + (i & 3); }

struct Unit { int pm, pn; };
struct Gemm { const bf16_t* A; const bf16_t* Bt; int M, N, K; };

struct StaticOrder {
    int nM, nN, nwg, G, c;
    __host__ __device__ void init(int M, int N, int G_, int c_) { nM = M / BM; nN = N / BM; nwg = nM * nN; G = G_; c = c_; }
    __host__ __device__ bool next(int i, Unit& u) const {
        const long L = (long)i * G + c; if (L >= nwg) return false;
        int wgid = (int)L; { const int q = nwg / NXCD, r = nwg % NXCD, xcd = wgid % NXCD, off = wgid / NXCD; wgid = (xcd < r ? xcd * (q + 1) : r * (q + 1) + (xcd - r) * q) + off; }
        const int nig = WGM * nN, gid = wgid / nig, fm = gid * WGM, gsz = (nM - fm) < WGM ? (nM - fm) : WGM;
        u.pm = fm + ((wgid % nig) % gsz); u.pn = (wgid % nig) / gsz; return true;
    }
    __device__ __forceinline__ void a_ready(const Unit&) const {}
    __device__ __forceinline__ void done(const Unit&) const {}
};

__device__ __forceinline__ unsigned cvt_pk_bf16(float lo, float hi) { unsigned r; asm volatile("v_cvt_pk_bf16_f32 %0, %1, %2" : "=v"(r) : "v"(lo), "v"(hi)); return r; }
typedef float f32x2 __attribute__((ext_vector_type(2)));
typedef unsigned u32x2 __attribute__((ext_vector_type(2)));
__device__ __forceinline__ float silu_f(float x) { return x * __builtin_amdgcn_rcpf(1.0f + __expf(-x)); }
struct EpiStoreBf16 {
    static constexpr bool PERM = true, AFTER_DRAIN = false;
    bf16_t* O; int ldc;
    __device__ __forceinline__ void operator()(const f32x4 (&acc)[2][2][4][2], const Unit& u, int wr, int wc, int fr, int fq) const {
        const int row0 = u.pm * BM + wr * 64 + fr, col0 = u.pn * BM + wc * 32 + 8 * fq;
#pragma unroll
        for (int ai = 0; ai < 2; ++ai)
#pragma unroll
            for (int m = 0; m < 4; ++m) { bf16_t* rowp = O + (size_t)(row0 + ai * HALF + m * 16) * ldc + col0;
#pragma unroll
                for (int bj = 0; bj < 2; ++bj) { const f32x4 v0 = acc[ai][bj][m][0], v1 = acc[ai][bj][m][1];
                    u32x4 w; w.x = cvt_pk_bf16(v0[0], v0[1]); w.y = cvt_pk_bf16(v0[2], v0[3]); w.z = cvt_pk_bf16(v1[0], v1[1]); w.w = cvt_pk_bf16(v1[2], v1[3]);
                    *(u32x4*)(rowp + bj * HALF) = w; } }
    }
};
struct EpiStoreF32 {
    static constexpr bool PERM = true, AFTER_DRAIN = false;
    float* O; int ldc;
    __device__ __forceinline__ void operator()(const f32x4 (&acc)[2][2][4][2], const Unit& u, int wr, int wc, int fr, int fq) const {
        const int row0 = u.pm * BM + wr * 64 + fr, col0 = u.pn * BM + wc * 32 + 8 * fq;
#pragma unroll
        for (int ai = 0; ai < 2; ++ai)
#pragma unroll
            for (int m = 0; m < 4; ++m) { float* rowp = O + (size_t)(row0 + ai * HALF + m * 16) * ldc + col0;
#pragma unroll
                for (int bj = 0; bj < 2; ++bj) { *(f32x4*)(rowp + bj * HALF) = acc[ai][bj][m][0]; *(f32x4*)(rowp + bj * HALF + 4) = acc[ai][bj][m][1]; } }
    }
};
struct EpiSwiGLU {
    static constexpr bool PERM = true, AFTER_DRAIN = false;
    bf16_t* H; int ldh;
    __device__ __forceinline__ void operator()(const f32x4 (&acc)[2][2][4][2], const Unit& u, int wr, int wc, int fr, int fq) const {
        const int row0 = u.pm * BM + wr * 64 + fr, col0 = u.pn * (BM / 2) + wc * 16 + 4 * fq;
#pragma unroll
        for (int ai = 0; ai < 2; ++ai)
#pragma unroll
            for (int m = 0; m < 4; ++m) { bf16_t* rowp = H + (size_t)(row0 + ai * HALF + m * 16) * ldh + col0;
#pragma unroll
                for (int bj = 0; bj < 2; ++bj) { const f32x4 v0 = acc[ai][bj][m][0], v1 = acc[ai][bj][m][1];
                    u32x2 w; w.x = cvt_pk_bf16(silu_f(v0[0]) * v0[1], silu_f(v0[2]) * v0[3]); w.y = cvt_pk_bf16(silu_f(v1[0]) * v1[1], silu_f(v1[2]) * v1[3]);
                    *(u32x2*)(rowp + bj * (HALF / 2)) = w; } }
    }
};
template <class Epi, class Sched, bool ALIGN_EPI = false, bool SP2 = false>
__device__ __forceinline__ void gemm_phase(PG8_LAS unsigned char* lds, const Gemm g, const Sched& S, const Epi& E) {
    int tid_l = threadIdx.x; asm volatile("" : "+v"(tid_l));
    const int tid = tid_l, wid = __builtin_amdgcn_readfirstlane(tid >> 6), lane = tid & 63, wr = wid >> 2, wc = wid & 3, fr = lane & 15, fq = lane >> 4;
    const int K = g.K, nt = K / BK;
    unsigned voffA[2], voffB[2];
#pragma unroll
    for (int i = 0; i < 2; ++i) { int R, C; stage_rc(tid * 16 + i * 8192, R, C); const int Rb = Epi::PERM ? ((R & ~31) + perm32(R & 31)) : R;
        voffA[i] = (unsigned)(R * K + C) * 2u; voffB[i] = (unsigned)(Rb * K + C) * 2u; }
    const size_t kstep = (size_t)(BK * 2);
    const size_t hstep = (size_t)HALF * K * 2;
    const size_t tstep = 2 * hstep;
    const unsigned ldsw = (unsigned)wid * 1024u;
    const int aoff = lds_byte(wr * 64 + fr, fq * 8), boff = lds_byte(wc * 32 + fr, fq * 8);
#define PG8_SA(b, h) (((b) * 2 + (h)) * HTB)
#define PG8_SB(b, h) ((4 + (b) * 2 + (h)) * HTB)
#define PG8_STAGE(bufoff, gbase, voff) do { _Pragma("unroll") for (int _i = 0; _i < 2; ++_i) \
        __builtin_amdgcn_global_load_lds((const unsigned*)((const char*)(gbase) + (voff)[_i]), (PG8_LAS unsigned*)(lds + (bufoff) + ldsw + _i * 8192), 16, 0, 0); } while (0)
#define PG8_LDA(dst, b, h) do { _Pragma("unroll") for (int m = 0; m < 4; ++m) _Pragma("unroll") for (int k = 0; k < 2; ++k) dst[m][k] = *(const PG8_LAS bf16x8*)(lds + PG8_SA(b, h) + aoff + m * 2048 + k * 1024); } while (0)
#define PG8_LDB(dst, b, h) do { _Pragma("unroll") for (int n = 0; n < 2; ++n) _Pragma("unroll") for (int k = 0; k < 2; ++k) dst[n][k] = *(const PG8_LAS bf16x8*)(lds + PG8_SB(b, h) + boff + n * 2048 + k * 1024); } while (0)
#define PG8_MMA(ai, bj, At, Bt) do { __builtin_amdgcn_s_setprio(1); _Pragma("unroll") for (int m = 0; m < 4; ++m) _Pragma("unroll") for (int n = 0; n < 2; ++n) _Pragma("unroll") for (int k = 0; k < 2; ++k) \
        acc[ai][bj][m][n] = __builtin_amdgcn_mfma_f32_16x16x32_bf16(Bt[n][k], At[m][k], acc[ai][bj][m][n], 0, 0, 0); __builtin_amdgcn_s_setprio(0); } while (0)
#define PG8_WAIT_V(n) asm volatile("s_waitcnt vmcnt(" #n ")" ::: "memory")
#define PG8_WAIT_L(n) asm volatile("s_waitcnt lgkmcnt(" #n ")" ::: "memory")
#define PG8_BAR __builtin_amdgcn_s_barrier()
#define PG8_SCHED __builtin_amdgcn_sched_barrier(0)
    Unit cur, nxt; int ui = 0;
    if (!S.next(0, cur)) return;
    f32x4 acc[2][2][4][2];
#pragma unroll
    for (int a = 0; a < 2; ++a)
#pragma unroll
        for (int b = 0; b < 2; ++b)
#pragma unroll
            for (int m = 0; m < 4; ++m)
#pragma unroll
                for (int n = 0; n < 2; ++n) acc[a][b][m][n] = (f32x4){0.f, 0.f, 0.f, 0.f};
    bf16x8 At[4][2], B0[2][2], B1[2][2];
    const char* cA = (const char*)g.A + (size_t)cur.pm * tstep; const char* cB = (const char*)g.Bt + (size_t)cur.pn * tstep;
    S.a_ready(cur);
    if constexpr (SP2) {
        PG8_STAGE(PG8_SB(0, 0), cB, voffB); PG8_STAGE(PG8_SB(0, 1), cB + hstep, voffB); PG8_STAGE(PG8_SA(0, 0), cA, voffA); PG8_STAGE(PG8_SA(0, 1), cA + hstep, voffA);
        if (wr == 1) PG8_BAR;
        PG8_WAIT_V(2); PG8_BAR;
        PG8_STAGE(PG8_SB(1, 0), cB + kstep, voffB); PG8_STAGE(PG8_SA(1, 0), cA + kstep, voffA); PG8_STAGE(PG8_SB(1, 1), cB + hstep + kstep, voffB);
        PG8_WAIT_V(6); PG8_BAR;
    } else {
        PG8_STAGE(PG8_SB(0, 0), cB, voffB); PG8_STAGE(PG8_SA(0, 0), cA, voffA); PG8_STAGE(PG8_SB(0, 1), cB + hstep, voffB); PG8_STAGE(PG8_SA(0, 1), cA + hstep, voffA);
        if (wr == 1) PG8_BAR;
        PG8_WAIT_V(4); PG8_BAR;
        PG8_STAGE(PG8_SB(1, 0), cB + kstep, voffB); PG8_STAGE(PG8_SA(1, 0), cA + kstep, voffA); PG8_STAGE(PG8_SB(1, 1), cB + hstep + kstep, voffB);
        PG8_WAIT_V(6); PG8_BAR;
    }
    for (;;) {
        const bool has_next = S.next(ui + 1, nxt);
        const char* nA = has_next ? (const char*)g.A + (size_t)nxt.pm * tstep : cA; const char* nB = has_next ? (const char*)g.Bt + (size_t)nxt.pn * tstep : cB;
        for (int t = 0; t < nt; t += 2) {
            const bool last = (t == nt - 2);
            const char* a1 = cA + (size_t)(t + 1) * kstep;
            const char* a2 = last ? nA : cA + (size_t)(t + 2) * kstep; const char* b2 = last ? nB : cB + (size_t)(t + 2) * kstep;
            const char* a3 = a2 + kstep; const char* b3 = b2 + kstep;
            if (last && has_next) S.a_ready(nxt);
            if constexpr (SP2) {
            PG8_LDB(B0, 0, 0); PG8_LDB(B1, 0, 1); PG8_SCHED; PG8_LDA(At, 0, 0); PG8_STAGE(PG8_SA(1, 1), a1 + hstep, voffA);
            PG8_WAIT_V(8); PG8_WAIT_L(0); PG8_BAR; PG8_MMA(0, 0, At, B0); PG8_MMA(0, 1, At, B1); PG8_BAR; PG8_SCHED;
            PG8_LDA(At, 0, 1); PG8_STAGE(PG8_SB(0, 0), b2, voffB); PG8_STAGE(PG8_SB(0, 1), b2 + hstep, voffB); PG8_STAGE(PG8_SA(0, 0), a2, voffA);
            PG8_WAIT_V(8); PG8_WAIT_L(0); PG8_BAR; PG8_MMA(1, 0, At, B0); PG8_MMA(1, 1, At, B1); PG8_BAR; PG8_SCHED;
            PG8_LDB(B0, 1, 0); PG8_LDB(B1, 1, 1); PG8_SCHED; PG8_LDA(At, 1, 0); PG8_STAGE(PG8_SA(0, 1), a2 + hstep, voffA);
            PG8_WAIT_V(8); PG8_WAIT_L(0); PG8_BAR; PG8_MMA(0, 0, At, B0); PG8_MMA(0, 1, At, B1); PG8_BAR; PG8_SCHED;
            PG8_LDA(At, 1, 1); PG8_STAGE(PG8_SB(1, 0), b3, voffB); PG8_STAGE(PG8_SB(1, 1), b3 + hstep, voffB); PG8_STAGE(PG8_SA(1, 0), a3, voffA);
            PG8_WAIT_V(8); PG8_WAIT_L(0); PG8_BAR; PG8_MMA(1, 0, At, B0); PG8_MMA(1, 1, At, B1); PG8_BAR; PG8_SCHED;
            } else {
            PG8_LDB(B0, 0, 0); PG8_SCHED; PG8_LDA(At, 0, 0); PG8_STAGE(PG8_SA(1, 1), a1 + hstep, voffA);
            PG8_WAIT_L(8); PG8_BAR; PG8_WAIT_L(0); PG8_MMA(0, 0, At, B0); PG8_BAR; PG8_SCHED;
            PG8_LDB(B1, 0, 1); PG8_STAGE(PG8_SB(0, 0), b2, voffB);
            PG8_BAR; PG8_WAIT_L(0); PG8_MMA(0, 1, At, B1); PG8_BAR;
            PG8_LDA(At, 0, 1); PG8_STAGE(PG8_SA(0, 0), a2, voffA);
            PG8_BAR; PG8_WAIT_L(0); PG8_MMA(1, 0, At, B0); PG8_BAR; PG8_SCHED;
            PG8_STAGE(PG8_SB(0, 1), b2 + hstep, voffB);
            PG8_WAIT_V(6); PG8_BAR; PG8_MMA(1, 1, At, B1); PG8_BAR;
            PG8_LDB(B0, 1, 0); PG8_SCHED; PG8_LDA(At, 1, 0); PG8_STAGE(PG8_SA(0, 1), a2 + hstep, voffA);
            PG8_WAIT_L(8); PG8_BAR; PG8_WAIT_L(0); PG8_MMA(0, 0, At, B0); PG8_BAR; PG8_SCHED;
            PG8_LDB(B1, 1, 1); PG8_STAGE(PG8_SB(1, 0), b3, voffB);
            PG8_BAR; PG8_WAIT_L(0); PG8_MMA(0, 1, At, B1); PG8_BAR;
            PG8_LDA(At, 1, 1); PG8_STAGE(PG8_SA(1, 0), a3, voffA);
            PG8_BAR; PG8_WAIT_L(0); PG8_MMA(1, 0, At, B0); PG8_BAR; PG8_SCHED;
            PG8_STAGE(PG8_SB(1, 1), b3 + hstep, voffB);
            PG8_WAIT_V(6); PG8_BAR; PG8_MMA(1, 1, At, B1); PG8_BAR;
            }
        }
        if constexpr (ALIGN_EPI) { if (wr == 0) PG8_BAR; }
        if constexpr (!Epi::AFTER_DRAIN) { E(acc, cur, wr, wc, fr, fq); S.done(cur); }
        if (!has_next) break;
#pragma unroll
        for (int a = 0; a < 2; ++a)
#pragma unroll
            for (int b = 0; b < 2; ++b)
#pragma unroll
                for (int m = 0; m < 4; ++m)
#pragma unroll
                    for (int n = 0; n < 2; ++n) acc[a][b][m][n] = (f32x4){0.f, 0.f, 0.f, 0.f};
        cur = nxt; cA = nA; cB = nB; ++ui;
        if constexpr (ALIGN_EPI) { if (wr == 1) PG8_BAR; }
    }
    PG8_WAIT_V(0);
    if constexpr (!ALIGN_EPI) { if (wr == 0) PG8_BAR; }
    PG8_BAR;
    if constexpr (Epi::AFTER_DRAIN) { E.fused(acc, cur, wr, wc, fr, fq, lds, wid, lane); S.done(cur); }
#undef PG8_SA
#undef PG8_SB
#undef PG8_STAGE
#undef PG8_LDA
#undef PG8_LDB
#undef PG8_MMA
#undef PG8_WAIT_V
#undef PG8_WAIT_L
#undef PG8_BAR
#undef PG8_SCHED
}
}
constexpr int BATCH = 4, SEQ = 4096, DM = 1024, NCH = 64, CH = 64, MTOK = BATCH * SEQ, DEPTH = 2;
constexpr int NPROJ = 3072, IN_COLS = 3088, FF = 2816;
constexpr float EPS = 1e-6f;
constexpr size_t MiB = 1u << 20;
constexpr size_t WS_SMALL = 1 * MiB, WS_ACS = 2 * MiB, WS_CDEC = 2 * MiB + 512 * 1024, WS_EGL = 2 * MiB + 768 * 1024;
constexpr size_t WS_WIN = 3 * MiB, WS_WOUT = 9 * MiB, WS_WGU = 11 * MiB, WS_WDN = 22 * MiB;
constexpr size_t WS_XN = 28 * MiB;
constexpr size_t WS_GU = 28 * MiB, WS_GW = 36 * MiB, WS_GQE = 44 * MiB, WS_GQK = 52 * MiB, WS_GKDT = 244 * MiB;
constexpr size_t WS_PROJ = 60 * MiB, WS_H = 60 * MiB;
constexpr size_t WS_MIX = 156 * MiB;
constexpr size_t WS_STATES = 188 * MiB, WS_YPART = 220 * MiB, WS_CCONV = 236 * MiB, WS_TMP = 188 * MiB;
constexpr size_t WS_END = 252 * MiB;
constexpr int LDS_BYTES = 147456;
#ifndef REP_C
#define REP_C 1
#endif
#ifndef REP_D
#define REP_D 1
#endif
#ifndef REP_E
#define REP_E 1
#endif

#define LAS __attribute__((address_space(3)))
#define DEV __device__ __forceinline__
typedef unsigned short bf16;
typedef short bf16x8 __attribute__((ext_vector_type(8)));
typedef float f32x4 __attribute__((ext_vector_type(4)));
typedef unsigned u32x4 __attribute__((ext_vector_type(4)));
typedef unsigned u32x2 __attribute__((ext_vector_type(2)));

DEV unsigned f2bf(float f) { unsigned u = __builtin_bit_cast(unsigned, f); return (u + 0x7fffu + ((u >> 16) & 1u)) >> 16; }
DEV unsigned pk2(float lo, float hi) { return f2bf(lo) | (f2bf(hi) << 16); }
DEV float bf2f(unsigned b) { return __builtin_bit_cast(float, b << 16); }
DEV float bflo(unsigned w) { return __builtin_bit_cast(float, w << 16); }
DEV float bfhi(unsigned w) { return __builtin_bit_cast(float, w & 0xffff0000u); }
DEV float silu(float x) { return x / (1.0f + __expf(-x)); }
DEV float softplus(float x) { return fmaxf(x, 0.f) + log1pf(expf(-fabsf(x))); }
DEV float wave_sum(float v) {
#pragma unroll
    for (int o = 1; o < 64; o <<= 1) v += __shfl_xor(v, o);
    return v;
}
DEV float wave_incl_scan(float v, int lane) {
#pragma unroll
    for (int o = 1; o < 64; o <<= 1) { const float t = __shfl_up(v, o); if (lane >= o) v += t; }
    return v;
}
DEV f32x4 mma_tile(const LAS bf16* A, int lda, const LAS bf16* B, int ldb, int K, int lane, f32x4 acc) {
    const LAS bf16* ap = A + (lane & 15) * lda + (lane >> 4) * 8;
    const LAS bf16* bp = B + (lane & 15) * ldb + (lane >> 4) * 8;
    for (int k = 0; k < K; k += 32) {
        const bf16x8 a = *(const LAS bf16x8*)(ap + k), b = *(const LAS bf16x8*)(bp + k);
        acc = __builtin_amdgcn_mfma_f32_16x16x32_bf16(a, b, acc, 0, 0, 0);
    }
    return acc;
}

struct Params {
    const float *x, *pre_mix, *post_mix, *pre_ffn, *post_ffn, *w_in, *w_out, *sinks, *sconv_w, *sconv_b, *sdt_bias, *sA_log, *sD, *snorm_w,
                *gconv_w, *gdt_bias, *gA_log, *gnorm_w, *w_gate, *w_up, *w_down;
    float* out; unsigned char* ws;
};

DEV void tr_item(const float* W, int ldw, int col0, bf16* WT, int K, int drow0, int rs, LAS float* scr, int kb, int nb, int lane) {
    const int k0 = 64 * kb, n0 = 32 * nb;
#pragma unroll 8
    for (int i = 0; i < 32; ++i) { const int kk = 2 * i + (lane >> 5); scr[kk * 33 + (lane & 31)] = W[(size_t)(k0 + kk) * ldw + col0 + n0 + (lane & 31)]; }
    asm volatile("s_waitcnt lgkmcnt(0)" ::: "memory");
    const int c = lane & 7;
#pragma unroll
    for (int j = 0; j < 4; ++j) { const int n = (lane >> 3) + 8 * j; const LAS float* s = scr + (8 * c) * 33 + n;
        u32x4 o; o.x = pk2(s[0 * 33], s[1 * 33]); o.y = pk2(s[2 * 33], s[3 * 33]); o.z = pk2(s[4 * 33], s[5 * 33]); o.w = pk2(s[6 * 33], s[7 * 33]);
        *(u32x4*)(WT + (size_t)(drow0 + (n0 + n) * rs) * K + k0 + 8 * c) = o; }
    asm volatile("s_waitcnt lgkmcnt(0)" ::: "memory");
}
DEV void convert_weights(const Params& p, int l, LAS unsigned char* lds, int gw, int NGW, int wave, int lane) {
    LAS float* scr = (LAS float*)(lds + wave * 8448);
    const float* win = p.w_in + (size_t)l * DM * IN_COLS; const float* wout = p.w_out + (size_t)l * DM * DM;
    const float* wg = p.w_gate + (size_t)l * DM * FF; const float* wu = p.w_up + (size_t)l * DM * FF; const float* wd = p.w_down + (size_t)l * FF * DM;
    bf16* WIN = (bf16*)(p.ws + WS_WIN); bf16* WOUT = (bf16*)(p.ws + WS_WOUT); bf16* WGU = (bf16*)(p.ws + WS_WGU); bf16* WDN = (bf16*)(p.ws + WS_WDN);
    constexpr int I_IN = 16 * 96, I_OUT = 16 * 32, I_G = 16 * 88, I_D = 44 * 32;
    constexpr int NIT = I_IN + I_OUT + 2 * I_G + I_D;
    for (int it = gw; it < NIT; it += NGW) {
        int r = it;
        if (r < I_IN) { const int kb = r / 96, nb = r % 96;
            if (nb < 64) tr_item(win, IN_COLS, 0, WIN, DM, 0, 1, scr, kb, nb, lane); else tr_item(win, IN_COLS, 2056, WIN, DM, 2048, 1, scr, kb, nb - 64, lane);
            continue; } r -= I_IN;
        if (r < I_OUT) { tr_item(wout, DM, 0, WOUT, DM, 0, 1, scr, r / 32, r % 32, lane); continue; } r -= I_OUT;
        if (r < I_G) { tr_item(wg, FF, 0, WGU, DM, 0, 2, scr, r / 88, r % 88, lane); continue; } r -= I_G;
        if (r < I_G) { tr_item(wu, FF, 0, WGU, DM, 1, 2, scr, r / 88, r % 88, lane); continue; } r -= I_G;
        tr_item(wd, DM, 0, WDN, FF, 0, 1, scr, r / 32, r % 32, lane);
    }
}
DEV void stage_small(const Params& p, int l, LAS float* wsT, int tid) {
    const float* win = p.w_in + (size_t)l * DM * IN_COLS;
    for (int idx = tid; idx < 16 * DM; idx += 512) { const int k = idx >> 4, c = idx & 15; const int sc = c < 8 ? 2048 + c : 3072 + c; wsT[c * DM + k] = win[(size_t)k * IN_COLS + sc]; }
}
template <int MODE>
DEV void rowpass(const float* res, const float* tmp, const float* wpost, const float* wnext, float* xout, bf16* XN, float* SMALL, const LAS float* wsT, int gw, int NGW, int lane) {
    f32x4 wp[4], wn[4];
#pragma unroll
    for (int j = 0; j < 4; ++j) {
        if (MODE != 0) wp[j] = *((const f32x4*)wpost + lane + 64 * j);
        if (MODE != 3) wn[j] = *((const f32x4*)wnext + lane + 64 * j);
    }
    for (int m = gw; m < MTOK; m += NGW) {
        f32x4 v[4];
#pragma unroll
        for (int j = 0; j < 4; ++j) v[j] = *((const f32x4*)(res + (size_t)m * DM) + lane + 64 * j);
        if (MODE != 0) {
            f32x4 t[4]; float ss = 0.f;
#pragma unroll
            for (int j = 0; j < 4; ++j) { t[j] = *((const f32x4*)(tmp + (size_t)m * DM) + lane + 64 * j); ss += (t[j].x * t[j].x + t[j].y * t[j].y) + (t[j].z * t[j].z + t[j].w * t[j].w); }
            const float rstd = rsqrtf(wave_sum(ss) * (1.0f / DM) + EPS);
#pragma unroll
            for (int j = 0; j < 4; ++j) { v[j] = v[j] + t[j] * rstd * wp[j]; *((f32x4*)(xout + (size_t)m * DM) + lane + 64 * j) = v[j]; }
        }
        if (MODE != 3) {
            float ss = 0.f;
#pragma unroll
            for (int j = 0; j < 4; ++j) ss += (v[j].x * v[j].x + v[j].y * v[j].y) + (v[j].z * v[j].z + v[j].w * v[j].w);
            const float rstd = rsqrtf(wave_sum(ss) * (1.0f / DM) + EPS);
#pragma unroll
            for (int j = 0; j < 4; ++j) { v[j] = v[j] * rstd * wn[j];
                u32x2 o; o.x = pk2(v[j].x, v[j].y); o.y = pk2(v[j].z, v[j].w); *((u32x2*)(XN + (size_t)m * DM) + lane + 64 * j) = o; }
            if (MODE == 0 || MODE == 2) {
                float part[16];
#pragma unroll
                for (int c = 0; c < 16; ++c) { float s = 0.f; asm volatile("" ::: "memory");
#pragma unroll
                    for (int j = 0; j < 4; ++j) { const f32x4 w = *((const LAS f32x4*)(wsT + c * DM) + lane + 64 * j); s += (v[j].x * w.x + v[j].y * w.y) + (v[j].z * w.z + v[j].w * w.w); }
                    part[c] = wave_sum(s); }
                float mine = 0.f;
#pragma unroll
                for (int c = 0; c < 16; ++c) mine = (lane == c) ? part[c] : mine;
                if (lane < 16) SMALL[(size_t)m * 16 + lane] = mine;
            }
        }
    }
}

DEV void attn_unit(const Params& p, int l, int u, LAS unsigned char* lds, int tid) {
    const int b = u >> 7, c = (u >> 1) & 63, kvh = u & 1, wave = tid >> 6, lane = tid & 63;
    const bf16* PROJ = (const bf16*)(p.ws + WS_PROJ); bf16* MIX = (bf16*)(p.ws + WS_MIX);
    LAS bf16* Qs = (LAS bf16*)lds;
    LAS bf16* Ks = Qs + 128 * 72;
    LAS bf16* Vt = Ks + 192 * 72;
    LAS bf16* Ps = Vt + 64 * 200;
    const size_t t0 = (size_t)b * SEQ + (size_t)c * CH;
    for (int idx = tid; idx < 1024; idx += 512) { const int r = idx >> 3, v = idx & 7, g = r >> 6, i = r & 63;
        *(LAS u32x4*)(Qs + r * 72 + v * 8) = *(const u32x4*)(PROJ + (t0 + i) * NPROJ + kvh * 128 + g * 64 + v * 8); }
    for (int idx = tid; idx < 1536; idx += 512) { const int j = idx >> 3, v = idx & 7; const bool valid = (c - 2 + (j >> 6)) >= 0;
        u32x4 kv = (u32x4){0u, 0u, 0u, 0u}, vv = kv;
        if (valid) { const bf16* rowp = PROJ + (size_t)((long)t0 - 128 + j) * NPROJ; kv = *(const u32x4*)(rowp + 256 + kvh * 64 + v * 8); vv = *(const u32x4*)(rowp + 384 + kvh * 64 + v * 8); }
        *(LAS u32x4*)(Ks + j * 72 + v * 8) = kv;
        LAS bf16* vt = Vt + (v * 8) * 200 + j;
        vt[0 * 200] = (bf16)(vv.x & 0xffffu); vt[1 * 200] = (bf16)(vv.x >> 16); vt[2 * 200] = (bf16)(vv.y & 0xffffu); vt[3 * 200] = (bf16)(vv.y >> 16);
        vt[4 * 200] = (bf16)(vv.z & 0xffffu); vt[5 * 200] = (bf16)(vv.z >> 16); vt[6 * 200] = (bf16)(vv.w & 0xffffu); vt[7 * 200] = (bf16)(vv.w >> 16); }
    __syncthreads();
    {
        const int g = wave >> 2, h = kvh * 2 + g;
        const float slope = exp2f(-2.0f * (float)(h + 1)), sink = p.sinks[l * 4 + h];
        f32x4 s[12];
#pragma unroll
        for (int nt = 0; nt < 12; ++nt) s[nt] = mma_tile(Qs + wave * 16 * 72, 72, Ks + nt * 16 * 72, 72, 64, lane, (f32x4){0.f, 0.f, 0.f, 0.f});
#pragma unroll
        for (int j = 0; j < 4; ++j) {
            const int r = wave * 16 + (lane >> 4) * 4 + j, i = r & 63;
            float mx = sink;
#pragma unroll
            for (int nt = 0; nt < 12; ++nt) { const int jj = nt * 16 + (lane & 15);
                float val = s[nt][j] * 0.125f - slope * fabsf((float)(i + 128 - jj));
                if (c - 2 + (nt >> 2) < 0) val = -INFINITY;
                s[nt][j] = val; mx = fmaxf(mx, val); }
            mx = fmaxf(mx, __shfl_xor(mx, 1)); mx = fmaxf(mx, __shfl_xor(mx, 2)); mx = fmaxf(mx, __shfl_xor(mx, 4)); mx = fmaxf(mx, __shfl_xor(mx, 8));
            float sum = 0.f;
#pragma unroll
            for (int nt = 0; nt < 12; ++nt) { const float e = __expf(s[nt][j] - mx); s[nt][j] = e; sum += e; }
            sum += __shfl_xor(sum, 1); sum += __shfl_xor(sum, 2); sum += __shfl_xor(sum, 4); sum += __shfl_xor(sum, 8);
            sum += __expf(sink - mx);
            const float inv = 1.0f / sum;
#pragma unroll
            for (int nt = 0; nt < 12; ++nt) Ps[r * 200 + nt * 16 + (lane & 15)] = (bf16)f2bf(s[nt][j] * inv);
        }
    }
    __syncthreads();
#pragma unroll
    for (int nt = 0; nt < 4; ++nt) {
        const f32x4 acc = mma_tile(Vt + nt * 16 * 200, 200, Ps + wave * 16 * 200, 200, 192, lane, (f32x4){0.f, 0.f, 0.f, 0.f});
        const int r = wave * 16 + (lane & 15), g = r >> 6, i = r & 63, d0 = nt * 16 + (lane >> 4) * 4;
        u32x2 o; o.x = pk2(acc[0], acc[1]); o.y = pk2(acc[2], acc[3]);
        *(u32x2*)(MIX + (t0 + i) * DM + (kvh * 2 + g) * 64 + d0) = o;
    }
    __syncthreads();
}

DEV void load_raw(const bf16* PROJ, size_t t0, int c, int col0, int ncols, LAS bf16* Raw, int rawld, int dcol0, int tid) {
    const int vpr = ncols >> 3;
    for (int idx = tid; idx < 67 * vpr; idx += 512) { const int r = idx / vpr, v = idx % vpr;
        u32x4 val = (u32x4){0u, 0u, 0u, 0u};
        if (c > 0 || r >= 3) val = *(const u32x4*)(PROJ + (size_t)((long)t0 - 3 + r) * NPROJ + col0 + v * 8);
        *(LAS u32x4*)(Raw + r * rawld + dcol0 + v * 8) = val; }
}
DEV void ssd_p1_unit(const Params& p, int l, int u, LAS unsigned char* lds, int tid) {
    const int b = u >> 7, c = (u >> 1) & 63, g = u & 1, wave = tid >> 6, lane = tid & 63;
    const bf16* PROJ = (const bf16*)(p.ws + WS_PROJ);
    const float* SMALL = (const float*)(p.ws + WS_SMALL);
    float* ACS = (float*)(p.ws + WS_ACS); float* CDEC = (float*)(p.ws + WS_CDEC);
    bf16* STATES = (bf16*)(p.ws + WS_STATES); bf16* YPART = (bf16*)(p.ws + WS_YPART); bf16* CCONV = (bf16*)(p.ws + WS_CCONV);
    LAS bf16* XsT = (LAS bf16*)lds;
    LAS bf16* Bm = XsT + 4 * 64 * 72;
    LAS bf16* Cm = Bm + 64 * 136;
    LAS bf16* BmT = Cm + 64 * 136;
    LAS bf16* Sc = BmT + 128 * 72;
    LAS bf16* Raw = Sc;
    LAS float* dtS = (LAS float*)(Sc + 4 * 64 * 72);
    LAS float* acsS = dtS + 256;
    LAS float* fS = acsS + 256;
    const size_t t0 = (size_t)b * SEQ + (size_t)c * CH;
    if (tid < 256) {
        const int h = tid >> 6, hh = g * 4 + h;
        const float dt = softplus(SMALL[(t0 + lane) * 16 + hh] + p.sdt_bias[l * 8 + hh]);
        const float a = -expf(p.sA_log[l * 8 + hh]);
        const float acs = wave_incl_scan(dt * a, lane);
        const float alast = __shfl(acs, 63);
        dtS[tid] = dt; acsS[tid] = acs; fS[tid] = dt * expf(alast - acs);
        ACS[(t0 + lane) * 8 + hh] = acs;
        if (lane == 63) CDEC[((size_t)b * NCH + c) * 8 + hh] = expf(acs);
    }
    load_raw(PROJ, t0, c, 1024 + g * 256, 256, Raw, 256, 0, tid);
    __syncthreads();
    {
        const int ch = tid & 255, half = tid >> 8, chg = g * 256 + ch, h = ch >> 6, pp = ch & 63;
        const float* cw = p.sconv_w + (size_t)l * 4096 + chg; const float w0 = cw[0], w1 = cw[1024], w2 = cw[2048], w3 = cw[3072], bias = p.sconv_b[l * 1024 + chg];
        const int r0 = half * 32;
        float x0 = bf2f(Raw[(r0 + 0) * 256 + ch]), x1 = bf2f(Raw[(r0 + 1) * 256 + ch]), x2 = bf2f(Raw[(r0 + 2) * 256 + ch]);
        LAS bf16* dst = XsT + h * 64 * 72 + pp * 72 + r0;
        for (int r = 0; r < 32; ++r) { const float x3 = bf2f(Raw[(r0 + r + 3) * 256 + ch]);
            const float y = silu(w0 * x0 + w1 * x1 + w2 * x2 + w3 * x3 + bias);
            dst[r] = (bf16)f2bf(y); x0 = x1; x1 = x2; x2 = x3; }
    }
    __syncthreads();
    load_raw(PROJ, t0, c, 1024 + 512 + g * 128, 128, Raw, 256, 0, tid);
    load_raw(PROJ, t0, c, 1024 + 768 + g * 128, 128, Raw, 256, 128, tid);
    __syncthreads();
    {
        const int ch = tid & 255, half = tid >> 8, isC = ch >> 7, n = ch & 127, chg = 512 + isC * 256 + g * 128 + n;
        const float* cw = p.sconv_w + (size_t)l * 4096 + chg; const float w0 = cw[0], w1 = cw[1024], w2 = cw[2048], w3 = cw[3072], bias = p.sconv_b[l * 1024 + chg];
        const int r0 = half * 32;
        float x0 = bf2f(Raw[(r0 + 0) * 256 + ch]), x1 = bf2f(Raw[(r0 + 1) * 256 + ch]), x2 = bf2f(Raw[(r0 + 2) * 256 + ch]);
        for (int r = 0; r < 32; ++r) { const float x3 = bf2f(Raw[(r0 + r + 3) * 256 + ch]);
            const bf16 y = (bf16)f2bf(silu(w0 * x0 + w1 * x1 + w2 * x2 + w3 * x3 + bias));
            if (isC) Cm[(r0 + r) * 136 + n] = y; else { Bm[(r0 + r) * 136 + n] = y; BmT[n * 72 + r0 + r] = y; }
            x0 = x1; x1 = x2; x2 = x3; }
    }
    __syncthreads();
    for (int idx = tid; idx < 1024; idx += 512) { const int r = idx >> 4, v = idx & 15; *(u32x4*)(CCONV + (t0 + r) * 256 + g * 128 + v * 8) = *(const LAS u32x4*)(Cm + r * 136 + v * 8); }
#pragma unroll
    for (int ti = 0; ti < 2; ++ti) {
        const int tt = wave * 2 + ti, mt = tt >> 2, nt = tt & 3;
        f32x4 acc = (f32x4){0.f, 0.f, 0.f, 0.f};
        if (nt <= mt) acc = mma_tile(Cm + mt * 16 * 136, 136, Bm + nt * 16 * 136, 136, 128, lane, acc);
        const int s = nt * 16 + (lane & 15);
#pragma unroll
        for (int h = 0; h < 4; ++h) { const float as = acsS[h * 64 + s], ds = dtS[h * 64 + s];
#pragma unroll
            for (int j = 0; j < 4; ++j) { const int lr = mt * 16 + (lane >> 4) * 4 + j;
                const float val = (s <= lr) ? acc[j] * expf(acsS[h * 64 + lr] - as) * ds : 0.f;
                Sc[h * 64 * 72 + lr * 72 + s] = (bf16)f2bf(val); } }
    }
    __syncthreads();
    {
        const int h = wave >> 1, hh = g * 4 + h; const float Dh = p.sD[l * 8 + hh];
        for (int ti = 0; ti < 8; ++ti) { const int tt = (wave & 1) * 8 + ti, mt = tt >> 2, nt = tt & 3;
            const f32x4 acc = mma_tile(Sc + h * 64 * 72 + mt * 16 * 72, 72, XsT + h * 64 * 72 + nt * 16 * 72, 72, 64, lane, (f32x4){0.f, 0.f, 0.f, 0.f});
            const int pp = nt * 16 + (lane & 15), lr0 = mt * 16 + (lane >> 4) * 4;
            const u32x2 xw = *(const LAS u32x2*)(XsT + h * 64 * 72 + pp * 72 + lr0);
            const float xs[4] = {bflo(xw.x), bfhi(xw.x), bflo(xw.y), bfhi(xw.y)};
#pragma unroll
            for (int j = 0; j < 4; ++j) YPART[(t0 + lr0 + j) * 512 + hh * 64 + pp] = (bf16)f2bf(acc[j] + Dh * xs[j]); }
#pragma unroll
        for (int pi = 0; pi < 2; ++pi) { const int pt = (wave & 1) * 2 + pi;
            bf16x8 xf[2];
#pragma unroll
            for (int k = 0; k < 2; ++k) { const int l0 = k * 32 + (lane >> 4) * 8;
                const u32x4 xw = *(const LAS u32x4*)(XsT + h * 64 * 72 + (pt * 16 + (lane & 15)) * 72 + l0);
                const f32x4 f0 = *(const LAS f32x4*)(fS + h * 64 + l0), f1 = *(const LAS f32x4*)(fS + h * 64 + l0 + 4);
                u32x4 o; o.x = pk2(bflo(xw.x) * f0.x, bfhi(xw.x) * f0.y); o.y = pk2(bflo(xw.y) * f0.z, bfhi(xw.y) * f0.w);
                o.z = pk2(bflo(xw.z) * f1.x, bfhi(xw.z) * f1.y); o.w = pk2(bflo(xw.w) * f1.z, bfhi(xw.w) * f1.w);
                xf[k] = __builtin_bit_cast(bf16x8, o); }
            for (int nt = 0; nt < 8; ++nt) {
                f32x4 acc = (f32x4){0.f, 0.f, 0.f, 0.f};
#pragma unroll
                for (int k = 0; k < 2; ++k) { const bf16x8 bfr = *(const LAS bf16x8*)(BmT + (nt * 16 + (lane & 15)) * 72 + k * 32 + (lane >> 4) * 8);
                    acc = __builtin_amdgcn_mfma_f32_16x16x32_bf16(bfr, xf[k], acc, 0, 0, 0); }
                u32x2 o; o.x = pk2(acc[0], acc[1]); o.y = pk2(acc[2], acc[3]);
                *(u32x2*)(STATES + ((((size_t)b * NCH + c) * 8 + hh) * 64 + pt * 16 + (lane & 15)) * 128 + nt * 16 + (lane >> 4) * 4) = o; } }
    }
    __syncthreads();
}
DEV void ssd_scan_unit(const Params& p, int u, int tid) {
    bf16* STATES = (bf16*)(p.ws + WS_STATES); const float* CDEC = (const float*)(p.ws + WS_CDEC);
    const int idx = u * 512 + tid, b = idx >> 14, rem = idx & 16383, hh = rem >> 11, pn = rem & 2047;
    bf16* base = STATES + ((size_t)b * NCH * 8 + hh) * 8192 + (size_t)pn * 4;
    const float* dec = CDEC + (size_t)b * NCH * 8 + hh;
    float s0 = 0.f, s1 = 0.f, s2 = 0.f, s3 = 0.f;
    for (int c0 = 0; c0 < NCH; c0 += 8) {
        u32x2 nw[8]; float d[8];
#pragma unroll
        for (int k = 0; k < 8; ++k) { nw[k] = *(const u32x2*)(base + (size_t)(c0 + k) * 8 * 8192); d[k] = dec[(c0 + k) * 8]; }
#pragma unroll
        for (int k = 0; k < 8; ++k) { u32x2 o; o.x = pk2(s0, s1); o.y = pk2(s2, s3); *(u32x2*)(base + (size_t)(c0 + k) * 8 * 8192) = o;
            s0 = s0 * d[k] + bflo(nw[k].x); s1 = s1 * d[k] + bfhi(nw[k].x); s2 = s2 * d[k] + bflo(nw[k].y); s3 = s3 * d[k] + bfhi(nw[k].y); }
    }
}
DEV void ssd_p3_unit(const Params& p, int l, int u, LAS unsigned char* lds, int tid) {
    const int b = u >> 7, c = (u >> 1) & 63, g = u & 1, wave = tid >> 6, lane = tid & 63;
    const bf16* PROJ = (const bf16*)(p.ws + WS_PROJ); const float* ACS = (const float*)(p.ws + WS_ACS);
    const bf16* STATES = (const bf16*)(p.ws + WS_STATES); const bf16* YPART = (const bf16*)(p.ws + WS_YPART); const bf16* CCONV = (const bf16*)(p.ws + WS_CCONV);
    bf16* MIX = (bf16*)(p.ws + WS_MIX);
    LAS bf16* Cm = (LAS bf16*)lds;
    LAS bf16* Prev = Cm + 64 * 136;
    LAS float* Gb = (LAS float*)Prev;
    LAS float* acsS = (LAS float*)(Prev + 4 * 64 * 136);
    const size_t t0 = (size_t)b * SEQ + (size_t)c * CH;
    for (int idx = tid; idx < 1024; idx += 512) { const int r = idx >> 4, v = idx & 15; *(LAS u32x4*)(Cm + r * 136 + v * 8) = *(const u32x4*)(CCONV + (t0 + r) * 256 + g * 128 + v * 8); }
    for (int idx = tid; idx < 4096; idx += 512) { const int h = idx >> 10, r = (idx >> 4) & 63, v = idx & 15;
        *(LAS u32x4*)(Prev + h * 64 * 136 + r * 136 + v * 8) = *(const u32x4*)(STATES + ((((size_t)b * NCH + c) * 8 + g * 4 + h) * 64 + r) * 128 + v * 8); }
    if (tid < 256) acsS[tid] = ACS[(t0 + (tid & 63)) * 8 + g * 4 + (tid >> 6)];
    __syncthreads();
    const int h = wave >> 1, hh = g * 4 + h;
    f32x4 acc[8];
#pragma unroll
    for (int ti = 0; ti < 8; ++ti) { const int tt = (wave & 1) * 8 + ti, mt = tt >> 2, nt = tt & 3;
        acc[ti] = mma_tile(Cm + mt * 16 * 136, 136, Prev + h * 64 * 136 + nt * 16 * 136, 136, 128, lane, (f32x4){0.f, 0.f, 0.f, 0.f}); }
    __syncthreads();
#pragma unroll
    for (int ti = 0; ti < 8; ++ti) { const int tt = (wave & 1) * 8 + ti, mt = tt >> 2, nt = tt & 3, pp = nt * 16 + (lane & 15);
#pragma unroll
        for (int j = 0; j < 4; ++j) { const int lr = mt * 16 + (lane >> 4) * 4 + j;
            const float y = bf2f(YPART[(t0 + lr) * 512 + hh * 64 + pp]) + expf(acsS[h * 64 + lr]) * acc[ti][j];
            const float z = bf2f(PROJ[(t0 + lr) * NPROJ + 512 + hh * 64 + pp]);
            Gb[lr * 260 + h * 64 + pp] = y * silu(z); } }
    __syncthreads();
    {
        const int lr = tid >> 3, part = tid & 7;
        float v[32]; float ss = 0.f;
#pragma unroll
        for (int k = 0; k < 8; ++k) { const f32x4 q = *(const LAS f32x4*)(Gb + lr * 260 + part * 32 + k * 4); v[4 * k] = q.x; v[4 * k + 1] = q.y; v[4 * k + 2] = q.z; v[4 * k + 3] = q.w;
            ss += (q.x * q.x + q.y * q.y) + (q.z * q.z + q.w * q.w); }
        ss += __shfl_xor(ss, 1); ss += __shfl_xor(ss, 2); ss += __shfl_xor(ss, 4);
        const float rstd = rsqrtf(ss * (1.0f / 256.0f) + EPS);
        const float* nw = p.snorm_w + (size_t)l * 512 + g * 256 + part * 32;
        bf16* dst = MIX + (t0 + lr) * DM + 256 + g * 256 + part * 32;
#pragma unroll
        for (int k = 0; k < 4; ++k) { u32x4 o;
            o.x = pk2(v[8 * k] * rstd * nw[8 * k], v[8 * k + 1] * rstd * nw[8 * k + 1]); o.y = pk2(v[8 * k + 2] * rstd * nw[8 * k + 2], v[8 * k + 3] * rstd * nw[8 * k + 3]);
            o.z = pk2(v[8 * k + 4] * rstd * nw[8 * k + 4], v[8 * k + 5] * rstd * nw[8 * k + 5]); o.w = pk2(v[8 * k + 6] * rstd * nw[8 * k + 6], v[8 * k + 7] * rstd * nw[8 * k + 7]);
            *(u32x4*)(dst + 8 * k) = o; }
    }
    __syncthreads();
}

DEV void gdn_pre_unit(const Params& p, int l, int u, LAS unsigned char* lds, int tid) {
    const int b = u >> 8, c = (u >> 2) & 63, hg = u & 3, wave = tid >> 6, lane = tid & 63;
    const int ub = (b * 4 + hg) * 64 + c;
    const bf16* PROJ = (const bf16*)(p.ws + WS_PROJ); const float* SMALL = (const float*)(p.ws + WS_SMALL);
    bf16* GU = (bf16*)(p.ws + WS_GU) + (size_t)ub * 4096; bf16* GW = (bf16*)(p.ws + WS_GW) + (size_t)ub * 4096; bf16* GQE = (bf16*)(p.ws + WS_GQE) + (size_t)ub * 4096;
    bf16* GQK = (bf16*)(p.ws + WS_GQK) + (size_t)ub * 4096; bf16* GKDT = (bf16*)(p.ws + WS_GKDT) + (size_t)ub * 4096; float* EGL = (float*)(p.ws + WS_EGL);
    LAS bf16* Raw = (LAS bf16*)lds;
    LAS float* Qs = (LAS float*)(lds + 25728);
    LAS float* Ks = Qs + 64 * 65;
    LAS float* Vs = Ks + 64 * 65;
    LAS float* Am = Vs + 64 * 65;
    LAS float* betaS = Am + 64 * 64;
    LAS float* gcS = betaS + 64;
    LAS float* Xs = gcS + 64;
    LAS float* At = Xs + 64 * 128;
    const size_t t0 = (size_t)b * SEQ + (size_t)c * CH;
    if (wave == 0) {
        const float beta = 1.0f / (1.0f + expf(-SMALL[(t0 + lane) * 16 + 8 + hg]));
        const float gg = -expf(p.gA_log[l * 4 + hg]) * softplus(SMALL[(t0 + lane) * 16 + 12 + hg] + p.gdt_bias[l * 4 + hg]);
        const float gc = wave_incl_scan(gg, lane);
        betaS[lane] = beta; gcS[lane] = gc;
        if (lane == 63) EGL[ub] = expf(gc);
    }
    load_raw(PROJ, t0, c, 2048 + hg * 64, 64, Raw, 192, 0, tid);
    load_raw(PROJ, t0, c, 2048 + 256 + hg * 64, 64, Raw, 192, 64, tid);
    load_raw(PROJ, t0, c, 2048 + 512 + hg * 64, 64, Raw, 192, 128, tid);
    __syncthreads();
#pragma unroll
    for (int seg = 0; seg < 3; ++seg) {
        const float* cw = p.gconv_w + (size_t)l * 3072 + seg * 256 + hg * 64 + lane; const float w0 = cw[0], w1 = cw[768], w2 = cw[1536], w3 = cw[2304];
        LAS float* dst = seg == 0 ? Qs : (seg == 1 ? Ks : Vs);
        const int r0 = wave * 8;
        float x0 = bf2f(Raw[(r0 + 0) * 192 + seg * 64 + lane]), x1 = bf2f(Raw[(r0 + 1) * 192 + seg * 64 + lane]), x2 = bf2f(Raw[(r0 + 2) * 192 + seg * 64 + lane]);
#pragma unroll
        for (int r = 0; r < 8; ++r) { const float x3 = bf2f(Raw[(r0 + r + 3) * 192 + seg * 64 + lane]);
            float y = silu(w0 * x0 + w1 * x1 + w2 * x2 + w3 * x3);
            if (seg < 2) { const float ss = wave_sum(y * y); y *= rsqrtf(ss + EPS); if (seg == 0) y *= 0.125f; }
            dst[(r0 + r) * 65 + lane] = y; x0 = x1; x1 = x2; x2 = x3; }
    }
    __syncthreads();
    {
        const int i = tid >> 3, j0 = (tid & 7) * 8;
        float kk[8], qk[8];
#pragma unroll
        for (int jj = 0; jj < 8; ++jj) { kk[jj] = 0.f; qk[jj] = 0.f; }
        if (j0 <= i) {
            for (int d = 0; d < 64; ++d) { const float ki = Ks[i * 65 + d], qi = Qs[i * 65 + d];
#pragma unroll
                for (int jj = 0; jj < 8; ++jj) { const float kj = Ks[(j0 + jj) * 65 + d]; kk[jj] += ki * kj; qk[jj] += qi * kj; } }
        }
        const float gi = gcS[i], bi = betaS[i];
        float qv[8];
#pragma unroll
        for (int jj = 0; jj < 8; ++jj) { const int j = j0 + jj; const float dec = (j <= i) ? expf(gi - gcS[j]) : 0.f;
            const float av = (j < i) ? bi * kk[jj] * dec : 0.f; Am[i * 64 + j] = av; At[j * 64 + i] = av; qv[jj] = (j <= i) ? qk[jj] * dec : 0.f; }
        u32x4 o; o.x = pk2(qv[0], qv[1]); o.y = pk2(qv[2], qv[3]); o.z = pk2(qv[4], qv[5]); o.w = pk2(qv[6], qv[7]);
        *(u32x4*)(GQK + i * 64 + j0) = o;
    }
    __syncthreads();
    if (tid < 128) {
        const int col = tid & 63; const bool isw = tid >= 64;
        LAS float* X = Xs + tid;
        bf16* dst = (isw ? GW : GU) + col;
#pragma unroll 1
        for (int rb = 0; rb < 4; ++rb) {
            float r[16];
#pragma unroll
            for (int ii = 0; ii < 16; ++ii) { const int i = rb * 16 + ii; const float bi = betaS[i];
                r[ii] = isw ? Ks[i * 65 + col] * bi * expf(gcS[i]) : Vs[i * 65 + col] * bi; }
#pragma unroll 2
            for (int j = 0; j < rb * 16; ++j) {
                const float xj = X[j * 128];
                const LAS f32x4* at = (const LAS f32x4*)(At + j * 64 + rb * 16);
                const f32x4 a0 = at[0], a1 = at[1], a2 = at[2], a3 = at[3];
                r[0] -= a0.x * xj; r[1] -= a0.y * xj; r[2] -= a0.z * xj; r[3] -= a0.w * xj;
                r[4] -= a1.x * xj; r[5] -= a1.y * xj; r[6] -= a1.z * xj; r[7] -= a1.w * xj;
                r[8] -= a2.x * xj; r[9] -= a2.y * xj; r[10] -= a2.z * xj; r[11] -= a2.w * xj;
                r[12] -= a3.x * xj; r[13] -= a3.y * xj; r[14] -= a3.z * xj; r[15] -= a3.w * xj;
            }
#pragma unroll
            for (int ii = 1; ii < 16; ++ii) {
                float acc = r[ii];
#pragma unroll
                for (int q = 0; q < 4; ++q) if (q * 4 < ii) { const f32x4 a = *(const LAS f32x4*)(Am + (rb * 16 + ii) * 64 + rb * 16 + q * 4);
                    if (q * 4 + 0 < ii) acc -= a.x * r[q * 4 + 0];
                    if (q * 4 + 1 < ii) acc -= a.y * r[q * 4 + 1];
                    if (q * 4 + 2 < ii) acc -= a.z * r[q * 4 + 2];
                    if (q * 4 + 3 < ii) acc -= a.w * r[q * 4 + 3]; }
                r[ii] = acc;
            }
#pragma unroll
            for (int ii = 0; ii < 16; ++ii) { X[(rb * 16 + ii) * 128] = r[ii]; dst[(rb * 16 + ii) * 64] = (bf16)f2bf(r[ii]); }
        }
    } else {
        const float glast = gcS[63];
        for (int idx = tid - 128; idx < 4096; idx += 384) { const int r = idx >> 6, d = idx & 63;
            GQE[idx] = (bf16)f2bf(Qs[r * 65 + d] * expf(gcS[r]));
            const int dd = idx >> 6, ll = idx & 63;
            GKDT[idx] = (bf16)f2bf(Ks[ll * 65 + dd] * expf(glast - gcS[ll])); }
    }
    __syncthreads();
}
DEV void gdn_scan_block(const Params& p, int bh, LAS unsigned char* lds, int tid) {
    const int b = bh >> 2, hg = bh & 3, wave = tid >> 6, lane = tid & 63;
    const size_t ub0 = (size_t)bh * 64;
    const bf16* GM[5] = {(const bf16*)(p.ws + WS_GW) + ub0 * 4096, (const bf16*)(p.ws + WS_GQE) + ub0 * 4096, (const bf16*)(p.ws + WS_GQK) + ub0 * 4096,
                         (const bf16*)(p.ws + WS_GKDT) + ub0 * 4096, (const bf16*)(p.ws + WS_GU) + ub0 * 4096};
    const float* EGL = (const float*)(p.ws + WS_EGL) + ub0;
    bf16* MIX = (bf16*)(p.ws + WS_MIX);
    LAS bf16* OPS = (LAS bf16*)lds;
    LAS bf16* St = OPS + 2 * 5 * 4608;
    LAS bf16* VnT = St + 2 * 4608;
    const int row = tid >> 3, vv = tid & 7;
    for (int idx = tid; idx < 4608; idx += 512) St[idx] = 0;
#pragma unroll
    for (int m = 0; m < 5; ++m) *(LAS u32x4*)(OPS + m * 4608 + row * 72 + vv * 8) = *(const u32x4*)(GM[m] + row * 64 + vv * 8);
    f32x4 Sacc[2] = {(f32x4){0.f, 0.f, 0.f, 0.f}, (f32x4){0.f, 0.f, 0.f, 0.f}};
    __syncthreads();
    for (int c = 0; c < NCH; ++c) {
        const LAS bf16* Wb = OPS + (c & 1) * 5 * 4608; const LAS bf16* QEb = Wb + 4608; const LAS bf16* QKb = Wb + 2 * 4608; const LAS bf16* KDTb = Wb + 3 * 4608; const LAS bf16* Ub = Wb + 4 * 4608;
        const LAS bf16* Sc = St + (c & 1) * 4608; LAS bf16* Sn = St + ((c + 1) & 1) * 4608;
        u32x4 nx[5];
        if (c + 1 < NCH) {
#pragma unroll
            for (int m = 0; m < 5; ++m) nx[m] = *(const u32x4*)(GM[m] + (size_t)(c + 1) * 4096 + row * 64 + vv * 8);
        }
        const float egl = EGL[c];
#pragma unroll
        for (int ti = 0; ti < 2; ++ti) { const int tt = wave * 2 + ti, mt = tt >> 2, nt = tt & 3;
            const f32x4 acc = mma_tile(Wb + mt * 16 * 72, 72, Sc + nt * 16 * 72, 72, 64, lane, (f32x4){0.f, 0.f, 0.f, 0.f});
            const int e = nt * 16 + (lane & 15), l0 = mt * 16 + (lane >> 4) * 4;
            float vn[4];
#pragma unroll
            for (int j = 0; j < 4; ++j) vn[j] = bf2f(Ub[(l0 + j) * 72 + e]) - acc[j];
            u32x2 o; o.x = pk2(vn[0], vn[1]); o.y = pk2(vn[2], vn[3]);
            *(LAS u32x2*)(VnT + e * 72 + l0) = o; }
        __syncthreads();
#pragma unroll
        for (int ti = 0; ti < 2; ++ti) { const int tt = wave * 2 + ti, mt = tt >> 2, nt = tt & 3;
            f32x4 acc = mma_tile(QEb + mt * 16 * 72, 72, Sc + nt * 16 * 72, 72, 64, lane, (f32x4){0.f, 0.f, 0.f, 0.f});
            acc = mma_tile(QKb + mt * 16 * 72, 72, VnT + nt * 16 * 72, 72, 64, lane, acc);
            const int e = nt * 16 + (lane & 15), l0 = mt * 16 + (lane >> 4) * 4;
            bf16* dst = MIX + ((size_t)b * SEQ + (size_t)c * CH + l0) * DM + 768 + hg * 64 + e;
#pragma unroll
            for (int j = 0; j < 4; ++j) dst[(size_t)j * DM] = (bf16)f2bf(acc[j]);
            Sacc[ti] = Sacc[ti] * egl;
            Sacc[ti] = mma_tile(KDTb + mt * 16 * 72, 72, VnT + nt * 16 * 72, 72, 64, lane, Sacc[ti]);
            u32x2 o; o.x = pk2(Sacc[ti][0], Sacc[ti][1]); o.y = pk2(Sacc[ti][2], Sacc[ti][3]);
            *(LAS u32x2*)(Sn + e * 72 + l0) = o; }
        if (c + 1 < NCH) {
            LAS bf16* nb = OPS + ((c + 1) & 1) * 5 * 4608;
#pragma unroll
            for (int m = 0; m < 5; ++m) *(LAS u32x4*)(nb + m * 4608 + row * 72 + vv * 8) = nx[m];
        }
        __syncthreads();
    }
}
DEV void gdn_post(const Params& p, int l, int gw, int NGW, int lane) {
    bf16* MIX = (bf16*)(p.ws + WS_MIX); const bf16* PROJ = (const bf16*)(p.ws + WS_PROJ);
    const f32x4 nw = *((const f32x4*)(p.gnorm_w + (size_t)l * 64) + (lane & 15));
    for (int m = gw; m < MTOK; m += NGW) {
        bf16* op = MIX + (size_t)m * DM + 768 + lane * 4;
        const u32x2 ow = *(const u32x2*)op; const u32x2 zw = *(const u32x2*)(PROJ + (size_t)m * NPROJ + 2816 + lane * 4);
        const float o0 = bflo(ow.x), o1 = bfhi(ow.x), o2 = bflo(ow.y), o3 = bfhi(ow.y);
        float ss = (o0 * o0 + o1 * o1) + (o2 * o2 + o3 * o3);
        ss += __shfl_xor(ss, 1); ss += __shfl_xor(ss, 2); ss += __shfl_xor(ss, 4); ss += __shfl_xor(ss, 8);
        const float rstd = rsqrtf(ss * (1.0f / 64.0f) + EPS);
        u32x2 r; r.x = pk2(o0 * rstd * nw.x * silu(bflo(zw.x)), o1 * rstd * nw.y * silu(bfhi(zw.x))); r.y = pk2(o2 * rstd * nw.z * silu(bflo(zw.y)), o3 * rstd * nw.w * silu(bfhi(zw.y)));
        *(u32x2*)op = r;
    }
}

__global__ void __launch_bounds__(512, 2) fwd_megakernel(Params p) {
    extern __shared__ __attribute__((aligned(16))) unsigned char lds_raw[];
    cg::grid_group grid = cg::this_grid();
    LAS unsigned char* lds = (LAS unsigned char*)lds_raw;
    const int tid = threadIdx.x, lane = tid & 63, wave = __builtin_amdgcn_readfirstlane(tid >> 6);
    const int G = gridDim.x, bx = blockIdx.x, gw = bx * 8 + wave, NGW = G * 8;
    bf16* XN = (bf16*)(p.ws + WS_XN); float* SMALL = (float*)(p.ws + WS_SMALL); float* TMP = (float*)(p.ws + WS_TMP);
    bf16* PROJ = (bf16*)(p.ws + WS_PROJ); bf16* MIX = (bf16*)(p.ws + WS_MIX); bf16* HB = (bf16*)(p.ws + WS_H);
    LAS float* wsT = (LAS float*)(lds + 69632);

#define PHASE_IDS() int tidp = threadIdx.x; int lq = l; asm volatile("" : "+v"(tidp), "+s"(lq)); const int lanep = tidp & 63; const int wavep = __builtin_amdgcn_readfirstlane(tidp >> 6); const int gwp = bx * 8 + wavep; (void)lanep; (void)gwp; (void)lq
#pragma unroll 1
    for (int l = 0; l < DEPTH; ++l) {
        {
            PHASE_IDS();
            convert_weights(p, lq, lds, gwp, NGW, wavep, lanep);
            if (lq == 0) {
                stage_small(p, 0, wsT, tidp);
                __syncthreads();
                rowpass<0>(p.x, nullptr, nullptr, p.pre_mix, nullptr, XN, SMALL, wsT, gwp, NGW, lanep);
            }
        }
        grid.sync();
        {
            pg8::Gemm g{XN, (const bf16*)(p.ws + WS_WIN), MTOK, NPROJ, DM}; pg8::StaticOrder S; S.init(MTOK, NPROJ, G, bx);
            pg8::EpiStoreBf16 E{PROJ, NPROJ};
            pg8::gemm_phase<pg8::EpiStoreBf16, pg8::StaticOrder, true, true>(lds, g, S, E);
        }
        grid.sync();
        {
            PHASE_IDS();
            for (int rep = 0; rep < REP_C; ++rep) {
                if (rep) grid.sync();
                for (int u = bx; u < 1536; u += G) { if (u < 1024) gdn_pre_unit(p, lq, u, lds, tidp); else ssd_p1_unit(p, lq, u - 1024, lds, tidp); }
            }
        }
        grid.sync();
        {
            PHASE_IDS();
            for (int rep = 0; rep < REP_D; ++rep) {
                if (rep) grid.sync();
                if (bx < 16) gdn_scan_block(p, bx, lds, tidp);
                else { for (int u = bx - 16; u < 640; u += G - 16) { if (u < 128) { if (rep == 0) ssd_scan_unit(p, u, tidp); } else attn_unit(p, lq, u - 128, lds, tidp); } }
            }
        }
        grid.sync();
        {
            PHASE_IDS();
            for (int rep = 0; rep < REP_E; ++rep) {
                if (rep) grid.sync();
                for (int u = bx; u < 512; u += G) ssd_p3_unit(p, lq, u, lds, tidp);
            }
            gdn_post(p, lq, gwp, NGW, lanep);
        }
        grid.sync();
        {
            pg8::Gemm g{MIX, (const bf16*)(p.ws + WS_WOUT), MTOK, DM, DM}; pg8::StaticOrder S; S.init(MTOK, DM, G, bx);
            pg8::EpiStoreF32 E{TMP, DM};
            pg8::gemm_phase<pg8::EpiStoreF32, pg8::StaticOrder, true, true>(lds, g, S, E);
        }
        grid.sync();
        {
            PHASE_IDS();
            rowpass<1>(lq == 0 ? p.x : p.out, TMP, p.post_mix + (size_t)lq * DM, p.pre_ffn + (size_t)lq * DM, p.out, XN, nullptr, wsT, gwp, NGW, lanep);
        }
        grid.sync();
        {
            pg8::Gemm g{XN, (const bf16*)(p.ws + WS_WGU), MTOK, 2 * FF, DM}; pg8::StaticOrder S; S.init(MTOK, 2 * FF, G, bx);
            pg8::EpiSwiGLU E{HB, FF};
            pg8::gemm_phase<pg8::EpiSwiGLU, pg8::StaticOrder, true, true>(lds, g, S, E);
        }
        grid.sync();
        {
            pg8::Gemm g{HB, (const bf16*)(p.ws + WS_WDN), MTOK, DM, FF}; pg8::StaticOrder S; S.init(MTOK, DM, G, bx);
            pg8::EpiStoreF32 E{TMP, DM};
            pg8::gemm_phase<pg8::EpiStoreF32, pg8::StaticOrder, true, true>(lds, g, S, E);
        }
        grid.sync();
        {
            PHASE_IDS();
            if (lq + 1 < DEPTH) {
                stage_small(p, lq + 1, wsT, tidp);
                __syncthreads();
                rowpass<2>(p.out, TMP, p.post_ffn + (size_t)lq * DM, p.pre_mix + (size_t)(lq + 1) * DM, p.out, XN, SMALL, wsT, gwp, NGW, lanep);
                __syncthreads();
            } else {
                rowpass<3>(p.out, TMP, p.post_ffn + (size_t)lq * DM, nullptr, p.out, nullptr, nullptr, wsT, gwp, NGW, lanep);
            }
        }
    }
}

extern "C" void kernel_launch(void* const* d_in, const int* in_sizes, int n_in, void* d_out, int out_size, void* d_ws, size_t ws_size, hipStream_t stream) {
    static int grid = 0;
    if (grid == 0) {
        if (n_in != 21 || out_size != MTOK * DM || ws_size < WS_END) { fprintf(stderr, "kernel_launch: unexpected shapes (n_in %d out %d ws %zu)\n", n_in, out_size, ws_size); grid = -1; return; }
        int dev = 0, cus = 0, per_cu = 0;
        hipGetDevice(&dev); hipDeviceGetAttribute(&cus, hipDeviceAttributeMultiprocessorCount, dev);
        if (hipFuncSetAttribute((const void*)fwd_megakernel, hipFuncAttributeMaxDynamicSharedMemorySize, LDS_BYTES) != hipSuccess) { fprintf(stderr, "kernel_launch: hipFuncSetAttribute failed\n"); grid = -1; return; }
        hipOccupancyMaxActiveBlocksPerMultiprocessor(&per_cu, (const void*)fwd_megakernel, 512, LDS_BYTES);
        if (per_cu < 1) { fprintf(stderr, "kernel_launch: occupancy query says %d blocks per CU\n", per_cu); per_cu = 1; }
        (void)hipGetLastError();
        grid = cus;
    }
    if (grid < 0) return;
    Params p{};
    const float** pp = (const float**)&p;
    for (int i = 0; i < 21; ++i) pp[i] = (const float*)d_in[i];
    p.out = (float*)d_out; p.ws = (unsigned char*)d_ws;
    void* args[] = {&p};
    hipError_t e = hipLaunchCooperativeKernel((const void*)fwd_megakernel, dim3(grid), dim3(512), args, LDS_BYTES, stream);
    if (e != hipSuccess) fprintf(stderr, "cooperative launch failed: %s (grid %d)\n", hipGetErrorString(e), grid);
}
```

```cpp
#include <hip/hip_runtime.h>
#include <hip/hip_cooperative_groups.h>
#include <cstdio>
#include <cstdint>
namespace cg = cooperative_groups;
namespace pg8 {
#define PG8_LAS __attribute__((address_space(3)))
typedef unsigned short bf16_t;
typedef short bf16x8 __attribute__((ext_vector_type(8)));
typedef float f32x4 __attribute__((ext_vector_type(4)));
typedef unsigned u32x4 __attribute__((ext_vector_type(4)));
constexpr int BM = 256, BK = 64, HALF = 128, HTB = HALF * BK * 2  , STAGE_BYTES = 8 * HTB, NXCD = 8, WGM = 8;

__host__ __device__ __forceinline__ int lds_byte(int r, int c) { const int st = (r >> 4) * 2 + (c >> 5), rr = r & 15, cc = c & 31, ob = rr * 64 + cc * 2; return st * 1024 + (ob ^ (((ob >> 9) & 1) << 5)); }
__host__ __device__ __forceinline__ void stage_rc(int b, int& R, int& C) { const int st = b / 1024, sb = b % 1024, swz = sb ^ (((sb >> 9) & 1) << 5); R = (st >> 1) * 16 + swz / 64; C = (st & 1) * 32 + (swz % 64) / 2; }
__host__ __device__ __forceinline__ int perm32(int rho) { const int n = rho >> 4, i = rho & 15; return 8 * (i >> 2) + 4 * n + (i & 3); }

struct Unit { int pm, pn; };
struct Gemm { const bf16_t* A; const bf16_t* Bt; int M, N, K; };

struct StaticOrder {
    int nM, nN, nwg, G, c;
    __host__ __device__ void init(int M, int N, int G_, int c_) { nM = M / BM; nN = N / BM; nwg = nM * nN; G = G_; c = c_; }
    __host__ __device__ bool next(int i, Unit& u) const {
        const long L = (long)i * G + c; if (L >= nwg) return false;
        int wgid = (int)L; { const int q = nwg / NXCD, r = nwg % NXCD, xcd = wgid % NXCD, off = wgid / NXCD; wgid = (xcd < r ? xcd * (q + 1) : r * (q + 1) + (xcd - r) * q) + off; }
        const int nig = WGM * nN, gid = wgid / nig, fm = gid * WGM, gsz = (nM - fm) < WGM ? (nM - fm) : WGM;
        u.pm = fm + ((wgid % nig) % gsz); u.pn = (wgid % nig) / gsz; return true;
    }
    __device__ __forceinline__ void a_ready(const Unit&) const {}
    __device__ __forceinline__ void done(const Unit&) const {}
};

__device__ __forceinline__ unsigned cvt_pk_bf16(float lo, float hi) { unsigned r; asm volatile("v_cvt_pk_bf16_f32 %0, %1, %2" : "=v"(r) : "v"(lo), "v"(hi)); return r; }
typedef float f32x2 __attribute__((ext_vector_type(2)));
typedef unsigned u32x2 __attribute__((ext_vector_type(2)));
__device__ __forceinline__ float silu_f(float x) { return x * __builtin_amdgcn_rcpf(1.0f + __expf(-x)); }
struct EpiStoreBf16 {
    static constexpr bool PERM = true, AFTER_DRAIN = false;
    bf16_t* O; int ldc;
    __device__ __forceinline__ void operator()(const f32x4 (&acc)[2][2][4][2], const Unit& u, int wr, int wc, int fr, int fq) const {
        const int row0 = u.pm * BM + wr * 64 + fr, col0 = u.pn * BM + wc * 32 + 8 * fq;
#pragma unroll
        for (int ai = 0; ai < 2; ++ai)
#pragma unroll
            for (int m = 0; m < 4; ++m) { bf16_t* rowp = O + (size_t)(row0 + ai * HALF + m * 16) * ldc + col0;
#pragma unroll
                for (int bj = 0; bj < 2; ++bj) { const f32x4 v0 = acc[ai][bj][m][0], v1 = acc[ai][bj][m][1];
                    u32x4 w; w.x = cvt_pk_bf16(v0[0], v0[1]); w.y = cvt_pk_bf16(v0[2], v0[3]); w.z = cvt_pk_bf16(v1[0], v1[1]); w.w = cvt_pk_bf16(v1[2], v1[3]);
                    *(u32x4*)(rowp + bj * HALF) = w; } }
    }
};
struct EpiStoreF32 {
    static constexpr bool PERM = true, AFTER_DRAIN = false;
    float* O; int ldc;
    __device__ __forceinline__ void operator()(const f32x4 (&acc)[2][2][4][2], const Unit& u, int wr, int wc, int fr, int fq) const {
        const int row0 = u.pm * BM + wr * 64 + fr, col0 = u.pn * BM + wc * 32 + 8 * fq;
#pragma unroll
        for (int ai = 0; ai < 2; ++ai)
#pragma unroll
            for (int m = 0; m < 4; ++m) { float* rowp = O + (size_t)(row0 + ai * HALF + m * 16) * ldc + col0;
#pragma unroll
                for (int bj = 0; bj < 2; ++bj) { *(f32x4*)(rowp + bj * HALF) = acc[ai][bj][m][0]; *(f32x4*)(rowp + bj * HALF + 4) = acc[ai][bj][m][1]; } }
    }
};
struct EpiSwiGLU {
    static constexpr bool PERM = true, AFTER_DRAIN = false;
    bf16_t* H; int ldh;
    __device__ __forceinline__ void operator()(const f32x4 (&acc)[2][2][4][2], const Unit& u, int wr, int wc, int fr, int fq) const {
        const int row0 = u.pm * BM + wr * 64 + fr, col0 = u.pn * (BM / 2) + wc * 16 + 4 * fq;
#pragma unroll
        for (int ai = 0; ai < 2; ++ai)
#pragma unroll
            for (int m = 0; m < 4; ++m) { bf16_t* rowp = H + (size_t)(row0 + ai * HALF + m * 16) * ldh + col0;
#pragma unroll
                for (int bj = 0; bj < 2; ++bj) { const f32x4 v0 = acc[ai][bj][m][0], v1 = acc[ai][bj][m][1];
                    u32x2 w; w.x = cvt_pk_bf16(silu_f(v0[0]) * v0[1], silu_f(v0[2]) * v0[3]); w.y = cvt_pk_bf16(silu_f(v1[0]) * v1[1], silu_f(v1[2]) * v1[3]);
                    *(u32x2*)(rowp + bj * (HALF / 2)) = w; } }
    }
};
template <class Epi, class Sched, bool ALIGN_EPI = false, bool SP2 = false>
__device__ __forceinline__ void gemm_phase(PG8_LAS unsigned char* lds, const Gemm g, const Sched& S, const Epi& E) {
    int tid_l = threadIdx.x; asm volatile("" : "+v"(tid_l));
    const int tid = tid_l, wid = __builtin_amdgcn_readfirstlane(tid >> 6), lane = tid & 63, wr = wid >> 2, wc = wid & 3, fr = lane & 15, fq = lane >> 4;
    const int K = g.K, nt = K / BK;
    unsigned voffA[2], voffB[2];
#pragma unroll
    for (int i = 0; i < 2; ++i) { int R, C; stage_rc(tid * 16 + i * 8192, R, C); const int Rb = Epi::PERM ? ((R & ~31) + perm32(R & 31)) : R;
        voffA[i] = (unsigned)(R * K + C) * 2u; voffB[i] = (unsigned)(Rb * K + C) * 2u; }
    const size_t kstep = (size_t)(BK * 2);
    const size_t hstep = (size_t)HALF * K * 2;
    const size_t tstep = 2 * hstep;
    const unsigned ldsw = (unsigned)wid * 1024u;
    const int aoff = lds_byte(wr * 64 + fr, fq * 8), boff = lds_byte(wc * 32 + fr, fq * 8);
#define PG8_SA(b, h) (((b) * 2 + (h)) * HTB)
#define PG8_SB(b, h) ((4 + (b) * 2 + (h)) * HTB)
#define PG8_STAGE(bufoff, gbase, voff) do { _Pragma("unroll") for (int _i = 0; _i < 2; ++_i) \
        __builtin_amdgcn_global_load_lds((const unsigned*)((const char*)(gbase) + (voff)[_i]), (PG8_LAS unsigned*)(lds + (bufoff) + ldsw + _i * 8192), 16, 0, 0); } while (0)
#define PG8_LDA(dst, b, h) do { _Pragma("unroll") for (int m = 0; m < 4; ++m) _Pragma("unroll") for (int k = 0; k < 2; ++k) dst[m][k] = *(const PG8_LAS bf16x8*)(lds + PG8_SA(b, h) + aoff + m * 2048 + k * 1024); } while (0)
#define PG8_LDB(dst, b, h) do { _Pragma("unroll") for (int n = 0; n < 2; ++n) _Pragma("unroll") for (int k = 0; k < 2; ++k) dst[n][k] = *(const PG8_LAS bf16x8*)(lds + PG8_SB(b, h) + boff + n * 2048 + k * 1024); } while (0)
#define PG8_MMA(ai, bj, At, Bt) do { __builtin_amdgcn_s_setprio(1); _Pragma("unroll") for (int m = 0; m < 4; ++m) _Pragma("unroll") for (int n = 0; n < 2; ++n) _Pragma("unroll") for (int k = 0; k < 2; ++k) \
        acc[ai][bj][m][n] = __builtin_amdgcn_mfma_f32_16x16x32_bf16(Bt[n][k], At[m][k], acc[ai][bj][m][n], 0, 0, 0); __builtin_amdgcn_s_setprio(0); } while (0)
#define PG8_WAIT_V(n) asm volatile("s_waitcnt vmcnt(" #n ")" ::: "memory")
#define PG8_WAIT_L(n) asm volatile("s_waitcnt lgkmcnt(" #n ")" ::: "memory")
#define PG8_BAR __builtin_amdgcn_s_barrier()
#define PG8_SCHED __builtin_amdgcn_sched_barrier(0)
    Unit cur, nxt; int ui = 0;
    if (!S.next(0, cur)) return;
    f32x4 acc[2][2][4][2];
#pragma unroll
    for (int a = 0; a < 2; ++a)
#pragma unroll
        for (int b = 0; b < 2; ++b)
#pragma unroll
            for (int m = 0; m < 4; ++m)
#pragma unroll
                for (int n = 0; n < 2; ++n) acc[a][b][m][n] = (f32x4){0.f, 0.f, 0.f, 0.f};
    bf16x8 At[4][2], B0[2][2], B1[2][2];
    const char* cA = (const char*)g.A + (size_t)cur.pm * tstep; const char* cB = (const char*)g.Bt + (size_t)cur.pn * tstep;
    S.a_ready(cur);
    if constexpr (SP2) {
        PG8_STAGE(PG8_SB(0, 0), cB, voffB); PG8_STAGE(PG8_SB(0, 1), cB + hstep, voffB); PG8_STAGE(PG8_SA(0, 0), cA, voffA); PG8_STAGE(PG8_SA(0, 1), cA + hstep, voffA);
        if (wr == 1) PG8_BAR;
        PG8_WAIT_V(2); PG8_BAR;
        PG8_STAGE(PG8_SB(1, 0), cB + kstep, voffB); PG8_STAGE(PG8_SA(1, 0), cA + kstep, voffA); PG8_STAGE(PG8_SB(1, 1), cB + hstep + kstep, voffB);
        PG8_WAIT_V(6); PG8_BAR;
    } else {
        PG8_STAGE(PG8_SB(0, 0), cB, voffB); PG8_STAGE(PG8_SA(0, 0), cA, voffA); PG8_STAGE(PG8_SB(0, 1), cB + hstep, voffB); PG8_STAGE(PG8_SA(0, 1), cA + hstep, voffA);
        if (wr == 1) PG8_BAR;
        PG8_WAIT_V(4); PG8_BAR;
        PG8_STAGE(PG8_SB(1, 0), cB + kstep, voffB); PG8_STAGE(PG8_SA(1, 0), cA + kstep, voffA); PG8_STAGE(PG8_SB(1, 1), cB + hstep + kstep, voffB);
        PG8_WAIT_V(6); PG8_BAR;
    }
    for (;;) {
        const bool has_next = S.next(ui + 1, nxt);
        const char* nA = has_next ? (const char*)g.A + (size_t)nxt.pm * tstep : cA; const char* nB = has_next ? (const char*)g.Bt + (size_t)nxt.pn * tstep : cB;
        for (int t = 0; t < nt; t += 2) {
            const bool last = (t == nt - 2);
            const char* a1 = cA + (size_t)(t + 1) * kstep;
            const char* a2 = last ? nA : cA + (size_t)(t + 2) * kstep; const char* b2 = last ? nB : cB + (size_t)(t + 2) * kstep;
            const char* a3 = a2 + kstep; const char* b3 = b2 + kstep;
            if (last && has_next) S.a_ready(nxt);
            if constexpr (SP2) {
            PG8_LDB(B0, 0, 0); PG8_LDB(B1, 0, 1); PG8_SCHED; PG8_LDA(At, 0, 0); PG8_STAGE(PG8_SA(1, 1), a1 + hstep, voffA);
            PG8_WAIT_V(8); PG8_WAIT_L(0); PG8_BAR; PG8_MMA(0, 0, At, B0); PG8_MMA(0, 1, At, B1); PG8_BAR; PG8_SCHED;
            PG8_LDA(At, 0, 1); PG8_STAGE(PG8_SB(0, 0), b2, voffB); PG8_STAGE(PG8_SB(0, 1), b2 + hstep, voffB); PG8_STAGE(PG8_SA(0, 0), a2, voffA);
            PG8_WAIT_V(8); PG8_WAIT_L(0); PG8_BAR; PG8_MMA(1, 0, At, B0); PG8_MMA(1, 1, At, B1); PG8_BAR; PG8_SCHED;
            PG8_LDB(B0, 1, 0); PG8_LDB(B1, 1, 1); PG8_SCHED; PG8_LDA(At, 1, 0); PG8_STAGE(PG8_SA(0, 1), a2 + hstep, voffA);
            PG8_WAIT_V(8); PG8_WAIT_L(0); PG8_BAR; PG8_MMA(0, 0, At, B0); PG8_MMA(0, 1, At, B1); PG8_BAR; PG8_SCHED;
            PG8_LDA(At, 1, 1); PG8_STAGE(PG8_SB(1, 0), b3, voffB); PG8_STAGE(PG8_SB(1, 1), b3 + hstep, voffB); PG8_STAGE(PG8_SA(1, 0), a3, voffA);
            PG8_WAIT_V(8); PG8_WAIT_L(0); PG8_BAR; PG8_MMA(1, 0, At, B0); PG8_MMA(1, 1, At, B1); PG8_BAR; PG8_SCHED;
            } else {
            PG8_LDB(B0, 0, 0); PG8_SCHED; PG8_LDA(At, 0, 0); PG8_STAGE(PG8_SA(1, 1), a1 + hstep, voffA);
            PG8_WAIT_L(8); PG8_BAR; PG8_WAIT_L(0); PG8_MMA(0, 0, At, B0); PG8_BAR; PG8_SCHED;
            PG8_LDB(B1, 0, 1); PG8_STAGE(PG8_SB(0, 0), b2, voffB);
            PG8_BAR; PG8_WAIT_L(0); PG8_MMA(0, 1, At, B1); PG8_BAR;
            PG8_LDA(At, 0, 1); PG8_STAGE(PG8_SA(0, 0), a2, voffA);
            PG8_BAR; PG8_WAIT_L(0); PG8_MMA(1, 0, At, B0); PG8_BAR; PG8_SCHED;
            PG8_STAGE(PG8_SB(0, 1), b2 + hstep, voffB);
            PG8_WAIT_V(6); PG8_BAR; PG8_MMA(1, 1, At, B1); PG8_BAR;
            PG8_LDB(B0, 1, 0); PG8_SCHED; PG8_LDA(At, 1, 0); PG8_STAGE(PG8_SA(0, 1), a2 + hstep, voffA);
            PG8_WAIT_L(8); PG8_BAR; PG8_WAIT_L(0); PG8_MMA(0, 0, At, B0); PG8_BAR; PG8_SCHED;
            PG8_LDB(B1, 1, 1); PG8_STAGE(PG8_SB(1, 0), b3, voffB);
            PG8_BAR; PG8_WAIT_L(0); PG8_MMA(0, 1, At, B1); PG8_BAR;
            PG8_LDA(At, 1, 1); PG8_STAGE(PG8_SA(1, 0), a3, voffA);
            PG8_BAR; PG8_WAIT_L(0); PG8_MMA(1, 0, At, B0); PG8_BAR; PG8_SCHED;
            PG8_STAGE(PG8_SB(1, 1), b3 + hstep, voffB);
            PG8_WAIT_V(6); PG8_BAR; PG8_MMA(1, 1, At, B1); PG8_BAR;
            }
        }
        if constexpr (ALIGN_EPI) { if (wr == 0) PG8_BAR; }
        if constexpr (!Epi::AFTER_DRAIN) { E(acc, cur, wr, wc, fr, fq); S.done(cur); }
        if (!has_next) break;
#pragma unroll
        for (int a = 0; a < 2; ++a)
#pragma unroll
            for (int b = 0; b < 2; ++b)
#pragma unroll
                for (int m = 0; m < 4; ++m)
#pragma unroll
                    for (int n = 0; n < 2; ++n) acc[a][b][m][n] = (f32x4){0.f, 0.f, 0.f, 0.f};
        cur = nxt; cA = nA; cB = nB; ++ui;
        if constexpr (ALIGN_EPI) { if (wr == 1) PG8_BAR; }
    }
    PG8_WAIT_V(0);
    if constexpr (!ALIGN_EPI) { if (wr == 0) PG8_BAR; }
    PG8_BAR;
    if constexpr (Epi::AFTER_DRAIN) { E.fused(acc, cur, wr, wc, fr, fq, lds, wid, lane); S.done(cur); }
#undef PG8_SA
#undef PG8_SB
#undef PG8_STAGE
#undef PG8_LDA
#undef PG8_LDB
#undef PG8_MMA
#undef PG8_WAIT_V
#undef PG8_WAIT_L
#undef PG8_BAR
#undef PG8_SCHED
}
}
constexpr int BATCH = 4, SEQ = 4096, DM = 1024, NCH = 64, CH = 64, MTOK = BATCH * SEQ, DEPTH = 2;
constexpr int NPROJ = 3072, IN_COLS = 3088, FF = 2816;
constexpr float EPS = 1e-6f;
constexpr size_t MiB = 1u << 20;
constexpr size_t WS_SMALL = 1 * MiB, WS_ACS = 2 * MiB, WS_CDEC = 2 * MiB + 512 * 1024, WS_EGL = 2 * MiB + 768 * 1024;
constexpr size_t WS_WIN = 3 * MiB, WS_WOUT = 9 * MiB, WS_WGU = 11 * MiB, WS_WDN = 22 * MiB;
constexpr size_t WS_XN = 28 * MiB;
constexpr size_t WS_GU = 28 * MiB, WS_GW = 36 * MiB, WS_GQE = 44 * MiB, WS_GQK = 52 * MiB, WS_GKDT = 244 * MiB;
constexpr size_t WS_PROJ = 60 * MiB, WS_H = 60 * MiB;
constexpr size_t WS_MIX = 156 * MiB;
constexpr size_t WS_STATES = 188 * MiB, WS_YPART = 220 * MiB, WS_CCONV = 236 * MiB, WS_TMP = 188 * MiB;
constexpr size_t WS_END = 252 * MiB;
constexpr int LDS_BYTES = 147456;
#ifndef REP_C
#define REP_C 1
#endif
#ifndef REP_D
#define REP_D 1
#endif
#ifndef REP_E
#define REP_E 1
#endif

#define LAS __attribute__((address_space(3)))
#define DEV __device__ __forceinline__
typedef unsigned short bf16;
typedef short bf16x8 __attribute__((ext_vector_type(8)));
typedef float f32x4 __attribute__((ext_vector_type(4)));
typedef unsigned u32x4 __attribute__((ext_vector_type(4)));
typedef unsigned u32x2 __attribute__((ext_vector_type(2)));

DEV unsigned f2bf(float f) { unsigned u = __builtin_bit_cast(unsigned, f); return (u + 0x7fffu + ((u >> 16) & 1u)) >> 16; }
DEV unsigned pk2(float lo, float hi) { return f2bf(lo) | (f2bf(hi) << 16); }
DEV float bf2f(unsigned b) { return __builtin_bit_cast(float, b << 16); }
DEV float bflo(unsigned w) { return __builtin_bit_cast(float, w << 16); }
DEV float bfhi(unsigned w) { return __builtin_bit_cast(float, w & 0xffff0000u); }
DEV float silu(float x) { return x / (1.0f + __expf(-x)); }
DEV float softplus(float x) { return fmaxf(x, 0.f) + log1pf(expf(-fabsf(x))); }
DEV float wave_sum(float v) {
#pragma unroll
    for (int o = 1; o < 64; o <<= 1) v += __shfl_xor(v, o);
    return v;
}
DEV float wave_incl_scan(float v, int lane) {
#pragma unroll
    for (int o = 1; o < 64; o <<= 1) { const float t = __shfl_up(v, o); if (lane >= o) v += t; }
    return v;
}
DEV f32x4 mma_tile(const LAS bf16* A, int lda, const LAS bf16* B, int ldb, int K, int lane, f32x4 acc) {
    const LAS bf16* ap = A + (lane & 15) * lda + (lane >> 4) * 8;
    const LAS bf16* bp = B + (lane & 15) * ldb + (lane >> 4) * 8;
    for (int k = 0; k < K; k += 32) {
        const bf16x8 a = *(const LAS bf16x8*)(ap + k), b = *(const LAS bf16x8*)(bp + k);
        acc = __builtin_amdgcn_mfma_f32_16x16x32_bf16(a, b, acc, 0, 0, 0);
    }
    return acc;
}

struct Params {
    const float *x, *pre_mix, *post_mix, *pre_ffn, *post_ffn, *w_in, *w_out, *sinks, *sconv_w, *sconv_b, *sdt_bias, *sA_log, *sD, *snorm_w,
                *gconv_w, *gdt_bias, *gA_log, *gnorm_w, *w_gate, *w_up, *w_down;
    float* out; unsigned char* ws;
};

DEV void tr_item(const float* W, int ldw, int col0, bf16* WT, int K, int drow0, int rs, LAS float* scr, int kb, int nb, int lane) {
    const int k0 = 64 * kb, n0 = 32 * nb;
#pragma unroll 8
    for (int i = 0; i < 32; ++i) { const int kk = 2 * i + (lane >> 5); scr[kk * 33 + (lane & 31)] = W[(size_t)(k0 + kk) * ldw + col0 + n0 + (lane & 31)]; }
    asm volatile("s_waitcnt lgkmcnt(0)" ::: "memory");
    const int c = lane & 7;
#pragma unroll
    for (int j = 0; j < 4; ++j) { const int n = (lane >> 3) + 8 * j; const LAS float* s = scr + (8 * c) * 33 + n;
        u32x4 o; o.x = pk2(s[0 * 33], s[1 * 33]); o.y = pk2(s[2 * 33], s[3 * 33]); o.z = pk2(s[4 * 33], s[5 * 33]); o.w = pk2(s[6 * 33], s[7 * 33]);
        *(u32x4*)(WT + (size_t)(drow0 + (n0 + n) * rs) * K + k0 + 8 * c) = o; }
    asm volatile("s_waitcnt lgkmcnt(0)" ::: "memory");
}
DEV void convert_weights(const Params& p, int l, LAS unsigned char* lds, int gw, int NGW, int wave, int lane) {
    LAS float* scr = (LAS float*)(lds + wave * 8448);
    const float* win = p.w_in + (size_t)l * DM * IN_COLS; const float* wout = p.w_out + (size_t)l * DM * DM;
    const float* wg = p.w_gate + (size_t)l * DM * FF; const float* wu = p.w_up + (size_t)l * DM * FF; const float* wd = p.w_down + (size_t)l * FF * DM;
    bf16* WIN = (bf16*)(p.ws + WS_WIN); bf16* WOUT = (bf16*)(p.ws + WS_WOUT); bf16* WGU = (bf16*)(p.ws + WS_WGU); bf16* WDN = (bf16*)(p.ws + WS_WDN);
    constexpr int I_IN = 16 * 96, I_OUT = 16 * 32, I_G = 16 * 88, I_D = 44 * 32;
    constexpr int NIT = I_IN + I_OUT + 2 * I_G + I_D;
    for (int it = gw; it < NIT; it += NGW) {
        int r = it;
        if (r < I_IN) { const int kb = r / 96, nb = r % 96;
            if (nb < 64) tr_item(win, IN_COLS, 0, WIN, DM, 0, 1, scr, kb, nb, lane); else tr_item(win, IN_COLS, 2056, WIN, DM, 2048, 1, scr, kb, nb - 64, lane);
            continue; } r -= I_IN;
        if (r < I_OUT) { tr_item(wout, DM, 0, WOUT, DM, 0, 1, scr, r / 32, r % 32, lane); continue; } r -= I_OUT;
        if (r < I_G) { tr_item(wg, FF, 0, WGU, DM, 0, 2, scr, r / 88, r % 88, lane); continue; } r -= I_G;
        if (r < I_G) { tr_item(wu, FF, 0, WGU, DM, 1, 2, scr, r / 88, r % 88, lane); continue; } r -= I_G;
        tr_item(wd, DM, 0, WDN, FF, 0, 1, scr, r / 32, r % 32, lane);
    }
}
DEV void stage_small(const Params& p, int l, LAS float* wsT, int tid) {
    const float* win = p.w_in + (size_t)l * DM * IN_COLS;
    for (int idx = tid; idx < 16 * DM; idx += 512) { const int k = idx >> 4, c = idx & 15; const int sc = c < 8 ? 2048 + c : 3072 + c; wsT[c * DM + k] = win[(size_t)k * IN_COLS + sc]; }
}
template <int MODE>
DEV void rowpass(const float* res, const float* tmp, const float* wpost, const float* wnext, float* xout, bf16* XN, float* SMALL, const LAS float* wsT, int gw, int NGW, int lane) {
    f32x4 wp[4], wn[4];
#pragma unroll
    for (int j = 0; j < 4; ++j) {
        if (MODE != 0) wp[j] = *((const f32x4*)wpost + lane + 64 * j);
        if (MODE != 3) wn[j] = *((const f32x4*)wnext + lane + 64 * j);
    }
    for (int m = gw; m < MTOK; m += NGW) {
        f32x4 v[4];
#pragma unroll
        for (int j = 0; j < 4; ++j) v[j] = *((const f32x4*)(res + (size_t)m * DM) + lane + 64 * j);
        if (MODE != 0) {
            f32x4 t[4]; float ss = 0.f;
#pragma unroll
            for (int j = 0; j < 4; ++j) { t[j] = *((const f32x4*)(tmp + (size_t)m * DM) + lane + 64 * j); ss += (t[j].x * t[j].x + t[j].y * t[j].y) + (t[j].z * t[j].z + t[j].w * t[j].w); }
            const float rstd = rsqrtf(wave_sum(ss) * (1.0f / DM) + EPS);
#pragma unroll
            for (int j = 0; j < 4; ++j) { v[j] = v[j] + t[j] * rstd * wp[j]; *((f32x4*)(xout + (size_t)m * DM) + lane + 64 * j) = v[j]; }
        }
        if (MODE != 3) {
            float ss = 0.f;
#pragma unroll
            for (int j = 0; j < 4; ++j) ss += (v[j].x * v[j].x + v[j].y * v[j].y) + (v[j].z * v[j].z + v[j].w * v[j].w);
            const float rstd = rsqrtf(wave_sum(ss) * (1.0f / DM) + EPS);
#pragma unroll
            for (int j = 0; j < 4; ++j) { v[j] = v[j] * rstd * wn[j];
                u32x2 o; o.x = pk2(v[j].x, v[j].y); o.y = pk2(v[j].z, v[j].w); *((u32x2*)(XN + (size_t)m * DM) + lane + 64 * j) = o; }
            if (MODE == 0 || MODE == 2) {
                float part[16];
#pragma unroll
                for (int c = 0; c < 16; ++c) { float s = 0.f; asm volatile("" ::: "memory");
#pragma unroll
                    for (int j = 0; j < 4; ++j) { const f32x4 w = *((const LAS f32x4*)(wsT + c * DM) + lane + 64 * j); s += (v[j].x * w.x + v[j].y * w.y) + (v[j].z * w.z + v[j].w * w.w); }
                    part[c] = wave_sum(s); }
                float mine = 0.f;
#pragma unroll
                for (int c = 0; c < 16; ++c) mine = (lane == c) ? part[c] : mine;
                if (lane < 16) SMALL[(size_t)m * 16 + lane] = mine;
            }
        }
    }
}

DEV void attn_unit(const Params& p, int l, int u, LAS unsigned char* lds, int tid) {
    asm volatile("" : "+v"(tid));
    const int b = u >> 7, c = (u >> 1) & 63, kvh = u & 1, wave = tid >> 6, lane = tid & 63;
    const bf16* PROJ = (const bf16*)(p.ws + WS_PROJ); bf16* MIX = (bf16*)(p.ws + WS_MIX);
    LAS bf16* Qs = (LAS bf16*)lds;
    LAS bf16* Ks = Qs + 128 * 72;
    LAS bf16* Vt = Ks + 192 * 72;
    LAS bf16* Ps = Vt + 64 * 200;
    const size_t t0 = (size_t)b * SEQ + (size_t)c * CH;
    {
        u32x4 rq[2], rk[3], rv[3];
#pragma unroll
        for (int k = 0; k < 2; ++k) { const int idx = tid + k * 512, r = idx >> 3, v = idx & 7, g = r >> 6, i = r & 63;
            rq[k] = *(const u32x4*)(PROJ + (t0 + i) * NPROJ + kvh * 128 + g * 64 + v * 8); }
#pragma unroll
        for (int k = 0; k < 3; ++k) { const int idx = tid + k * 512, j = idx >> 3, v = idx & 7; const bool valid = (c - 2 + (j >> 6)) >= 0;
            rk[k] = (u32x4){0u, 0u, 0u, 0u}; rv[k] = rk[k];
            if (valid) { const bf16* rowp = PROJ + (size_t)((long)t0 - 128 + j) * NPROJ; rk[k] = *(const u32x4*)(rowp + 256 + kvh * 64 + v * 8); rv[k] = *(const u32x4*)(rowp + 384 + kvh * 64 + v * 8); } }
#pragma unroll
        for (int k = 0; k < 2; ++k) { const int idx = tid + k * 512, r = idx >> 3, v = idx & 7; *(LAS u32x4*)(Qs + r * 72 + v * 8) = rq[k]; }
#pragma unroll
        for (int k = 0; k < 3; ++k) { const int idx = tid + k * 512, j = idx >> 3, v = idx & 7; const u32x4 vv = rv[k];
            *(LAS u32x4*)(Ks + j * 72 + v * 8) = rk[k];
            LAS bf16* vt = Vt + (v * 8) * 200 + j;
            vt[0 * 200] = (bf16)(vv.x & 0xffffu); vt[1 * 200] = (bf16)(vv.x >> 16); vt[2 * 200] = (bf16)(vv.y & 0xffffu); vt[3 * 200] = (bf16)(vv.y >> 16);
            vt[4 * 200] = (bf16)(vv.z & 0xffffu); vt[5 * 200] = (bf16)(vv.z >> 16); vt[6 * 200] = (bf16)(vv.w & 0xffffu); vt[7 * 200] = (bf16)(vv.w >> 16); }
    }
    __syncthreads();
    {
        const int g = wave >> 2, h = kvh * 2 + g;
        const float slope = exp2f(-2.0f * (float)(h + 1)), sink = p.sinks[l * 4 + h];
        f32x4 s[12];
#pragma unroll
        for (int nt = 0; nt < 12; ++nt) s[nt] = mma_tile(Qs + wave * 16 * 72, 72, Ks + nt * 16 * 72, 72, 64, lane, (f32x4){0.f, 0.f, 0.f, 0.f});
#pragma unroll
        for (int j = 0; j < 4; ++j) {
            const int r = wave * 16 + (lane >> 4) * 4 + j, i = r & 63;
            float mx = sink;
#pragma unroll
            for (int nt = 0; nt < 12; ++nt) { const int jj = nt * 16 + (lane & 15);
                float val = s[nt][j] * 0.125f - slope * fabsf((float)(i + 128 - jj));
                if (c - 2 + (nt >> 2) < 0) val = -INFINITY;
                s[nt][j] = val; mx = fmaxf(mx, val); }
            mx = fmaxf(mx, __shfl_xor(mx, 1)); mx = fmaxf(mx, __shfl_xor(mx, 2)); mx = fmaxf(mx, __shfl_xor(mx, 4)); mx = fmaxf(mx, __shfl_xor(mx, 8));
            float sum = 0.f;
#pragma unroll
            for (int nt = 0; nt < 12; ++nt) { const float e = __expf(s[nt][j] - mx); s[nt][j] = e; sum += e; }
            sum += __shfl_xor(sum, 1); sum += __shfl_xor(sum, 2); sum += __shfl_xor(sum, 4); sum += __shfl_xor(sum, 8);
            sum += __expf(sink - mx);
            const float inv = 1.0f / sum;
#pragma unroll
            for (int nt = 0; nt < 12; ++nt) Ps[r * 200 + nt * 16 + (lane & 15)] = (bf16)f2bf(s[nt][j] * inv);
        }
    }
    __syncthreads();
#pragma unroll
    for (int nt = 0; nt < 4; ++nt) {
        const f32x4 acc = mma_tile(Vt + nt * 16 * 200, 200, Ps + wave * 16 * 200, 200, 192, lane, (f32x4){0.f, 0.f, 0.f, 0.f});
        const int r = wave * 16 + (lane & 15), g = r >> 6, i = r & 63, d0 = nt * 16 + (lane >> 4) * 4;
        u32x2 o; o.x = pk2(acc[0], acc[1]); o.y = pk2(acc[2], acc[3]);
        *(u32x2*)(MIX + (t0 + i) * DM + (kvh * 2 + g) * 64 + d0) = o;
    }
    __syncthreads();
}

template <int NCOLS> struct RawTile {
    static constexpr int VPR = NCOLS / 8, NV = 67 * VPR, NIT = (NV + 511) / 512;
    u32x4 r[NIT];
    DEV void issue(const bf16* PROJ, size_t t0, int c, int col0, int tid) {
#pragma unroll
        for (int k = 0; k < NIT; ++k) { const int idx = tid + k * 512, row = idx / VPR, v = idx % VPR;
            r[k] = (u32x4){0u, 0u, 0u, 0u};
            if (idx < NV && (c > 0 || row >= 3)) r[k] = *(const u32x4*)(PROJ + (size_t)((long)t0 - 3 + row) * NPROJ + col0 + v * 8); }
    }
    DEV void commit(LAS bf16* Raw, int rawld, int dcol0, int tid) const {
#pragma unroll
        for (int k = 0; k < NIT; ++k) { const int idx = tid + k * 512, row = idx / VPR, v = idx % VPR;
            if (idx < NV) *(LAS u32x4*)(Raw + row * rawld + dcol0 + v * 8) = r[k]; }
    }
};
DEV void ssd_p1_unit(const Params& p, int l, int u, LAS unsigned char* lds, int tid) {
    asm volatile("" : "+v"(tid));
    const int b = u >> 7, c = (u >> 1) & 63, g = u & 1, wave = tid >> 6, lane = tid & 63;
    const bf16* PROJ = (const bf16*)(p.ws + WS_PROJ);
    const float* SMALL = (const float*)(p.ws + WS_SMALL);
    float* ACS = (float*)(p.ws + WS_ACS); float* CDEC = (float*)(p.ws + WS_CDEC);
    bf16* STATES = (bf16*)(p.ws + WS_STATES); bf16* YPART = (bf16*)(p.ws + WS_YPART); bf16* CCONV = (bf16*)(p.ws + WS_CCONV);
    LAS bf16* XsT = (LAS bf16*)lds;
    LAS bf16* Bm = XsT + 4 * 64 * 72;
    LAS bf16* Cm = Bm + 64 * 136;
    LAS bf16* BmT = Cm + 64 * 136;
    LAS bf16* Sc = BmT + 128 * 72;
    LAS bf16* Raw = Sc;
    LAS float* dtS = (LAS float*)(Sc + 4 * 64 * 72);
    LAS float* acsS = dtS + 256;
    LAS float* fS = acsS + 256;
    const size_t t0 = (size_t)b * SEQ + (size_t)c * CH;
    RawTile<256> R1; RawTile<128> R2b, R2c;
    R1.issue(PROJ, t0, c, 1024 + g * 256, tid); R2b.issue(PROJ, t0, c, 1024 + 512 + g * 128, tid); R2c.issue(PROJ, t0, c, 1024 + 768 + g * 128, tid);
    if (tid < 256) {
        const int h = tid >> 6, hh = g * 4 + h;
        const float dt = softplus(SMALL[(t0 + lane) * 16 + hh] + p.sdt_bias[l * 8 + hh]);
        const float a = -expf(p.sA_log[l * 8 + hh]);
        const float acs = wave_incl_scan(dt * a, lane);
        const float alast = __shfl(acs, 63);
        dtS[tid] = dt; acsS[tid] = acs; fS[tid] = dt * expf(alast - acs);
        ACS[(t0 + lane) * 8 + hh] = acs;
        if (lane == 63) CDEC[((size_t)b * NCH + c) * 8 + hh] = expf(acs);
    }
    R1.commit(Raw, 256, 0, tid);
    __syncthreads();
    {
        const int ch = tid & 255, half = tid >> 8, chg = g * 256 + ch, h = ch >> 6, pp = ch & 63;
        const float* cw = p.sconv_w + (size_t)l * 4096 + chg; const float w0 = cw[0], w1 = cw[1024], w2 = cw[2048], w3 = cw[3072], bias = p.sconv_b[l * 1024 + chg];
        const int r0 = half * 32;
        float x0 = bf2f(Raw[(r0 + 0) * 256 + ch]), x1 = bf2f(Raw[(r0 + 1) * 256 + ch]), x2 = bf2f(Raw[(r0 + 2) * 256 + ch]);
        LAS bf16* dst = XsT + h * 64 * 72 + pp * 72 + r0;
        for (int r = 0; r < 32; ++r) { const float x3 = bf2f(Raw[(r0 + r + 3) * 256 + ch]);
            const float y = silu(w0 * x0 + w1 * x1 + w2 * x2 + w3 * x3 + bias);
            dst[r] = (bf16)f2bf(y); x0 = x1; x1 = x2; x2 = x3; }
    }
    __syncthreads();
    R2b.commit(Raw, 256, 0, tid); R2c.commit(Raw, 256, 128, tid);
    __syncthreads();
    {
        const int ch = tid & 255, half = tid >> 8, isC = ch >> 7, n = ch & 127, chg = 512 + isC * 256 + g * 128 + n;
        const float* cw = p.sconv_w + (size_t)l * 4096 + chg; const float w0 = cw[0], w1 = cw[1024], w2 = cw[2048], w3 = cw[3072], bias = p.sconv_b[l * 1024 + chg];
        const int r0 = half * 32;
        float x0 = bf2f(Raw[(r0 + 0) * 256 + ch]), x1 = bf2f(Raw[(r0 + 1) * 256 + ch]), x2 = bf2f(Raw[(r0 + 2) * 256 + ch]);
        for (int r = 0; r < 32; ++r) { const float x3 = bf2f(Raw[(r0 + r + 3) * 256 + ch]);
            const bf16 y = (bf16)f2bf(silu(w0 * x0 + w1 * x1 + w2 * x2 + w3 * x3 + bias));
            if (isC) Cm[(r0 + r) * 136 + n] = y; else { Bm[(r0 + r) * 136 + n] = y; BmT[n * 72 + r0 + r] = y; }
            x0 = x1; x1 = x2; x2 = x3; }
    }
    __syncthreads();
    for (int idx = tid; idx < 1024; idx += 512) { const int r = idx >> 4, v = idx & 15; *(u32x4*)(CCONV + (t0 + r) * 256 + g * 128 + v * 8) = *(const LAS u32x4*)(Cm + r * 136 + v * 8); }
#pragma unroll
    for (int ti = 0; ti < 2; ++ti) {
        const int tt = wave * 2 + ti, mt = tt >> 2, nt = tt & 3;
        f32x4 acc = (f32x4){0.f, 0.f, 0.f, 0.f};
        if (nt <= mt) acc = mma_tile(Bm + nt * 16 * 136, 136, Cm + mt * 16 * 136, 136, 128, lane, acc);
        const int lr = mt * 16 + (lane & 15), s0 = nt * 16 + (lane >> 4) * 4;
#pragma unroll
        for (int h = 0; h < 4; ++h) { const f32x4 as = *(const LAS f32x4*)(acsS + h * 64 + s0), ds = *(const LAS f32x4*)(dtS + h * 64 + s0); const float al = acsS[h * 64 + lr];
            float v[4];
#pragma unroll
            for (int j = 0; j < 4; ++j) v[j] = (s0 + j <= lr) ? acc[j] * __expf(al - as[j]) * ds[j] : 0.f;
            u32x2 o; o.x = pk2(v[0], v[1]); o.y = pk2(v[2], v[3]);
            *(LAS u32x2*)(Sc + h * 64 * 72 + lr * 72 + s0) = o; }
    }
    __syncthreads();
    {
        const int h = wave >> 1, hh = g * 4 + h; const float Dh = p.sD[l * 8 + hh];
#pragma unroll 2
        for (int ti = 0; ti < 8; ++ti) { const int tt = (wave & 1) * 8 + ti, mt = tt >> 2, nt = tt & 3;
            const f32x4 acc = mma_tile(XsT + h * 64 * 72 + nt * 16 * 72, 72, Sc + h * 64 * 72 + mt * 16 * 72, 72, 64, lane, (f32x4){0.f, 0.f, 0.f, 0.f});
            const int lr = mt * 16 + (lane & 15), p0 = nt * 16 + (lane >> 4) * 4;
            const LAS bf16* xp = XsT + h * 64 * 72 + p0 * 72 + lr;
            u32x2 o; o.x = pk2(acc[0] + Dh * bf2f(xp[0]), acc[1] + Dh * bf2f(xp[72])); o.y = pk2(acc[2] + Dh * bf2f(xp[144]), acc[3] + Dh * bf2f(xp[216]));
            *(u32x2*)(YPART + (t0 + lr) * 512 + hh * 64 + p0) = o; }
#pragma unroll
        for (int pi = 0; pi < 2; ++pi) { const int pt = (wave & 1) * 2 + pi;
            bf16x8 xf[2];
#pragma unroll
            for (int k = 0; k < 2; ++k) { const int l0 = k * 32 + (lane >> 4) * 8;
                const u32x4 xw = *(const LAS u32x4*)(XsT + h * 64 * 72 + (pt * 16 + (lane & 15)) * 72 + l0);
                const f32x4 f0 = *(const LAS f32x4*)(fS + h * 64 + l0), f1 = *(const LAS f32x4*)(fS + h * 64 + l0 + 4);
                u32x4 o; o.x = pk2(bflo(xw.x) * f0.x, bfhi(xw.x) * f0.y); o.y = pk2(bflo(xw.y) * f0.z, bfhi(xw.y) * f0.w);
                o.z = pk2(bflo(xw.z) * f1.x, bfhi(xw.z) * f1.y); o.w = pk2(bflo(xw.w) * f1.z, bfhi(xw.w) * f1.w);
                xf[k] = __builtin_bit_cast(bf16x8, o); }
            for (int nt = 0; nt < 8; ++nt) {
                f32x4 acc = (f32x4){0.f, 0.f, 0.f, 0.f};
#pragma unroll
                for (int k = 0; k < 2; ++k) { const bf16x8 bfr = *(const LAS bf16x8*)(BmT + (nt * 16 + (lane & 15)) * 72 + k * 32 + (lane >> 4) * 8);
                    acc = __builtin_amdgcn_mfma_f32_16x16x32_bf16(bfr, xf[k], acc, 0, 0, 0); }
                u32x2 o; o.x = pk2(acc[0], acc[1]); o.y = pk2(acc[2], acc[3]);
                *(u32x2*)(STATES + ((((size_t)b * NCH + c) * 8 + hh) * 64 + pt * 16 + (lane & 15)) * 128 + nt * 16 + (lane >> 4) * 4) = o; } }
    }
    __syncthreads();
}
DEV void ssd_scan_unit(const Params& p, int u, int tid) {
    asm volatile("" : "+v"(tid));
    bf16* STATES = (bf16*)(p.ws + WS_STATES); const float* CDEC = (const float*)(p.ws + WS_CDEC);
    const int idx = u * 512 + tid, b = idx >> 14, rem = idx & 16383, hh = rem >> 11, pn = rem & 2047;
    bf16* base = STATES + ((size_t)b * NCH * 8 + hh) * 8192 + (size_t)pn * 4;
    const float* dec = CDEC + (size_t)b * NCH * 8 + hh;
    float s0 = 0.f, s1 = 0.f, s2 = 0.f, s3 = 0.f;
    for (int c0 = 0; c0 < NCH; c0 += 8) {
        u32x2 nw[8]; float d[8];
#pragma unroll
        for (int k = 0; k < 8; ++k) { nw[k] = *(const u32x2*)(base + (size_t)(c0 + k) * 8 * 8192); d[k] = dec[(c0 + k) * 8]; }
#pragma unroll
        for (int k = 0; k < 8; ++k) { u32x2 o; o.x = pk2(s0, s1); o.y = pk2(s2, s3); *(u32x2*)(base + (size_t)(c0 + k) * 8 * 8192) = o;
            s0 = s0 * d[k] + bflo(nw[k].x); s1 = s1 * d[k] + bfhi(nw[k].x); s2 = s2 * d[k] + bflo(nw[k].y); s3 = s3 * d[k] + bfhi(nw[k].y); }
    }
}
DEV void ssd_p3_unit(const Params& p, int l, int u, LAS unsigned char* lds, int tid) {
    asm volatile("" : "+v"(tid));
    const int b = u >> 7, c = (u >> 1) & 63, g = u & 1, wave = tid >> 6, lane = tid & 63;
    const bf16* PROJ = (const bf16*)(p.ws + WS_PROJ); const float* ACS = (const float*)(p.ws + WS_ACS);
    const bf16* STATES = (const bf16*)(p.ws + WS_STATES); const bf16* YPART = (const bf16*)(p.ws + WS_YPART); const bf16* CCONV = (const bf16*)(p.ws + WS_CCONV);
    bf16* MIX = (bf16*)(p.ws + WS_MIX);
    LAS bf16* Cm = (LAS bf16*)lds;
    LAS bf16* Prev = Cm + 64 * 136;
    LAS float* Gb = (LAS float*)Prev;
    LAS float* acsS = (LAS float*)(Prev + 4 * 64 * 136);
    const size_t t0 = (size_t)b * SEQ + (size_t)c * CH;
    const int h = wave >> 1, hh = g * 4 + h;
    u32x4 rc[2], rp[8]; u32x2 ry[8], rz[8]; float racs = 0.f;
#pragma unroll
    for (int k = 0; k < 2; ++k) { const int idx = tid + k * 512, r = idx >> 4, v = idx & 15; rc[k] = *(const u32x4*)(CCONV + (t0 + r) * 256 + g * 128 + v * 8); }
#pragma unroll
    for (int k = 0; k < 8; ++k) { const int idx = tid + k * 512, hq = idx >> 10, r = (idx >> 4) & 63, v = idx & 15;
        rp[k] = *(const u32x4*)(STATES + ((((size_t)b * NCH + c) * 8 + g * 4 + hq) * 64 + r) * 128 + v * 8); }
    if (tid < 256) racs = ACS[(t0 + (tid & 63)) * 8 + g * 4 + (tid >> 6)];
#pragma unroll
    for (int ti = 0; ti < 8; ++ti) { const int tt = (wave & 1) * 8 + ti, mt = tt >> 2, nt = tt & 3, lr = mt * 16 + (lane & 15), p0 = nt * 16 + (lane >> 4) * 4;
        ry[ti] = *(const u32x2*)(YPART + (t0 + lr) * 512 + hh * 64 + p0); rz[ti] = *(const u32x2*)(PROJ + (t0 + lr) * NPROJ + 512 + hh * 64 + p0); }
#pragma unroll
    for (int k = 0; k < 2; ++k) { const int idx = tid + k * 512, r = idx >> 4, v = idx & 15; *(LAS u32x4*)(Cm + r * 136 + v * 8) = rc[k]; }
#pragma unroll
    for (int k = 0; k < 8; ++k) { const int idx = tid + k * 512, hq = idx >> 10, r = (idx >> 4) & 63, v = idx & 15; *(LAS u32x4*)(Prev + hq * 64 * 136 + r * 136 + v * 8) = rp[k]; }
    if (tid < 256) acsS[tid] = racs;
    __syncthreads();
    f32x4 acc[8];
#pragma unroll
    for (int ti = 0; ti < 8; ++ti) { const int tt = (wave & 1) * 8 + ti, mt = tt >> 2, nt = tt & 3;
        acc[ti] = mma_tile(Prev + h * 64 * 136 + nt * 16 * 136, 136, Cm + mt * 16 * 136, 136, 128, lane, (f32x4){0.f, 0.f, 0.f, 0.f}); }
    __syncthreads();
#pragma unroll
    for (int ti = 0; ti < 8; ++ti) { const int tt = (wave & 1) * 8 + ti, mt = tt >> 2, nt = tt & 3, lr = mt * 16 + (lane & 15), p0 = nt * 16 + (lane >> 4) * 4;
        const float ea = __expf(acsS[h * 64 + lr]);
        f32x4 gv;
        gv.x = (bflo(ry[ti].x) + ea * acc[ti][0]) * silu(bflo(rz[ti].x)); gv.y = (bfhi(ry[ti].x) + ea * acc[ti][1]) * silu(bfhi(rz[ti].x));
        gv.z = (bflo(ry[ti].y) + ea * acc[ti][2]) * silu(bflo(rz[ti].y)); gv.w = (bfhi(ry[ti].y) + ea * acc[ti][3]) * silu(bfhi(rz[ti].y));
        *(LAS f32x4*)(Gb + lr * 260 + h * 64 + p0) = gv; }
    __syncthreads();
    {
        const int lr = tid >> 3, part = tid & 7;
        const f32x4* nwp = (const f32x4*)(p.snorm_w + (size_t)l * 512 + g * 256 + part * 32);
        f32x4 nw[8], v[8]; float ss = 0.f;
#pragma unroll
        for (int k = 0; k < 8; ++k) nw[k] = nwp[k];
#pragma unroll
        for (int k = 0; k < 8; ++k) { v[k] = *(const LAS f32x4*)(Gb + lr * 260 + part * 32 + k * 4); ss += (v[k].x * v[k].x + v[k].y * v[k].y) + (v[k].z * v[k].z + v[k].w * v[k].w); }
        ss += __shfl_xor(ss, 1); ss += __shfl_xor(ss, 2); ss += __shfl_xor(ss, 4);
        const float rstd = rsqrtf(ss * (1.0f / 256.0f) + EPS);
        bf16* dst = MIX + (t0 + lr) * DM + 256 + g * 256 + part * 32;
#pragma unroll
        for (int k = 0; k < 4; ++k) { const f32x4 a = v[2 * k] * rstd * nw[2 * k], bq = v[2 * k + 1] * rstd * nw[2 * k + 1];
            u32x4 o; o.x = pk2(a.x, a.y); o.y = pk2(a.z, a.w); o.z = pk2(bq.x, bq.y); o.w = pk2(bq.z, bq.w);
            *(u32x4*)(dst + 8 * k) = o; }
    }
    __syncthreads();
}

DEV void gdn_pre_unit(const Params& p, int l, int u, LAS unsigned char* lds, int tid) {
    asm volatile("" : "+v"(tid));
    const int b = u >> 8, c = (u >> 2) & 63, hg = u & 3, wave = tid >> 6, lane = tid & 63;
    const int ub = (b * 4 + hg) * 64 + c;
    const bf16* PROJ = (const bf16*)(p.ws + WS_PROJ); const float* SMALL = (const float*)(p.ws + WS_SMALL);
    bf16* GU = (bf16*)(p.ws + WS_GU) + (size_t)ub * 4096; bf16* GW = (bf16*)(p.ws + WS_GW) + (size_t)ub * 4096; bf16* GQE = (bf16*)(p.ws + WS_GQE) + (size_t)ub * 4096;
    bf16* GQK = (bf16*)(p.ws + WS_GQK) + (size_t)ub * 4096; bf16* GKDT = (bf16*)(p.ws + WS_GKDT) + (size_t)ub * 4096; float* EGL = (float*)(p.ws + WS_EGL);
    LAS bf16* Raw = (LAS bf16*)lds;
    LAS float* Qs = (LAS float*)(lds + 25728);
    LAS float* Ks = Qs + 64 * 65;
    LAS float* Vs = Ks + 64 * 65;
    LAS float* Am = Vs + 64 * 65;
    LAS float* betaS = Am + 64 * 64;
    LAS float* gcS = betaS + 64;
    LAS float* Xs = gcS + 64;
    LAS float* At = Xs + 64 * 128;
    const size_t t0 = (size_t)b * SEQ + (size_t)c * CH;
    u32x4 rr[4];
#pragma unroll
    for (int k = 0; k < 4; ++k) { const int idx = tid + k * 512, row = idx / 24, rem = idx % 24, seg = rem >> 3, v = rem & 7;
        rr[k] = (u32x4){0u, 0u, 0u, 0u};
        if (idx < 67 * 24 && (c > 0 || row >= 3)) rr[k] = *(const u32x4*)(PROJ + (size_t)((long)t0 - 3 + row) * NPROJ + 2048 + seg * 256 + hg * 64 + v * 8); }
    if (wave == 0) {
        const float beta = 1.0f / (1.0f + expf(-SMALL[(t0 + lane) * 16 + 8 + hg]));
        const float gg = -expf(p.gA_log[l * 4 + hg]) * softplus(SMALL[(t0 + lane) * 16 + 12 + hg] + p.gdt_bias[l * 4 + hg]);
        const float gc = wave_incl_scan(gg, lane);
        betaS[lane] = beta; gcS[lane] = gc;
        if (lane == 63) EGL[ub] = expf(gc);
    }
#pragma unroll
    for (int k = 0; k < 4; ++k) { const int idx = tid + k * 512, row = idx / 24, rem = idx % 24;
        if (idx < 67 * 24) *(LAS u32x4*)(Raw + row * 192 + rem * 8) = rr[k]; }
    __syncthreads();
#pragma unroll
    for (int seg = 0; seg < 3; ++seg) {
        const float* cw = p.gconv_w + (size_t)l * 3072 + seg * 256 + hg * 64 + lane; const float w0 = cw[0], w1 = cw[768], w2 = cw[1536], w3 = cw[2304];
        LAS float* dst = seg == 0 ? Qs : (seg == 1 ? Ks : Vs);
        const int r0 = wave * 8;
        float x0 = bf2f(Raw[(r0 + 0) * 192 + seg * 64 + lane]), x1 = bf2f(Raw[(r0 + 1) * 192 + seg * 64 + lane]), x2 = bf2f(Raw[(r0 + 2) * 192 + seg * 64 + lane]);
#pragma unroll
        for (int r = 0; r < 8; ++r) { const float x3 = bf2f(Raw[(r0 + r + 3) * 192 + seg * 64 + lane]);
            float y = silu(w0 * x0 + w1 * x1 + w2 * x2 + w3 * x3);
            if (seg < 2) { const float ss = wave_sum(y * y); y *= rsqrtf(ss + EPS); if (seg == 0) y *= 0.125f; }
            dst[(r0 + r) * 65 + lane] = y; x0 = x1; x1 = x2; x2 = x3; }
    }
    __syncthreads();
    {
        const int i = tid >> 3, j0 = (tid & 7) * 8;
        float kk[8], qk[8];
#pragma unroll
        for (int jj = 0; jj < 8; ++jj) { kk[jj] = 0.f; qk[jj] = 0.f; }
        if (j0 <= i) {
            for (int d = 0; d < 64; ++d) { const float ki = Ks[i * 65 + d], qi = Qs[i * 65 + d];
#pragma unroll
                for (int jj = 0; jj < 8; ++jj) { const float kj = Ks[(j0 + jj) * 65 + d]; kk[jj] += ki * kj; qk[jj] += qi * kj; } }
        }
        const float gi = gcS[i], bi = betaS[i];
        float qv[8];
#pragma unroll
        for (int jj = 0; jj < 8; ++jj) { const int j = j0 + jj; const float dec = (j <= i) ? expf(gi - gcS[j]) : 0.f;
            const float av = (j < i) ? bi * kk[jj] * dec : 0.f; Am[i * 64 + j] = av; At[j * 64 + i] = av; qv[jj] = (j <= i) ? qk[jj] * dec : 0.f; }
        u32x4 o; o.x = pk2(qv[0], qv[1]); o.y = pk2(qv[2], qv[3]); o.z = pk2(qv[4], qv[5]); o.w = pk2(qv[6], qv[7]);
        *(u32x4*)(GQK + i * 64 + j0) = o;
    }
    __syncthreads();
    if (tid < 128) {
        const int col = tid & 63; const bool isw = tid >= 64;
        LAS float* X = Xs + tid;
        bf16* dst = (isw ? GW : GU) + col;
#pragma unroll 1
        for (int rb = 0; rb < 4; ++rb) {
            float r[16];
#pragma unroll
            for (int ii = 0; ii < 16; ++ii) { const int i = rb * 16 + ii; const float bi = betaS[i];
                r[ii] = isw ? Ks[i * 65 + col] * bi * expf(gcS[i]) : Vs[i * 65 + col] * bi; }
#pragma unroll 2
            for (int j = 0; j < rb * 16; ++j) {
                const float xj = X[j * 128];
                const LAS f32x4* at = (const LAS f32x4*)(At + j * 64 + rb * 16);
                const f32x4 a0 = at[0], a1 = at[1], a2 = at[2], a3 = at[3];
                r[0] -= a0.x * xj; r[1] -= a0.y * xj; r[2] -= a0.z * xj; r[3] -= a0.w * xj;
                r[4] -= a1.x * xj; r[5] -= a1.y * xj; r[6] -= a1.z * xj; r[7] -= a1.w * xj;
                r[8] -= a2.x * xj; r[9] -= a2.y * xj; r[10] -= a2.z * xj; r[11] -= a2.w * xj;
                r[12] -= a3.x * xj; r[13] -= a3.y * xj; r[14] -= a3.z * xj; r[15] -= a3.w * xj;
            }
#pragma unroll
            for (int ii = 1; ii < 16; ++ii) {
                float acc = r[ii];
#pragma unroll
                for (int q = 0; q < 4; ++q) if (q * 4 < ii) { const f32x4 a = *(const LAS f32x4*)(Am + (rb * 16 + ii) * 64 + rb * 16 + q * 4);
                    if (q * 4 + 0 < ii) acc -= a.x * r[q * 4 + 0];
                    if (q * 4 + 1 < ii) acc -= a.y * r[q * 4 + 1];
                    if (q * 4 + 2 < ii) acc -= a.z * r[q * 4 + 2];
                    if (q * 4 + 3 < ii) acc -= a.w * r[q * 4 + 3]; }
                r[ii] = acc;
            }
#pragma unroll
            for (int ii = 0; ii < 16; ++ii) { X[(rb * 16 + ii) * 128] = r[ii]; dst[(rb * 16 + ii) * 64] = (bf16)f2bf(r[ii]); }
        }
    } else {
        const float glast = gcS[63];
        for (int idx = tid - 128; idx < 4096; idx += 384) { const int r = idx >> 6, d = idx & 63;
            GQE[idx] = (bf16)f2bf(Qs[r * 65 + d] * expf(gcS[r]));
            const int dd = idx >> 6, ll = idx & 63;
            GKDT[idx] = (bf16)f2bf(Ks[ll * 65 + dd] * expf(glast - gcS[ll])); }
    }
    __syncthreads();
}
DEV void gdn_scan_block(const Params& p, int bh, LAS unsigned char* lds, int tid) {
    asm volatile("" : "+v"(tid));
    const int b = bh >> 2, hg = bh & 3, wave = tid >> 6, lane = tid & 63;
    const size_t ub0 = (size_t)bh * 64;
    const bf16* GM[5] = {(const bf16*)(p.ws + WS_GW) + ub0 * 4096, (const bf16*)(p.ws + WS_GQE) + ub0 * 4096, (const bf16*)(p.ws + WS_GQK) + ub0 * 4096,
                         (const bf16*)(p.ws + WS_GKDT) + ub0 * 4096, (const bf16*)(p.ws + WS_GU) + ub0 * 4096};
    const float* EGL = (const float*)(p.ws + WS_EGL) + ub0;
    bf16* MIX = (bf16*)(p.ws + WS_MIX);
    LAS bf16* OPS = (LAS bf16*)lds;
    LAS bf16* St = OPS + 2 * 5 * 4608;
    LAS bf16* VnT = St + 2 * 4608;
    const int row = tid >> 3, vv = tid & 7;
    for (int idx = tid; idx < 4608; idx += 512) St[idx] = 0;
#pragma unroll
    for (int m = 0; m < 5; ++m) *(LAS u32x4*)(OPS + m * 4608 + row * 72 + vv * 8) = *(const u32x4*)(GM[m] + row * 64 + vv * 8);
    f32x4 Sacc[2] = {(f32x4){0.f, 0.f, 0.f, 0.f}, (f32x4){0.f, 0.f, 0.f, 0.f}};
    __syncthreads();
    for (int c = 0; c < NCH; ++c) {
        const LAS bf16* Wb = OPS + (c & 1) * 5 * 4608; const LAS bf16* QEb = Wb + 4608; const LAS bf16* QKb = Wb + 2 * 4608; const LAS bf16* KDTb = Wb + 3 * 4608; const LAS bf16* Ub = Wb + 4 * 4608;
        const LAS bf16* Sc = St + (c & 1) * 4608; LAS bf16* Sn = St + ((c + 1) & 1) * 4608;
        u32x4 nx[5];
        if (c + 1 < NCH) {
#pragma unroll
            for (int m = 0; m < 5; ++m) nx[m] = *(const u32x4*)(GM[m] + (size_t)(c + 1) * 4096 + row * 64 + vv * 8);
        }
        const float egl = EGL[c];
#pragma unroll
        for (int ti = 0; ti < 2; ++ti) { const int tt = wave * 2 + ti, mt = tt >> 2, nt = tt & 3;
            const f32x4 acc = mma_tile(Wb + mt * 16 * 72, 72, Sc + nt * 16 * 72, 72, 64, lane, (f32x4){0.f, 0.f, 0.f, 0.f});
            const int e = nt * 16 + (lane & 15), l0 = mt * 16 + (lane >> 4) * 4;
            float vn[4];
#pragma unroll
            for (int j = 0; j < 4; ++j) vn[j] = bf2f(Ub[(l0 + j) * 72 + e]) - acc[j];
            u32x2 o; o.x = pk2(vn[0], vn[1]); o.y = pk2(vn[2], vn[3]);
            *(LAS u32x2*)(VnT + e * 72 + l0) = o; }
        __syncthreads();
#pragma unroll
        for (int ti = 0; ti < 2; ++ti) { const int tt = wave * 2 + ti, mt = tt >> 2, nt = tt & 3;
            f32x4 acc = mma_tile(QEb + mt * 16 * 72, 72, Sc + nt * 16 * 72, 72, 64, lane, (f32x4){0.f, 0.f, 0.f, 0.f});
            acc = mma_tile(QKb + mt * 16 * 72, 72, VnT + nt * 16 * 72, 72, 64, lane, acc);
            const int e = nt * 16 + (lane & 15), l0 = mt * 16 + (lane >> 4) * 4;
            bf16* dst = MIX + ((size_t)b * SEQ + (size_t)c * CH + l0) * DM + 768 + hg * 64 + e;
#pragma unroll
            for (int j = 0; j < 4; ++j) dst[(size_t)j * DM] = (bf16)f2bf(acc[j]);
            Sacc[ti] = Sacc[ti] * egl;
            Sacc[ti] = mma_tile(KDTb + mt * 16 * 72, 72, VnT + nt * 16 * 72, 72, 64, lane, Sacc[ti]);
            u32x2 o; o.x = pk2(Sacc[ti][0], Sacc[ti][1]); o.y = pk2(Sacc[ti][2], Sacc[ti][3]);
            *(LAS u32x2*)(Sn + e * 72 + l0) = o; }
        if (c + 1 < NCH) {
            LAS bf16* nb = OPS + ((c + 1) & 1) * 5 * 4608;
#pragma unroll
            for (int m = 0; m < 5; ++m) *(LAS u32x4*)(nb + m * 4608 + row * 72 + vv * 8) = nx[m];
        }
        __syncthreads();
    }
}
DEV void gdn_post(const Params& p, int l, int gw, int NGW, int lane) {
    bf16* MIX = (bf16*)(p.ws + WS_MIX); const bf16* PROJ = (const bf16*)(p.ws + WS_PROJ);
    const f32x4 nw = *((const f32x4*)(p.gnorm_w + (size_t)l * 64) + (lane & 15));
    for (int m = gw; m < MTOK; m += NGW) {
        bf16* op = MIX + (size_t)m * DM + 768 + lane * 4;
        const u32x2 ow = *(const u32x2*)op; const u32x2 zw = *(const u32x2*)(PROJ + (size_t)m * NPROJ + 2816 + lane * 4);
        const float o0 = bflo(ow.x), o1 = bfhi(ow.x), o2 = bflo(ow.y), o3 = bfhi(ow.y);
        float ss = (o0 * o0 + o1 * o1) + (o2 * o2 + o3 * o3);
        ss += __shfl_xor(ss, 1); ss += __shfl_xor(ss, 2); ss += __shfl_xor(ss, 4); ss += __shfl_xor(ss, 8);
        const float rstd = rsqrtf(ss * (1.0f / 64.0f) + EPS);
        u32x2 r; r.x = pk2(o0 * rstd * nw.x * silu(bflo(zw.x)), o1 * rstd * nw.y * silu(bfhi(zw.x))); r.y = pk2(o2 * rstd * nw.z * silu(bflo(zw.y)), o3 * rstd * nw.w * silu(bfhi(zw.y)));
        *(u32x2*)op = r;
    }
}

#define XB_TMO      128
#define XB_XCNT(j)  (256  + 64 * (j))
#define XB_XSUB(j)  (1280 + 64 * (j))
#define XB_XGEN(j)  (2304 + 64 * (j))
#define XB_TOP      3328
#define XB_TOPGEN   3392
#define XCD_BAR_WORDS 3456
#define XB_SPIN_CAP (1u << 18)

__device__ __forceinline__ unsigned xb_ld(unsigned* p)              { return __hip_atomic_load(p, __ATOMIC_RELAXED, __HIP_MEMORY_SCOPE_AGENT); }
__device__ __forceinline__ unsigned xb_add(unsigned* p, unsigned v) { return __hip_atomic_fetch_add(p, v, __ATOMIC_RELAXED, __HIP_MEMORY_SCOPE_AGENT); }
__device__ __forceinline__ unsigned xb_xcc_id() { return (unsigned)__builtin_amdgcn_s_getreg((3 << 11) | 20) & 0xFu; }
#define XB_SPIN(cond, bar) do { unsigned _sp = 0; while (cond) { __builtin_amdgcn_s_sleep(1); \
    if ((++_sp & 255u) == 0u) { if (xb_ld(&(bar)[XB_TMO])) break; if (_sp > XB_SPIN_CAP) { atomicAdd(&(bar)[XB_TMO], 1u); break; } } } } while (0)

struct XcdBarrier {
    unsigned* bar; unsigned x;
    volatile LAS unsigned* st;
};

__device__ __forceinline__ XcdBarrier xcd_barrier_post(unsigned* bar, volatile LAS unsigned* st) {
    XcdBarrier b; b.bar = bar; b.x = xb_xcc_id(); b.st = st;
    if (threadIdx.x == 0) (void)xb_add(&bar[XB_XCNT(b.x)], 1u);
    return b;
}
__device__ __forceinline__ void xcd_barrier_complete(unsigned* bar, unsigned x, unsigned& nloc, unsigned& nx) {
    const unsigned G = gridDim.x * gridDim.y * gridDim.z;
    unsigned sum, cnt, mine, sp = 0u;
    for (;;) {
        sum = 0u; cnt = 0u; mine = 0u;
#pragma unroll
        for (unsigned j = 0; j < 16; ++j) { const unsigned c = xb_ld(&bar[XB_XCNT(j)]); sum += c; cnt += (c > 0u) ? 1u : 0u; mine = (j == x) ? c : mine; }
        if (sum == G) break;
        __builtin_amdgcn_s_sleep(1);
        if ((++sp & 255u) == 0u) { if (xb_ld(&bar[XB_TMO])) break; if (sp > XB_SPIN_CAP) { atomicAdd(&bar[XB_TMO], 1u); break; } }
    }
    nloc = mine > 0u ? mine : 1u; nx = cnt > 0u ? cnt : 1u;
}

__device__ __forceinline__ void xcd_barrier(const XcdBarrier& b) {
    asm volatile("s_waitcnt vmcnt(0)" ::: "memory");
    __syncthreads();
    if (threadIdx.x == 0) {
        unsigned* bar = b.bar;
        __builtin_amdgcn_s_waitcnt(0);
        unsigned nloc = b.st[0], nx = b.st[1];
        if (nloc == 0u) { xcd_barrier_complete(bar, b.x, nloc, nx); b.st[0] = nloc; b.st[1] = nx; }
        const unsigned old = xb_add(&bar[XB_XSUB(b.x)], 1u);
        const unsigned gen = old / nloc;
        if (old + 1u == (gen + 1u) * nloc) {
            __builtin_amdgcn_fence(__ATOMIC_RELEASE, "agent");
            asm volatile("s_waitcnt vmcnt(0)" ::: "memory");
            const unsigned og = xb_add(&bar[XB_TOP], 1u);
            const unsigned tg = og / nx;
            if (og + 1u == (tg + 1u) * nx) xb_add(&bar[XB_TOPGEN], 1u);
            else XB_SPIN(xb_ld(&bar[XB_TOPGEN]) == tg, bar);
            __builtin_amdgcn_fence(__ATOMIC_ACQUIRE, "agent");
            xb_add(&bar[XB_XGEN(b.x)], 1u);
            asm volatile("s_waitcnt vmcnt(0)" ::: "memory");
        } else {
            XB_SPIN(xb_ld(&bar[XB_XGEN(b.x)]) == gen, bar);
            __builtin_amdgcn_fence(__ATOMIC_ACQUIRE, "agent");
            asm volatile("s_waitcnt vmcnt(0)" ::: "memory");
        }
    }
    __syncthreads();
}
__global__ void __launch_bounds__(512, 2) fwd_megakernel(Params p) {
    extern __shared__ __attribute__((aligned(16))) unsigned char lds_raw[];
    cg::grid_group grid = cg::this_grid();
    LAS unsigned char* lds = (LAS unsigned char*)lds_raw;
    const int tid = threadIdx.x, lane = tid & 63, wave = __builtin_amdgcn_readfirstlane(tid >> 6);
    const int G = gridDim.x, bx = blockIdx.x, gw = bx * 8 + wave, NGW = G * 8;
    bf16* XN = (bf16*)(p.ws + WS_XN); float* SMALL = (float*)(p.ws + WS_SMALL); float* TMP = (float*)(p.ws + WS_TMP);
    bf16* PROJ = (bf16*)(p.ws + WS_PROJ); bf16* MIX = (bf16*)(p.ws + WS_MIX); bf16* HB = (bf16*)(p.ws + WS_H);
    LAS float* wsT = (LAS float*)(lds + 69632);
    volatile LAS unsigned* misc = (volatile LAS unsigned*)(lds + 147200);
    if (tid < 4) misc[tid] = 0u;
    __syncthreads();
    XcdBarrier xbar = xcd_barrier_post((unsigned*)p.ws, misc);
#define GSYNC() xcd_barrier(xbar)

#define PHASE_IDS() int tidp = threadIdx.x; int lq = l; asm volatile("" : "+v"(tidp), "+s"(lq)); const int lanep = tidp & 63; const int wavep = __builtin_amdgcn_readfirstlane(tidp >> 6); const int gwp = bx * 8 + wavep; (void)lanep; (void)gwp; (void)lq
#pragma unroll 1
    for (int l = 0; l < DEPTH; ++l) {
        {
            PHASE_IDS();
            convert_weights(p, lq, lds, gwp, NGW, wavep, lanep);
            if (lq == 0) {
                stage_small(p, 0, wsT, tidp);
                __syncthreads();
                rowpass<0>(p.x, nullptr, nullptr, p.pre_mix, nullptr, XN, SMALL, wsT, gwp, NGW, lanep);
            }
        }
        if (l == 0) grid.sync(); else GSYNC();
#ifdef REP_SYNC
        for (int rep = 0; rep < REP_SYNC; ++rep) GSYNC();
#endif
        {
            pg8::Gemm g{XN, (const bf16*)(p.ws + WS_WIN), MTOK, NPROJ, DM}; pg8::StaticOrder S; S.init(MTOK, NPROJ, G, bx);
            pg8::EpiStoreBf16 E{PROJ, NPROJ};
            pg8::gemm_phase<pg8::EpiStoreBf16, pg8::StaticOrder, true, true>(lds, g, S, E);
        }
        GSYNC();
        {
            PHASE_IDS();
            for (int rep = 0; rep < REP_C; ++rep) {
                if (rep) GSYNC();
                for (int u = bx; u < 1536; u += G) { if (u < 1024) gdn_pre_unit(p, lq, u, lds, tidp); else ssd_p1_unit(p, lq, u - 1024, lds, tidp); }
            }
        }
        GSYNC();
        {
            PHASE_IDS();
            for (int rep = 0; rep < REP_D; ++rep) {
                if (rep) GSYNC();
                if (bx < 16) gdn_scan_block(p, bx, lds, tidp);
                else { for (int u = bx - 16; u < 640; u += G - 16) { if (u < 128) { if (rep == 0) ssd_scan_unit(p, u, tidp); } else attn_unit(p, lq, u - 128, lds, tidp); } }
            }
        }
        GSYNC();
        {
            PHASE_IDS();
            for (int rep = 0; rep < REP_E; ++rep) {
                if (rep) GSYNC();
                for (int u = bx; u < 512; u += G) ssd_p3_unit(p, lq, u, lds, tidp);
            }
            gdn_post(p, lq, gwp, NGW, lanep);
        }
        GSYNC();
        {
            pg8::Gemm g{MIX, (const bf16*)(p.ws + WS_WOUT), MTOK, DM, DM}; pg8::StaticOrder S; S.init(MTOK, DM, G, bx);
            pg8::EpiStoreF32 E{TMP, DM};
            pg8::gemm_phase<pg8::EpiStoreF32, pg8::StaticOrder, true, true>(lds, g, S, E);
        }
        GSYNC();
        {
            PHASE_IDS();
            rowpass<1>(lq == 0 ? p.x : p.out, TMP, p.post_mix + (size_t)lq * DM, p.pre_ffn + (size_t)lq * DM, p.out, XN, nullptr, wsT, gwp, NGW, lanep);
        }
        GSYNC();
        {
            pg8::Gemm g{XN, (const bf16*)(p.ws + WS_WGU), MTOK, 2 * FF, DM}; pg8::StaticOrder S; S.init(MTOK, 2 * FF, G, bx);
            pg8::EpiSwiGLU E{HB, FF};
            pg8::gemm_phase<pg8::EpiSwiGLU, pg8::StaticOrder, true, true>(lds, g, S, E);
        }
        GSYNC();
        {
            pg8::Gemm g{HB, (const bf16*)(p.ws + WS_WDN), MTOK, DM, FF}; pg8::StaticOrder S; S.init(MTOK, DM, G, bx);
            pg8::EpiStoreF32 E{TMP, DM};
            pg8::gemm_phase<pg8::EpiStoreF32, pg8::StaticOrder, true, true>(lds, g, S, E);
        }
        GSYNC();
        {
            PHASE_IDS();
            if (lq + 1 < DEPTH) {
                stage_small(p, lq + 1, wsT, tidp);
                __syncthreads();
                rowpass<2>(p.out, TMP, p.post_ffn + (size_t)lq * DM, p.pre_mix + (size_t)(lq + 1) * DM, p.out, XN, SMALL, wsT, gwp, NGW, lanep);
                __syncthreads();
            } else {
                rowpass<3>(p.out, TMP, p.post_ffn + (size_t)lq * DM, nullptr, p.out, nullptr, nullptr, wsT, gwp, NGW, lanep);
            }
        }
    }
}

extern "C" void kernel_launch(void* const* d_in, const int* in_sizes, int n_in, void* d_out, int out_size, void* d_ws, size_t ws_size, hipStream_t stream) {
    static int grid = 0;
    if (grid == 0) {
        if (n_in != 21 || out_size != MTOK * DM || ws_size < WS_END) { fprintf(stderr, "kernel_launch: unexpected shapes (n_in %d out %d ws %zu)\n", n_in, out_size, ws_size); grid = -1; return; }
        int dev = 0, cus = 0, per_cu = 0;
        hipGetDevice(&dev); hipDeviceGetAttribute(&cus, hipDeviceAttributeMultiprocessorCount, dev);
        if (hipFuncSetAttribute((const void*)fwd_megakernel, hipFuncAttributeMaxDynamicSharedMemorySize, LDS_BYTES) != hipSuccess) { fprintf(stderr, "kernel_launch: hipFuncSetAttribute failed\n"); grid = -1; return; }
        hipOccupancyMaxActiveBlocksPerMultiprocessor(&per_cu, (const void*)fwd_megakernel, 512, LDS_BYTES);
        if (per_cu < 1) { fprintf(stderr, "kernel_launch: occupancy query says %d blocks per CU\n", per_cu); per_cu = 1; }
        (void)hipGetLastError();
        grid = cus;
    }
    if (grid < 0) return;
    if (hipMemsetAsync(d_ws, 0, 16384, stream) != hipSuccess) { fprintf(stderr, "kernel_launch: memset of the barrier words failed\n"); return; }
    Params p{};
    const float** pp = (const float**)&p;
    for (int i = 0; i < 21; ++i) pp[i] = (const float*)d_in[i];
    p.out = (float*)d_out; p.ws = (unsigned char*)d_ws;
    void* args[] = {&p};
    hipError_t e = hipLaunchCooperativeKernel((const void*)fwd_megakernel, dim3(grid), dim3(512), args, LDS_BYTES, stream);
    if (e != hipSuccess) fprintf(stderr, "cooperative launch failed: %s (grid %d)\n", hipGetErrorString(e), grid);
}
```

```cpp
#include <hip/hip_runtime.h>
#include <hip/hip_cooperative_groups.h>
#include <cstdio>
#include <cstdint>
namespace cg = cooperative_groups;
namespace pg8 {
#define PG8_LAS __attribute__((address_space(3)))
typedef unsigned short bf16_t;
typedef short bf16x8 __attribute__((ext_vector_type(8)));
typedef float f32x4 __attribute__((ext_vector_type(4)));
typedef unsigned u32x4 __attribute__((ext_vector_type(4)));
constexpr int BM = 256, BK = 64, HALF = 128, HTB = HALF * BK * 2  , STAGE_BYTES = 8 * HTB, NXCD = 8, WGM = 8;

__host__ __device__ __forceinline__ int lds_byte(int r, int c) { const int st = (r >> 4) * 2 + (c >> 5), rr = r & 15, cc = c & 31, ob = rr * 64 + cc * 2; return st * 1024 + (ob ^ (((ob >> 9) & 1) << 5)); }
__host__ __device__ __forceinline__ void stage_rc(int b, int& R, int& C) { const int st = b / 1024, sb = b % 1024, swz = sb ^ (((sb >> 9) & 1) << 5); R = (st >> 1) * 16 + swz / 64; C = (st & 1) * 32 + (swz % 64) / 2; }
__host__ __device__ __forceinline__ int perm32(int rho) { const int n = rho >> 4, i = rho & 15; return 8 * (i >> 2) + 4 * n + (i & 3); }

struct Unit { int pm, pn; };
struct Gemm { const bf16_t* A; const bf16_t* Bt; int M, N, K; };

struct StaticOrder {
    int nM, nN, nwg, G, c;
    __host__ __device__ void init(int M, int N, int G_, int c_) { nM = M / BM; nN = N / BM; nwg = nM * nN; G = G_; c = c_; }
    __host__ __device__ bool next(int i, Unit& u) const {
        const long L = (long)i * G + c; if (L >= nwg) return false;
        int wgid = (int)L; { const int q = nwg / NXCD, r = nwg % NXCD, xcd = wgid % NXCD, off = wgid / NXCD; wgid = (xcd < r ? xcd * (q + 1) : r * (q + 1) + (xcd - r) * q) + off; }
        const int nig = WGM * nN, gid = wgid / nig, fm = gid * WGM, gsz = (nM - fm) < WGM ? (nM - fm) : WGM;
        u.pm = fm + ((wgid % nig) % gsz); u.pn = (wgid % nig) / gsz; return true;
    }
    __device__ __forceinline__ void a_ready(const Unit&) const {}
    __device__ __forceinline__ void done(const Unit&) const {}
};

__device__ __forceinline__ unsigned cvt_pk_bf16(float lo, float hi) { unsigned r; asm volatile("v_cvt_pk_bf16_f32 %0, %1, %2" : "=v"(r) : "v"(lo), "v"(hi)); return r; }
typedef float f32x2 __attribute__((ext_vector_type(2)));
typedef unsigned u32x2 __attribute__((ext_vector_type(2)));
__device__ __forceinline__ float silu_f(float x) { return x * __builtin_amdgcn_rcpf(1.0f + __expf(-x)); }
struct EpiStoreBf16 {
    static constexpr bool PERM = true, AFTER_DRAIN = false;
    bf16_t* O; int ldc;
    __device__ __forceinline__ void operator()(const f32x4 (&acc)[2][2][4][2], const Unit& u, int wr, int wc, int fr, int fq) const {
        const int row0 = u.pm * BM + wr * 64 + fr, col0 = u.pn * BM + wc * 32 + 8 * fq;
#pragma unroll
        for (int ai = 0; ai < 2; ++ai)
#pragma unroll
            for (int m = 0; m < 4; ++m) { bf16_t* rowp = O + (size_t)(row0 + ai * HALF + m * 16) * ldc + col0;
#pragma unroll
                for (int bj = 0; bj < 2; ++bj) { const f32x4 v0 = acc[ai][bj][m][0], v1 = acc[ai][bj][m][1];
                    u32x4 w; w.x = cvt_pk_bf16(v0[0], v0[1]); w.y = cvt_pk_bf16(v0[2], v0[3]); w.z = cvt_pk_bf16(v1[0], v1[1]); w.w = cvt_pk_bf16(v1[2], v1[3]);
                    *(u32x4*)(rowp + bj * HALF) = w; } }
    }
};
struct EpiStoreF32 {
    static constexpr bool PERM = true, AFTER_DRAIN = false;
    float* O; int ldc;
    __device__ __forceinline__ void operator()(const f32x4 (&acc)[2][2][4][2], const Unit& u, int wr, int wc, int fr, int fq) const {
        const int row0 = u.pm * BM + wr * 64 + fr, col0 = u.pn * BM + wc * 32 + 8 * fq;
#pragma unroll
        for (int ai = 0; ai < 2; ++ai)
#pragma unroll
            for (int m = 0; m < 4; ++m) { float* rowp = O + (size_t)(row0 + ai * HALF + m * 16) * ldc + col0;
#pragma unroll
                for (int bj = 0; bj < 2; ++bj) { *(f32x4*)(rowp + bj * HALF) = acc[ai][bj][m][0]; *(f32x4*)(rowp + bj * HALF + 4) = acc[ai][bj][m][1]; } }
    }
};
struct EpiSwiGLU {
    static constexpr bool PERM = true, AFTER_DRAIN = false;
    bf16_t* H; int ldh;
    __device__ __forceinline__ void operator()(const f32x4 (&acc)[2][2][4][2], const Unit& u, int wr, int wc, int fr, int fq) const {
        const int row0 = u.pm * BM + wr * 64 + fr, col0 = u.pn * (BM / 2) + wc * 16 + 4 * fq;
#pragma unroll
        for (int ai = 0; ai < 2; ++ai)
#pragma unroll
            for (int m = 0; m < 4; ++m) { bf16_t* rowp = H + (size_t)(row0 + ai * HALF + m * 16) * ldh + col0;
#pragma unroll
                for (int bj = 0; bj < 2; ++bj) { const f32x4 v0 = acc[ai][bj][m][0], v1 = acc[ai][bj][m][1];
                    u32x2 w; w.x = cvt_pk_bf16(silu_f(v0[0]) * v0[1], silu_f(v0[2]) * v0[3]); w.y = cvt_pk_bf16(silu_f(v1[0]) * v1[1], silu_f(v1[2]) * v1[3]);
                    *(u32x2*)(rowp + bj * (HALF / 2)) = w; } }
    }
};
template <class Epi, class Sched, bool ALIGN_EPI = false, bool SP2 = false>
__device__ __forceinline__ void gemm_phase(PG8_LAS unsigned char* lds, const Gemm g, const Sched& S, const Epi& E) {
    int tid_l = threadIdx.x; asm volatile("" : "+v"(tid_l));
    const int tid = tid_l, wid = __builtin_amdgcn_readfirstlane(tid >> 6), lane = tid & 63, wr = wid >> 2, wc = wid & 3, fr = lane & 15, fq = lane >> 4;
    const int K = g.K, nt = K / BK;
    unsigned voffA[2], voffB[2];
#pragma unroll
    for (int i = 0; i < 2; ++i) { int R, C; stage_rc(tid * 16 + i * 8192, R, C); const int Rb = Epi::PERM ? ((R & ~31) + perm32(R & 31)) : R;
        voffA[i] = (unsigned)(R * K + C) * 2u; voffB[i] = (unsigned)(Rb * K + C) * 2u; }
    const size_t kstep = (size_t)(BK * 2);
    const size_t hstep = (size_t)HALF * K * 2;
    const size_t tstep = 2 * hstep;
    const unsigned ldsw = (unsigned)wid * 1024u;
    const int aoff = lds_byte(wr * 64 + fr, fq * 8), boff = lds_byte(wc * 32 + fr, fq * 8);
#define PG8_SA(b, h) (((b) * 2 + (h)) * HTB)
#define PG8_SB(b, h) ((4 + (b) * 2 + (h)) * HTB)
#define PG8_STAGE(bufoff, gbase, voff) do { _Pragma("unroll") for (int _i = 0; _i < 2; ++_i) \
        __builtin_amdgcn_global_load_lds((const unsigned*)((const char*)(gbase) + (voff)[_i]), (PG8_LAS unsigned*)(lds + (bufoff) + ldsw + _i * 8192), 16, 0, 0); } while (0)
#define PG8_LDA(dst, b, h) do { _Pragma("unroll") for (int m = 0; m < 4; ++m) _Pragma("unroll") for (int k = 0; k < 2; ++k) dst[m][k] = *(const PG8_LAS bf16x8*)(lds + PG8_SA(b, h) + aoff + m * 2048 + k * 1024); } while (0)
#define PG8_LDB(dst, b, h) do { _Pragma("unroll") for (int n = 0; n < 2; ++n) _Pragma("unroll") for (int k = 0; k < 2; ++k) dst[n][k] = *(const PG8_LAS bf16x8*)(lds + PG8_SB(b, h) + boff + n * 2048 + k * 1024); } while (0)
#define PG8_MMA(ai, bj, At, Bt) do { __builtin_amdgcn_s_setprio(1); _Pragma("unroll") for (int m = 0; m < 4; ++m) _Pragma("unroll") for (int n = 0; n < 2; ++n) _Pragma("unroll") for (int k = 0; k < 2; ++k) \
        acc[ai][bj][m][n] = __builtin_amdgcn_mfma_f32_16x16x32_bf16(Bt[n][k], At[m][k], acc[ai][bj][m][n], 0, 0, 0); __builtin_amdgcn_s_setprio(0); } while (0)
#define PG8_WAIT_V(n) asm volatile("s_waitcnt vmcnt(" #n ")" ::: "memory")
#define PG8_WAIT_L(n) asm volatile("s_waitcnt lgkmcnt(" #n ")" ::: "memory")
#define PG8_BAR __builtin_amdgcn_s_barrier()
#define PG8_SCHED __builtin_amdgcn_sched_barrier(0)
    Unit cur, nxt; int ui = 0;
    if (!S.next(0, cur)) return;
    f32x4 acc[2][2][4][2];
#pragma unroll
    for (int a = 0; a < 2; ++a)
#pragma unroll
        for (int b = 0; b < 2; ++b)
#pragma unroll
            for (int m = 0; m < 4; ++m)
#pragma unroll
                for (int n = 0; n < 2; ++n) acc[a][b][m][n] = (f32x4){0.f, 0.f, 0.f, 0.f};
    bf16x8 At[4][2], B0[2][2], B1[2][2];
    const char* cA = (const char*)g.A + (size_t)cur.pm * tstep; const char* cB = (const char*)g.Bt + (size_t)cur.pn * tstep;
    S.a_ready(cur);
    if constexpr (SP2) {
        PG8_STAGE(PG8_SB(0, 0), cB, voffB); PG8_STAGE(PG8_SB(0, 1), cB + hstep, voffB); PG8_STAGE(PG8_SA(0, 0), cA, voffA); PG8_STAGE(PG8_SA(0, 1), cA + hstep, voffA);
        if (wr == 1) PG8_BAR;
        PG8_WAIT_V(2); PG8_BAR;
        PG8_STAGE(PG8_SB(1, 0), cB + kstep, voffB); PG8_STAGE(PG8_SA(1, 0), cA + kstep, voffA); PG8_STAGE(PG8_SB(1, 1), cB + hstep + kstep, voffB);
        PG8_WAIT_V(6); PG8_BAR;
    } else {
        PG8_STAGE(PG8_SB(0, 0), cB, voffB); PG8_STAGE(PG8_SA(0, 0), cA, voffA); PG8_STAGE(PG8_SB(0, 1), cB + hstep, voffB); PG8_STAGE(PG8_SA(0, 1), cA + hstep, voffA);
        if (wr == 1) PG8_BAR;
        PG8_WAIT_V(4); PG8_BAR;
        PG8_STAGE(PG8_SB(1, 0), cB + kstep, voffB); PG8_STAGE(PG8_SA(1, 0), cA + kstep, voffA); PG8_STAGE(PG8_SB(1, 1), cB + hstep + kstep, voffB);
        PG8_WAIT_V(6); PG8_BAR;
    }
    for (;;) {
        const bool has_next = S.next(ui + 1, nxt);
        const char* nA = has_next ? (const char*)g.A + (size_t)nxt.pm * tstep : cA; const char* nB = has_next ? (const char*)g.Bt + (size_t)nxt.pn * tstep : cB;
        for (int t = 0; t < nt; t += 2) {
            const bool last = (t == nt - 2);
            const char* a1 = cA + (size_t)(t + 1) * kstep;
            const char* a2 = last ? nA : cA + (size_t)(t + 2) * kstep; const char* b2 = last ? nB : cB + (size_t)(t + 2) * kstep;
            const char* a3 = a2 + kstep; const char* b3 = b2 + kstep;
            if (last && has_next) S.a_ready(nxt);
            if constexpr (SP2) {
            PG8_LDB(B0, 0, 0); PG8_LDB(B1, 0, 1); PG8_SCHED; PG8_LDA(At, 0, 0); PG8_STAGE(PG8_SA(1, 1), a1 + hstep, voffA);
            PG8_WAIT_V(8); PG8_WAIT_L(0); PG8_BAR; PG8_MMA(0, 0, At, B0); PG8_MMA(0, 1, At, B1); PG8_BAR; PG8_SCHED;
            PG8_LDA(At, 0, 1); PG8_STAGE(PG8_SB(0, 0), b2, voffB); PG8_STAGE(PG8_SB(0, 1), b2 + hstep, voffB); PG8_STAGE(PG8_SA(0, 0), a2, voffA);
            PG8_WAIT_V(8); PG8_WAIT_L(0); PG8_BAR; PG8_MMA(1, 0, At, B0); PG8_MMA(1, 1, At, B1); PG8_BAR; PG8_SCHED;
            PG8_LDB(B0, 1, 0); PG8_LDB(B1, 1, 1); PG8_SCHED; PG8_LDA(At, 1, 0); PG8_STAGE(PG8_SA(0, 1), a2 + hstep, voffA);
            PG8_WAIT_V(8); PG8_WAIT_L(0); PG8_BAR; PG8_MMA(0, 0, At, B0); PG8_MMA(0, 1, At, B1); PG8_BAR; PG8_SCHED;
            PG8_LDA(At, 1, 1); PG8_STAGE(PG8_SB(1, 0), b3, voffB); PG8_STAGE(PG8_SB(1, 1), b3 + hstep, voffB); PG8_STAGE(PG8_SA(1, 0), a3, voffA);
            PG8_WAIT_V(8); PG8_WAIT_L(0); PG8_BAR; PG8_MMA(1, 0, At, B0); PG8_MMA(1, 1, At, B1); PG8_BAR; PG8_SCHED;
            } else {
            PG8_LDB(B0, 0, 0); PG8_SCHED; PG8_LDA(At, 0, 0); PG8_STAGE(PG8_SA(1, 1), a1 + hstep, voffA);
            PG8_WAIT_L(8); PG8_BAR; PG8_WAIT_L(0); PG8_MMA(0, 0, At, B0); PG8_BAR; PG8_SCHED;
            PG8_LDB(B1, 0, 1); PG8_STAGE(PG8_SB(0, 0), b2, voffB);
            PG8_BAR; PG8_WAIT_L(0); PG8_MMA(0, 1, At, B1); PG8_BAR;
            PG8_LDA(At, 0, 1); PG8_STAGE(PG8_SA(0, 0), a2, voffA);
            PG8_BAR; PG8_WAIT_L(0); PG8_MMA(1, 0, At, B0); PG8_BAR; PG8_SCHED;
            PG8_STAGE(PG8_SB(0, 1), b2 + hstep, voffB);
            PG8_WAIT_V(6); PG8_BAR; PG8_MMA(1, 1, At, B1); PG8_BAR;
            PG8_LDB(B0, 1, 0); PG8_SCHED; PG8_LDA(At, 1, 0); PG8_STAGE(PG8_SA(0, 1), a2 + hstep, voffA);
            PG8_WAIT_L(8); PG8_BAR; PG8_WAIT_L(0); PG8_MMA(0, 0, At, B0); PG8_BAR; PG8_SCHED;
            PG8_LDB(B1, 1, 1); PG8_STAGE(PG8_SB(1, 0), b3, voffB);
            PG8_BAR; PG8_WAIT_L(0); PG8_MMA(0, 1, At, B1); PG8_BAR;
            PG8_LDA(At, 1, 1); PG8_STAGE(PG8_SA(1, 0), a3, voffA);
            PG8_BAR; PG8_WAIT_L(0); PG8_MMA(1, 0, At, B0); PG8_BAR; PG8_SCHED;
            PG8_STAGE(PG8_SB(1, 1), b3 + hstep, voffB);
            PG8_WAIT_V(6); PG8_BAR; PG8_MMA(1, 1, At, B1); PG8_BAR;
            }
        }
        if constexpr (ALIGN_EPI) { if (wr == 0) PG8_BAR; }
        if constexpr (!Epi::AFTER_DRAIN) { E(acc, cur, wr, wc, fr, fq); S.done(cur); }
        if (!has_next) break;
#pragma unroll
        for (int a = 0; a < 2; ++a)
#pragma unroll
            for (int b = 0; b < 2; ++b)
#pragma unroll
                for (int m = 0; m < 4; ++m)
#pragma unroll
                    for (int n = 0; n < 2; ++n) acc[a][b][m][n] = (f32x4){0.f, 0.f, 0.f, 0.f};
        cur = nxt; cA = nA; cB = nB; ++ui;
        if constexpr (ALIGN_EPI) { if (wr == 1) PG8_BAR; }
    }
    PG8_WAIT_V(0);
    if constexpr (!ALIGN_EPI) { if (wr == 0) PG8_BAR; }
    PG8_BAR;
    if constexpr (Epi::AFTER_DRAIN) { E.fused(acc, cur, wr, wc, fr, fq, lds, wid, lane); S.done(cur); }
#undef PG8_SA
#undef PG8_SB
#undef PG8_STAGE
#undef PG8_LDA
#undef PG8_LDB
#undef PG8_MMA
#undef PG8_WAIT_V
#undef PG8_WAIT_L
#undef PG8_BAR
#undef PG8_SCHED
}
}
constexpr int BATCH = 4, SEQ = 4096, DM = 1024, NCH = 64, CH = 64, MTOK = BATCH * SEQ, DEPTH = 2;
constexpr int NPROJ = 3072, IN_COLS = 3088, FF = 2816;
constexpr float EPS = 1e-6f;
constexpr size_t MiB = 1u << 20;
constexpr size_t WS_SMALL = 1 * MiB, WS_ACS = 2 * MiB, WS_CDEC = 2 * MiB + 512 * 1024, WS_EGL = 2 * MiB + 768 * 1024;
constexpr size_t WS_WIN = 3 * MiB, WS_WOUT = 9 * MiB, WS_WGU = 11 * MiB, WS_WDN = 22 * MiB;
constexpr size_t WS_XN = 28 * MiB;
constexpr size_t WS_GU = 28 * MiB, WS_GW = 36 * MiB, WS_GQE = 44 * MiB, WS_GQK = 52 * MiB, WS_GKDT = 244 * MiB;
constexpr size_t WS_PROJ = 60 * MiB, WS_H = 60 * MiB;
constexpr size_t WS_MIX = 156 * MiB;
constexpr size_t WS_STATES = 188 * MiB, WS_YPART = 220 * MiB, WS_CCONV = 236 * MiB, WS_TMP = 188 * MiB;
constexpr size_t WS_END = 252 * MiB;
constexpr int LDS_BYTES = 147456;
#ifndef REP_C
#define REP_C 1
#endif
#ifndef RG_CONV
#define RG_CONV 1
#endif
#ifndef RG_KK
#define RG_KK 1
#endif
#ifndef RG_SOLVE
#define RG_SOLVE 1
#endif
#ifndef REP_C1
#define REP_C1 1
#endif
#ifndef REP_C2
#define REP_C2 1
#endif
#ifndef REP_D
#define REP_D 1
#endif
#ifndef REP_E
#define REP_E 1
#endif

#define LAS __attribute__((address_space(3)))
#define DEV __device__ __forceinline__
typedef unsigned short bf16;
typedef short bf16x8 __attribute__((ext_vector_type(8)));
typedef float f32x4 __attribute__((ext_vector_type(4)));
typedef unsigned u32x4 __attribute__((ext_vector_type(4)));
typedef unsigned u32x2 __attribute__((ext_vector_type(2)));

DEV unsigned f2bf(float f) { unsigned u = __builtin_bit_cast(unsigned, f); return (u + 0x7fffu + ((u >> 16) & 1u)) >> 16; }
DEV unsigned pk2(float lo, float hi) { return f2bf(lo) | (f2bf(hi) << 16); }
DEV float bf2f(unsigned b) { return __builtin_bit_cast(float, b << 16); }
DEV float bflo(unsigned w) { return __builtin_bit_cast(float, w << 16); }
DEV float bfhi(unsigned w) { return __builtin_bit_cast(float, w & 0xffff0000u); }
DEV float silu(float x) { return x * __builtin_amdgcn_rcpf(1.0f + __expf(-x)); }
DEV float softplus(float x) { return fmaxf(x, 0.f) + log1pf(expf(-fabsf(x))); }
template <int CTRL> DEV float dpp_f(float v) { return __builtin_bit_cast(float, __builtin_amdgcn_update_dpp(0, __builtin_bit_cast(int, v), CTRL, 0xF, 0xF, true)); }
DEV float red4_sum(float v) { v += dpp_f<0xB1>(v); v += dpp_f<0x4E>(v); return v; }
DEV float red8_sum(float v) { v = red4_sum(v); v += dpp_f<0x141>(v); return v; }
DEV float red16_sum(float v) { v = red8_sum(v); v += dpp_f<0x140>(v); return v; }
DEV float red16_max(float v) { v = fmaxf(v, dpp_f<0xB1>(v)); v = fmaxf(v, dpp_f<0x4E>(v)); v = fmaxf(v, dpp_f<0x141>(v)); v = fmaxf(v, dpp_f<0x140>(v)); return v; }
DEV float rdlane(float v, int l) { return __builtin_bit_cast(float, __builtin_amdgcn_readlane(__builtin_bit_cast(int, v), l)); }
DEV float wave_sum(float v) { v = red16_sum(v); return (rdlane(v, 0) + rdlane(v, 16)) + (rdlane(v, 32) + rdlane(v, 48)); }
DEV float wave_incl_scan(float v, int lane) {
    v += dpp_f<0x111>(v); v += dpp_f<0x112>(v); v += dpp_f<0x114>(v); v += dpp_f<0x118>(v);
    const float t0 = rdlane(v, 15), t1 = rdlane(v, 31), t2 = rdlane(v, 47);
    const int r = lane >> 4;
    return v + (r > 0 ? t0 : 0.f) + (r > 1 ? t1 : 0.f) + (r > 2 ? t2 : 0.f);
}
DEV float frcp(float x) { return __builtin_amdgcn_rcpf(x); }
DEV f32x4 mma_tile(const LAS bf16* A, int lda, const LAS bf16* B, int ldb, int K, int lane, f32x4 acc) {
    const LAS bf16* ap = A + (lane & 15) * lda + (lane >> 4) * 8;
    const LAS bf16* bp = B + (lane & 15) * ldb + (lane >> 4) * 8;
    for (int k = 0; k < K; k += 32) {
        const bf16x8 a = *(const LAS bf16x8*)(ap + k), b = *(const LAS bf16x8*)(bp + k);
        acc = __builtin_amdgcn_mfma_f32_16x16x32_bf16(a, b, acc, 0, 0, 0);
    }
    return acc;
}

struct Params {
    const float *x, *pre_mix, *post_mix, *pre_ffn, *post_ffn, *w_in, *w_out, *sinks, *sconv_w, *sconv_b, *sdt_bias, *sA_log, *sD, *snorm_w,
                *gconv_w, *gdt_bias, *gA_log, *gnorm_w, *w_gate, *w_up, *w_down;
    float* out; unsigned char* ws;
};

DEV void tr_item(const float* W, int ldw, int col0, bf16* WT, int K, int drow0, int rs, LAS float* scr, int kb, int nb, int lane) {
    const int k0 = 64 * kb, n0 = 32 * nb;
#pragma unroll 8
    for (int i = 0; i < 32; ++i) { const int kk = 2 * i + (lane >> 5); scr[kk * 33 + (lane & 31)] = W[(size_t)(k0 + kk) * ldw + col0 + n0 + (lane & 31)]; }
    asm volatile("s_waitcnt lgkmcnt(0)" ::: "memory");
    const int c = lane & 7;
#pragma unroll
    for (int j = 0; j < 4; ++j) { const int n = (lane >> 3) + 8 * j; const LAS float* s = scr + (8 * c) * 33 + n;
        u32x4 o; o.x = pk2(s[0 * 33], s[1 * 33]); o.y = pk2(s[2 * 33], s[3 * 33]); o.z = pk2(s[4 * 33], s[5 * 33]); o.w = pk2(s[6 * 33], s[7 * 33]);
        *(u32x4*)(WT + (size_t)(drow0 + (n0 + n) * rs) * K + k0 + 8 * c) = o; }
    asm volatile("s_waitcnt lgkmcnt(0)" ::: "memory");
}
DEV void convert_weights(const Params& p, int l, LAS unsigned char* lds, int gw, int NGW, int wave, int lane) {
    LAS float* scr = (LAS float*)(lds + wave * 8448);
    const float* win = p.w_in + (size_t)l * DM * IN_COLS; const float* wout = p.w_out + (size_t)l * DM * DM;
    const float* wg = p.w_gate + (size_t)l * DM * FF; const float* wu = p.w_up + (size_t)l * DM * FF; const float* wd = p.w_down + (size_t)l * FF * DM;
    bf16* WIN = (bf16*)(p.ws + WS_WIN); bf16* WOUT = (bf16*)(p.ws + WS_WOUT); bf16* WGU = (bf16*)(p.ws + WS_WGU); bf16* WDN = (bf16*)(p.ws + WS_WDN);
    constexpr int I_IN = 16 * 96, I_OUT = 16 * 32, I_G = 16 * 88, I_D = 44 * 32;
    constexpr int NIT = I_IN + I_OUT + 2 * I_G + I_D;
    for (int it = gw; it < NIT; it += NGW) {
        int r = it;
        if (r < I_IN) { const int kb = r / 96, nb = r % 96;
            if (nb < 64) tr_item(win, IN_COLS, 0, WIN, DM, 0, 1, scr, kb, nb, lane); else tr_item(win, IN_COLS, 2056, WIN, DM, 2048, 1, scr, kb, nb - 64, lane);
            continue; } r -= I_IN;
        if (r < I_OUT) { tr_item(wout, DM, 0, WOUT, DM, 0, 1, scr, r / 32, r % 32, lane); continue; } r -= I_OUT;
        if (r < I_G) { tr_item(wg, FF, 0, WGU, DM, 0, 2, scr, r / 88, r % 88, lane); continue; } r -= I_G;
        if (r < I_G) { tr_item(wu, FF, 0, WGU, DM, 1, 2, scr, r / 88, r % 88, lane); continue; } r -= I_G;
        tr_item(wd, DM, 0, WDN, FF, 0, 1, scr, r / 32, r % 32, lane);
    }
}
DEV void stage_small(const Params& p, int l, LAS float* wsT, int tid) {
    const float* win = p.w_in + (size_t)l * DM * IN_COLS;
    for (int idx = tid; idx < 16 * DM; idx += 512) { const int k = idx >> 4, c = idx & 15; const int sc = c < 8 ? 2048 + c : 3072 + c; wsT[c * DM + k] = win[(size_t)k * IN_COLS + sc]; }
}
template <int MODE>
DEV void rowpass(const float* res, const float* tmp, const float* wpost, const float* wnext, float* xout, bf16* XN, float* SMALL, const LAS float* wsT, int gw, int NGW, int lane) {
    f32x4 wp[4], wn[4];
#pragma unroll
    for (int j = 0; j < 4; ++j) {
        if (MODE != 0) wp[j] = *((const f32x4*)wpost + lane + 64 * j);
        if (MODE != 3) wn[j] = *((const f32x4*)wnext + lane + 64 * j);
    }
    for (int m = gw; m < MTOK; m += NGW) {
        f32x4 v[4];
#pragma unroll
        for (int j = 0; j < 4; ++j) v[j] = *((const f32x4*)(res + (size_t)m * DM) + lane + 64 * j);
        if (MODE != 0) {
            f32x4 t[4]; float ss = 0.f;
#pragma unroll
            for (int j = 0; j < 4; ++j) { t[j] = *((const f32x4*)(tmp + (size_t)m * DM) + lane + 64 * j); ss += (t[j].x * t[j].x + t[j].y * t[j].y) + (t[j].z * t[j].z + t[j].w * t[j].w); }
            const float rstd = rsqrtf(wave_sum(ss) * (1.0f / DM) + EPS);
#pragma unroll
            for (int j = 0; j < 4; ++j) { v[j] = v[j] + t[j] * rstd * wp[j]; *((f32x4*)(xout + (size_t)m * DM) + lane + 64 * j) = v[j]; }
        }
        if (MODE != 3) {
            float ss = 0.f;
#pragma unroll
            for (int j = 0; j < 4; ++j) ss += (v[j].x * v[j].x + v[j].y * v[j].y) + (v[j].z * v[j].z + v[j].w * v[j].w);
            const float rstd = rsqrtf(wave_sum(ss) * (1.0f / DM) + EPS);
#pragma unroll
            for (int j = 0; j < 4; ++j) { v[j] = v[j] * rstd * wn[j];
                u32x2 o; o.x = pk2(v[j].x, v[j].y); o.y = pk2(v[j].z, v[j].w); *((u32x2*)(XN + (size_t)m * DM) + lane + 64 * j) = o; }
            if (MODE == 0 || MODE == 2) {
                float mine = 0.f;
#pragma unroll
                for (int c = 0; c < 16; ++c) { float s = 0.f; asm volatile("" ::: "memory");
#pragma unroll
                    for (int j = 0; j < 4; ++j) { const f32x4 w = *((const LAS f32x4*)(wsT + c * DM) + lane + 64 * j); s += (v[j].x * w.x + v[j].y * w.y) + (v[j].z * w.z + v[j].w * w.w); }
                    s = red16_sum(s); mine = ((lane & 15) == c) ? s : mine; }
                mine += __shfl_xor(mine, 16); mine += __shfl_xor(mine, 32);
                if (lane < 16) SMALL[(size_t)m * 16 + lane] = mine;
            }
        }
    }
}

DEV void attn_unit(const Params& p, int l, int u, LAS unsigned char* lds, int tid) {
    asm volatile("" : "+v"(tid));
    const int b = u >> 7, c = (u >> 1) & 63, kvh = u & 1, wave = tid >> 6, lane = tid & 63;
    const bf16* PROJ = (const bf16*)(p.ws + WS_PROJ); bf16* MIX = (bf16*)(p.ws + WS_MIX);
    LAS bf16* Qs = (LAS bf16*)lds;
    LAS bf16* Ks = Qs + 128 * 72;
    LAS bf16* Vt = Ks + 192 * 72;
    LAS bf16* Ps = Vt + 64 * 200;
    const size_t t0 = (size_t)b * SEQ + (size_t)c * CH;
    {
        u32x4 rq[2], rk[3], rv[3];
#pragma unroll
        for (int k = 0; k < 2; ++k) { const int idx = tid + k * 512, r = idx >> 3, v = idx & 7, g = r >> 6, i = r & 63;
            rq[k] = *(const u32x4*)(PROJ + (t0 + i) * NPROJ + kvh * 128 + g * 64 + v * 8); }
#pragma unroll
        for (int k = 0; k < 3; ++k) { const int idx = tid + k * 512, j = idx >> 3, v = idx & 7; const bool valid = (c - 2 + (j >> 6)) >= 0;
            rk[k] = (u32x4){0u, 0u, 0u, 0u}; rv[k] = rk[k];
            if (valid) { const bf16* rowp = PROJ + (size_t)((long)t0 - 128 + j) * NPROJ; rk[k] = *(const u32x4*)(rowp + 256 + kvh * 64 + v * 8); rv[k] = *(const u32x4*)(rowp + 384 + kvh * 64 + v * 8); } }
#pragma unroll
        for (int k = 0; k < 2; ++k) { const int idx = tid + k * 512, r = idx >> 3, v = idx & 7; *(LAS u32x4*)(Qs + r * 72 + v * 8) = rq[k]; }
#pragma unroll
        for (int k = 0; k < 3; ++k) { const int idx = tid + k * 512, j = idx >> 3, v = idx & 7; const u32x4 vv = rv[k];
            *(LAS u32x4*)(Ks + j * 72 + v * 8) = rk[k];
            LAS bf16* vt = Vt + (v * 8) * 200 + j;
            vt[0 * 200] = (bf16)(vv.x & 0xffffu); vt[1 * 200] = (bf16)(vv.x >> 16); vt[2 * 200] = (bf16)(vv.y & 0xffffu); vt[3 * 200] = (bf16)(vv.y >> 16);
            vt[4 * 200] = (bf16)(vv.z & 0xffffu); vt[5 * 200] = (bf16)(vv.z >> 16); vt[6 * 200] = (bf16)(vv.w & 0xffffu); vt[7 * 200] = (bf16)(vv.w >> 16); }
    }
    __syncthreads();
    {
        const int g = wave >> 2, h = kvh * 2 + g;
        const float slope = exp2f(-2.0f * (float)(h + 1)), sink = p.sinks[l * 4 + h];
        f32x4 s[12];
#pragma unroll
        for (int nt = 0; nt < 12; ++nt) s[nt] = mma_tile(Qs + wave * 16 * 72, 72, Ks + nt * 16 * 72, 72, 64, lane, (f32x4){0.f, 0.f, 0.f, 0.f});
#pragma unroll
        for (int j = 0; j < 4; ++j) {
            const int r = wave * 16 + (lane >> 4) * 4 + j, i = r & 63;
            float mx = sink;
#pragma unroll
            for (int nt = 0; nt < 12; ++nt) { const int jj = nt * 16 + (lane & 15);
                float val = s[nt][j] * 0.125f - slope * fabsf((float)(i + 128 - jj));
                if (c - 2 + (nt >> 2) < 0) val = -INFINITY;
                s[nt][j] = val; mx = fmaxf(mx, val); }
            mx = red16_max(mx);
            float sum = 0.f;
#pragma unroll
            for (int nt = 0; nt < 12; ++nt) { const float e = __expf(s[nt][j] - mx); s[nt][j] = e; sum += e; }
            sum = red16_sum(sum);
            sum += __expf(sink - mx);
            const float inv = frcp(sum);
#pragma unroll
            for (int nt = 0; nt < 12; ++nt) Ps[r * 200 + nt * 16 + (lane & 15)] = (bf16)f2bf(s[nt][j] * inv);
        }
    }
    __syncthreads();
#pragma unroll
    for (int nt = 0; nt < 4; ++nt) {
        const f32x4 acc = mma_tile(Vt + nt * 16 * 200, 200, Ps + wave * 16 * 200, 200, 192, lane, (f32x4){0.f, 0.f, 0.f, 0.f});
        const int r = wave * 16 + (lane & 15), g = r >> 6, i = r & 63, d0 = nt * 16 + (lane >> 4) * 4;
        u32x2 o; o.x = pk2(acc[0], acc[1]); o.y = pk2(acc[2], acc[3]);
        *(u32x2*)(MIX + (t0 + i) * DM + (kvh * 2 + g) * 64 + d0) = o;
    }
    __syncthreads();
}

template <int NCOLS> struct RawTile {
    static constexpr int VPR = NCOLS / 8, NV = 67 * VPR, NIT = (NV + 511) / 512;
    u32x4 r[NIT];
    DEV void issue(const bf16* PROJ, size_t t0, int c, int col0, int tid) {
#pragma unroll
        for (int k = 0; k < NIT; ++k) { const int idx = tid + k * 512, row = idx / VPR, v = idx % VPR;
            r[k] = (u32x4){0u, 0u, 0u, 0u};
            if (idx < NV && (c > 0 || row >= 3)) r[k] = *(const u32x4*)(PROJ + (size_t)((long)t0 - 3 + row) * NPROJ + col0 + v * 8); }
    }
    DEV void commit(LAS bf16* Raw, int rawld, int dcol0, int tid) const {
#pragma unroll
        for (int k = 0; k < NIT; ++k) { const int idx = tid + k * 512, row = idx / VPR, v = idx % VPR;
            if (idx < NV) *(LAS u32x4*)(Raw + row * rawld + dcol0 + v * 8) = r[k]; }
    }
};
DEV void ssd_p1_unit(const Params& p, int l, int u, LAS unsigned char* lds, int tid) {
    asm volatile("" : "+v"(tid));
    const int b = u >> 7, c = (u >> 1) & 63, g = u & 1, wave = tid >> 6, lane = tid & 63;
    const bf16* PROJ = (const bf16*)(p.ws + WS_PROJ);
    const float* SMALL = (const float*)(p.ws + WS_SMALL);
    float* ACS = (float*)(p.ws + WS_ACS); float* CDEC = (float*)(p.ws + WS_CDEC);
    bf16* STATES = (bf16*)(p.ws + WS_STATES); bf16* YPART = (bf16*)(p.ws + WS_YPART); bf16* CCONV = (bf16*)(p.ws + WS_CCONV);
    LAS bf16* XsT = (LAS bf16*)lds;
    LAS bf16* Bm = XsT + 4 * 64 * 72;
    LAS bf16* Cm = Bm + 64 * 136;
    LAS bf16* BmT = Cm + 64 * 136;
    LAS bf16* Sc = BmT + 128 * 72;
    LAS bf16* Raw = Sc;
    LAS float* dtS = (LAS float*)(Sc + 4 * 64 * 72);
    LAS float* acsS = dtS + 256;
    LAS float* fS = acsS + 256;
    const size_t t0 = (size_t)b * SEQ + (size_t)c * CH;
    RawTile<256> R1; RawTile<128> R2b, R2c;
    R1.issue(PROJ, t0, c, 1024 + g * 256, tid); R2b.issue(PROJ, t0, c, 1024 + 512 + g * 128, tid); R2c.issue(PROJ, t0, c, 1024 + 768 + g * 128, tid);
    if (tid < 256) {
        const int h = tid >> 6, hh = g * 4 + h;
        const float dt = softplus(SMALL[(t0 + lane) * 16 + hh] + p.sdt_bias[l * 8 + hh]);
        const float a = -expf(p.sA_log[l * 8 + hh]);
        const float acs = wave_incl_scan(dt * a, lane);
        const float alast = rdlane(acs, 63);
        dtS[tid] = dt; acsS[tid] = acs; fS[tid] = dt * expf(alast - acs);
        ACS[(t0 + lane) * 8 + hh] = acs;
        if (lane == 63) CDEC[((size_t)b * NCH + c) * 8 + hh] = expf(acs);
    }
    R1.commit(Raw, 256, 0, tid);
    __syncthreads();
    {
        const int ch = tid & 255, half = tid >> 8, chg = g * 256 + ch, h = ch >> 6, pp = ch & 63;
        const float* cw = p.sconv_w + (size_t)l * 4096 + chg; const float w0 = cw[0], w1 = cw[1024], w2 = cw[2048], w3 = cw[3072], bias = p.sconv_b[l * 1024 + chg];
        const int r0 = half * 32;
        float x0 = bf2f(Raw[(r0 + 0) * 256 + ch]), x1 = bf2f(Raw[(r0 + 1) * 256 + ch]), x2 = bf2f(Raw[(r0 + 2) * 256 + ch]);
        LAS bf16* dst = XsT + h * 64 * 72 + pp * 72 + r0;
        for (int r = 0; r < 32; ++r) { const float x3 = bf2f(Raw[(r0 + r + 3) * 256 + ch]);
            const float y = silu(w0 * x0 + w1 * x1 + w2 * x2 + w3 * x3 + bias);
            dst[r] = (bf16)f2bf(y); x0 = x1; x1 = x2; x2 = x3; }
    }
    __syncthreads();
    R2b.commit(Raw, 256, 0, tid); R2c.commit(Raw, 256, 128, tid);
    __syncthreads();
    {
        const int ch = tid & 255, half = tid >> 8, isC = ch >> 7, n = ch & 127, chg = 512 + isC * 256 + g * 128 + n;
        const float* cw = p.sconv_w + (size_t)l * 4096 + chg; const float w0 = cw[0], w1 = cw[1024], w2 = cw[2048], w3 = cw[3072], bias = p.sconv_b[l * 1024 + chg];
        const int r0 = half * 32;
        float x0 = bf2f(Raw[(r0 + 0) * 256 + ch]), x1 = bf2f(Raw[(r0 + 1) * 256 + ch]), x2 = bf2f(Raw[(r0 + 2) * 256 + ch]);
        for (int r = 0; r < 32; ++r) { const float x3 = bf2f(Raw[(r0 + r + 3) * 256 + ch]);
            const bf16 y = (bf16)f2bf(silu(w0 * x0 + w1 * x1 + w2 * x2 + w3 * x3 + bias));
            if (isC) Cm[(r0 + r) * 136 + n] = y; else { Bm[(r0 + r) * 136 + n] = y; BmT[n * 72 + r0 + r] = y; }
            x0 = x1; x1 = x2; x2 = x3; }
    }
    __syncthreads();
    for (int idx = tid; idx < 1024; idx += 512) { const int r = idx >> 4, v = idx & 15; *(u32x4*)(CCONV + (t0 + r) * 256 + g * 128 + v * 8) = *(const LAS u32x4*)(Cm + r * 136 + v * 8); }
#pragma unroll
    for (int ti = 0; ti < 2; ++ti) {
        const int tt = wave * 2 + ti, mt = tt >> 2, nt = tt & 3;
        f32x4 acc = (f32x4){0.f, 0.f, 0.f, 0.f};
        if (nt <= mt) acc = mma_tile(Bm + nt * 16 * 136, 136, Cm + mt * 16 * 136, 136, 128, lane, acc);
        const int lr = mt * 16 + (lane & 15), s0 = nt * 16 + (lane >> 4) * 4;
#pragma unroll
        for (int h = 0; h < 4; ++h) { const f32x4 as = *(const LAS f32x4*)(acsS + h * 64 + s0), ds = *(const LAS f32x4*)(dtS + h * 64 + s0); const float al = acsS[h * 64 + lr];
            float v[4];
#pragma unroll
            for (int j = 0; j < 4; ++j) v[j] = (s0 + j <= lr) ? acc[j] * __expf(al - as[j]) * ds[j] : 0.f;
            u32x2 o; o.x = pk2(v[0], v[1]); o.y = pk2(v[2], v[3]);
            *(LAS u32x2*)(Sc + h * 64 * 72 + lr * 72 + s0) = o; }
    }
    __syncthreads();
    {
        const int h = wave >> 1, hh = g * 4 + h; const float Dh = p.sD[l * 8 + hh];
#pragma unroll 2
        for (int ti = 0; ti < 8; ++ti) { const int tt = (wave & 1) * 8 + ti, mt = tt >> 2, nt = tt & 3;
            const f32x4 acc = mma_tile(XsT + h * 64 * 72 + nt * 16 * 72, 72, Sc + h * 64 * 72 + mt * 16 * 72, 72, 64, lane, (f32x4){0.f, 0.f, 0.f, 0.f});
            const int lr = mt * 16 + (lane & 15), p0 = nt * 16 + (lane >> 4) * 4;
            const LAS bf16* xp = XsT + h * 64 * 72 + p0 * 72 + lr;
            u32x2 o; o.x = pk2(acc[0] + Dh * bf2f(xp[0]), acc[1] + Dh * bf2f(xp[72])); o.y = pk2(acc[2] + Dh * bf2f(xp[144]), acc[3] + Dh * bf2f(xp[216]));
            *(u32x2*)(YPART + (t0 + lr) * 512 + hh * 64 + p0) = o; }
#pragma unroll
        for (int pi = 0; pi < 2; ++pi) { const int pt = (wave & 1) * 2 + pi;
            bf16x8 xf[2];
#pragma unroll
            for (int k = 0; k < 2; ++k) { const int l0 = k * 32 + (lane >> 4) * 8;
                const u32x4 xw = *(const LAS u32x4*)(XsT + h * 64 * 72 + (pt * 16 + (lane & 15)) * 72 + l0);
                const f32x4 f0 = *(const LAS f32x4*)(fS + h * 64 + l0), f1 = *(const LAS f32x4*)(fS + h * 64 + l0 + 4);
                u32x4 o; o.x = pk2(bflo(xw.x) * f0.x, bfhi(xw.x) * f0.y); o.y = pk2(bflo(xw.y) * f0.z, bfhi(xw.y) * f0.w);
                o.z = pk2(bflo(xw.z) * f1.x, bfhi(xw.z) * f1.y); o.w = pk2(bflo(xw.w) * f1.z, bfhi(xw.w) * f1.w);
                xf[k] = __builtin_bit_cast(bf16x8, o); }
            for (int nt = 0; nt < 8; ++nt) {
                f32x4 acc = (f32x4){0.f, 0.f, 0.f, 0.f};
#pragma unroll
                for (int k = 0; k < 2; ++k) { const bf16x8 bfr = *(const LAS bf16x8*)(BmT + (nt * 16 + (lane & 15)) * 72 + k * 32 + (lane >> 4) * 8);
                    acc = __builtin_amdgcn_mfma_f32_16x16x32_bf16(bfr, xf[k], acc, 0, 0, 0); }
                u32x2 o; o.x = pk2(acc[0], acc[1]); o.y = pk2(acc[2], acc[3]);
                *(u32x2*)(STATES + ((((size_t)b * NCH + c) * 8 + hh) * 64 + pt * 16 + (lane & 15)) * 128 + nt * 16 + (lane >> 4) * 4) = o; } }
    }
    __syncthreads();
}
DEV void ssd_scan_unit(const Params& p, int u, int tid) {
    asm volatile("" : "+v"(tid));
    bf16* STATES = (bf16*)(p.ws + WS_STATES); const float* CDEC = (const float*)(p.ws + WS_CDEC);
    const int idx = u * 512 + tid, b = idx >> 14, rem = idx & 16383, hh = rem >> 11, pn = rem & 2047;
    bf16* base = STATES + ((size_t)b * NCH * 8 + hh) * 8192 + (size_t)pn * 4;
    const float* dec = CDEC + (size_t)b * NCH * 8 + hh;
    float s0 = 0.f, s1 = 0.f, s2 = 0.f, s3 = 0.f;
    for (int c0 = 0; c0 < NCH; c0 += 8) {
        u32x2 nw[8]; float d[8];
#pragma unroll
        for (int k = 0; k < 8; ++k) { nw[k] = *(const u32x2*)(base + (size_t)(c0 + k) * 8 * 8192); d[k] = dec[(c0 + k) * 8]; }
#pragma unroll
        for (int k = 0; k < 8; ++k) { u32x2 o; o.x = pk2(s0, s1); o.y = pk2(s2, s3); *(u32x2*)(base + (size_t)(c0 + k) * 8 * 8192) = o;
            s0 = s0 * d[k] + bflo(nw[k].x); s1 = s1 * d[k] + bfhi(nw[k].x); s2 = s2 * d[k] + bflo(nw[k].y); s3 = s3 * d[k] + bfhi(nw[k].y); }
    }
}
DEV void ssd_p3_unit(const Params& p, int l, int u, LAS unsigned char* lds, int tid) {
    asm volatile("" : "+v"(tid));
    const int b = u >> 7, c = (u >> 1) & 63, g = u & 1, wave = tid >> 6, lane = tid & 63;
    const bf16* PROJ = (const bf16*)(p.ws + WS_PROJ); const float* ACS = (const float*)(p.ws + WS_ACS);
    const bf16* STATES = (const bf16*)(p.ws + WS_STATES); const bf16* YPART = (const bf16*)(p.ws + WS_YPART); const bf16* CCONV = (const bf16*)(p.ws + WS_CCONV);
    bf16* MIX = (bf16*)(p.ws + WS_MIX);
    LAS bf16* Cm = (LAS bf16*)lds;
    LAS bf16* Prev = Cm + 64 * 136;
    LAS float* Gb = (LAS float*)Prev;
    LAS float* acsS = (LAS float*)(Prev + 4 * 64 * 136);
    const size_t t0 = (size_t)b * SEQ + (size_t)c * CH;
    const int h = wave >> 1, hh = g * 4 + h;
    u32x4 rc[2], rp[8]; u32x2 ry[8], rz[8]; float racs = 0.f;
#pragma unroll
    for (int k = 0; k < 2; ++k) { const int idx = tid + k * 512, r = idx >> 4, v = idx & 15; rc[k] = *(const u32x4*)(CCONV + (t0 + r) * 256 + g * 128 + v * 8); }
#pragma unroll
    for (int k = 0; k < 8; ++k) { const int idx = tid + k * 512, hq = idx >> 10, r = (idx >> 4) & 63, v = idx & 15;
        rp[k] = *(const u32x4*)(STATES + ((((size_t)b * NCH + c) * 8 + g * 4 + hq) * 64 + r) * 128 + v * 8); }
    if (tid < 256) racs = ACS[(t0 + (tid & 63)) * 8 + g * 4 + (tid >> 6)];
#pragma unroll
    for (int ti = 0; ti < 8; ++ti) { const int tt = (wave & 1) * 8 + ti, mt = tt >> 2, nt = tt & 3, lr = mt * 16 + (lane & 15), p0 = nt * 16 + (lane >> 4) * 4;
        ry[ti] = *(const u32x2*)(YPART + (t0 + lr) * 512 + hh * 64 + p0); rz[ti] = *(const u32x2*)(PROJ + (t0 + lr) * NPROJ + 512 + hh * 64 + p0); }
#pragma unroll
    for (int k = 0; k < 2; ++k) { const int idx = tid + k * 512, r = idx >> 4, v = idx & 15; *(LAS u32x4*)(Cm + r * 136 + v * 8) = rc[k]; }
#pragma unroll
    for (int k = 0; k < 8; ++k) { const int idx = tid + k * 512, hq = idx >> 10, r = (idx >> 4) & 63, v = idx & 15; *(LAS u32x4*)(Prev + hq * 64 * 136 + r * 136 + v * 8) = rp[k]; }
    if (tid < 256) acsS[tid] = racs;
    __syncthreads();
    f32x4 acc[8];
#pragma unroll
    for (int ti = 0; ti < 8; ++ti) { const int tt = (wave & 1) * 8 + ti, mt = tt >> 2, nt = tt & 3;
        acc[ti] = mma_tile(Prev + h * 64 * 136 + nt * 16 * 136, 136, Cm + mt * 16 * 136, 136, 128, lane, (f32x4){0.f, 0.f, 0.f, 0.f}); }
    __syncthreads();
#pragma unroll
    for (int ti = 0; ti < 8; ++ti) { const int tt = (wave & 1) * 8 + ti, mt = tt >> 2, nt = tt & 3, lr = mt * 16 + (lane & 15), p0 = nt * 16 + (lane >> 4) * 4;
        const float ea = __expf(acsS[h * 64 + lr]);
        f32x4 gv;
        gv.x = (bflo(ry[ti].x) + ea * acc[ti][0]) * silu(bflo(rz[ti].x)); gv.y = (bfhi(ry[ti].x) + ea * acc[ti][1]) * silu(bfhi(rz[ti].x));
        gv.z = (bflo(ry[ti].y) + ea * acc[ti][2]) * silu(bflo(rz[ti].y)); gv.w = (bfhi(ry[ti].y) + ea * acc[ti][3]) * silu(bfhi(rz[ti].y));
        *(LAS f32x4*)(Gb + lr * 260 + h * 64 + p0) = gv; }
    __syncthreads();
    {
        const int lr = tid >> 3, part = tid & 7;
        const f32x4* nwp = (const f32x4*)(p.snorm_w + (size_t)l * 512 + g * 256 + part * 32);
        f32x4 nw[8], v[8]; float ss = 0.f;
#pragma unroll
        for (int k = 0; k < 8; ++k) nw[k] = nwp[k];
#pragma unroll
        for (int k = 0; k < 8; ++k) { v[k] = *(const LAS f32x4*)(Gb + lr * 260 + part * 32 + k * 4); ss += (v[k].x * v[k].x + v[k].y * v[k].y) + (v[k].z * v[k].z + v[k].w * v[k].w); }
        ss = red8_sum(ss);
        const float rstd = rsqrtf(ss * (1.0f / 256.0f) + EPS);
        bf16* dst = MIX + (t0 + lr) * DM + 256 + g * 256 + part * 32;
#pragma unroll
        for (int k = 0; k < 4; ++k) { const f32x4 a = v[2 * k] * rstd * nw[2 * k], bq = v[2 * k + 1] * rstd * nw[2 * k + 1];
            u32x4 o; o.x = pk2(a.x, a.y); o.y = pk2(a.z, a.w); o.z = pk2(bq.x, bq.y); o.w = pk2(bq.z, bq.w);
            *(u32x4*)(dst + 8 * k) = o; }
    }
    __syncthreads();
}

DEV void gdn_pre_unit(const Params& p, int l, int u, LAS unsigned char* lds, int tid) {
    asm volatile("" : "+v"(tid));
    const int b = u >> 8, c = (u >> 2) & 63, hg = u & 3, wave = tid >> 6, lane = tid & 63;
    const int ub = (b * 4 + hg) * 64 + c;
    const bf16* PROJ = (const bf16*)(p.ws + WS_PROJ); const float* SMALL = (const float*)(p.ws + WS_SMALL);
    bf16* GU = (bf16*)(p.ws + WS_GU) + (size_t)ub * 4096; bf16* GW = (bf16*)(p.ws + WS_GW) + (size_t)ub * 4096; bf16* GQE = (bf16*)(p.ws + WS_GQE) + (size_t)ub * 4096;
    bf16* GQK = (bf16*)(p.ws + WS_GQK) + (size_t)ub * 4096; bf16* GKDT = (bf16*)(p.ws + WS_GKDT) + (size_t)ub * 4096; float* EGL = (float*)(p.ws + WS_EGL);
    LAS bf16* Raw = (LAS bf16*)lds;
    LAS float* Xn = (LAS float*)lds;
    LAS float* Qs = (LAS float*)(lds + 25728);
    LAS float* Ks = Qs + 64 * 65;
    LAS float* Vs = Ks + 64 * 65;
    LAS float* Am = Vs + 64 * 65;
    LAS float* betaS = Am + 64 * 64;
    LAS float* gcS = betaS + 64;
    LAS float* scwS = gcS + 64;
    LAS float* egS = scwS + 64;
    LAS float* kdS = egS + 64;
    LAS float* R = kdS + 64;
    LAS float* At = R + 64 * 128;
    LAS float* Dv = At + 64 * 64;
    const size_t t0 = (size_t)b * SEQ + (size_t)c * CH;
    u32x4 rr[4];
#pragma unroll
    for (int k = 0; k < 4; ++k) { const int idx = tid + k * 512, row = idx / 24, rem = idx % 24, seg = rem >> 3, v = rem & 7;
        rr[k] = (u32x4){0u, 0u, 0u, 0u};
        if (idx < 67 * 24 && (c > 0 || row >= 3)) rr[k] = *(const u32x4*)(PROJ + (size_t)((long)t0 - 3 + row) * NPROJ + 2048 + seg * 256 + hg * 64 + v * 8); }
    if (wave == 0) {
        const float beta = frcp(1.0f + expf(-SMALL[(t0 + lane) * 16 + 8 + hg]));
        const float gg = -expf(p.gA_log[l * 4 + hg]) * softplus(SMALL[(t0 + lane) * 16 + 12 + hg] + p.gdt_bias[l * 4 + hg]);
        const float gc = wave_incl_scan(gg, lane);
        const float glast = rdlane(gc, 63), eg = expf(gc);
        betaS[lane] = beta; gcS[lane] = gc; scwS[lane] = beta * eg; egS[lane] = eg; kdS[lane] = expf(glast - gc);
        if (lane == 63) EGL[ub] = eg;
    }
#pragma unroll
    for (int k = 0; k < 4; ++k) { const int idx = tid + k * 512, row = idx / 24, rem = idx % 24;
        if (idx < 67 * 24) *(LAS u32x4*)(Raw + row * 192 + rem * 8) = rr[k]; }
    __syncthreads();
    for (int rq_ = 0; rq_ < RG_CONV; ++rq_)
#pragma unroll
    for (int seg = 0; seg < 3; ++seg) {
        const float* cw = p.gconv_w + (size_t)l * 3072 + seg * 256 + hg * 64 + lane; const float w0 = cw[0], w1 = cw[768], w2 = cw[1536], w3 = cw[2304];
        LAS float* dst = seg == 0 ? Qs : (seg == 1 ? Ks : Vs);
        const int r0 = wave * 8;
        float x0 = bf2f(Raw[(r0 + 0) * 192 + seg * 64 + lane]), x1 = bf2f(Raw[(r0 + 1) * 192 + seg * 64 + lane]), x2 = bf2f(Raw[(r0 + 2) * 192 + seg * 64 + lane]);
#pragma unroll
        for (int r = 0; r < 8; ++r) { const float x3 = bf2f(Raw[(r0 + r + 3) * 192 + seg * 64 + lane]);
            float y = silu(w0 * x0 + w1 * x1 + w2 * x2 + w3 * x3);
            if (seg < 2) { const float ss = wave_sum(y * y); y *= rsqrtf(ss + EPS); if (seg == 0) y *= 0.125f; }
            dst[(r0 + r) * 65 + lane] = y; x0 = x1; x1 = x2; x2 = x3; }
    }
    __syncthreads();
    for (int rq_ = 0; rq_ < RG_KK; ++rq_)
    {
        for (int t = wave; t < 20; t += 8) {
            const bool isqk = t >= 10; const int idx = isqk ? t - 10 : t;
            const int mt = idx >= 6 ? 3 : (idx >= 3 ? 2 : (idx >= 1 ? 1 : 0)), nt = idx - mt * (mt + 1) / 2;
            const LAS float* ap = (isqk ? Qs : Ks) + (mt * 16 + (lane & 15)) * 65 + (lane >> 4);
            const LAS float* bp = Ks + (nt * 16 + (lane & 15)) * 65 + (lane >> 4);
            f32x4 acc = (f32x4){0.f, 0.f, 0.f, 0.f};
#pragma unroll
            for (int ks = 0; ks < 16; ++ks) acc = __builtin_amdgcn_mfma_f32_16x16x4f32(ap[ks * 4], bp[ks * 4], acc, 0, 0, 0);
            const int j = nt * 16 + (lane & 15), i0 = mt * 16 + (lane >> 4) * 4; const float gj = gcS[j];
            float v[4];
#pragma unroll
            for (int jj = 0; jj < 4; ++jj) { const int i = i0 + jj; const float dec = (j <= i) ? __expf(gcS[i] - gj) : 0.f;
                v[jj] = isqk ? acc[jj] * dec : ((j < i) ? betaS[i] * acc[jj] * dec : 0.f); }
            if (!isqk) {
#pragma unroll
                for (int jj = 0; jj < 4; ++jj) Am[(i0 + jj) * 64 + j] = v[jj];
                *(LAS f32x4*)(At + j * 64 + i0) = (f32x4){v[0], v[1], v[2], v[3]};
            } else {
#pragma unroll
                for (int jj = 0; jj < 4; ++jj) GQK[(i0 + jj) * 64 + j] = (bf16)f2bf(v[jj]);
            }
        }
        { const int e0 = tid * 8, i = e0 >> 6, j = e0 & 63; if ((j >> 4) > (i >> 4)) *(u32x4*)(GQK + e0) = (u32x4){0u, 0u, 0u, 0u}; }
    }
    __syncthreads();
    for (int rq_ = 0; rq_ < RG_SOLVE; ++rq_) {
    if (wave == 7) {
        const int bb = lane >> 4, cc = lane & 15;
        float x[16];
#pragma unroll
        for (int i = 0; i < 16; ++i) {
            float acc = (i == cc) ? 1.f : 0.f;
#pragma unroll
            for (int q4 = 0; q4 < 4; ++q4) if (q4 * 4 < i) { const f32x4 a = *(const LAS f32x4*)(Am + (bb * 16 + i) * 64 + bb * 16 + q4 * 4);
                if (q4 * 4 + 0 < i) acc -= a.x * x[q4 * 4 + 0];
                if (q4 * 4 + 1 < i) acc -= a.y * x[q4 * 4 + 1];
                if (q4 * 4 + 2 < i) acc -= a.z * x[q4 * 4 + 2];
                if (q4 * 4 + 3 < i) acc -= a.w * x[q4 * 4 + 3]; }
            x[i] = acc;
            Dv[bb * 256 + i * 16 + cc] = acc;
        }
    } else {
#pragma unroll 4
        for (int e = tid; e < 8192; e += 448) { const int i = e >> 7, col = e & 127;
            R[e] = (col < 64) ? Vs[i * 65 + col] * betaS[i] : Ks[i * 65 + col - 64] * scwS[i]; }
#pragma unroll 4
        for (int e = tid; e < 4096; e += 448) { const int r = e >> 6, d = e & 63;
            GQE[e] = (bf16)f2bf(Qs[r * 65 + d] * egS[r]);
            GKDT[e] = (bf16)f2bf(Ks[d * 65 + r] * kdS[d]); }
    }
    __syncthreads();
    {
        const int col = tid & 127, q = tid >> 7;
        bf16* dstg = (col >= 64 ? GW : GU) + (col & 63);
#pragma unroll 1
        for (int rb = 0; rb < 4; ++rb) {
            if (rb > 0) {
                LAS float* rp = R + (16 * rb + 4 * q) * 128 + col;
                float r0 = rp[0], r1 = rp[128], r2 = rp[256], r3 = rp[384];
                const LAS float* xp = Xn + col; const LAS float* ap = At + 16 * rb + 4 * q;
#pragma unroll 8
                for (int j = 0; j < 16 * rb; ++j) { const float xj = xp[j * 128]; const f32x4 a = *(const LAS f32x4*)(ap + j * 64);
                    r0 -= a.x * xj; r1 -= a.y * xj; r2 -= a.z * xj; r3 -= a.w * xj; }
                rp[0] = r0; rp[128] = r1; rp[256] = r2; rp[384] = r3;
                __syncthreads();
            }
            float rv[16];
#pragma unroll
            for (int jj = 0; jj < 16; ++jj) rv[jj] = R[(16 * rb + jj) * 128 + col];
#pragma unroll
            for (int k = 0; k < 4; ++k) { const int ii = 4 * q + k; const LAS f32x4* dp = (const LAS f32x4*)(Dv + rb * 256 + ii * 16);
                const f32x4 d0 = dp[0], d1 = dp[1], d2 = dp[2], d3 = dp[3];
                const float acc = ((d0.x * rv[0] + d0.y * rv[1]) + (d0.z * rv[2] + d0.w * rv[3])) + ((d1.x * rv[4] + d1.y * rv[5]) + (d1.z * rv[6] + d1.w * rv[7]))
                                + ((d2.x * rv[8] + d2.y * rv[9]) + (d2.z * rv[10] + d2.w * rv[11])) + ((d3.x * rv[12] + d3.y * rv[13]) + (d3.z * rv[14] + d3.w * rv[15]));
                Xn[(16 * rb + ii) * 128 + col] = acc; dstg[(16 * rb + ii) * 64] = (bf16)f2bf(acc); }
            __syncthreads();
        }
    }
    }
}
DEV void gdn_scan_block(const Params& p, int bh, LAS unsigned char* lds, int tid) {
    asm volatile("" : "+v"(tid));
    const int b = bh >> 2, hg = bh & 3, wave = tid >> 6, lane = tid & 63;
    const size_t ub0 = (size_t)bh * 64;
    const bf16* GM[5] = {(const bf16*)(p.ws + WS_GW) + ub0 * 4096, (const bf16*)(p.ws + WS_GQE) + ub0 * 4096, (const bf16*)(p.ws + WS_GQK) + ub0 * 4096,
                         (const bf16*)(p.ws + WS_GKDT) + ub0 * 4096, (const bf16*)(p.ws + WS_GU) + ub0 * 4096};
    const float* EGL = (const float*)(p.ws + WS_EGL) + ub0;
    bf16* MIX = (bf16*)(p.ws + WS_MIX);
    LAS bf16* OPS = (LAS bf16*)lds;
    LAS bf16* St = OPS + 2 * 5 * 4608;
    LAS bf16* VnT = St + 2 * 4608;
    const int row = tid >> 3, vv = tid & 7;
    for (int idx = tid; idx < 4608; idx += 512) St[idx] = 0;
#pragma unroll
    for (int m = 0; m < 5; ++m) *(LAS u32x4*)(OPS + m * 4608 + row * 72 + vv * 8) = *(const u32x4*)(GM[m] + row * 64 + vv * 8);
    f32x4 Sacc[2] = {(f32x4){0.f, 0.f, 0.f, 0.f}, (f32x4){0.f, 0.f, 0.f, 0.f}};
    __syncthreads();
    for (int c = 0; c < NCH; ++c) {
        const LAS bf16* Wb = OPS + (c & 1) * 5 * 4608; const LAS bf16* QEb = Wb + 4608; const LAS bf16* QKb = Wb + 2 * 4608; const LAS bf16* KDTb = Wb + 3 * 4608; const LAS bf16* Ub = Wb + 4 * 4608;
        const LAS bf16* Sc = St + (c & 1) * 4608; LAS bf16* Sn = St + ((c + 1) & 1) * 4608;
        u32x4 nx[5];
        if (c + 1 < NCH) {
#pragma unroll
            for (int m = 0; m < 5; ++m) nx[m] = *(const u32x4*)(GM[m] + (size_t)(c + 1) * 4096 + row * 64 + vv * 8);
        }
        const float egl = EGL[c];
#pragma unroll
        for (int ti = 0; ti < 2; ++ti) { const int tt = wave * 2 + ti, mt = tt >> 2, nt = tt & 3;
            const f32x4 acc = mma_tile(Wb + mt * 16 * 72, 72, Sc + nt * 16 * 72, 72, 64, lane, (f32x4){0.f, 0.f, 0.f, 0.f});
            const int e = nt * 16 + (lane & 15), l0 = mt * 16 + (lane >> 4) * 4;
            float vn[4];
#pragma unroll
            for (int j = 0; j < 4; ++j) vn[j] = bf2f(Ub[(l0 + j) * 72 + e]) - acc[j];
            u32x2 o; o.x = pk2(vn[0], vn[1]); o.y = pk2(vn[2], vn[3]);
            *(LAS u32x2*)(VnT + e * 72 + l0) = o; }
        __syncthreads();
#pragma unroll
        for (int ti = 0; ti < 2; ++ti) { const int tt = wave * 2 + ti, mt = tt >> 2, nt = tt & 3;
            f32x4 acc = mma_tile(QEb + mt * 16 * 72, 72, Sc + nt * 16 * 72, 72, 64, lane, (f32x4){0.f, 0.f, 0.f, 0.f});
            acc = mma_tile(QKb + mt * 16 * 72, 72, VnT + nt * 16 * 72, 72, 64, lane, acc);
            const int e = nt * 16 + (lane & 15), l0 = mt * 16 + (lane >> 4) * 4;
            bf16* dst = MIX + ((size_t)b * SEQ + (size_t)c * CH + l0) * DM + 768 + hg * 64 + e;
#pragma unroll
            for (int j = 0; j < 4; ++j) dst[(size_t)j * DM] = (bf16)f2bf(acc[j]);
            Sacc[ti] = Sacc[ti] * egl;
            Sacc[ti] = mma_tile(KDTb + mt * 16 * 72, 72, VnT + nt * 16 * 72, 72, 64, lane, Sacc[ti]);
            u32x2 o; o.x = pk2(Sacc[ti][0], Sacc[ti][1]); o.y = pk2(Sacc[ti][2], Sacc[ti][3]);
            *(LAS u32x2*)(Sn + e * 72 + l0) = o; }
        if (c + 1 < NCH) {
            LAS bf16* nb = OPS + ((c + 1) & 1) * 5 * 4608;
#pragma unroll
            for (int m = 0; m < 5; ++m) *(LAS u32x4*)(nb + m * 4608 + row * 72 + vv * 8) = nx[m];
        }
        __syncthreads();
    }
}
DEV void gdn_post(const Params& p, int l, int gw, int NGW, int lane) {
    bf16* MIX = (bf16*)(p.ws + WS_MIX); const bf16* PROJ = (const bf16*)(p.ws + WS_PROJ);
    const f32x4 nw = *((const f32x4*)(p.gnorm_w + (size_t)l * 64) + (lane & 15));
    for (int m = gw; m < MTOK; m += NGW) {
        bf16* op = MIX + (size_t)m * DM + 768 + lane * 4;
        const u32x2 ow = *(const u32x2*)op; const u32x2 zw = *(const u32x2*)(PROJ + (size_t)m * NPROJ + 2816 + lane * 4);
        const float o0 = bflo(ow.x), o1 = bfhi(ow.x), o2 = bflo(ow.y), o3 = bfhi(ow.y);
        float ss = (o0 * o0 + o1 * o1) + (o2 * o2 + o3 * o3);
        ss = red16_sum(ss);
        const float rstd = rsqrtf(ss * (1.0f / 64.0f) + EPS);
        u32x2 r; r.x = pk2(o0 * rstd * nw.x * silu(bflo(zw.x)), o1 * rstd * nw.y * silu(bfhi(zw.x))); r.y = pk2(o2 * rstd * nw.z * silu(bflo(zw.y)), o3 * rstd * nw.w * silu(bfhi(zw.y)));
        *(u32x2*)op = r;
    }
}

#define XB_TMO      128
#define XB_XCNT(j)  (256  + 64 * (j))
#define XB_XSUB(j)  (1280 + 64 * (j))
#define XB_XGEN(j)  (2304 + 64 * (j))
#define XB_TOP      3328
#define XB_TOPGEN   3392
#define XCD_BAR_WORDS 3456
#define XB_SPIN_CAP (1u << 18)

__device__ __forceinline__ unsigned xb_ld(unsigned* p)              { return __hip_atomic_load(p, __ATOMIC_RELAXED, __HIP_MEMORY_SCOPE_AGENT); }
__device__ __forceinline__ unsigned xb_add(unsigned* p, unsigned v) { return __hip_atomic_fetch_add(p, v, __ATOMIC_RELAXED, __HIP_MEMORY_SCOPE_AGENT); }
__device__ __forceinline__ unsigned xb_xcc_id() { return (unsigned)__builtin_amdgcn_s_getreg((3 << 11) | 20) & 0xFu; }
#define XB_SPIN(cond, bar) do { unsigned _sp = 0; while (cond) { __builtin_amdgcn_s_sleep(1); \
    if ((++_sp & 255u) == 0u) { if (xb_ld(&(bar)[XB_TMO])) break; if (_sp > XB_SPIN_CAP) { atomicAdd(&(bar)[XB_TMO], 1u); break; } } } } while (0)

struct XcdBarrier {
    unsigned* bar; unsigned x;
    volatile LAS unsigned* st;
};

__device__ __forceinline__ XcdBarrier xcd_barrier_post(unsigned* bar, volatile LAS unsigned* st) {
    XcdBarrier b; b.bar = bar; b.x = xb_xcc_id(); b.st = st;
    if (threadIdx.x == 0) (void)xb_add(&bar[XB_XCNT(b.x)], 1u);
    return b;
}
__device__ __forceinline__ void xcd_barrier_complete(unsigned* bar, unsigned x, unsigned& nloc, unsigned& nx) {
    const unsigned G = gridDim.x * gridDim.y * gridDim.z;
    unsigned sum, cnt, mine, sp = 0u;
    for (;;) {
        sum = 0u; cnt = 0u; mine = 0u;
#pragma unroll
        for (unsigned j = 0; j < 16; ++j) { const unsigned c = xb_ld(&bar[XB_XCNT(j)]); sum += c; cnt += (c > 0u) ? 1u : 0u; mine = (j == x) ? c : mine; }
        if (sum == G) break;
        __builtin_amdgcn_s_sleep(1);
        if ((++sp & 255u) == 0u) { if (xb_ld(&bar[XB_TMO])) break; if (sp > XB_SPIN_CAP) { atomicAdd(&bar[XB_TMO], 1u); break; } }
    }
    nloc = mine > 0u ? mine : 1u; nx = cnt > 0u ? cnt : 1u;
}

__device__ __forceinline__ void xcd_barrier(const XcdBarrier& b) {
    asm volatile("s_waitcnt vmcnt(0)" ::: "memory");
    __syncthreads();
    if (threadIdx.x == 0) {
        unsigned* bar = b.bar;
        __builtin_amdgcn_s_waitcnt(0);
        unsigned nloc = b.st[0], nx = b.st[1];
        if (nloc == 0u) { xcd_barrier_complete(bar, b.x, nloc, nx); b.st[0] = nloc; b.st[1] = nx; }
        const unsigned old = xb_add(&bar[XB_XSUB(b.x)], 1u);
        const unsigned gen = old / nloc;
        if (old + 1u == (gen + 1u) * nloc) {
            __builtin_amdgcn_fence(__ATOMIC_RELEASE, "agent");
            asm volatile("s_waitcnt vmcnt(0)" ::: "memory");
            const unsigned og = xb_add(&bar[XB_TOP], 1u);
            const unsigned tg = og / nx;
            if (og + 1u == (tg + 1u) * nx) xb_add(&bar[XB_TOPGEN], 1u);
            else XB_SPIN(xb_ld(&bar[XB_TOPGEN]) == tg, bar);
            __builtin_amdgcn_fence(__ATOMIC_ACQUIRE, "agent");
            xb_add(&bar[XB_XGEN(b.x)], 1u);
            asm volatile("s_waitcnt vmcnt(0)" ::: "memory");
        } else {
            XB_SPIN(xb_ld(&bar[XB_XGEN(b.x)]) == gen, bar);
            __builtin_amdgcn_fence(__ATOMIC_ACQUIRE, "agent");
            asm volatile("s_waitcnt vmcnt(0)" ::: "memory");
        }
    }
    __syncthreads();
}
__global__ void __launch_bounds__(512, 2) fwd_megakernel(Params p) {
    extern __shared__ __attribute__((aligned(16))) unsigned char lds_raw[];
    cg::grid_group grid = cg::this_grid();
    LAS unsigned char* lds = (LAS unsigned char*)lds_raw;
    const int tid = threadIdx.x, lane = tid & 63, wave = __builtin_amdgcn_readfirstlane(tid >> 6);
    const int G = gridDim.x, bx = blockIdx.x, gw = bx * 8 + wave, NGW = G * 8;
    bf16* XN = (bf16*)(p.ws + WS_XN); float* SMALL = (float*)(p.ws + WS_SMALL); float* TMP = (float*)(p.ws + WS_TMP);
    bf16* PROJ = (bf16*)(p.ws + WS_PROJ); bf16* MIX = (bf16*)(p.ws + WS_MIX); bf16* HB = (bf16*)(p.ws + WS_H);
    LAS float* wsT = (LAS float*)(lds + 69632);
    volatile LAS unsigned* misc = (volatile LAS unsigned*)(lds + 147200);
    if (tid < 4) misc[tid] = 0u;
    __syncthreads();
    XcdBarrier xbar = xcd_barrier_post((unsigned*)p.ws, misc);
#define GSYNC() xcd_barrier(xbar)

#define PHASE_IDS() int tidp = threadIdx.x; int lq = l; asm volatile("" : "+v"(tidp), "+s"(lq)); const int lanep = tidp & 63; const int wavep = __builtin_amdgcn_readfirstlane(tidp >> 6); const int gwp = bx * 8 + wavep; (void)lanep; (void)gwp; (void)lq
#pragma unroll 1
    for (int l = 0; l < DEPTH; ++l) {
        {
            PHASE_IDS();
            convert_weights(p, lq, lds, gwp, NGW, wavep, lanep);
            if (lq == 0) {
                stage_small(p, 0, wsT, tidp);
                __syncthreads();
                rowpass<0>(p.x, nullptr, nullptr, p.pre_mix, nullptr, XN, SMALL, wsT, gwp, NGW, lanep);
            }
        }
        if (l == 0) grid.sync(); else GSYNC();
#ifdef REP_SYNC
        for (int rep = 0; rep < REP_SYNC; ++rep) GSYNC();
#endif
        {
            pg8::Gemm g{XN, (const bf16*)(p.ws + WS_WIN), MTOK, NPROJ, DM}; pg8::StaticOrder S; S.init(MTOK, NPROJ, G, bx);
            pg8::EpiStoreBf16 E{PROJ, NPROJ};
            pg8::gemm_phase<pg8::EpiStoreBf16, pg8::StaticOrder, true, true>(lds, g, S, E);
        }
        GSYNC();
        {
            PHASE_IDS();
            for (int rep = 0; rep < REP_C; ++rep) {
                if (rep) GSYNC();
                for (int u = bx; u < 1536; u += G) {
                    if (u < 1024) { for (int r2 = 0; r2 < REP_C1; ++r2) gdn_pre_unit(p, lq, u, lds, tidp); }
                    else { for (int r2 = 0; r2 < REP_C2; ++r2) ssd_p1_unit(p, lq, u - 1024, lds, tidp); } }
            }
        }
        GSYNC();
        {
            PHASE_IDS();
            for (int rep = 0; rep < REP_D; ++rep) {
                if (rep) GSYNC();
                if (bx < 16) gdn_scan_block(p, bx, lds, tidp);
                else { for (int u = bx - 16; u < 640; u += G - 16) { if (u < 128) { if (rep == 0) ssd_scan_unit(p, u, tidp); } else attn_unit(p, lq, u - 128, lds, tidp); } }
            }
        }
        GSYNC();
        {
            PHASE_IDS();
            for (int rep = 0; rep < REP_E; ++rep) {
                if (rep) GSYNC();
                for (int u = bx; u < 512; u += G) ssd_p3_unit(p, lq, u, lds, tidp);
            }
            gdn_post(p, lq, gwp, NGW, lanep);
        }
        GSYNC();
        {
            pg8::Gemm g{MIX, (const bf16*)(p.ws + WS_WOUT), MTOK, DM, DM}; pg8::StaticOrder S; S.init(MTOK, DM, G, bx);
            pg8::EpiStoreF32 E{TMP, DM};
            pg8::gemm_phase<pg8::EpiStoreF32, pg8::StaticOrder, true, true>(lds, g, S, E);
        }
        GSYNC();
        {
            PHASE_IDS();
            rowpass<1>(lq == 0 ? p.x : p.out, TMP, p.post_mix + (size_t)lq * DM, p.pre_ffn + (size_t)lq * DM, p.out, XN, nullptr, wsT, gwp, NGW, lanep);
        }
        GSYNC();
        {
            pg8::Gemm g{XN, (const bf16*)(p.ws + WS_WGU), MTOK, 2 * FF, DM}; pg8::StaticOrder S; S.init(MTOK, 2 * FF, G, bx);
            pg8::EpiSwiGLU E{HB, FF};
            pg8::gemm_phase<pg8::EpiSwiGLU, pg8::StaticOrder, true, true>(lds, g, S, E);
        }
        GSYNC();
        {
            pg8::Gemm g{HB, (const bf16*)(p.ws + WS_WDN), MTOK, DM, FF}; pg8::StaticOrder S; S.init(MTOK, DM, G, bx);
            pg8::EpiStoreF32 E{TMP, DM};
            pg8::gemm_phase<pg8::EpiStoreF32, pg8::StaticOrder, true, true>(lds, g, S, E);
        }
        GSYNC();
        {
            PHASE_IDS();
            if (lq + 1 < DEPTH) {
                stage_small(p, lq + 1, wsT, tidp);
                __syncthreads();
                rowpass<2>(p.out, TMP, p.post_ffn + (size_t)lq * DM, p.pre_mix + (size_t)(lq + 1) * DM, p.out, XN, SMALL, wsT, gwp, NGW, lanep);
                __syncthreads();
            } else {
                rowpass<3>(p.out, TMP, p.post_ffn + (size_t)lq * DM, nullptr, p.out, nullptr, nullptr, wsT, gwp, NGW, lanep);
            }
        }
    }
}

extern "C" void kernel_launch(void* const* d_in, const int* in_sizes, int n_in, void* d_out, int out_size, void* d_ws, size_t ws_size, hipStream_t stream) {
    static int grid = 0;
    if (grid == 0) {
        if (n_in != 21 || out_size != MTOK * DM || ws_size < WS_END) { fprintf(stderr, "kernel_launch: unexpected shapes (n_in %d out %d ws %zu)\n", n_in, out_size, ws_size); grid = -1; return; }
        int dev = 0, cus = 0, per_cu = 0;
        hipGetDevice(&dev); hipDeviceGetAttribute(&cus, hipDeviceAttributeMultiprocessorCount, dev);
        if (hipFuncSetAttribute((const void*)fwd_megakernel, hipFuncAttributeMaxDynamicSharedMemorySize, LDS_BYTES) != hipSuccess) { fprintf(stderr, "kernel_launch: hipFuncSetAttribute failed\n"); grid = -1; return; }
        hipOccupancyMaxActiveBlocksPerMultiprocessor(&per_cu, (const void*)fwd_megakernel, 512, LDS_BYTES);
        if (per_cu < 1) { fprintf(stderr, "kernel_launch: occupancy query says %d blocks per CU\n", per_cu); per_cu = 1; }
        (void)hipGetLastError();
        grid = cus;
    }
    if (grid < 0) return;
    if (hipMemsetAsync(d_ws, 0, 16384, stream) != hipSuccess) { fprintf(stderr, "kernel_launch: memset of the barrier words failed\n"); return; }
    Params p{};
    const float** pp = (const float**)&p;
    for (int i = 0; i < 21; ++i) pp[i] = (const float*)d_in[i];
    p.out = (float*)d_out; p.ws = (unsigned char*)d_ws;
    void* args[] = {&p};
    hipError_t e = hipLaunchCooperativeKernel((const void*)fwd_megakernel, dim3(grid), dim3(512), args, LDS_BYTES, stream);
    if (e != hipSuccess) fprintf(stderr, "cooperative launch failed: %s (grid %d)\n", hipGetErrorString(e), grid);
}
```

```cpp
#include <hip/hip_runtime.h>
#include <hip/hip_cooperative_groups.h>
#include <cstdio>
#include <cstdint>
namespace cg = cooperative_groups;
namespace pg8 {
#define PG8_LAS __attribute__((address_space(3)))
typedef unsigned short bf16_t;
typedef short bf16x8 __attribute__((ext_vector_type(8)));
typedef float f32x4 __attribute__((ext_vector_type(4)));
typedef unsigned u32x4 __attribute__((ext_vector_type(4)));
constexpr int BM = 256, BK = 64, HALF = 128, HTB = HALF * BK * 2  , STAGE_BYTES = 8 * HTB, NXCD = 8, WGM = 8;

__host__ __device__ __forceinline__ int lds_byte(int r, int c) { const int st = (r >> 4) * 2 + (c >> 5), rr = r & 15, cc = c & 31, ob = rr * 64 + cc * 2; return st * 1024 + (ob ^ (((ob >> 9) & 1) << 5)); }
__host__ __device__ __forceinline__ void stage_rc(int b, int& R, int& C) { const int st = b / 1024, sb = b % 1024, swz = sb ^ (((sb >> 9) & 1) << 5); R = (st >> 1) * 16 + swz / 64; C = (st & 1) * 32 + (swz % 64) / 2; }
__host__ __device__ __forceinline__ int perm32(int rho) { const int n = rho >> 4, i = rho & 15; return 8 * (i >> 2) + 4 * n + (i & 3); }

struct Unit { int pm, pn; };
struct Gemm { const bf16_t* A; const bf16_t* Bt; int M, N, K; };

struct StaticOrder {
    int nM, nN, nwg, G, c;
    __host__ __device__ void init(int M, int N, int G_, int c_) { nM = M / BM; nN = N / BM; nwg = nM * nN; G = G_; c = c_; }
    __host__ __device__ bool next(int i, Unit& u) const {
        const long L = (long)i * G + c; if (L >= nwg) return false;
        int wgid = (int)L; { const int q = nwg / NXCD, r = nwg % NXCD, xcd = wgid % NXCD, off = wgid / NXCD; wgid = (xcd < r ? xcd * (q + 1) : r * (q + 1) + (xcd - r) * q) + off; }
        const int nig = WGM * nN, gid = wgid / nig, fm = gid * WGM, gsz = (nM - fm) < WGM ? (nM - fm) : WGM;
        u.pm = fm + ((wgid % nig) % gsz); u.pn = (wgid % nig) / gsz; return true;
    }
    __device__ __forceinline__ void a_ready(const Unit&) const {}
    __device__ __forceinline__ void done(const Unit&) const {}
};

__device__ __forceinline__ unsigned cvt_pk_bf16(float lo, float hi) { unsigned r; asm volatile("v_cvt_pk_bf16_f32 %0, %1, %2" : "=v"(r) : "v"(lo), "v"(hi)); return r; }
typedef float f32x2 __attribute__((ext_vector_type(2)));
typedef unsigned u32x2 __attribute__((ext_vector_type(2)));
__device__ __forceinline__ float silu_f(float x) { return x * __builtin_amdgcn_rcpf(1.0f + __expf(-x)); }
struct EpiStoreBf16 {
    static constexpr bool PERM = true, AFTER_DRAIN = false;
    bf16_t* O; int ldc;
    __device__ __forceinline__ void operator()(const f32x4 (&acc)[2][2][4][2], const Unit& u, int wr, int wc, int fr, int fq) const {
        const int row0 = u.pm * BM + wr * 64 + fr, col0 = u.pn * BM + wc * 32 + 8 * fq;
#pragma unroll
        for (int ai = 0; ai < 2; ++ai)
#pragma unroll
            for (int m = 0; m < 4; ++m) { bf16_t* rowp = O + (size_t)(row0 + ai * HALF + m * 16) * ldc + col0;
#pragma unroll
                for (int bj = 0; bj < 2; ++bj) { const f32x4 v0 = acc[ai][bj][m][0], v1 = acc[ai][bj][m][1];
                    u32x4 w; w.x = cvt_pk_bf16(v0[0], v0[1]); w.y = cvt_pk_bf16(v0[2], v0[3]); w.z = cvt_pk_bf16(v1[0], v1[1]); w.w = cvt_pk_bf16(v1[2], v1[3]);
                    *(u32x4*)(rowp + bj * HALF) = w; } }
    }
};
struct EpiStoreF32 {
    static constexpr bool PERM = true, AFTER_DRAIN = false;
    float* O; int ldc;
    __device__ __forceinline__ void operator()(const f32x4 (&acc)[2][2][4][2], const Unit& u, int wr, int wc, int fr, int fq) const {
        const int row0 = u.pm * BM + wr * 64 + fr, col0 = u.pn * BM + wc * 32 + 8 * fq;
#pragma unroll
        for (int ai = 0; ai < 2; ++ai)
#pragma unroll
            for (int m = 0; m < 4; ++m) { float* rowp = O + (size_t)(row0 + ai * HALF + m * 16) * ldc + col0;
#pragma unroll
                for (int bj = 0; bj < 2; ++bj) { *(f32x4*)(rowp + bj * HALF) = acc[ai][bj][m][0]; *(f32x4*)(rowp + bj * HALF + 4) = acc[ai][bj][m][1]; } }
    }
};
struct EpiSwiGLU {
    static constexpr bool PERM = true, AFTER_DRAIN = false;
    bf16_t* H; int ldh;
    __device__ __forceinline__ void operator()(const f32x4 (&acc)[2][2][4][2], const Unit& u, int wr, int wc, int fr, int fq) const {
        const int row0 = u.pm * BM + wr * 64 + fr, col0 = u.pn * (BM / 2) + wc * 16 + 4 * fq;
#pragma unroll
        for (int ai = 0; ai < 2; ++ai)
#pragma unroll
            for (int m = 0; m < 4; ++m) { bf16_t* rowp = H + (size_t)(row0 + ai * HALF + m * 16) * ldh + col0;
#pragma unroll
                for (int bj = 0; bj < 2; ++bj) { const f32x4 v0 = acc[ai][bj][m][0], v1 = acc[ai][bj][m][1];
                    u32x2 w; w.x = cvt_pk_bf16(silu_f(v0[0]) * v0[1], silu_f(v0[2]) * v0[3]); w.y = cvt_pk_bf16(silu_f(v1[0]) * v1[1], silu_f(v1[2]) * v1[3]);
                    *(u32x2*)(rowp + bj * (HALF / 2)) = w; } }
    }
};
template <class Epi, class Sched, bool ALIGN_EPI = false, bool SP2 = false>
__device__ __forceinline__ void gemm_phase(PG8_LAS unsigned char* lds, const Gemm g, const Sched& S, const Epi& E) {
    int tid_l = threadIdx.x; asm volatile("" : "+v"(tid_l));
    const int tid = tid_l, wid = __builtin_amdgcn_readfirstlane(tid >> 6), lane = tid & 63, wr = wid >> 2, wc = wid & 3, fr = lane & 15, fq = lane >> 4;
    const int K = g.K, nt = K / BK;
    unsigned voffA[2], voffB[2];
#pragma unroll
    for (int i = 0; i < 2; ++i) { int R, C; stage_rc(tid * 16 + i * 8192, R, C); const int Rb = Epi::PERM ? ((R & ~31) + perm32(R & 31)) : R;
        voffA[i] = (unsigned)(R * K + C) * 2u; voffB[i] = (unsigned)(Rb * K + C) * 2u; }
    const size_t kstep = (size_t)(BK * 2);
    const size_t hstep = (size_t)HALF * K * 2;
    const size_t tstep = 2 * hstep;
    const unsigned ldsw = (unsigned)wid * 1024u;
    const int aoff = lds_byte(wr * 64 + fr, fq * 8), boff = lds_byte(wc * 32 + fr, fq * 8);
#define PG8_SA(b, h) (((b) * 2 + (h)) * HTB)
#define PG8_SB(b, h) ((4 + (b) * 2 + (h)) * HTB)
#define PG8_STAGE(bufoff, gbase, voff) do { _Pragma("unroll") for (int _i = 0; _i < 2; ++_i) \
        __builtin_amdgcn_global_load_lds((const unsigned*)((const char*)(gbase) + (voff)[_i]), (PG8_LAS unsigned*)(lds + (bufoff) + ldsw + _i * 8192), 16, 0, 0); } while (0)
#define PG8_LDA(dst, b, h) do { _Pragma("unroll") for (int m = 0; m < 4; ++m) _Pragma("unroll") for (int k = 0; k < 2; ++k) dst[m][k] = *(const PG8_LAS bf16x8*)(lds + PG8_SA(b, h) + aoff + m * 2048 + k * 1024); } while (0)
#define PG8_LDB(dst, b, h) do { _Pragma("unroll") for (int n = 0; n < 2; ++n) _Pragma("unroll") for (int k = 0; k < 2; ++k) dst[n][k] = *(const PG8_LAS bf16x8*)(lds + PG8_SB(b, h) + boff + n * 2048 + k * 1024); } while (0)
#define PG8_MMA(ai, bj, At, Bt) do { __builtin_amdgcn_s_setprio(1); _Pragma("unroll") for (int m = 0; m < 4; ++m) _Pragma("unroll") for (int n = 0; n < 2; ++n) _Pragma("unroll") for (int k = 0; k < 2; ++k) \
        acc[ai][bj][m][n] = __builtin_amdgcn_mfma_f32_16x16x32_bf16(Bt[n][k], At[m][k], acc[ai][bj][m][n], 0, 0, 0); __builtin_amdgcn_s_setprio(0); } while (0)
#define PG8_WAIT_V(n) asm volatile("s_waitcnt vmcnt(" #n ")" ::: "memory")
#define PG8_WAIT_L(n) asm volatile("s_waitcnt lgkmcnt(" #n ")" ::: "memory")
#define PG8_BAR __builtin_amdgcn_s_barrier()
#define PG8_SCHED __builtin_amdgcn_sched_barrier(0)
    Unit cur, nxt; int ui = 0;
    if (!S.next(0, cur)) return;
    f32x4 acc[2][2][4][2];
#pragma unroll
    for (int a = 0; a < 2; ++a)
#pragma unroll
        for (int b = 0; b < 2; ++b)
#pragma unroll
            for (int m = 0; m < 4; ++m)
#pragma unroll
                for (int n = 0; n < 2; ++n) acc[a][b][m][n] = (f32x4){0.f, 0.f, 0.f, 0.f};
    bf16x8 At[4][2], B0[2][2], B1[2][2];
    const char* cA = (const char*)g.A + (size_t)cur.pm * tstep; const char* cB = (const char*)g.Bt + (size_t)cur.pn * tstep;
    S.a_ready(cur);
    if constexpr (SP2) {
        PG8_STAGE(PG8_SB(0, 0), cB, voffB); PG8_STAGE(PG8_SB(0, 1), cB + hstep, voffB); PG8_STAGE(PG8_SA(0, 0), cA, voffA); PG8_STAGE(PG8_SA(0, 1), cA + hstep, voffA);
        if (wr == 1) PG8_BAR;
        PG8_WAIT_V(2); PG8_BAR;
        PG8_STAGE(PG8_SB(1, 0), cB + kstep, voffB); PG8_STAGE(PG8_SA(1, 0), cA + kstep, voffA); PG8_STAGE(PG8_SB(1, 1), cB + hstep + kstep, voffB);
        PG8_WAIT_V(6); PG8_BAR;
    } else {
        PG8_STAGE(PG8_SB(0, 0), cB, voffB); PG8_STAGE(PG8_SA(0, 0), cA, voffA); PG8_STAGE(PG8_SB(0, 1), cB + hstep, voffB); PG8_STAGE(PG8_SA(0, 1), cA + hstep, voffA);
        if (wr == 1) PG8_BAR;
        PG8_WAIT_V(4); PG8_BAR;
        PG8_STAGE(PG8_SB(1, 0), cB + kstep, voffB); PG8_STAGE(PG8_SA(1, 0), cA + kstep, voffA); PG8_STAGE(PG8_SB(1, 1), cB + hstep + kstep, voffB);
        PG8_WAIT_V(6); PG8_BAR;
    }
    for (;;) {
        const bool has_next = S.next(ui + 1, nxt);
        const char* nA = has_next ? (const char*)g.A + (size_t)nxt.pm * tstep : cA; const char* nB = has_next ? (const char*)g.Bt + (size_t)nxt.pn * tstep : cB;
        for (int t = 0; t < nt; t += 2) {
            const bool last = (t == nt - 2);
            const char* a1 = cA + (size_t)(t + 1) * kstep;
            const char* a2 = last ? nA : cA + (size_t)(t + 2) * kstep; const char* b2 = last ? nB : cB + (size_t)(t + 2) * kstep;
            const char* a3 = a2 + kstep; const char* b3 = b2 + kstep;
            if (last && has_next) S.a_ready(nxt);
            if constexpr (SP2) {
            PG8_LDB(B0, 0, 0); PG8_LDB(B1, 0, 1); PG8_SCHED; PG8_LDA(At, 0, 0); PG8_STAGE(PG8_SA(1, 1), a1 + hstep, voffA);
            PG8_WAIT_V(8); PG8_WAIT_L(0); PG8_BAR; PG8_MMA(0, 0, At, B0); PG8_MMA(0, 1, At, B1); PG8_BAR; PG8_SCHED;
            PG8_LDA(At, 0, 1); PG8_STAGE(PG8_SB(0, 0), b2, voffB); PG8_STAGE(PG8_SB(0, 1), b2 + hstep, voffB); PG8_STAGE(PG8_SA(0, 0), a2, voffA);
            PG8_WAIT_V(8); PG8_WAIT_L(0); PG8_BAR; PG8_MMA(1, 0, At, B0); PG8_MMA(1, 1, At, B1); PG8_BAR; PG8_SCHED;
            PG8_LDB(B0, 1, 0); PG8_LDB(B1, 1, 1); PG8_SCHED; PG8_LDA(At, 1, 0); PG8_STAGE(PG8_SA(0, 1), a2 + hstep, voffA);
            PG8_WAIT_V(8); PG8_WAIT_L(0); PG8_BAR; PG8_MMA(0, 0, At, B0); PG8_MMA(0, 1, At, B1); PG8_BAR; PG8_SCHED;
            PG8_LDA(At, 1, 1); PG8_STAGE(PG8_SB(1, 0), b3, voffB); PG8_STAGE(PG8_SB(1, 1), b3 + hstep, voffB); PG8_STAGE(PG8_SA(1, 0), a3, voffA);
            PG8_WAIT_V(8); PG8_WAIT_L(0); PG8_BAR; PG8_MMA(1, 0, At, B0); PG8_MMA(1, 1, At, B1); PG8_BAR; PG8_SCHED;
            } else {
            PG8_LDB(B0, 0, 0); PG8_SCHED; PG8_LDA(At, 0, 0); PG8_STAGE(PG8_SA(1, 1), a1 + hstep, voffA);
            PG8_WAIT_L(8); PG8_BAR; PG8_WAIT_L(0); PG8_MMA(0, 0, At, B0); PG8_BAR; PG8_SCHED;
            PG8_LDB(B1, 0, 1); PG8_STAGE(PG8_SB(0, 0), b2, voffB);
            PG8_BAR; PG8_WAIT_L(0); PG8_MMA(0, 1, At, B1); PG8_BAR;
            PG8_LDA(At, 0, 1); PG8_STAGE(PG8_SA(0, 0), a2, voffA);
            PG8_BAR; PG8_WAIT_L(0); PG8_MMA(1, 0, At, B0); PG8_BAR; PG8_SCHED;
            PG8_STAGE(PG8_SB(0, 1), b2 + hstep, voffB);
            PG8_WAIT_V(6); PG8_BAR; PG8_MMA(1, 1, At, B1); PG8_BAR;
            PG8_LDB(B0, 1, 0); PG8_SCHED; PG8_LDA(At, 1, 0); PG8_STAGE(PG8_SA(0, 1), a2 + hstep, voffA);
            PG8_WAIT_L(8); PG8_BAR; PG8_WAIT_L(0); PG8_MMA(0, 0, At, B0); PG8_BAR; PG8_SCHED;
            PG8_LDB(B1, 1, 1); PG8_STAGE(PG8_SB(1, 0), b3, voffB);
            PG8_BAR; PG8_WAIT_L(0); PG8_MMA(0, 1, At, B1); PG8_BAR;
            PG8_LDA(At, 1, 1); PG8_STAGE(PG8_SA(1, 0), a3, voffA);
            PG8_BAR; PG8_WAIT_L(0); PG8_MMA(1, 0, At, B0); PG8_BAR; PG8_SCHED;
            PG8_STAGE(PG8_SB(1, 1), b3 + hstep, voffB);
            PG8_WAIT_V(6); PG8_BAR; PG8_MMA(1, 1, At, B1); PG8_BAR;
            }
        }
        if constexpr (ALIGN_EPI) { if (wr == 0) PG8_BAR; }
        if constexpr (!Epi::AFTER_DRAIN) { E(acc, cur, wr, wc, fr, fq); S.done(cur); }
        if (!has_next) break;
#pragma unroll
        for (int a = 0; a < 2; ++a)
#pragma unroll
            for (int b = 0; b < 2; ++b)
#pragma unroll
                for (int m = 0; m < 4; ++m)
#pragma unroll
                    for (int n = 0; n < 2; ++n) acc[a][b][m][n] = (f32x4){0.f, 0.f, 0.f, 0.f};
        cur = nxt; cA = nA; cB = nB; ++ui;
        if constexpr (ALIGN_EPI) { if (wr == 1) PG8_BAR; }
    }
    PG8_WAIT_V(0);
    if constexpr (!ALIGN_EPI) { if (wr == 0) PG8_BAR; }
    PG8_BAR;
    if constexpr (Epi::AFTER_DRAIN) { E.fused(acc, cur, wr, wc, fr, fq, lds, wid, lane); S.done(cur); }
#undef PG8_SA
#undef PG8_SB
#undef PG8_STAGE
#undef PG8_LDA
#undef PG8_LDB
#undef PG8_MMA
#undef PG8_WAIT_V
#undef PG8_WAIT_L
#undef PG8_BAR
#undef PG8_SCHED
}
}
constexpr int BATCH = 4, SEQ = 4096, DM = 1024, NCH = 64, CH = 64, MTOK = BATCH * SEQ, DEPTH = 2;
constexpr int NPROJ = 3072, IN_COLS = 3088, FF = 2816;
constexpr float EPS = 1e-6f;
constexpr size_t MiB = 1u << 20;
constexpr size_t WS_SMALL = 1 * MiB, WS_ACS = 2 * MiB, WS_CDEC = 2 * MiB + 512 * 1024, WS_EGL = 2 * MiB + 768 * 1024;
constexpr size_t WS_WIN = 3 * MiB, WS_WOUT = 9 * MiB, WS_WGU = 11 * MiB, WS_WDN = 22 * MiB;
constexpr size_t WS_XN = 28 * MiB;
constexpr size_t WS_GU = 28 * MiB, WS_GW = 36 * MiB, WS_GQE = 44 * MiB, WS_GQK = 52 * MiB, WS_GKDT = 244 * MiB;
constexpr size_t WS_PROJ = 60 * MiB, WS_H = 60 * MiB;
constexpr size_t WS_MIX = 156 * MiB;
constexpr size_t WS_STATES = 188 * MiB, WS_YPART = 220 * MiB, WS_CCONV = 236 * MiB, WS_TMP = 188 * MiB;
constexpr size_t WS_END = 252 * MiB;
constexpr int LDS_BYTES = 147456;
#ifndef REP_C
#define REP_C 1
#endif
#ifndef REP_ATT
#define REP_ATT 1
#endif
#ifndef RG_CONV
#define RG_CONV 1
#endif
#ifndef RG_KK
#define RG_KK 1
#endif
#ifndef RG_SOLVE
#define RG_SOLVE 1
#endif
#ifndef REP_C1
#define REP_C1 1
#endif
#ifndef REP_C2
#define REP_C2 1
#endif
#ifndef REP_D
#define REP_D 1
#endif
#ifndef REP_E
#define REP_E 1
#endif

#define LAS __attribute__((address_space(3)))
#define DEV __device__ __forceinline__
typedef unsigned short bf16;
typedef short bf16x8 __attribute__((ext_vector_type(8)));
typedef float f32x4 __attribute__((ext_vector_type(4)));
typedef unsigned u32x4 __attribute__((ext_vector_type(4)));
typedef unsigned u32x2 __attribute__((ext_vector_type(2)));

DEV unsigned f2bf(float f) { unsigned u = __builtin_bit_cast(unsigned, f); return (u + 0x7fffu + ((u >> 16) & 1u)) >> 16; }
DEV unsigned pk2(float lo, float hi) { return f2bf(lo) | (f2bf(hi) << 16); }
DEV float bf2f(unsigned b) { return __builtin_bit_cast(float, b << 16); }
DEV float bflo(unsigned w) { return __builtin_bit_cast(float, w << 16); }
DEV float bfhi(unsigned w) { return __builtin_bit_cast(float, w & 0xffff0000u); }
DEV float silu(float x) { return x * __builtin_amdgcn_rcpf(1.0f + __expf(-x)); }
DEV float softplus(float x) { return fmaxf(x, 0.f) + log1pf(expf(-fabsf(x))); }
template <int CTRL> DEV float dpp_f(float v) { return __builtin_bit_cast(float, __builtin_amdgcn_update_dpp(0, __builtin_bit_cast(int, v), CTRL, 0xF, 0xF, true)); }
DEV float red4_sum(float v) { v += dpp_f<0xB1>(v); v += dpp_f<0x4E>(v); return v; }
DEV float red8_sum(float v) { v = red4_sum(v); v += dpp_f<0x141>(v); return v; }
DEV float red16_sum(float v) { v = red8_sum(v); v += dpp_f<0x140>(v); return v; }
DEV float red16_max(float v) { v = fmaxf(v, dpp_f<0xB1>(v)); v = fmaxf(v, dpp_f<0x4E>(v)); v = fmaxf(v, dpp_f<0x141>(v)); v = fmaxf(v, dpp_f<0x140>(v)); return v; }
DEV float rdlane(float v, int l) { return __builtin_bit_cast(float, __builtin_amdgcn_readlane(__builtin_bit_cast(int, v), l)); }
DEV float wave_sum(float v) { v = red16_sum(v); return (rdlane(v, 0) + rdlane(v, 16)) + (rdlane(v, 32) + rdlane(v, 48)); }
DEV float wave_incl_scan(float v, int lane) {
    v += dpp_f<0x111>(v); v += dpp_f<0x112>(v); v += dpp_f<0x114>(v); v += dpp_f<0x118>(v);
    const float t0 = rdlane(v, 15), t1 = rdlane(v, 31), t2 = rdlane(v, 47);
    const int r = lane >> 4;
    return v + (r > 0 ? t0 : 0.f) + (r > 1 ? t1 : 0.f) + (r > 2 ? t2 : 0.f);
}
DEV float frcp(float x) { return __builtin_amdgcn_rcpf(x); }
DEV f32x4 mma_tile(const LAS bf16* A, int lda, const LAS bf16* B, int ldb, int K, int lane, f32x4 acc) {
    const LAS bf16* ap = A + (lane & 15) * lda + (lane >> 4) * 8;
    const LAS bf16* bp = B + (lane & 15) * ldb + (lane >> 4) * 8;
    for (int k = 0; k < K; k += 32) {
        const bf16x8 a = *(const LAS bf16x8*)(ap + k), b = *(const LAS bf16x8*)(bp + k);
        acc = __builtin_amdgcn_mfma_f32_16x16x32_bf16(a, b, acc, 0, 0, 0);
    }
    return acc;
}

struct Params {
    const float *x, *pre_mix, *post_mix, *pre_ffn, *post_ffn, *w_in, *w_out, *sinks, *sconv_w, *sconv_b, *sdt_bias, *sA_log, *sD, *snorm_w,
                *gconv_w, *gdt_bias, *gA_log, *gnorm_w, *w_gate, *w_up, *w_down;
    float* out; unsigned char* ws;
};

DEV void tr_item(const float* W, int ldw, int col0, bf16* WT, int K, int drow0, int rs, LAS float* scr, int kb, int nb, int lane) {
    const int k0 = 64 * kb, n0 = 32 * nb;
#pragma unroll 8
    for (int i = 0; i < 32; ++i) { const int kk = 2 * i + (lane >> 5); scr[kk * 33 + (lane & 31)] = W[(size_t)(k0 + kk) * ldw + col0 + n0 + (lane & 31)]; }
    asm volatile("s_waitcnt lgkmcnt(0)" ::: "memory");
    const int c = lane & 7;
#pragma unroll
    for (int j = 0; j < 4; ++j) { const int n = (lane >> 3) + 8 * j; const LAS float* s = scr + (8 * c) * 33 + n;
        u32x4 o; o.x = pk2(s[0 * 33], s[1 * 33]); o.y = pk2(s[2 * 33], s[3 * 33]); o.z = pk2(s[4 * 33], s[5 * 33]); o.w = pk2(s[6 * 33], s[7 * 33]);
        *(u32x4*)(WT + (size_t)(drow0 + (n0 + n) * rs) * K + k0 + 8 * c) = o; }
    asm volatile("s_waitcnt lgkmcnt(0)" ::: "memory");
}
DEV void convert_weights(const Params& p, int l, LAS unsigned char* lds, int gw, int NGW, int wave, int lane) {
    LAS float* scr = (LAS float*)(lds + wave * 8448);
    const float* win = p.w_in + (size_t)l * DM * IN_COLS; const float* wout = p.w_out + (size_t)l * DM * DM;
    const float* wg = p.w_gate + (size_t)l * DM * FF; const float* wu = p.w_up + (size_t)l * DM * FF; const float* wd = p.w_down + (size_t)l * FF * DM;
    bf16* WIN = (bf16*)(p.ws + WS_WIN); bf16* WOUT = (bf16*)(p.ws + WS_WOUT); bf16* WGU = (bf16*)(p.ws + WS_WGU); bf16* WDN = (bf16*)(p.ws + WS_WDN);
    constexpr int I_IN = 16 * 96, I_OUT = 16 * 32, I_G = 16 * 88, I_D = 44 * 32;
    constexpr int NIT = I_IN + I_OUT + 2 * I_G + I_D;
    for (int it = gw; it < NIT; it += NGW) {
        int r = it;
        if (r < I_IN) { const int kb = r / 96, nb = r % 96;
            if (nb < 64) tr_item(win, IN_COLS, 0, WIN, DM, 0, 1, scr, kb, nb, lane); else tr_item(win, IN_COLS, 2056, WIN, DM, 2048, 1, scr, kb, nb - 64, lane);
            continue; } r -= I_IN;
        if (r < I_OUT) { tr_item(wout, DM, 0, WOUT, DM, 0, 1, scr, r / 32, r % 32, lane); continue; } r -= I_OUT;
        if (r < I_G) { tr_item(wg, FF, 0, WGU, DM, 0, 2, scr, r / 88, r % 88, lane); continue; } r -= I_G;
        if (r < I_G) { tr_item(wu, FF, 0, WGU, DM, 1, 2, scr, r / 88, r % 88, lane); continue; } r -= I_G;
        tr_item(wd, DM, 0, WDN, FF, 0, 1, scr, r / 32, r % 32, lane);
    }
}
DEV void stage_small(const Params& p, int l, LAS float* wsT, int tid) {
    const float* win = p.w_in + (size_t)l * DM * IN_COLS;
    for (int idx = tid; idx < 16 * DM; idx += 512) { const int k = idx >> 4, c = idx & 15; const int sc = c < 8 ? 2048 + c : 3072 + c; wsT[c * DM + k] = win[(size_t)k * IN_COLS + sc]; }
}
template <int MODE>
DEV void rowpass(const float* res, const bf16* tmp, const float* wpost, const float* wnext, float* xout, bf16* XN, float* SMALL, const LAS float* wsT, int gw, int NGW, int lane) {
    f32x4 wp[4], wn[4];
#pragma unroll
    for (int j = 0; j < 4; ++j) {
        if (MODE != 0) wp[j] = *((const f32x4*)wpost + lane + 64 * j);
        if (MODE != 3) wn[j] = *((const f32x4*)wnext + lane + 64 * j);
    }
    for (int m = gw; m < MTOK; m += NGW) {
        f32x4 v[4];
#pragma unroll
        for (int j = 0; j < 4; ++j) v[j] = *((const f32x4*)(res + (size_t)m * DM) + lane + 64 * j);
        if (MODE != 0) {
            f32x4 t[4]; float ss = 0.f;
#pragma unroll
            for (int j = 0; j < 4; ++j) { const u32x2 tw = *((const u32x2*)(tmp + (size_t)m * DM) + lane + 64 * j); t[j] = (f32x4){bflo(tw.x), bfhi(tw.x), bflo(tw.y), bfhi(tw.y)}; ss += (t[j].x * t[j].x + t[j].y * t[j].y) + (t[j].z * t[j].z + t[j].w * t[j].w); }
            const float rstd = rsqrtf(wave_sum(ss) * (1.0f / DM) + EPS);
#pragma unroll
            for (int j = 0; j < 4; ++j) { v[j] = v[j] + t[j] * rstd * wp[j]; *((f32x4*)(xout + (size_t)m * DM) + lane + 64 * j) = v[j]; }
        }
        if (MODE != 3) {
            float ss = 0.f;
#pragma unroll
            for (int j = 0; j < 4; ++j) ss += (v[j].x * v[j].x + v[j].y * v[j].y) + (v[j].z * v[j].z + v[j].w * v[j].w);
            const float rstd = rsqrtf(wave_sum(ss) * (1.0f / DM) + EPS);
#pragma unroll
            for (int j = 0; j < 4; ++j) { v[j] = v[j] * rstd * wn[j];
                u32x2 o; o.x = pk2(v[j].x, v[j].y); o.y = pk2(v[j].z, v[j].w); *((u32x2*)(XN + (size_t)m * DM) + lane + 64 * j) = o; }
            if (MODE == 0 || MODE == 2) {
                float mine = 0.f;
#pragma unroll
                for (int c = 0; c < 16; ++c) { float s = 0.f; asm volatile("" ::: "memory");
#pragma unroll
                    for (int j = 0; j < 4; ++j) { const f32x4 w = *((const LAS f32x4*)(wsT + c * DM) + lane + 64 * j); s += (v[j].x * w.x + v[j].y * w.y) + (v[j].z * w.z + v[j].w * w.w); }
                    s = red16_sum(s); mine = ((lane & 15) == c) ? s : mine; }
                mine += __shfl_xor(mine, 16); mine += __shfl_xor(mine, 32);
                if (lane < 16) SMALL[(size_t)m * 16 + lane] = mine;
            }
        }
    }
}

DEV void attn_unit(const Params& p, int l, int u, LAS unsigned char* lds, int tid) {
    asm volatile("" : "+v"(tid));
    const int b = u >> 7, c = (u >> 1) & 63, kvh = u & 1, wave = tid >> 6, lane = tid & 63;
    const bf16* PROJ = (const bf16*)(p.ws + WS_PROJ); bf16* MIX = (bf16*)(p.ws + WS_MIX);
    LAS bf16* Qs = (LAS bf16*)lds;
    LAS bf16* Ks = Qs + 128 * 72;
    LAS bf16* Vt = Ks + 192 * 72;
    LAS bf16* Ps = Vt + 64 * 200;
    const size_t t0 = (size_t)b * SEQ + (size_t)c * CH;
    {
        u32x4 rq[2], rk[3], rv[3];
#pragma unroll
        for (int k = 0; k < 2; ++k) { const int idx = tid + k * 512, r = idx >> 3, v = idx & 7, g = r >> 6, i = r & 63;
            rq[k] = *(const u32x4*)(PROJ + (t0 + i) * NPROJ + kvh * 128 + g * 64 + v * 8); }
#pragma unroll
        for (int k = 0; k < 3; ++k) { const int idx = tid + k * 512, j = idx >> 3, v = idx & 7; const bool valid = (c - 2 + (j >> 6)) >= 0;
            rk[k] = (u32x4){0u, 0u, 0u, 0u}; rv[k] = rk[k];
            if (valid) { const bf16* rowp = PROJ + (size_t)((long)t0 - 128 + j) * NPROJ; rk[k] = *(const u32x4*)(rowp + 256 + kvh * 64 + v * 8); rv[k] = *(const u32x4*)(rowp + 384 + kvh * 64 + v * 8); } }
#pragma unroll
        for (int k = 0; k < 2; ++k) { const int idx = tid + k * 512, r = idx >> 3, v = idx & 7; *(LAS u32x4*)(Qs + r * 72 + v * 8) = rq[k]; }
#pragma unroll
        for (int k = 0; k < 3; ++k) { const int idx = tid + k * 512, j = idx >> 3, v = idx & 7; const u32x4 vv = rv[k];
            *(LAS u32x4*)(Ks + j * 72 + v * 8) = rk[k];
            LAS bf16* vt = Vt + (v * 8) * 200 + j;
            vt[0 * 200] = (bf16)(vv.x & 0xffffu); vt[1 * 200] = (bf16)(vv.x >> 16); vt[2 * 200] = (bf16)(vv.y & 0xffffu); vt[3 * 200] = (bf16)(vv.y >> 16);
            vt[4 * 200] = (bf16)(vv.z & 0xffffu); vt[5 * 200] = (bf16)(vv.z >> 16); vt[6 * 200] = (bf16)(vv.w & 0xffffu); vt[7 * 200] = (bf16)(vv.w >> 16); }
    }
    __syncthreads();
    {
        const int g = wave >> 2, h = kvh * 2 + g;
        const float slope = exp2f(-2.0f * (float)(h + 1)), sink = p.sinks[l * 4 + h];
        f32x4 s[12];
#pragma unroll
        for (int nt = 0; nt < 12; ++nt) s[nt] = mma_tile(Qs + wave * 16 * 72, 72, Ks + nt * 16 * 72, 72, 64, lane, (f32x4){0.f, 0.f, 0.f, 0.f});
#pragma unroll
        for (int j = 0; j < 4; ++j) {
            const int r = wave * 16 + (lane >> 4) * 4 + j, i = r & 63;
            float mx = sink;
#pragma unroll
            for (int nt = 0; nt < 12; ++nt) { const int jj = nt * 16 + (lane & 15);
                float val = s[nt][j] * 0.125f - slope * fabsf((float)(i + 128 - jj));
                if (c - 2 + (nt >> 2) < 0) val = -INFINITY;
                s[nt][j] = val; mx = fmaxf(mx, val); }
            mx = red16_max(mx);
            float sum = 0.f;
#pragma unroll
            for (int nt = 0; nt < 12; ++nt) { const float e = __expf(s[nt][j] - mx); s[nt][j] = e; sum += e; }
            sum = red16_sum(sum);
            sum += __expf(sink - mx);
            const float inv = frcp(sum);
#pragma unroll
            for (int nt = 0; nt < 12; ++nt) Ps[r * 200 + nt * 16 + (lane & 15)] = (bf16)f2bf(s[nt][j] * inv);
        }
    }
    __syncthreads();
#pragma unroll
    for (int nt = 0; nt < 4; ++nt) {
        const f32x4 acc = mma_tile(Vt + nt * 16 * 200, 200, Ps + wave * 16 * 200, 200, 192, lane, (f32x4){0.f, 0.f, 0.f, 0.f});
        const int r = wave * 16 + (lane & 15), g = r >> 6, i = r & 63, d0 = nt * 16 + (lane >> 4) * 4;
        u32x2 o; o.x = pk2(acc[0], acc[1]); o.y = pk2(acc[2], acc[3]);
        *(u32x2*)(MIX + (t0 + i) * DM + (kvh * 2 + g) * 64 + d0) = o;
    }
    __syncthreads();
}

template <int NCOLS> struct RawTile {
    static constexpr int VPR = NCOLS / 8, NV = 67 * VPR, NIT = (NV + 511) / 512;
    u32x4 r[NIT];
    DEV void issue(const bf16* PROJ, size_t t0, int c, int col0, int tid) {
#pragma unroll
        for (int k = 0; k < NIT; ++k) { const int idx = tid + k * 512, row = idx / VPR, v = idx % VPR;
            r[k] = (u32x4){0u, 0u, 0u, 0u};
            if (idx < NV && (c > 0 || row >= 3)) r[k] = *(const u32x4*)(PROJ + (size_t)((long)t0 - 3 + row) * NPROJ + col0 + v * 8); }
    }
    DEV void commit(LAS bf16* Raw, int rawld, int dcol0, int tid) const {
#pragma unroll
        for (int k = 0; k < NIT; ++k) { const int idx = tid + k * 512, row = idx / VPR, v = idx % VPR;
            if (idx < NV) *(LAS u32x4*)(Raw + row * rawld + dcol0 + v * 8) = r[k]; }
    }
};
DEV void ssd_p1_unit(const Params& p, int l, int u, LAS unsigned char* lds, int tid) {
    asm volatile("" : "+v"(tid));
    const int b = u >> 7, c = (u >> 1) & 63, g = u & 1, wave = tid >> 6, lane = tid & 63;
    const bf16* PROJ = (const bf16*)(p.ws + WS_PROJ);
    const float* SMALL = (const float*)(p.ws + WS_SMALL);
    float* ACS = (float*)(p.ws + WS_ACS); float* CDEC = (float*)(p.ws + WS_CDEC);
    bf16* STATES = (bf16*)(p.ws + WS_STATES); bf16* YPART = (bf16*)(p.ws + WS_YPART); bf16* CCONV = (bf16*)(p.ws + WS_CCONV);
    LAS bf16* XsT = (LAS bf16*)lds;
    LAS bf16* Bm = XsT + 4 * 64 * 72;
    LAS bf16* Cm = Bm + 64 * 136;
    LAS bf16* BmT = Cm + 64 * 136;
    LAS bf16* Sc = BmT + 128 * 72;
    LAS bf16* Raw = Sc;
    LAS float* dtS = (LAS float*)(Sc + 4 * 64 * 72);
    LAS float* acsS = dtS + 256;
    LAS float* fS = acsS + 256;
    const size_t t0 = (size_t)b * SEQ + (size_t)c * CH;
    RawTile<256> R1; RawTile<128> R2b, R2c;
    R1.issue(PROJ, t0, c, 1024 + g * 256, tid); R2b.issue(PROJ, t0, c, 1024 + 512 + g * 128, tid); R2c.issue(PROJ, t0, c, 1024 + 768 + g * 128, tid);
    if (tid < 256) {
        const int h = tid >> 6, hh = g * 4 + h;
        const float dt = softplus(SMALL[(t0 + lane) * 16 + hh] + p.sdt_bias[l * 8 + hh]);
        const float a = -expf(p.sA_log[l * 8 + hh]);
        const float acs = wave_incl_scan(dt * a, lane);
        const float alast = rdlane(acs, 63);
        dtS[tid] = dt; acsS[tid] = acs; fS[tid] = dt * expf(alast - acs);
        ACS[(t0 + lane) * 8 + hh] = acs;
        if (lane == 63) CDEC[((size_t)b * NCH + c) * 8 + hh] = expf(acs);
    }
    R1.commit(Raw, 256, 0, tid);
    __syncthreads();
    {
        const int ch = tid & 255, half = tid >> 8, chg = g * 256 + ch, h = ch >> 6, pp = ch & 63;
        const float* cw = p.sconv_w + (size_t)l * 4096 + chg; const float w0 = cw[0], w1 = cw[1024], w2 = cw[2048], w3 = cw[3072], bias = p.sconv_b[l * 1024 + chg];
        const int r0 = half * 32;
        float x0 = bf2f(Raw[(r0 + 0) * 256 + ch]), x1 = bf2f(Raw[(r0 + 1) * 256 + ch]), x2 = bf2f(Raw[(r0 + 2) * 256 + ch]);
        LAS bf16* dst = XsT + h * 64 * 72 + pp * 72 + r0;
        for (int r = 0; r < 32; ++r) { const float x3 = bf2f(Raw[(r0 + r + 3) * 256 + ch]);
            const float y = silu(w0 * x0 + w1 * x1 + w2 * x2 + w3 * x3 + bias);
            dst[r] = (bf16)f2bf(y); x0 = x1; x1 = x2; x2 = x3; }
    }
    __syncthreads();
    R2b.commit(Raw, 256, 0, tid); R2c.commit(Raw, 256, 128, tid);
    __syncthreads();
    {
        const int ch = tid & 255, half = tid >> 8, isC = ch >> 7, n = ch & 127, chg = 512 + isC * 256 + g * 128 + n;
        const float* cw = p.sconv_w + (size_t)l * 4096 + chg; const float w0 = cw[0], w1 = cw[1024], w2 = cw[2048], w3 = cw[3072], bias = p.sconv_b[l * 1024 + chg];
        const int r0 = half * 32;
        float x0 = bf2f(Raw[(r0 + 0) * 256 + ch]), x1 = bf2f(Raw[(r0 + 1) * 256 + ch]), x2 = bf2f(Raw[(r0 + 2) * 256 + ch]);
        for (int r = 0; r < 32; ++r) { const float x3 = bf2f(Raw[(r0 + r + 3) * 256 + ch]);
            const bf16 y = (bf16)f2bf(silu(w0 * x0 + w1 * x1 + w2 * x2 + w3 * x3 + bias));
            if (isC) Cm[(r0 + r) * 136 + n] = y; else { Bm[(r0 + r) * 136 + n] = y; BmT[n * 72 + r0 + r] = y; }
            x0 = x1; x1 = x2; x2 = x3; }
    }
    __syncthreads();
    for (int idx = tid; idx < 1024; idx += 512) { const int r = idx >> 4, v = idx & 15; *(u32x4*)(CCONV + (t0 + r) * 256 + g * 128 + v * 8) = *(const LAS u32x4*)(Cm + r * 136 + v * 8); }
#pragma unroll
    for (int ti = 0; ti < 2; ++ti) {
        const int tt = wave * 2 + ti, mt = tt >> 2, nt = tt & 3;
        f32x4 acc = (f32x4){0.f, 0.f, 0.f, 0.f};
        if (nt <= mt) acc = mma_tile(Bm + nt * 16 * 136, 136, Cm + mt * 16 * 136, 136, 128, lane, acc);
        const int lr = mt * 16 + (lane & 15), s0 = nt * 16 + (lane >> 4) * 4;
#pragma unroll
        for (int h = 0; h < 4; ++h) { const f32x4 as = *(const LAS f32x4*)(acsS + h * 64 + s0), ds = *(const LAS f32x4*)(dtS + h * 64 + s0); const float al = acsS[h * 64 + lr];
            float v[4];
#pragma unroll
            for (int j = 0; j < 4; ++j) v[j] = (s0 + j <= lr) ? acc[j] * __expf(al - as[j]) * ds[j] : 0.f;
            u32x2 o; o.x = pk2(v[0], v[1]); o.y = pk2(v[2], v[3]);
            *(LAS u32x2*)(Sc + h * 64 * 72 + lr * 72 + s0) = o; }
    }
    __syncthreads();
    {
        const int h = wave >> 1, hh = g * 4 + h; const float Dh = p.sD[l * 8 + hh];
#pragma unroll 2
        for (int ti = 0; ti < 8; ++ti) { const int tt = (wave & 1) * 8 + ti, mt = tt >> 2, nt = tt & 3;
            const f32x4 acc = mma_tile(XsT + h * 64 * 72 + nt * 16 * 72, 72, Sc + h * 64 * 72 + mt * 16 * 72, 72, 64, lane, (f32x4){0.f, 0.f, 0.f, 0.f});
            const int lr = mt * 16 + (lane & 15), p0 = nt * 16 + (lane >> 4) * 4;
            const LAS bf16* xp = XsT + h * 64 * 72 + p0 * 72 + lr;
            u32x2 o; o.x = pk2(acc[0] + Dh * bf2f(xp[0]), acc[1] + Dh * bf2f(xp[72])); o.y = pk2(acc[2] + Dh * bf2f(xp[144]), acc[3] + Dh * bf2f(xp[216]));
            *(u32x2*)(YPART + (t0 + lr) * 512 + hh * 64 + p0) = o; }
#pragma unroll
        for (int pi = 0; pi < 2; ++pi) { const int pt = (wave & 1) * 2 + pi;
            bf16x8 xf[2];
#pragma unroll
            for (int k = 0; k < 2; ++k) { const int l0 = k * 32 + (lane >> 4) * 8;
                const u32x4 xw = *(const LAS u32x4*)(XsT + h * 64 * 72 + (pt * 16 + (lane & 15)) * 72 + l0);
                const f32x4 f0 = *(const LAS f32x4*)(fS + h * 64 + l0), f1 = *(const LAS f32x4*)(fS + h * 64 + l0 + 4);
                u32x4 o; o.x = pk2(bflo(xw.x) * f0.x, bfhi(xw.x) * f0.y); o.y = pk2(bflo(xw.y) * f0.z, bfhi(xw.y) * f0.w);
                o.z = pk2(bflo(xw.z) * f1.x, bfhi(xw.z) * f1.y); o.w = pk2(bflo(xw.w) * f1.z, bfhi(xw.w) * f1.w);
                xf[k] = __builtin_bit_cast(bf16x8, o); }
            for (int nt = 0; nt < 8; ++nt) {
                f32x4 acc = (f32x4){0.f, 0.f, 0.f, 0.f};
#pragma unroll
                for (int k = 0; k < 2; ++k) { const bf16x8 bfr = *(const LAS bf16x8*)(BmT + (nt * 16 + (lane & 15)) * 72 + k * 32 + (lane >> 4) * 8);
                    acc = __builtin_amdgcn_mfma_f32_16x16x32_bf16(bfr, xf[k], acc, 0, 0, 0); }
                u32x2 o; o.x = pk2(acc[0], acc[1]); o.y = pk2(acc[2], acc[3]);
                *(u32x2*)(STATES + ((((size_t)b * NCH + c) * 8 + hh) * 64 + pt * 16 + (lane & 15)) * 128 + nt * 16 + (lane >> 4) * 4) = o; } }
    }
    __syncthreads();
}
DEV void ssd_scan_all(const Params& p, int bx, LAS unsigned char* lds, int tid) {
    asm volatile("" : "+v"(tid));
    bf16* STATES = (bf16*)(p.ws + WS_STATES); const float* CDEC = (const float*)(p.ws + WS_CDEC);
    LAS float* decS = (LAS float*)lds;
    const int idx = bx * 512 + tid, b = idx >> 15, rem = idx & 32767, hh = rem >> 12, pn2 = rem & 4095;
    if (tid < 64) decS[tid] = CDEC[((size_t)b * NCH + tid) * 8 + hh];
    unsigned* base = (unsigned*)(STATES + ((size_t)b * NCH * 8 + hh) * 8192) + pn2;
    unsigned nw[NCH];
#pragma unroll
    for (int c = 0; c < NCH; ++c) nw[c] = base[(size_t)c * 8 * 4096];
    __syncthreads();
    float s0 = 0.f, s1 = 0.f;
#pragma unroll
    for (int c = 0; c < NCH; ++c) { const float d = decS[c];
        base[(size_t)c * 8 * 4096] = pk2(s0, s1);
        s0 = s0 * d + bflo(nw[c]); s1 = s1 * d + bfhi(nw[c]); }
    __syncthreads();
}
DEV void ssd_p3_unit(const Params& p, int l, int u, LAS unsigned char* lds, int tid) {
    asm volatile("" : "+v"(tid));
    const int b = u >> 7, c = (u >> 1) & 63, g = u & 1, wave = tid >> 6, lane = tid & 63;
    const bf16* PROJ = (const bf16*)(p.ws + WS_PROJ); const float* ACS = (const float*)(p.ws + WS_ACS);
    const bf16* STATES = (const bf16*)(p.ws + WS_STATES); const bf16* YPART = (const bf16*)(p.ws + WS_YPART); const bf16* CCONV = (const bf16*)(p.ws + WS_CCONV);
    bf16* MIX = (bf16*)(p.ws + WS_MIX);
    LAS bf16* Cm = (LAS bf16*)lds;
    LAS bf16* Prev = Cm + 64 * 136;
    LAS float* Gb = (LAS float*)Prev;
    LAS float* acsS = (LAS float*)(Prev + 4 * 64 * 136);
    const size_t t0 = (size_t)b * SEQ + (size_t)c * CH;
    const int h = wave >> 1, hh = g * 4 + h;
    u32x4 rc[2], rp[8]; u32x2 ry[8], rz[8]; float racs = 0.f;
#pragma unroll
    for (int k = 0; k < 2; ++k) { const int idx = tid + k * 512, r = idx >> 4, v = idx & 15; rc[k] = *(const u32x4*)(CCONV + (t0 + r) * 256 + g * 128 + v * 8); }
#pragma unroll
    for (int k = 0; k < 8; ++k) { const int idx = tid + k * 512, hq = idx >> 10, r = (idx >> 4) & 63, v = idx & 15;
        rp[k] = *(const u32x4*)(STATES + ((((size_t)b * NCH + c) * 8 + g * 4 + hq) * 64 + r) * 128 + v * 8); }
    if (tid < 256) racs = ACS[(t0 + (tid & 63)) * 8 + g * 4 + (tid >> 6)];
#pragma unroll
    for (int ti = 0; ti < 8; ++ti) { const int tt = (wave & 1) * 8 + ti, mt = tt >> 2, nt = tt & 3, lr = mt * 16 + (lane & 15), p0 = nt * 16 + (lane >> 4) * 4;
        ry[ti] = *(const u32x2*)(YPART + (t0 + lr) * 512 + hh * 64 + p0); rz[ti] = *(const u32x2*)(PROJ + (t0 + lr) * NPROJ + 512 + hh * 64 + p0); }
#pragma unroll
    for (int k = 0; k < 2; ++k) { const int idx = tid + k * 512, r = idx >> 4, v = idx & 15; *(LAS u32x4*)(Cm + r * 136 + v * 8) = rc[k]; }
#pragma unroll
    for (int k = 0; k < 8; ++k) { const int idx = tid + k * 512, hq = idx >> 10, r = (idx >> 4) & 63, v = idx & 15; *(LAS u32x4*)(Prev + hq * 64 * 136 + r * 136 + v * 8) = rp[k]; }
    if (tid < 256) acsS[tid] = racs;
    __syncthreads();
    f32x4 acc[8];
#pragma unroll
    for (int ti = 0; ti < 8; ++ti) { const int tt = (wave & 1) * 8 + ti, mt = tt >> 2, nt = tt & 3;
        acc[ti] = mma_tile(Prev + h * 64 * 136 + nt * 16 * 136, 136, Cm + mt * 16 * 136, 136, 128, lane, (f32x4){0.f, 0.f, 0.f, 0.f}); }
    __syncthreads();
#pragma unroll
    for (int ti = 0; ti < 8; ++ti) { const int tt = (wave & 1) * 8 + ti, mt = tt >> 2, nt = tt & 3, lr = mt * 16 + (lane & 15), p0 = nt * 16 + (lane >> 4) * 4;
        const float ea = __expf(acsS[h * 64 + lr]);
        f32x4 gv;
        gv.x = (bflo(ry[ti].x) + ea * acc[ti][0]) * silu(bflo(rz[ti].x)); gv.y = (bfhi(ry[ti].x) + ea * acc[ti][1]) * silu(bfhi(rz[ti].x));
        gv.z = (bflo(ry[ti].y) + ea * acc[ti][2]) * silu(bflo(rz[ti].y)); gv.w = (bfhi(ry[ti].y) + ea * acc[ti][3]) * silu(bfhi(rz[ti].y));
        *(LAS f32x4*)(Gb + lr * 260 + h * 64 + p0) = gv; }
    __syncthreads();
    {
        const int lr = tid >> 3, part = tid & 7;
        const f32x4* nwp = (const f32x4*)(p.snorm_w + (size_t)l * 512 + g * 256 + part * 32);
        f32x4 nw[8], v[8]; float ss = 0.f;
#pragma unroll
        for (int k = 0; k < 8; ++k) nw[k] = nwp[k];
#pragma unroll
        for (int k = 0; k < 8; ++k) { v[k] = *(const LAS f32x4*)(Gb + lr * 260 + part * 32 + k * 4); ss += (v[k].x * v[k].x + v[k].y * v[k].y) + (v[k].z * v[k].z + v[k].w * v[k].w); }
        ss = red8_sum(ss);
        const float rstd = rsqrtf(ss * (1.0f / 256.0f) + EPS);
        bf16* dst = MIX + (t0 + lr) * DM + 256 + g * 256 + part * 32;
#pragma unroll
        for (int k = 0; k < 4; ++k) { const f32x4 a = v[2 * k] * rstd * nw[2 * k], bq = v[2 * k + 1] * rstd * nw[2 * k + 1];
            u32x4 o; o.x = pk2(a.x, a.y); o.y = pk2(a.z, a.w); o.z = pk2(bq.x, bq.y); o.w = pk2(bq.z, bq.w);
            *(u32x4*)(dst + 8 * k) = o; }
    }
    __syncthreads();
}

DEV void gdn_pre_unit(const Params& p, int l, int u, LAS unsigned char* lds, int tid) {
    asm volatile("" : "+v"(tid));
    const int b = u >> 8, c = (u >> 2) & 63, hg = u & 3, wave = tid >> 6, lane = tid & 63;
    const int ub = (b * 4 + hg) * 64 + c;
    const bf16* PROJ = (const bf16*)(p.ws + WS_PROJ); const float* SMALL = (const float*)(p.ws + WS_SMALL);
    bf16* GU = (bf16*)(p.ws + WS_GU) + (size_t)ub * 4096; bf16* GW = (bf16*)(p.ws + WS_GW) + (size_t)ub * 4096; bf16* GQE = (bf16*)(p.ws + WS_GQE) + (size_t)ub * 4096;
    bf16* GQK = (bf16*)(p.ws + WS_GQK) + (size_t)ub * 4096; bf16* GKDT = (bf16*)(p.ws + WS_GKDT) + (size_t)ub * 4096; float* EGL = (float*)(p.ws + WS_EGL);
    LAS bf16* Raw = (LAS bf16*)lds;
    LAS float* Xn = (LAS float*)lds;
    LAS float* Qs = (LAS float*)(lds + 25728);
    LAS float* Ks = Qs + 64 * 65;
    LAS float* Vs = Ks + 64 * 65;
    LAS float* Am = Vs + 64 * 65;
    LAS float* betaS = Am + 64 * 64;
    LAS float* gcS = betaS + 64;
    LAS float* scwS = gcS + 64;
    LAS float* egS = scwS + 64;
    LAS float* kdS = egS + 64;
    LAS float* R = kdS + 64;
    LAS float* At = R + 64 * 128;
    LAS float* Dv = At + 64 * 64;
    const size_t t0 = (size_t)b * SEQ + (size_t)c * CH;
    u32x4 rr[4];
#pragma unroll
    for (int k = 0; k < 4; ++k) { const int idx = tid + k * 512, row = idx / 24, rem = idx % 24, seg = rem >> 3, v = rem & 7;
        rr[k] = (u32x4){0u, 0u, 0u, 0u};
        if (idx < 67 * 24 && (c > 0 || row >= 3)) rr[k] = *(const u32x4*)(PROJ + (size_t)((long)t0 - 3 + row) * NPROJ + 2048 + seg * 256 + hg * 64 + v * 8); }
    if (wave == 0) {
        const float beta = frcp(1.0f + expf(-SMALL[(t0 + lane) * 16 + 8 + hg]));
        const float gg = -expf(p.gA_log[l * 4 + hg]) * softplus(SMALL[(t0 + lane) * 16 + 12 + hg] + p.gdt_bias[l * 4 + hg]);
        const float gc = wave_incl_scan(gg, lane);
        const float glast = rdlane(gc, 63), eg = expf(gc);
        betaS[lane] = beta; gcS[lane] = gc; scwS[lane] = beta * eg; egS[lane] = eg; kdS[lane] = expf(glast - gc);
        if (lane == 63) EGL[ub] = eg;
    }
#pragma unroll
    for (int k = 0; k < 4; ++k) { const int idx = tid + k * 512, row = idx / 24, rem = idx % 24;
        if (idx < 67 * 24) *(LAS u32x4*)(Raw + row * 192 + rem * 8) = rr[k]; }
    __syncthreads();
    for (int rq_ = 0; rq_ < RG_CONV; ++rq_)
#pragma unroll
    for (int seg = 0; seg < 3; ++seg) {
        const float* cw = p.gconv_w + (size_t)l * 3072 + seg * 256 + hg * 64 + lane; const float w0 = cw[0], w1 = cw[768], w2 = cw[1536], w3 = cw[2304];
        LAS float* dst = seg == 0 ? Qs : (seg == 1 ? Ks : Vs);
        const int r0 = wave * 8;
        float x0 = bf2f(Raw[(r0 + 0) * 192 + seg * 64 + lane]), x1 = bf2f(Raw[(r0 + 1) * 192 + seg * 64 + lane]), x2 = bf2f(Raw[(r0 + 2) * 192 + seg * 64 + lane]);
#pragma unroll
        for (int r = 0; r < 8; ++r) { const float x3 = bf2f(Raw[(r0 + r + 3) * 192 + seg * 64 + lane]);
            float y = silu(w0 * x0 + w1 * x1 + w2 * x2 + w3 * x3);
            if (seg < 2) { const float ss = wave_sum(y * y); y *= rsqrtf(ss + EPS); if (seg == 0) y *= 0.125f; }
            dst[(r0 + r) * 65 + lane] = y; x0 = x1; x1 = x2; x2 = x3; }
    }
    __syncthreads();
    for (int rq_ = 0; rq_ < RG_KK; ++rq_)
    {
        for (int t = wave; t < 20; t += 8) {
            const bool isqk = t >= 10; const int idx = isqk ? t - 10 : t;
            const int mt = idx >= 6 ? 3 : (idx >= 3 ? 2 : (idx >= 1 ? 1 : 0)), nt = idx - mt * (mt + 1) / 2;
            const LAS float* ap = (isqk ? Qs : Ks) + (mt * 16 + (lane & 15)) * 65 + (lane >> 4);
            const LAS float* bp = Ks + (nt * 16 + (lane & 15)) * 65 + (lane >> 4);
            f32x4 acc = (f32x4){0.f, 0.f, 0.f, 0.f};
#pragma unroll
            for (int ks = 0; ks < 16; ++ks) acc = __builtin_amdgcn_mfma_f32_16x16x4f32(ap[ks * 4], bp[ks * 4], acc, 0, 0, 0);
            const int j = nt * 16 + (lane & 15), i0 = mt * 16 + (lane >> 4) * 4; const float gj = gcS[j];
            float v[4];
#pragma unroll
            for (int jj = 0; jj < 4; ++jj) { const int i = i0 + jj; const float dec = (j <= i) ? __expf(gcS[i] - gj) : 0.f;
                v[jj] = isqk ? acc[jj] * dec : ((j < i) ? betaS[i] * acc[jj] * dec : 0.f); }
            if (!isqk) {
#pragma unroll
                for (int jj = 0; jj < 4; ++jj) Am[(i0 + jj) * 64 + j] = v[jj];
                *(LAS f32x4*)(At + j * 64 + i0) = (f32x4){v[0], v[1], v[2], v[3]};
            } else {
#pragma unroll
                for (int jj = 0; jj < 4; ++jj) GQK[(i0 + jj) * 64 + j] = (bf16)f2bf(v[jj]);
            }
        }
        { const int e0 = tid * 8, i = e0 >> 6, j = e0 & 63; if ((j >> 4) > (i >> 4)) *(u32x4*)(GQK + e0) = (u32x4){0u, 0u, 0u, 0u}; }
    }
    __syncthreads();
    for (int rq_ = 0; rq_ < RG_SOLVE; ++rq_) {
    if (wave == 7) {
        const int bb = lane >> 4, cc = lane & 15;
        float x[16];
#pragma unroll
        for (int i = 0; i < 16; ++i) {
            float acc = (i == cc) ? 1.f : 0.f;
#pragma unroll
            for (int q4 = 0; q4 < 4; ++q4) if (q4 * 4 < i) { const f32x4 a = *(const LAS f32x4*)(Am + (bb * 16 + i) * 64 + bb * 16 + q4 * 4);
                if (q4 * 4 + 0 < i) acc -= a.x * x[q4 * 4 + 0];
                if (q4 * 4 + 1 < i) acc -= a.y * x[q4 * 4 + 1];
                if (q4 * 4 + 2 < i) acc -= a.z * x[q4 * 4 + 2];
                if (q4 * 4 + 3 < i) acc -= a.w * x[q4 * 4 + 3]; }
            x[i] = acc;
            Dv[bb * 256 + i * 16 + cc] = acc;
        }
    } else {
#pragma unroll 4
        for (int e = tid; e < 8192; e += 448) { const int i = e >> 7, col = e & 127;
            R[e] = (col < 64) ? Vs[i * 65 + col] * betaS[i] : Ks[i * 65 + col - 64] * scwS[i]; }
#pragma unroll 4
        for (int e = tid; e < 4096; e += 448) { const int r = e >> 6, d = e & 63;
            GQE[e] = (bf16)f2bf(Qs[r * 65 + d] * egS[r]);
            GKDT[e] = (bf16)f2bf(Ks[d * 65 + r] * kdS[d]); }
    }
    __syncthreads();
    {
        const int col = tid & 127, q = tid >> 7;
        bf16* dstg = (col >= 64 ? GW : GU) + (col & 63);
#pragma unroll 1
        for (int rb = 0; rb < 4; ++rb) {
            if (rb > 0) {
                LAS float* rp = R + (16 * rb + 4 * q) * 128 + col;
                float r0 = rp[0], r1 = rp[128], r2 = rp[256], r3 = rp[384];
                const LAS float* xp = Xn + col; const LAS float* ap = At + 16 * rb + 4 * q;
#pragma unroll 8
                for (int j = 0; j < 16 * rb; ++j) { const float xj = xp[j * 128]; const f32x4 a = *(const LAS f32x4*)(ap + j * 64);
                    r0 -= a.x * xj; r1 -= a.y * xj; r2 -= a.z * xj; r3 -= a.w * xj; }
                rp[0] = r0; rp[128] = r1; rp[256] = r2; rp[384] = r3;
                __syncthreads();
            }
            float rv[16];
#pragma unroll
            for (int jj = 0; jj < 16; ++jj) rv[jj] = R[(16 * rb + jj) * 128 + col];
#pragma unroll
            for (int k = 0; k < 4; ++k) { const int ii = 4 * q + k; const LAS f32x4* dp = (const LAS f32x4*)(Dv + rb * 256 + ii * 16);
                const f32x4 d0 = dp[0], d1 = dp[1], d2 = dp[2], d3 = dp[3];
                const float acc = ((d0.x * rv[0] + d0.y * rv[1]) + (d0.z * rv[2] + d0.w * rv[3])) + ((d1.x * rv[4] + d1.y * rv[5]) + (d1.z * rv[6] + d1.w * rv[7]))
                                + ((d2.x * rv[8] + d2.y * rv[9]) + (d2.z * rv[10] + d2.w * rv[11])) + ((d3.x * rv[12] + d3.y * rv[13]) + (d3.z * rv[14] + d3.w * rv[15]));
                Xn[(16 * rb + ii) * 128 + col] = acc; dstg[(16 * rb + ii) * 64] = (bf16)f2bf(acc); }
            __syncthreads();
        }
    }
    }
}
DEV void gdn_scan_block(const Params& p, int bh, LAS unsigned char* lds, int tid) {
    asm volatile("" : "+v"(tid));
    const int b = bh >> 2, hg = bh & 3, wave = tid >> 6, lane = tid & 63;
    const size_t ub0 = (size_t)bh * 64;
    const bf16* GM0 = (const bf16*)(p.ws + WS_GW) + ub0 * 4096; const bf16* GM1 = (const bf16*)(p.ws + WS_GQE) + ub0 * 4096;
    const bf16* GM2 = (const bf16*)(p.ws + WS_GQK) + ub0 * 4096; const bf16* GM3 = (const bf16*)(p.ws + WS_GKDT) + ub0 * 4096;
    const bf16* GM4 = (const bf16*)(p.ws + WS_GU) + ub0 * 4096;
    const float* EGL = (const float*)(p.ws + WS_EGL) + ub0;
    bf16* MIX = (bf16*)(p.ws + WS_MIX);
    LAS bf16* OPS = (LAS bf16*)lds;
    LAS bf16* PRV = OPS + 2 * 5 * 4608;
    LAS float* egS = (LAS float*)(PRV + 4 * 2 * 1152);
    if (tid < 64) egS[tid] = EGL[tid];
    if (wave < 4) {
        const int es = wave, fr = lane & 15, fq = lane >> 4;
        LAS bf16* Stp = PRV + es * 2304; LAS bf16* Vtp = Stp + 1152;
        for (int i = lane; i < 1152; i += 64) Stp[i] = 0;
        f32x4 Sacc[4];
#pragma unroll
        for (int mt = 0; mt < 4; ++mt) Sacc[mt] = (f32x4){0.f, 0.f, 0.f, 0.f};
        bf16* obase = MIX + ((size_t)b * SEQ + fr) * DM + 768 + hg * 64 + es * 16 + fq * 4;
        __syncthreads();
#pragma unroll 2
        for (int c = 0; c < NCH; ++c) {
            const LAS bf16* Wb = OPS + (c & 1) * 5 * 4608;
            const int fo = fr * 72 + fq * 8;
            const bf16x8 fS0 = *(const LAS bf16x8*)(Stp + fo), fS1 = *(const LAS bf16x8*)(Stp + fo + 32);
            bf16x8 fW[4][2], fQE[4][2], fQK[4][2], fKD[4][2]; u32x2 uw[4];
#pragma unroll
            for (int mt = 0; mt < 4; ++mt)
#pragma unroll
                for (int ks = 0; ks < 2; ++ks) fW[mt][ks] = *(const LAS bf16x8*)(Wb + mt * 16 * 72 + fo + ks * 32);
#pragma unroll
            for (int mt = 0; mt < 4; ++mt) uw[mt] = *(const LAS u32x2*)(Wb + 4 * 4608 + (mt * 16 + fr) * 72 + es * 16 + fq * 4);
#pragma unroll
            for (int mt = 0; mt < 4; ++mt)
#pragma unroll
                for (int ks = 0; ks < 2; ++ks) fQE[mt][ks] = *(const LAS bf16x8*)(Wb + 4608 + mt * 16 * 72 + fo + ks * 32);
#pragma unroll
            for (int mt = 0; mt < 4; ++mt)
#pragma unroll
                for (int ks = 0; ks < 2; ++ks) fKD[mt][ks] = *(const LAS bf16x8*)(Wb + 3 * 4608 + mt * 16 * 72 + fo + ks * 32);
#pragma unroll
            for (int mt = 0; mt < 4; ++mt)
#pragma unroll
                for (int ks = 0; ks < 2; ++ks) fQK[mt][ks] = *(const LAS bf16x8*)(Wb + 2 * 4608 + mt * 16 * 72 + fo + ks * 32);
            const float egl = egS[c];
            f32x4 av[4], ov[4];
#pragma unroll
            for (int mt = 0; mt < 4; ++mt) {
                av[mt] = __builtin_amdgcn_mfma_f32_16x16x32_bf16(fS0, fW[mt][0], (f32x4){0.f, 0.f, 0.f, 0.f}, 0, 0, 0);
                av[mt] = __builtin_amdgcn_mfma_f32_16x16x32_bf16(fS1, fW[mt][1], av[mt], 0, 0, 0); }
#pragma unroll
            for (int mt = 0; mt < 4; ++mt) {
                ov[mt] = __builtin_amdgcn_mfma_f32_16x16x32_bf16(fS0, fQE[mt][0], (f32x4){0.f, 0.f, 0.f, 0.f}, 0, 0, 0);
                ov[mt] = __builtin_amdgcn_mfma_f32_16x16x32_bf16(fS1, fQE[mt][1], ov[mt], 0, 0, 0); }
#pragma unroll
            for (int mt = 0; mt < 4; ++mt) {
                LAS bf16* vp = Vtp + (fq * 4) * 72 + mt * 16 + fr;
                vp[0] = (bf16)f2bf(bflo(uw[mt].x) - av[mt][0]); vp[72] = (bf16)f2bf(bfhi(uw[mt].x) - av[mt][1]);
                vp[144] = (bf16)f2bf(bflo(uw[mt].y) - av[mt][2]); vp[216] = (bf16)f2bf(bfhi(uw[mt].y) - av[mt][3]); }
            const bf16x8 fV0 = *(const LAS bf16x8*)(Vtp + fo), fV1 = *(const LAS bf16x8*)(Vtp + fo + 32);
#pragma unroll
            for (int mt = 0; mt < 4; ++mt) {
                f32x4 sa = Sacc[mt] * egl;
                sa = __builtin_amdgcn_mfma_f32_16x16x32_bf16(fKD[mt][0], fV0, sa, 0, 0, 0);
                sa = __builtin_amdgcn_mfma_f32_16x16x32_bf16(fKD[mt][1], fV1, sa, 0, 0, 0);
                Sacc[mt] = sa;
                u32x2 sw; sw.x = pk2(sa[0], sa[1]); sw.y = pk2(sa[2], sa[3]);
                *(LAS u32x2*)(Stp + fr * 72 + mt * 16 + fq * 4) = sw; }
#pragma unroll
            for (int mt = 0; mt < 4; ++mt) {
                f32x4 o = __builtin_amdgcn_mfma_f32_16x16x32_bf16(fV0, fQK[mt][0], ov[mt], 0, 0, 0);
                o = __builtin_amdgcn_mfma_f32_16x16x32_bf16(fV1, fQK[mt][1], o, 0, 0, 0);
                u32x2 ow; ow.x = pk2(o[0], o[1]); ow.y = pk2(o[2], o[3]);
                *(u32x2*)(obase + ((size_t)c * CH + mt * 16) * DM) = ow; }
            __syncthreads();
        }
    } else {
        const int lt = tid - 256;
        u32x4 rg[4][10];
#define GDN_ISSUE(k, ch) { const size_t co = (size_t)((ch) < NCH ? (ch) : NCH - 1) * 4096; \
            _Pragma("unroll") for (int h2 = 0; h2 < 2; ++h2) { const int idx = lt + h2 * 256, row = idx >> 3, v = idx & 7; \
                rg[k][0 + h2] = *(const u32x4*)(GM0 + co + row * 64 + v * 8); rg[k][2 + h2] = *(const u32x4*)(GM1 + co + row * 64 + v * 8); \
                rg[k][4 + h2] = *(const u32x4*)(GM2 + co + row * 64 + v * 8); rg[k][6 + h2] = *(const u32x4*)(GM3 + co + row * 64 + v * 8); \
                rg[k][8 + h2] = *(const u32x4*)(GM4 + co + row * 64 + v * 8); } }
#define GDN_COMMIT(k, set) { LAS bf16* sb = OPS + (set) * 5 * 4608; \
            _Pragma("unroll") for (int m = 0; m < 5; ++m) _Pragma("unroll") for (int h2 = 0; h2 < 2; ++h2) { const int idx = lt + h2 * 256, row = idx >> 3, v = idx & 7; \
                *(LAS u32x4*)(sb + m * 4608 + row * 72 + v * 8) = rg[k][m * 2 + h2]; } }
        GDN_ISSUE(0, 0) GDN_ISSUE(1, 1) GDN_ISSUE(2, 2) GDN_ISSUE(3, 3)
        GDN_COMMIT(0, 0)
        __syncthreads();
        for (int c = 0; c < NCH; c += 4) {
            GDN_COMMIT(1, 1) GDN_ISSUE(0, c + 4) __syncthreads();
            GDN_COMMIT(2, 0) GDN_ISSUE(1, c + 5) __syncthreads();
            GDN_COMMIT(3, 1) GDN_ISSUE(2, c + 6) __syncthreads();
            GDN_COMMIT(0, 0) GDN_ISSUE(3, c + 7) __syncthreads();
        }
#undef GDN_ISSUE
#undef GDN_COMMIT
    }
}
DEV void gdn_post(const Params& p, int l, int gw, int NGW, int lane) {
    bf16* MIX = (bf16*)(p.ws + WS_MIX); const bf16* PROJ = (const bf16*)(p.ws + WS_PROJ);
    const f32x4 nw = *((const f32x4*)(p.gnorm_w + (size_t)l * 64) + (lane & 15));
    for (int m = gw; m < MTOK; m += NGW) {
        bf16* op = MIX + (size_t)m * DM + 768 + lane * 4;
        const u32x2 ow = *(const u32x2*)op; const u32x2 zw = *(const u32x2*)(PROJ + (size_t)m * NPROJ + 2816 + lane * 4);
        const float o0 = bflo(ow.x), o1 = bfhi(ow.x), o2 = bflo(ow.y), o3 = bfhi(ow.y);
        float ss = (o0 * o0 + o1 * o1) + (o2 * o2 + o3 * o3);
        ss = red16_sum(ss);
        const float rstd = rsqrtf(ss * (1.0f / 64.0f) + EPS);
        u32x2 r; r.x = pk2(o0 * rstd * nw.x * silu(bflo(zw.x)), o1 * rstd * nw.y * silu(bfhi(zw.x))); r.y = pk2(o2 * rstd * nw.z * silu(bflo(zw.y)), o3 * rstd * nw.w * silu(bfhi(zw.y)));
        *(u32x2*)op = r;
    }
}

#define XB_TMO      128
#define XB_XCNT(j)  (256  + 64 * (j))
#define XB_XSUB(j)  (1280 + 64 * (j))
#define XB_XGEN(j)  (2304 + 64 * (j))
#define XB_TOP      3328
#define XB_TOPGEN   3392
#define XCD_BAR_WORDS 3456
#define XB_SPIN_CAP (1u << 18)

__device__ __forceinline__ unsigned xb_ld(unsigned* p)              { return __hip_atomic_load(p, __ATOMIC_RELAXED, __HIP_MEMORY_SCOPE_AGENT); }
__device__ __forceinline__ unsigned xb_add(unsigned* p, unsigned v) { return __hip_atomic_fetch_add(p, v, __ATOMIC_RELAXED, __HIP_MEMORY_SCOPE_AGENT); }
__device__ __forceinline__ unsigned xb_xcc_id() { return (unsigned)__builtin_amdgcn_s_getreg((3 << 11) | 20) & 0xFu; }
#define XB_SPIN(cond, bar) do { unsigned _sp = 0; while (cond) { __builtin_amdgcn_s_sleep(1); \
    if ((++_sp & 255u) == 0u) { if (xb_ld(&(bar)[XB_TMO])) break; if (_sp > XB_SPIN_CAP) { atomicAdd(&(bar)[XB_TMO], 1u); break; } } } } while (0)

struct XcdBarrier {
    unsigned* bar; unsigned x;
    volatile LAS unsigned* st;
};

__device__ __forceinline__ XcdBarrier xcd_barrier_post(unsigned* bar, volatile LAS unsigned* st) {
    XcdBarrier b; b.bar = bar; b.x = xb_xcc_id(); b.st = st;
    if (threadIdx.x == 0) (void)xb_add(&bar[XB_XCNT(b.x)], 1u);
    return b;
}
__device__ __forceinline__ void xcd_barrier_complete(unsigned* bar, unsigned x, unsigned& nloc, unsigned& nx) {
    const unsigned G = gridDim.x * gridDim.y * gridDim.z;
    unsigned sum, cnt, mine, sp = 0u;
    for (;;) {
        sum = 0u; cnt = 0u; mine = 0u;
#pragma unroll
        for (unsigned j = 0; j < 16; ++j) { const unsigned c = xb_ld(&bar[XB_XCNT(j)]); sum += c; cnt += (c > 0u) ? 1u : 0u; mine = (j == x) ? c : mine; }
        if (sum == G) break;
        __builtin_amdgcn_s_sleep(1);
        if ((++sp & 255u) == 0u) { if (xb_ld(&bar[XB_TMO])) break; if (sp > XB_SPIN_CAP) { atomicAdd(&bar[XB_TMO], 1u); break; } }
    }
    nloc = mine > 0u ? mine : 1u; nx = cnt > 0u ? cnt : 1u;
}

__device__ __forceinline__ void xcd_barrier(const XcdBarrier& b) {
    asm volatile("s_waitcnt vmcnt(0)" ::: "memory");
    __syncthreads();
    if (threadIdx.x == 0) {
        unsigned* bar = b.bar;
        __builtin_amdgcn_s_waitcnt(0);
        unsigned nloc = b.st[0], nx = b.st[1];
        if (nloc == 0u) { xcd_barrier_complete(bar, b.x, nloc, nx); b.st[0] = nloc; b.st[1] = nx; }
        const unsigned old = xb_add(&bar[XB_XSUB(b.x)], 1u);
        const unsigned gen = old / nloc;
        if (old + 1u == (gen + 1u) * nloc) {
            __builtin_amdgcn_fence(__ATOMIC_RELEASE, "agent");
            asm volatile("s_waitcnt vmcnt(0)" ::: "memory");
            const unsigned og = xb_add(&bar[XB_TOP], 1u);
            const unsigned tg = og / nx;
            if (og + 1u == (tg + 1u) * nx) xb_add(&bar[XB_TOPGEN], 1u);
            else XB_SPIN(xb_ld(&bar[XB_TOPGEN]) == tg, bar);
            __builtin_amdgcn_fence(__ATOMIC_ACQUIRE, "agent");
            xb_add(&bar[XB_XGEN(b.x)], 1u);
            asm volatile("s_waitcnt vmcnt(0)" ::: "memory");
        } else {
            XB_SPIN(xb_ld(&bar[XB_XGEN(b.x)]) == gen, bar);
            __builtin_amdgcn_fence(__ATOMIC_ACQUIRE, "agent");
            asm volatile("s_waitcnt vmcnt(0)" ::: "memory");
        }
    }
    __syncthreads();
}
__global__ void __launch_bounds__(512, 2) fwd_megakernel(Params p) {
    extern __shared__ __attribute__((aligned(16))) unsigned char lds_raw[];
    cg::grid_group grid = cg::this_grid();
    LAS unsigned char* lds = (LAS unsigned char*)lds_raw;
    const int tid = threadIdx.x, lane = tid & 63, wave = __builtin_amdgcn_readfirstlane(tid >> 6);
    const int G = gridDim.x, bx = blockIdx.x, gw = bx * 8 + wave, NGW = G * 8;
    bf16* XN = (bf16*)(p.ws + WS_XN); float* SMALL = (float*)(p.ws + WS_SMALL); bf16* TMP = (bf16*)(p.ws + WS_TMP);
    bf16* PROJ = (bf16*)(p.ws + WS_PROJ); bf16* MIX = (bf16*)(p.ws + WS_MIX); bf16* HB = (bf16*)(p.ws + WS_H);
    LAS float* wsT = (LAS float*)(lds + 69632);
    volatile LAS unsigned* misc = (volatile LAS unsigned*)(lds + 147200);
    if (tid < 4) misc[tid] = 0u;
    __syncthreads();
    XcdBarrier xbar = xcd_barrier_post((unsigned*)p.ws, misc);
#define GSYNC() xcd_barrier(xbar)

#define PHASE_IDS() int tidp = threadIdx.x; int lq = l; asm volatile("" : "+v"(tidp), "+s"(lq)); const int lanep = tidp & 63; const int wavep = __builtin_amdgcn_readfirstlane(tidp >> 6); const int gwp = bx * 8 + wavep; (void)lanep; (void)gwp; (void)lq
#pragma unroll 1
    for (int l = 0; l < DEPTH; ++l) {
        {
            PHASE_IDS();
            convert_weights(p, lq, lds, gwp, NGW, wavep, lanep);
            if (lq == 0) {
                stage_small(p, 0, wsT, tidp);
                __syncthreads();
                rowpass<0>(p.x, nullptr, nullptr, p.pre_mix, nullptr, XN, SMALL, wsT, gwp, NGW, lanep);
            }
        }
        if (l == 0) grid.sync(); else GSYNC();
#ifdef REP_SYNC
        for (int rep = 0; rep < REP_SYNC; ++rep) GSYNC();
#endif
        {
            pg8::Gemm g{XN, (const bf16*)(p.ws + WS_WIN), MTOK, NPROJ, DM}; pg8::StaticOrder S; S.init(MTOK, NPROJ, G, bx);
            pg8::EpiStoreBf16 E{PROJ, NPROJ};
            pg8::gemm_phase<pg8::EpiStoreBf16, pg8::StaticOrder, true, true>(lds, g, S, E);
        }
        GSYNC();
        {
            PHASE_IDS();
            for (int u = bx; u < 1024; u += G) gdn_pre_unit(p, lq, u, lds, tidp);
        }
        GSYNC();
        {
            PHASE_IDS();
            if (bx < 16) gdn_scan_block(p, bx, lds, tidp);
            else { for (int u = bx - 16; u < 1024; u += G - 16) { if (u < 512) ssd_p1_unit(p, lq, u, lds, tidp); else attn_unit(p, lq, u - 512, lds, tidp); } }
        }
        GSYNC();
        {
            PHASE_IDS();
            for (int vb = bx; vb < 256; vb += G) ssd_scan_all(p, vb, lds, tidp);
        }
        GSYNC();
        {
            PHASE_IDS();
            for (int rep = 0; rep < REP_E; ++rep) {
                if (rep) GSYNC();
                for (int u = bx; u < 512; u += G) ssd_p3_unit(p, lq, u, lds, tidp);
            }
            gdn_post(p, lq, gwp, NGW, lanep);
        }
        GSYNC();
        {
            pg8::Gemm g{MIX, (const bf16*)(p.ws + WS_WOUT), MTOK, DM, DM}; pg8::StaticOrder S; S.init(MTOK, DM, G, bx);
            pg8::EpiStoreBf16 E{TMP, DM};
            pg8::gemm_phase<pg8::EpiStoreBf16, pg8::StaticOrder, true, true>(lds, g, S, E);
        }
        GSYNC();
        {
            PHASE_IDS();
            rowpass<1>(lq == 0 ? p.x : p.out, TMP, p.post_mix + (size_t)lq * DM, p.pre_ffn + (size_t)lq * DM, p.out, XN, nullptr, wsT, gwp, NGW, lanep);
        }
        GSYNC();
        {
            pg8::Gemm g{XN, (const bf16*)(p.ws + WS_WGU), MTOK, 2 * FF, DM}; pg8::StaticOrder S; S.init(MTOK, 2 * FF, G, bx);
            pg8::EpiSwiGLU E{HB, FF};
            pg8::gemm_phase<pg8::EpiSwiGLU, pg8::StaticOrder, true, true>(lds, g, S, E);
        }
        GSYNC();
        {
            pg8::Gemm g{HB, (const bf16*)(p.ws + WS_WDN), MTOK, DM, FF}; pg8::StaticOrder S; S.init(MTOK, DM, G, bx);
            pg8::EpiStoreBf16 E{TMP, DM};
            pg8::gemm_phase<pg8::EpiStoreBf16, pg8::StaticOrder, true, true>(lds, g, S, E);
        }
        GSYNC();
        {
            PHASE_IDS();
            if (lq + 1 < DEPTH) {
                stage_small(p, lq + 1, wsT, tidp);
                __syncthreads();
                rowpass<2>(p.out, TMP, p.post_ffn + (size_t)lq * DM, p.pre_mix + (size_t)(lq + 1) * DM, p.out, XN, SMALL, wsT, gwp, NGW, lanep);
                __syncthreads();
            } else {
                rowpass<3>(p.out, TMP, p.post_ffn + (size_t)lq * DM, nullptr, p.out, nullptr, nullptr, wsT, gwp, NGW, lanep);
            }
        }
    }
}

extern "C" void kernel_launch(void* const* d_in, const int* in_sizes, int n_in, void* d_out, int out_size, void* d_ws, size_t ws_size, hipStream_t stream) {
    static int grid = 0;
    if (grid == 0) {
        if (n_in != 21 || out_size != MTOK * DM || ws_size < WS_END) { fprintf(stderr, "kernel_launch: unexpected shapes (n_in %d out %d ws %zu)\n", n_in, out_size, ws_size); grid = -1; return; }
        int dev = 0, cus = 0, per_cu = 0;
        hipGetDevice(&dev); hipDeviceGetAttribute(&cus, hipDeviceAttributeMultiprocessorCount, dev);
        if (hipFuncSetAttribute((const void*)fwd_megakernel, hipFuncAttributeMaxDynamicSharedMemorySize, LDS_BYTES) != hipSuccess) { fprintf(stderr, "kernel_launch: hipFuncSetAttribute failed\n"); grid = -1; return; }
        hipOccupancyMaxActiveBlocksPerMultiprocessor(&per_cu, (const void*)fwd_megakernel, 512, LDS_BYTES);
        if (per_cu < 1) { fprintf(stderr, "kernel_launch: occupancy query says %d blocks per CU\n", per_cu); per_cu = 1; }
        (void)hipGetLastError();
        grid = cus;
    }
    if (grid < 0) return;
    if (hipMemsetAsync(d_ws, 0, 16384, stream) != hipSuccess) { fprintf(stderr, "kernel_launch: memset of the barrier words failed\n"); return; }
    Params p{};
    const float** pp = (const float**)&p;
    for (int i = 0; i < 21; ++i) pp[i] = (const float*)d_in[i];
    p.out = (float*)d_out; p.ws = (unsigned char*)d_ws;
    void* args[] = {&p};
    hipError_t e = hipLaunchCooperativeKernel((const void*)fwd_megakernel, dim3(grid), dim3(512), args, LDS_BYTES, stream);
    if (e != hipSuccess) fprintf(stderr, "cooperative launch failed: %s (grid %d)\n", hipGetErrorString(e), grid);
}
```

```cpp
#include <hip/hip_runtime.h>
#include <hip/hip_cooperative_groups.h>
#include <cstdio>
#include <cstdint>
namespace cg = cooperative_groups;
namespace pg8 {
#define PG8_LAS __attribute__((address_space(3)))
typedef unsigned short bf16_t;
typedef short bf16x8 __attribute__((ext_vector_type(8)));
typedef float f32x4 __attribute__((ext_vector_type(4)));
typedef unsigned u32x4 __attribute__((ext_vector_type(4)));
constexpr int BM = 256, BK = 64, HALF = 128, HTB = HALF * BK * 2  , STAGE_BYTES = 8 * HTB, NXCD = 8, WGM = 8;

__host__ __device__ __forceinline__ int lds_byte(int r, int c) { const int st = (r >> 4) * 2 + (c >> 5), rr = r & 15, cc = c & 31, ob = rr * 64 + cc * 2; return st * 1024 + (ob ^ (((ob >> 9) & 1) << 5)); }
__host__ __device__ __forceinline__ void stage_rc(int b, int& R, int& C) { const int st = b / 1024, sb = b % 1024, swz = sb ^ (((sb >> 9) & 1) << 5); R = (st >> 1) * 16 + swz / 64; C = (st & 1) * 32 + (swz % 64) / 2; }
__host__ __device__ __forceinline__ int perm32(int rho) { const int n = rho >> 4, i = rho & 15; return 8 * (i >> 2) + 4 * n + (i & 3); }

struct Unit { int pm, pn; };
struct Gemm { const bf16_t* A; const bf16_t* Bt; int M, N, K; };

struct StaticOrder {
    int nM, nN, nwg, G, c;
    __host__ __device__ void init(int M, int N, int G_, int c_) { nM = M / BM; nN = N / BM; nwg = nM * nN; G = G_; c = c_; }
    __host__ __device__ bool next(int i, Unit& u) const {
        const long L = (long)i * G + c; if (L >= nwg) return false;
        int wgid = (int)L; { const int q = nwg / NXCD, r = nwg % NXCD, xcd = wgid % NXCD, off = wgid / NXCD; wgid = (xcd < r ? xcd * (q + 1) : r * (q + 1) + (xcd - r) * q) + off; }
        const int nig = WGM * nN, gid = wgid / nig, fm = gid * WGM, gsz = (nM - fm) < WGM ? (nM - fm) : WGM;
        u.pm = fm + ((wgid % nig) % gsz); u.pn = (wgid % nig) / gsz; return true;
    }
    __device__ __forceinline__ void a_ready(const Unit&) const {}
    __device__ __forceinline__ void done(const Unit&) const {}
};

__device__ __forceinline__ unsigned cvt_pk_bf16(float lo, float hi) { unsigned r; asm volatile("v_cvt_pk_bf16_f32 %0, %1, %2" : "=v"(r) : "v"(lo), "v"(hi)); return r; }
typedef float f32x2 __attribute__((ext_vector_type(2)));
typedef unsigned u32x2 __attribute__((ext_vector_type(2)));
__device__ __forceinline__ float silu_f(float x) { return x * __builtin_amdgcn_rcpf(1.0f + __expf(-x)); }
struct EpiStoreBf16 {
    static constexpr bool PERM = true, AFTER_DRAIN = false;
    bf16_t* O; int ldc;
    __device__ __forceinline__ void operator()(const f32x4 (&acc)[2][2][4][2], const Unit& u, int wr, int wc, int fr, int fq) const {
        const int row0 = u.pm * BM + wr * 64 + fr, col0 = u.pn * BM + wc * 32 + 8 * fq;
#pragma unroll
        for (int ai = 0; ai < 2; ++ai)
#pragma unroll
            for (int m = 0; m < 4; ++m) { bf16_t* rowp = O + (size_t)(row0 + ai * HALF + m * 16) * ldc + col0;
#pragma unroll
                for (int bj = 0; bj < 2; ++bj) { const f32x4 v0 = acc[ai][bj][m][0], v1 = acc[ai][bj][m][1];
                    u32x4 w; w.x = cvt_pk_bf16(v0[0], v0[1]); w.y = cvt_pk_bf16(v0[2], v0[3]); w.z = cvt_pk_bf16(v1[0], v1[1]); w.w = cvt_pk_bf16(v1[2], v1[3]);
                    *(u32x4*)(rowp + bj * HALF) = w; } }
    }
};
struct EpiStoreF32 {
    static constexpr bool PERM = true, AFTER_DRAIN = false;
    float* O; int ldc;
    __device__ __forceinline__ void operator()(const f32x4 (&acc)[2][2][4][2], const Unit& u, int wr, int wc, int fr, int fq) const {
        const int row0 = u.pm * BM + wr * 64 + fr, col0 = u.pn * BM + wc * 32 + 8 * fq;
#pragma unroll
        for (int ai = 0; ai < 2; ++ai)
#pragma unroll
            for (int m = 0; m < 4; ++m) { float* rowp = O + (size_t)(row0 + ai * HALF + m * 16) * ldc + col0;
#pragma unroll
                for (int bj = 0; bj < 2; ++bj) { *(f32x4*)(rowp + bj * HALF) = acc[ai][bj][m][0]; *(f32x4*)(rowp + bj * HALF + 4) = acc[ai][bj][m][1]; } }
    }
};
struct EpiSwiGLU {
    static constexpr bool PERM = true, AFTER_DRAIN = false;
    bf16_t* H; int ldh;
    __device__ __forceinline__ void operator()(const f32x4 (&acc)[2][2][4][2], const Unit& u, int wr, int wc, int fr, int fq) const {
        const int row0 = u.pm * BM + wr * 64 + fr, col0 = u.pn * (BM / 2) + wc * 16 + 4 * fq;
#pragma unroll
        for (int ai = 0; ai < 2; ++ai)
#pragma unroll
            for (int m = 0; m < 4; ++m) { bf16_t* rowp = H + (size_t)(row0 + ai * HALF + m * 16) * ldh + col0;
#pragma unroll
                for (int bj = 0; bj < 2; ++bj) { const f32x4 v0 = acc[ai][bj][m][0], v1 = acc[ai][bj][m][1];
                    u32x2 w; w.x = cvt_pk_bf16(silu_f(v0[0]) * v0[1], silu_f(v0[2]) * v0[3]); w.y = cvt_pk_bf16(silu_f(v1[0]) * v1[1], silu_f(v1[2]) * v1[3]);
                    *(u32x2*)(rowp + bj * (HALF / 2)) = w; } }
    }
};
template <class Epi, class Sched, bool ALIGN_EPI = false, bool SP2 = false>
__device__ __forceinline__ void gemm_phase(PG8_LAS unsigned char* lds, const Gemm g, const Sched& S, const Epi& E) {
    int tid_l = threadIdx.x; asm volatile("" : "+v"(tid_l));
    const int tid = tid_l, wid = __builtin_amdgcn_readfirstlane(tid >> 6), lane = tid & 63, wr = wid >> 2, wc = wid & 3, fr = lane & 15, fq = lane >> 4;
    const int K = g.K, nt = K / BK;
    unsigned voffA[2], voffB[2];
#pragma unroll
    for (int i = 0; i < 2; ++i) { int R, C; stage_rc(tid * 16 + i * 8192, R, C); const int Rb = Epi::PERM ? ((R & ~31) + perm32(R & 31)) : R;
        voffA[i] = (unsigned)(R * K + C) * 2u; voffB[i] = (unsigned)(Rb * K + C) * 2u; }
    const size_t kstep = (size_t)(BK * 2);
    const size_t hstep = (size_t)HALF * K * 2;
    const size_t tstep = 2 * hstep;
    const unsigned ldsw = (unsigned)wid * 1024u;
    const int aoff = lds_byte(wr * 64 + fr, fq * 8), boff = lds_byte(wc * 32 + fr, fq * 8);
#define PG8_SA(b, h) (((b) * 2 + (h)) * HTB)
#define PG8_SB(b, h) ((4 + (b) * 2 + (h)) * HTB)
#define PG8_STAGE(bufoff, gbase, voff) do { _Pragma("unroll") for (int _i = 0; _i < 2; ++_i) \
        __builtin_amdgcn_global_load_lds((const unsigned*)((const char*)(gbase) + (voff)[_i]), (PG8_LAS unsigned*)(lds + (bufoff) + ldsw + _i * 8192), 16, 0, 0); } while (0)
#define PG8_LDA(dst, b, h) do { _Pragma("unroll") for (int m = 0; m < 4; ++m) _Pragma("unroll") for (int k = 0; k < 2; ++k) dst[m][k] = *(const PG8_LAS bf16x8*)(lds + PG8_SA(b, h) + aoff + m * 2048 + k * 1024); } while (0)
#define PG8_LDB(dst, b, h) do { _Pragma("unroll") for (int n = 0; n < 2; ++n) _Pragma("unroll") for (int k = 0; k < 2; ++k) dst[n][k] = *(const PG8_LAS bf16x8*)(lds + PG8_SB(b, h) + boff + n * 2048 + k * 1024); } while (0)
#define PG8_MMA(ai, bj, At, Bt) do { __builtin_amdgcn_s_setprio(1); _Pragma("unroll") for (int m = 0; m < 4; ++m) _Pragma("unroll") for (int n = 0; n < 2; ++n) _Pragma("unroll") for (int k = 0; k < 2; ++k) \
        acc[ai][bj][m][n] = __builtin_amdgcn_mfma_f32_16x16x32_bf16(Bt[n][k], At[m][k], acc[ai][bj][m][n], 0, 0, 0); __builtin_amdgcn_s_setprio(0); } while (0)
#define PG8_WAIT_V(n) asm volatile("s_waitcnt vmcnt(" #n ")" ::: "memory")
#define PG8_WAIT_L(n) asm volatile("s_waitcnt lgkmcnt(" #n ")" ::: "memory")
#define PG8_BAR __builtin_amdgcn_s_barrier()
#define PG8_SCHED __builtin_amdgcn_sched_barrier(0)
    Unit cur, nxt; int ui = 0;
    if (!S.next(0, cur)) return;
    f32x4 acc[2][2][4][2];
#pragma unroll
    for (int a = 0; a < 2; ++a)
#pragma unroll
        for (int b = 0; b < 2; ++b)
#pragma unroll
            for (int m = 0; m < 4; ++m)
#pragma unroll
                for (int n = 0; n < 2; ++n) acc[a][b][m][n] = (f32x4){0.f, 0.f, 0.f, 0.f};
    bf16x8 At[4][2], B0[2][2], B1[2][2];
    const char* cA = (const char*)g.A + (size_t)cur.pm * tstep; const char* cB = (const char*)g.Bt + (size_t)cur.pn * tstep;
    S.a_ready(cur);
    if constexpr (SP2) {
        PG8_STAGE(PG8_SB(0, 0), cB, voffB); PG8_STAGE(PG8_SB(0, 1), cB + hstep, voffB); PG8_STAGE(PG8_SA(0, 0), cA, voffA); PG8_STAGE(PG8_SA(0, 1), cA + hstep, voffA);
        if (wr == 1) PG8_BAR;
        PG8_WAIT_V(2); PG8_BAR;
        PG8_STAGE(PG8_SB(1, 0), cB + kstep, voffB); PG8_STAGE(PG8_SA(1, 0), cA + kstep, voffA); PG8_STAGE(PG8_SB(1, 1), cB + hstep + kstep, voffB);
        PG8_WAIT_V(6); PG8_BAR;
    } else {
        PG8_STAGE(PG8_SB(0, 0), cB, voffB); PG8_STAGE(PG8_SA(0, 0), cA, voffA); PG8_STAGE(PG8_SB(0, 1), cB + hstep, voffB); PG8_STAGE(PG8_SA(0, 1), cA + hstep, voffA);
        if (wr == 1) PG8_BAR;
        PG8_WAIT_V(4); PG8_BAR;
        PG8_STAGE(PG8_SB(1, 0), cB + kstep, voffB); PG8_STAGE(PG8_SA(1, 0), cA + kstep, voffA); PG8_STAGE(PG8_SB(1, 1), cB + hstep + kstep, voffB);
        PG8_WAIT_V(6); PG8_BAR;
    }
    for (;;) {
        const bool has_next = S.next(ui + 1, nxt);
        const char* nA = has_next ? (const char*)g.A + (size_t)nxt.pm * tstep : cA; const char* nB = has_next ? (const char*)g.Bt + (size_t)nxt.pn * tstep : cB;
        for (int t = 0; t < nt; t += 2) {
            const bool last = (t == nt - 2);
            const char* a1 = cA + (size_t)(t + 1) * kstep;
            const char* a2 = last ? nA : cA + (size_t)(t + 2) * kstep; const char* b2 = last ? nB : cB + (size_t)(t + 2) * kstep;
            const char* a3 = a2 + kstep; const char* b3 = b2 + kstep;
            if (last && has_next) S.a_ready(nxt);
            if constexpr (SP2) {
            PG8_LDB(B0, 0, 0); PG8_LDB(B1, 0, 1); PG8_SCHED; PG8_LDA(At, 0, 0); PG8_STAGE(PG8_SA(1, 1), a1 + hstep, voffA);
            PG8_WAIT_V(8); PG8_WAIT_L(0); PG8_BAR; PG8_MMA(0, 0, At, B0); PG8_MMA(0, 1, At, B1); PG8_BAR; PG8_SCHED;
            PG8_LDA(At, 0, 1); PG8_STAGE(PG8_SB(0, 0), b2, voffB); PG8_STAGE(PG8_SB(0, 1), b2 + hstep, voffB); PG8_STAGE(PG8_SA(0, 0), a2, voffA);
            PG8_WAIT_V(8); PG8_WAIT_L(0); PG8_BAR; PG8_MMA(1, 0, At, B0); PG8_MMA(1, 1, At, B1); PG8_BAR; PG8_SCHED;
            PG8_LDB(B0, 1, 0); PG8_LDB(B1, 1, 1); PG8_SCHED; PG8_LDA(At, 1, 0); PG8_STAGE(PG8_SA(0, 1), a2 + hstep, voffA);
            PG8_WAIT_V(8); PG8_WAIT_L(0); PG8_BAR; PG8_MMA(0, 0, At, B0); PG8_MMA(0, 1, At, B1); PG8_BAR; PG8_SCHED;
            PG8_LDA(At, 1, 1); PG8_STAGE(PG8_SB(1, 0), b3, voffB); PG8_STAGE(PG8_SB(1, 1), b3 + hstep, voffB); PG8_STAGE(PG8_SA(1, 0), a3, voffA);
            PG8_WAIT_V(8); PG8_WAIT_L(0); PG8_BAR; PG8_MMA(1, 0, At, B0); PG8_MMA(1, 1, At, B1); PG8_BAR; PG8_SCHED;
            } else {
            PG8_LDB(B0, 0, 0); PG8_SCHED; PG8_LDA(At, 0, 0); PG8_STAGE(PG8_SA(1, 1), a1 + hstep, voffA);
            PG8_WAIT_L(8); PG8_BAR; PG8_WAIT_L(0); PG8_MMA(0, 0, At, B0); PG8_BAR; PG8_SCHED;
            PG8_LDB(B1, 0, 1); PG8_STAGE(PG8_SB(0, 0), b2, voffB);
            PG8_BAR; PG8_WAIT_L(0); PG8_MMA(0, 1, At, B1); PG8_BAR;
            PG8_LDA(At, 0, 1); PG8_STAGE(PG8_SA(0, 0), a2, voffA);
            PG8_BAR; PG8_WAIT_L(0); PG8_MMA(1, 0, At, B0); PG8_BAR; PG8_SCHED;
            PG8_STAGE(PG8_SB(0, 1), b2 + hstep, voffB);
            PG8_WAIT_V(6); PG8_BAR; PG8_MMA(1, 1, At, B1); PG8_BAR;
            PG8_LDB(B0, 1, 0); PG8_SCHED; PG8_LDA(At, 1, 0); PG8_STAGE(PG8_SA(0, 1), a2 + hstep, voffA);
            PG8_WAIT_L(8); PG8_BAR; PG8_WAIT_L(0); PG8_MMA(0, 0, At, B0); PG8_BAR; PG8_SCHED;
            PG8_LDB(B1, 1, 1); PG8_STAGE(PG8_SB(1, 0), b3, voffB);
            PG8_BAR; PG8_WAIT_L(0); PG8_MMA(0, 1, At, B1); PG8_BAR;
            PG8_LDA(At, 1, 1); PG8_STAGE(PG8_SA(1, 0), a3, voffA);
            PG8_BAR; PG8_WAIT_L(0); PG8_MMA(1, 0, At, B0); PG8_BAR; PG8_SCHED;
            PG8_STAGE(PG8_SB(1, 1), b3 + hstep, voffB);
            PG8_WAIT_V(6); PG8_BAR; PG8_MMA(1, 1, At, B1); PG8_BAR;
            }
        }
        if constexpr (ALIGN_EPI) { if (wr == 0) PG8_BAR; }
        if constexpr (!Epi::AFTER_DRAIN) { E(acc, cur, wr, wc, fr, fq); S.done(cur); }
        if (!has_next) break;
#pragma unroll
        for (int a = 0; a < 2; ++a)
#pragma unroll
            for (int b = 0; b < 2; ++b)
#pragma unroll
                for (int m = 0; m < 4; ++m)
#pragma unroll
                    for (int n = 0; n < 2; ++n) acc[a][b][m][n] = (f32x4){0.f, 0.f, 0.f, 0.f};
        cur = nxt; cA = nA; cB = nB; ++ui;
        if constexpr (ALIGN_EPI) { if (wr == 1) PG8_BAR; }
    }
    PG8_WAIT_V(0);
    if constexpr (!ALIGN_EPI) { if (wr == 0) PG8_BAR; }
    PG8_BAR;
    if constexpr (Epi::AFTER_DRAIN) { E.fused(acc, cur, wr, wc, fr, fq, lds, wid, lane); S.done(cur); }
#undef PG8_SA
#undef PG8_SB
#undef PG8_STAGE
#undef PG8_LDA
#undef PG8_LDB
#undef PG8_MMA
#undef PG8_WAIT_V
#undef PG8_WAIT_L
#undef PG8_BAR
#undef PG8_SCHED
}
}
constexpr int BATCH = 4, SEQ = 4096, DM = 1024, NCH = 64, CH = 64, MTOK = BATCH * SEQ, DEPTH = 2;
constexpr int NPROJ = 3072, IN_COLS = 3088, FF = 2816;
constexpr float EPS = 1e-6f;
constexpr size_t MiB = 1u << 20;
constexpr size_t WS_SMALL = 1 * MiB, WS_ACS = 2 * MiB, WS_CDEC = 2 * MiB + 512 * 1024, WS_EGL = 2 * MiB + 768 * 1024;
constexpr size_t WS_WIN = 3 * MiB, WS_WOUT = 9 * MiB, WS_WGU = 11 * MiB, WS_WDN = 22 * MiB;
constexpr size_t WS_XN = 28 * MiB;
constexpr size_t WS_GU = 28 * MiB, WS_GW = 36 * MiB, WS_GQE = 44 * MiB, WS_GQK = 52 * MiB, WS_GKDT = 244 * MiB;
constexpr size_t WS_PROJ = 60 * MiB, WS_H = 60 * MiB;
constexpr size_t WS_MIX = 156 * MiB;
constexpr size_t WS_STATES = 188 * MiB, WS_YPART = 220 * MiB, WS_CCONV = 236 * MiB, WS_TMP = 188 * MiB;
constexpr size_t WS_END = 252 * MiB;
constexpr int LDS_BYTES = 147456;
#ifndef REP_C
#define REP_C 1
#endif
#ifndef REP_P1
#define REP_P1 1
#endif
#ifndef REP_DS
#define REP_DS 1
#endif
#ifndef RP3_MMA
#define RP3_MMA 1
#endif
#ifndef REP_GEMM
#define REP_GEMM 1
#endif
#ifndef REP_ATT
#define REP_ATT 1
#endif
#ifndef RG_CONV
#define RG_CONV 1
#endif
#ifndef RG_KK
#define RG_KK 1
#endif
#ifndef RG_SOLVE
#define RG_SOLVE 1
#endif
#ifndef REP_C1
#define REP_C1 1
#endif
#ifndef REP_C2
#define REP_C2 1
#endif
#ifndef REP_D
#define REP_D 1
#endif
#ifndef REP_E
#define REP_E 1
#endif

#define LAS __attribute__((address_space(3)))
#define DEV __device__ __forceinline__
typedef unsigned short bf16;
typedef short bf16x8 __attribute__((ext_vector_type(8)));
typedef float f32x4 __attribute__((ext_vector_type(4)));
typedef unsigned u32x4 __attribute__((ext_vector_type(4)));
typedef unsigned u32x2 __attribute__((ext_vector_type(2)));

typedef float f32x2_t __attribute__((ext_vector_type(2)));
typedef __bf16 bf16x2_t __attribute__((ext_vector_type(2)));
DEV unsigned pk2(float lo, float hi) { const f32x2_t v = {lo, hi}; const bf16x2_t b = __builtin_convertvector(v, bf16x2_t); return __builtin_bit_cast(unsigned, b); }
DEV unsigned f2bf(float f) { return pk2(f, 0.f) & 0xffffu; }
DEV float bf2f(unsigned b) { return __builtin_bit_cast(float, b << 16); }
DEV float bflo(unsigned w) { return __builtin_bit_cast(float, w << 16); }
DEV float bfhi(unsigned w) { return __builtin_bit_cast(float, w & 0xffff0000u); }
DEV float silu(float x) { return x * __builtin_amdgcn_rcpf(1.0f + __expf(-x)); }
DEV float softplus(float x) { return fmaxf(x, 0.f) + log1pf(expf(-fabsf(x))); }
template <int CTRL> DEV float dpp_f(float v) { return __builtin_bit_cast(float, __builtin_amdgcn_update_dpp(0, __builtin_bit_cast(int, v), CTRL, 0xF, 0xF, true)); }
DEV float red4_sum(float v) { v += dpp_f<0xB1>(v); v += dpp_f<0x4E>(v); return v; }
DEV float red8_sum(float v) { v = red4_sum(v); v += dpp_f<0x141>(v); return v; }
DEV float red16_sum(float v) { v = red8_sum(v); v += dpp_f<0x140>(v); return v; }
DEV float red16_max(float v) { v = fmaxf(v, dpp_f<0xB1>(v)); v = fmaxf(v, dpp_f<0x4E>(v)); v = fmaxf(v, dpp_f<0x141>(v)); v = fmaxf(v, dpp_f<0x140>(v)); return v; }
DEV float rdlane(float v, int l) { return __builtin_bit_cast(float, __builtin_amdgcn_readlane(__builtin_bit_cast(int, v), l)); }
DEV float wave_sum(float v) { v = red16_sum(v); return (rdlane(v, 0) + rdlane(v, 16)) + (rdlane(v, 32) + rdlane(v, 48)); }
DEV float wave_incl_scan(float v, int lane) {
    v += dpp_f<0x111>(v); v += dpp_f<0x112>(v); v += dpp_f<0x114>(v); v += dpp_f<0x118>(v);
    const float t0 = rdlane(v, 15), t1 = rdlane(v, 31), t2 = rdlane(v, 47);
    const int r = lane >> 4;
    return v + (r > 0 ? t0 : 0.f) + (r > 1 ? t1 : 0.f) + (r > 2 ? t2 : 0.f);
}
DEV float frcp(float x) { return __builtin_amdgcn_rcpf(x); }
DEV f32x4 mma_tile(const LAS bf16* A, int lda, const LAS bf16* B, int ldb, int K, int lane, f32x4 acc) {
    const LAS bf16* ap = A + (lane & 15) * lda + (lane >> 4) * 8;
    const LAS bf16* bp = B + (lane & 15) * ldb + (lane >> 4) * 8;
    for (int k = 0; k < K; k += 32) {
        const bf16x8 a = *(const LAS bf16x8*)(ap + k), b = *(const LAS bf16x8*)(bp + k);
        acc = __builtin_amdgcn_mfma_f32_16x16x32_bf16(a, b, acc, 0, 0, 0);
    }
    return acc;
}

struct Params {
    const float *x, *pre_mix, *post_mix, *pre_ffn, *post_ffn, *w_in, *w_out, *sinks, *sconv_w, *sconv_b, *sdt_bias, *sA_log, *sD, *snorm_w,
                *gconv_w, *gdt_bias, *gA_log, *gnorm_w, *w_gate, *w_up, *w_down;
    float* out; unsigned char* ws;
};

DEV void tr_item(const float* W, int ldw, int col0, bf16* WT, int K, int drow0, int rs, LAS float* scr, int kb, int nb, int lane) {
    const int k0 = 64 * kb, n0 = 32 * nb;
#pragma unroll 8
    for (int i = 0; i < 32; ++i) { const int kk = 2 * i + (lane >> 5); scr[kk * 33 + (lane & 31)] = W[(size_t)(k0 + kk) * ldw + col0 + n0 + (lane & 31)]; }
    asm volatile("s_waitcnt lgkmcnt(0)" ::: "memory");
    const int c = lane & 7;
#pragma unroll
    for (int j = 0; j < 4; ++j) { const int n = (lane >> 3) + 8 * j; const LAS float* s = scr + (8 * c) * 33 + n;
        u32x4 o; o.x = pk2(s[0 * 33], s[1 * 33]); o.y = pk2(s[2 * 33], s[3 * 33]); o.z = pk2(s[4 * 33], s[5 * 33]); o.w = pk2(s[6 * 33], s[7 * 33]);
        *(u32x4*)(WT + (size_t)(drow0 + (n0 + n) * rs) * K + k0 + 8 * c) = o; }
    asm volatile("s_waitcnt lgkmcnt(0)" ::: "memory");
}
DEV void convert_weights(const Params& p, int l, LAS unsigned char* lds, int gw, int NGW, int wave, int lane) {
    LAS float* scr = (LAS float*)(lds + wave * 8448);
    const float* win = p.w_in + (size_t)l * DM * IN_COLS; const float* wout = p.w_out + (size_t)l * DM * DM;
    const float* wg = p.w_gate + (size_t)l * DM * FF; const float* wu = p.w_up + (size_t)l * DM * FF; const float* wd = p.w_down + (size_t)l * FF * DM;
    bf16* WIN = (bf16*)(p.ws + WS_WIN); bf16* WOUT = (bf16*)(p.ws + WS_WOUT); bf16* WGU = (bf16*)(p.ws + WS_WGU); bf16* WDN = (bf16*)(p.ws + WS_WDN);
    constexpr int I_IN = 16 * 96, I_OUT = 16 * 32, I_G = 16 * 88, I_D = 44 * 32;
    constexpr int NIT = I_IN + I_OUT + 2 * I_G + I_D;
    for (int it = gw; it < NIT; it += NGW) {
        int r = it;
        if (r < I_IN) { const int kb = r / 96, nb = r % 96;
            if (nb < 64) tr_item(win, IN_COLS, 0, WIN, DM, 0, 1, scr, kb, nb, lane); else tr_item(win, IN_COLS, 2056, WIN, DM, 2048, 1, scr, kb, nb - 64, lane);
            continue; } r -= I_IN;
        if (r < I_OUT) { tr_item(wout, DM, 0, WOUT, DM, 0, 1, scr, r / 32, r % 32, lane); continue; } r -= I_OUT;
        if (r < I_G) { tr_item(wg, FF, 0, WGU, DM, 0, 2, scr, r / 88, r % 88, lane); continue; } r -= I_G;
        if (r < I_G) { tr_item(wu, FF, 0, WGU, DM, 1, 2, scr, r / 88, r % 88, lane); continue; } r -= I_G;
        tr_item(wd, DM, 0, WDN, FF, 0, 1, scr, r / 32, r % 32, lane);
    }
}
DEV void stage_small(const Params& p, int l, LAS float* wsT, int tid) {
    const float* win = p.w_in + (size_t)l * DM * IN_COLS;
    for (int idx = tid; idx < 16 * DM; idx += 512) { const int k = idx >> 4, c = idx & 15; const int sc = c < 8 ? 2048 + c : 3072 + c; wsT[c * DM + k] = win[(size_t)k * IN_COLS + sc]; }
}
template <int MODE>
DEV void rowpass(const float* res, const bf16* tmp, const float* wpost, const float* wnext, float* xout, bf16* XN, float* SMALL, const LAS float* wsT, int gw, int NGW, int lane) {
    f32x4 wp[4], wn[4];
#pragma unroll
    for (int j = 0; j < 4; ++j) {
        if (MODE != 0) wp[j] = *((const f32x4*)wpost + lane + 64 * j);
        if (MODE != 3) wn[j] = *((const f32x4*)wnext + lane + 64 * j);
    }
    for (int m = gw; m < MTOK; m += NGW) {
        f32x4 v[4];
#pragma unroll
        for (int j = 0; j < 4; ++j) v[j] = *((const f32x4*)(res + (size_t)m * DM) + lane + 64 * j);
        if (MODE != 0) {
            f32x4 t[4]; float ss = 0.f;
#pragma unroll
            for (int j = 0; j < 4; ++j) { const u32x2 tw = *((const u32x2*)(tmp + (size_t)m * DM) + lane + 64 * j); t[j] = (f32x4){bflo(tw.x), bfhi(tw.x), bflo(tw.y), bfhi(tw.y)}; ss += (t[j].x * t[j].x + t[j].y * t[j].y) + (t[j].z * t[j].z + t[j].w * t[j].w); }
            const float rstd = rsqrtf(wave_sum(ss) * (1.0f / DM) + EPS);
#pragma unroll
            for (int j = 0; j < 4; ++j) { v[j] = v[j] + t[j] * rstd * wp[j]; *((f32x4*)(xout + (size_t)m * DM) + lane + 64 * j) = v[j]; }
        }
        if (MODE != 3) {
            float ss = 0.f;
#pragma unroll
            for (int j = 0; j < 4; ++j) ss += (v[j].x * v[j].x + v[j].y * v[j].y) + (v[j].z * v[j].z + v[j].w * v[j].w);
            const float rstd = rsqrtf(wave_sum(ss) * (1.0f / DM) + EPS);
#pragma unroll
            for (int j = 0; j < 4; ++j) { v[j] = v[j] * rstd * wn[j];
                u32x2 o; o.x = pk2(v[j].x, v[j].y); o.y = pk2(v[j].z, v[j].w); *((u32x2*)(XN + (size_t)m * DM) + lane + 64 * j) = o; }
            if (MODE == 0 || MODE == 2) {
                float mine = 0.f;
#pragma unroll
                for (int c = 0; c < 16; ++c) { float s = 0.f; asm volatile("" ::: "memory");
#pragma unroll
                    for (int j = 0; j < 4; ++j) { const f32x4 w = *((const LAS f32x4*)(wsT + c * DM) + lane + 64 * j); s += (v[j].x * w.x + v[j].y * w.y) + (v[j].z * w.z + v[j].w * w.w); }
                    s = red16_sum(s); mine = ((lane & 15) == c) ? s : mine; }
                mine += __shfl_xor(mine, 16); mine += __shfl_xor(mine, 32);
                if (lane < 16) SMALL[(size_t)m * 16 + lane] = mine;
            }
        }
    }
}

DEV void attn_unit(const Params& p, int l, int u, LAS unsigned char* lds, int tid) {
    asm volatile("" : "+v"(tid));
    const int b = u >> 7, c = (u >> 1) & 63, kvh = u & 1, wave = tid >> 6, lane = tid & 63;
    const bf16* PROJ = (const bf16*)(p.ws + WS_PROJ); bf16* MIX = (bf16*)(p.ws + WS_MIX);
    LAS bf16* Qs = (LAS bf16*)lds;
    LAS bf16* Ks = Qs + 128 * 72;
    LAS bf16* Vt = Ks + 192 * 72;
    LAS bf16* Ps = Vt + 64 * 200;
    const size_t t0 = (size_t)b * SEQ + (size_t)c * CH;
    {
        u32x4 rq[2], rk[3], rv[3];
#pragma unroll
        for (int k = 0; k < 2; ++k) { const int idx = tid + k * 512, r = idx >> 3, v = idx & 7, g = r >> 6, i = r & 63;
            rq[k] = *(const u32x4*)(PROJ + (t0 + i) * NPROJ + kvh * 128 + g * 64 + v * 8); }
#pragma unroll
        for (int k = 0; k < 3; ++k) { const int idx = tid + k * 512, j = idx >> 3, v = idx & 7; const bool valid = (c - 2 + (j >> 6)) >= 0;
            rk[k] = (u32x4){0u, 0u, 0u, 0u}; rv[k] = rk[k];
            if (valid) { const bf16* rowp = PROJ + (size_t)((long)t0 - 128 + j) * NPROJ; rk[k] = *(const u32x4*)(rowp + 256 + kvh * 64 + v * 8); rv[k] = *(const u32x4*)(rowp + 384 + kvh * 64 + v * 8); } }
#pragma unroll
        for (int k = 0; k < 2; ++k) { const int idx = tid + k * 512, r = idx >> 3, v = idx & 7; *(LAS u32x4*)(Qs + r * 72 + v * 8) = rq[k]; }
#pragma unroll
        for (int k = 0; k < 3; ++k) { const int idx = tid + k * 512, j = idx >> 3, v = idx & 7; const u32x4 vv = rv[k];
            *(LAS u32x4*)(Ks + j * 72 + v * 8) = rk[k];
            LAS bf16* vt = Vt + (v * 8) * 200 + j;
            vt[0 * 200] = (bf16)(vv.x & 0xffffu); vt[1 * 200] = (bf16)(vv.x >> 16); vt[2 * 200] = (bf16)(vv.y & 0xffffu); vt[3 * 200] = (bf16)(vv.y >> 16);
            vt[4 * 200] = (bf16)(vv.z & 0xffffu); vt[5 * 200] = (bf16)(vv.z >> 16); vt[6 * 200] = (bf16)(vv.w & 0xffffu); vt[7 * 200] = (bf16)(vv.w >> 16); }
    }
    __syncthreads();
    {
        const int g = wave >> 2, h = kvh * 2 + g;
        const float slope = exp2f(-2.0f * (float)(h + 1)), sink = p.sinks[l * 4 + h];
        f32x4 s[12];
#pragma unroll
        for (int nt = 0; nt < 12; ++nt) s[nt] = mma_tile(Qs + wave * 16 * 72, 72, Ks + nt * 16 * 72, 72, 64, lane, (f32x4){0.f, 0.f, 0.f, 0.f});
#pragma unroll
        for (int j = 0; j < 4; ++j) {
            const int r = wave * 16 + (lane >> 4) * 4 + j, i = r & 63;
            float mx = sink;
#pragma unroll
            for (int nt = 0; nt < 12; ++nt) { const int jj = nt * 16 + (lane & 15);
                float val = s[nt][j] * 0.125f - slope * fabsf((float)(i + 128 - jj));
                if (c - 2 + (nt >> 2) < 0) val = -INFINITY;
                s[nt][j] = val; mx = fmaxf(mx, val); }
            mx = red16_max(mx);
            float sum = 0.f;
#pragma unroll
            for (int nt = 0; nt < 12; ++nt) { const float e = __expf(s[nt][j] - mx); s[nt][j] = e; sum += e; }
            sum = red16_sum(sum);
            sum += __expf(sink - mx);
            const float inv = frcp(sum);
#pragma unroll
            for (int nt = 0; nt < 12; ++nt) Ps[r * 200 + nt * 16 + (lane & 15)] = (bf16)f2bf(s[nt][j] * inv);
        }
    }
    __syncthreads();
#pragma unroll
    for (int nt = 0; nt < 4; ++nt) {
        const f32x4 acc = mma_tile(Vt + nt * 16 * 200, 200, Ps + wave * 16 * 200, 200, 192, lane, (f32x4){0.f, 0.f, 0.f, 0.f});
        const int r = wave * 16 + (lane & 15), g = r >> 6, i = r & 63, d0 = nt * 16 + (lane >> 4) * 4;
        u32x2 o; o.x = pk2(acc[0], acc[1]); o.y = pk2(acc[2], acc[3]);
        *(u32x2*)(MIX + (t0 + i) * DM + (kvh * 2 + g) * 64 + d0) = o;
    }
    __syncthreads();
}

template <int NCOLS> struct RawTile {
    static constexpr int VPR = NCOLS / 8, NV = 67 * VPR, NIT = (NV + 511) / 512;
    u32x4 r[NIT];
    DEV void issue(const bf16* PROJ, size_t t0, int c, int col0, int tid) {
#pragma unroll
        for (int k = 0; k < NIT; ++k) { const int idx = tid + k * 512, row = idx / VPR, v = idx % VPR;
            r[k] = (u32x4){0u, 0u, 0u, 0u};
            if (idx < NV && (c > 0 || row >= 3)) r[k] = *(const u32x4*)(PROJ + (size_t)((long)t0 - 3 + row) * NPROJ + col0 + v * 8); }
    }
    DEV void commit(LAS bf16* Raw, int rawld, int dcol0, int tid) const {
#pragma unroll
        for (int k = 0; k < NIT; ++k) { const int idx = tid + k * 512, row = idx / VPR, v = idx % VPR;
            if (idx < NV) *(LAS u32x4*)(Raw + row * rawld + dcol0 + v * 8) = r[k]; }
    }
};
DEV void ssd_p1_unit(const Params& p, int l, int u, LAS unsigned char* lds, int tid) {
    asm volatile("" : "+v"(tid));
    const int b = u >> 7, c = (u >> 1) & 63, g = u & 1, wave = tid >> 6, lane = tid & 63;
    const bf16* PROJ = (const bf16*)(p.ws + WS_PROJ);
    const float* SMALL = (const float*)(p.ws + WS_SMALL);
    float* ACS = (float*)(p.ws + WS_ACS); float* CDEC = (float*)(p.ws + WS_CDEC);
    bf16* STATES = (bf16*)(p.ws + WS_STATES); bf16* YPART = (bf16*)(p.ws + WS_YPART); bf16* CCONV = (bf16*)(p.ws + WS_CCONV);
    LAS bf16* XsT = (LAS bf16*)lds;
    LAS bf16* Bm = XsT + 4 * 64 * 72;
    LAS bf16* Cm = Bm + 64 * 136;
    LAS bf16* BmT = Cm + 64 * 136;
    LAS bf16* Sc = BmT + 128 * 72;
    LAS bf16* Raw = Sc;
    LAS float* dtS = (LAS float*)(Sc + 4 * 64 * 72);
    LAS float* acsS = dtS + 256;
    LAS float* fS = acsS + 256;
    const size_t t0 = (size_t)b * SEQ + (size_t)c * CH;
    RawTile<256> R1; RawTile<128> R2b, R2c;
    R1.issue(PROJ, t0, c, 1024 + g * 256, tid); R2b.issue(PROJ, t0, c, 1024 + 512 + g * 128, tid); R2c.issue(PROJ, t0, c, 1024 + 768 + g * 128, tid);
    if (tid < 256) {
        const int h = tid >> 6, hh = g * 4 + h;
        const float dt = softplus(SMALL[(t0 + lane) * 16 + hh] + p.sdt_bias[l * 8 + hh]);
        const float a = -expf(p.sA_log[l * 8 + hh]);
        const float acs = wave_incl_scan(dt * a, lane);
        const float alast = rdlane(acs, 63);
        dtS[tid] = dt; acsS[tid] = acs; fS[tid] = dt * expf(alast - acs);
        ACS[(t0 + lane) * 8 + hh] = acs;
        if (lane == 63) CDEC[((size_t)b * NCH + c) * 8 + hh] = expf(acs);
    }
    R1.commit(Raw, 256, 0, tid);
    __syncthreads();
    {
        const int ch = tid & 255, half = tid >> 8, chg = g * 256 + ch, h = ch >> 6, pp = ch & 63;
        const float* cw = p.sconv_w + (size_t)l * 4096 + chg; const float w0 = cw[0], w1 = cw[1024], w2 = cw[2048], w3 = cw[3072], bias = p.sconv_b[l * 1024 + chg];
        const int r0 = half * 32;
        float x0 = bf2f(Raw[(r0 + 0) * 256 + ch]), x1 = bf2f(Raw[(r0 + 1) * 256 + ch]), x2 = bf2f(Raw[(r0 + 2) * 256 + ch]);
        LAS bf16* dst = XsT + h * 64 * 72 + pp * 72 + r0;
        for (int r = 0; r < 32; ++r) { const float x3 = bf2f(Raw[(r0 + r + 3) * 256 + ch]);
            const float y = silu(w0 * x0 + w1 * x1 + w2 * x2 + w3 * x3 + bias);
            dst[r] = (bf16)f2bf(y); x0 = x1; x1 = x2; x2 = x3; }
    }
    __syncthreads();
    R2b.commit(Raw, 256, 0, tid); R2c.commit(Raw, 256, 128, tid);
    __syncthreads();
    {
        const int ch = tid & 255, half = tid >> 8, isC = ch >> 7, n = ch & 127, chg = 512 + isC * 256 + g * 128 + n;
        const float* cw = p.sconv_w + (size_t)l * 4096 + chg; const float w0 = cw[0], w1 = cw[1024], w2 = cw[2048], w3 = cw[3072], bias = p.sconv_b[l * 1024 + chg];
        const int r0 = half * 32;
        float x0 = bf2f(Raw[(r0 + 0) * 256 + ch]), x1 = bf2f(Raw[(r0 + 1) * 256 + ch]), x2 = bf2f(Raw[(r0 + 2) * 256 + ch]);
        for (int r = 0; r < 32; ++r) { const float x3 = bf2f(Raw[(r0 + r + 3) * 256 + ch]);
            const bf16 y = (bf16)f2bf(silu(w0 * x0 + w1 * x1 + w2 * x2 + w3 * x3 + bias));
            if (isC) Cm[(r0 + r) * 136 + n] = y; else { Bm[(r0 + r) * 136 + n] = y; BmT[n * 72 + r0 + r] = y; }
            x0 = x1; x1 = x2; x2 = x3; }
    }
    __syncthreads();
    for (int idx = tid; idx < 1024; idx += 512) { const int r = idx >> 4, v = idx & 15; *(u32x4*)(CCONV + (t0 + r) * 256 + g * 128 + v * 8) = *(const LAS u32x4*)(Cm + r * 136 + v * 8); }
#pragma unroll
    for (int ti = 0; ti < 2; ++ti) {
        const int tt = wave * 2 + ti, mt = tt >> 2, nt = tt & 3;
        f32x4 acc = (f32x4){0.f, 0.f, 0.f, 0.f};
        if (nt <= mt) acc = mma_tile(Bm + nt * 16 * 136, 136, Cm + mt * 16 * 136, 136, 128, lane, acc);
        const int lr = mt * 16 + (lane & 15), s0 = nt * 16 + (lane >> 4) * 4;
#pragma unroll
        for (int h = 0; h < 4; ++h) { const f32x4 as = *(const LAS f32x4*)(acsS + h * 64 + s0), ds = *(const LAS f32x4*)(dtS + h * 64 + s0); const float al = acsS[h * 64 + lr];
            float v[4];
#pragma unroll
            for (int j = 0; j < 4; ++j) v[j] = (s0 + j <= lr) ? acc[j] * __expf(al - as[j]) * ds[j] : 0.f;
            u32x2 o; o.x = pk2(v[0], v[1]); o.y = pk2(v[2], v[3]);
            *(LAS u32x2*)(Sc + h * 64 * 72 + lr * 72 + s0) = o; }
    }
    __syncthreads();
    {
        const int h = wave >> 1, hh = g * 4 + h; const float Dh = p.sD[l * 8 + hh];
#pragma unroll 2
        for (int ti = 0; ti < 8; ++ti) { const int tt = (wave & 1) * 8 + ti, mt = tt >> 2, nt = tt & 3;
            const f32x4 acc = mma_tile(XsT + h * 64 * 72 + nt * 16 * 72, 72, Sc + h * 64 * 72 + mt * 16 * 72, 72, 64, lane, (f32x4){0.f, 0.f, 0.f, 0.f});
            const int lr = mt * 16 + (lane & 15), p0 = nt * 16 + (lane >> 4) * 4;
            const LAS bf16* xp = XsT + h * 64 * 72 + p0 * 72 + lr;
            u32x2 o; o.x = pk2(acc[0] + Dh * bf2f(xp[0]), acc[1] + Dh * bf2f(xp[72])); o.y = pk2(acc[2] + Dh * bf2f(xp[144]), acc[3] + Dh * bf2f(xp[216]));
            *(u32x2*)(YPART + (t0 + lr) * 512 + hh * 64 + p0) = o; }
#pragma unroll
        for (int pi = 0; pi < 2; ++pi) { const int pt = (wave & 1) * 2 + pi;
            bf16x8 xf[2];
#pragma unroll
            for (int k = 0; k < 2; ++k) { const int l0 = k * 32 + (lane >> 4) * 8;
                const u32x4 xw = *(const LAS u32x4*)(XsT + h * 64 * 72 + (pt * 16 + (lane & 15)) * 72 + l0);
                const f32x4 f0 = *(const LAS f32x4*)(fS + h * 64 + l0), f1 = *(const LAS f32x4*)(fS + h * 64 + l0 + 4);
                u32x4 o; o.x = pk2(bflo(xw.x) * f0.x, bfhi(xw.x) * f0.y); o.y = pk2(bflo(xw.y) * f0.z, bfhi(xw.y) * f0.w);
                o.z = pk2(bflo(xw.z) * f1.x, bfhi(xw.z) * f1.y); o.w = pk2(bflo(xw.w) * f1.z, bfhi(xw.w) * f1.w);
                xf[k] = __builtin_bit_cast(bf16x8, o); }
            for (int nt = 0; nt < 8; ++nt) {
                f32x4 acc = (f32x4){0.f, 0.f, 0.f, 0.f};
#pragma unroll
                for (int k = 0; k < 2; ++k) { const bf16x8 bfr = *(const LAS bf16x8*)(BmT + (nt * 16 + (lane & 15)) * 72 + k * 32 + (lane >> 4) * 8);
                    acc = __builtin_amdgcn_mfma_f32_16x16x32_bf16(bfr, xf[k], acc, 0, 0, 0); }
                u32x2 o; o.x = pk2(acc[0], acc[1]); o.y = pk2(acc[2], acc[3]);
                *(u32x2*)(STATES + ((((size_t)b * NCH + c) * 8 + hh) * 64 + pt * 16 + (lane & 15)) * 128 + nt * 16 + (lane >> 4) * 4) = o; } }
    }
    __syncthreads();
}
DEV void ssd_scan_all(const Params& p, int bx, LAS unsigned char* lds, int tid) {
    asm volatile("" : "+v"(tid));
    bf16* STATES = (bf16*)(p.ws + WS_STATES); const float* CDEC = (const float*)(p.ws + WS_CDEC);
    LAS float* decS = (LAS float*)lds;
    const int idx = bx * 512 + tid, b = idx >> 15, rem = idx & 32767, hh = rem >> 12, pn2 = rem & 4095;
    if (tid < 64) decS[tid] = CDEC[((size_t)b * NCH + tid) * 8 + hh];
    unsigned* base = (unsigned*)(STATES + ((size_t)b * NCH * 8 + hh) * 8192) + pn2;
    unsigned nw[NCH];
#pragma unroll
    for (int c = 0; c < NCH; ++c) nw[c] = base[(size_t)c * 8 * 4096];
    __syncthreads();
    float s0 = 0.f, s1 = 0.f;
#pragma unroll
    for (int c = 0; c < NCH; ++c) { const float d = decS[c];
        base[(size_t)c * 8 * 4096] = pk2(s0, s1);
        s0 = s0 * d + bflo(nw[c]); s1 = s1 * d + bfhi(nw[c]); }
    __syncthreads();
}
DEV void ssd_p3_unit(const Params& p, int l, int u, LAS unsigned char* lds, int tid) {
    asm volatile("" : "+v"(tid));
    const int b = u >> 7, c = (u >> 1) & 63, g = u & 1, wave = tid >> 6, lane = tid & 63;
    const bf16* PROJ = (const bf16*)(p.ws + WS_PROJ); const float* ACS = (const float*)(p.ws + WS_ACS);
    const bf16* STATES = (const bf16*)(p.ws + WS_STATES); const bf16* YPART = (const bf16*)(p.ws + WS_YPART); const bf16* CCONV = (const bf16*)(p.ws + WS_CCONV);
    bf16* MIX = (bf16*)(p.ws + WS_MIX);
    LAS bf16* Cm = (LAS bf16*)lds;
    LAS bf16* Prev = Cm + 64 * 136;
    LAS float* Gb = (LAS float*)Prev;
    LAS float* acsS = (LAS float*)(Prev + 4 * 64 * 136);
    const size_t t0 = (size_t)b * SEQ + (size_t)c * CH;
    const int h = wave >> 1, hh = g * 4 + h;
    u32x4 rc[2], rp[8]; u32x2 ry[8], rz[8]; float racs = 0.f;
#pragma unroll
    for (int k = 0; k < 2; ++k) { const int idx = tid + k * 512, r = idx >> 4, v = idx & 15; rc[k] = *(const u32x4*)(CCONV + (t0 + r) * 256 + g * 128 + v * 8); }
#pragma unroll
    for (int k = 0; k < 8; ++k) { const int idx = tid + k * 512, hq = idx >> 10, r = (idx >> 4) & 63, v = idx & 15;
        rp[k] = *(const u32x4*)(STATES + ((((size_t)b * NCH + c) * 8 + g * 4 + hq) * 64 + r) * 128 + v * 8); }
    if (tid < 256) racs = ACS[(t0 + (tid & 63)) * 8 + g * 4 + (tid >> 6)];
#pragma unroll
    for (int ti = 0; ti < 8; ++ti) { const int tt = (wave & 1) * 8 + ti, mt = tt >> 2, nt = tt & 3, lr = mt * 16 + (lane & 15), p0 = nt * 16 + (lane >> 4) * 4;
        ry[ti] = *(const u32x2*)(YPART + (t0 + lr) * 512 + hh * 64 + p0); rz[ti] = *(const u32x2*)(PROJ + (t0 + lr) * NPROJ + 512 + hh * 64 + p0); }
#pragma unroll
    for (int k = 0; k < 2; ++k) { const int idx = tid + k * 512, r = idx >> 4, v = idx & 15; *(LAS u32x4*)(Cm + r * 136 + v * 8) = rc[k]; }
#pragma unroll
    for (int k = 0; k < 8; ++k) { const int idx = tid + k * 512, hq = idx >> 10, r = (idx >> 4) & 63, v = idx & 15; *(LAS u32x4*)(Prev + hq * 64 * 136 + r * 136 + v * 8) = rp[k]; }
    if (tid < 256) acsS[tid] = racs;
    __syncthreads();
    f32x4 acc[8];
    for (int rq_ = 0; rq_ < RP3_MMA; ++rq_) {
#pragma unroll
    for (int ti = 0; ti < 8; ++ti) { const int tt = (wave & 1) * 8 + ti, mt = tt >> 2, nt = tt & 3;
        acc[ti] = mma_tile(Prev + h * 64 * 136 + nt * 16 * 136, 136, Cm + mt * 16 * 136, 136, 128, lane, (f32x4){0.f, 0.f, 0.f, 0.f}); }
    asm volatile("" ::: "memory"); }
    __syncthreads();
#pragma unroll
    for (int ti = 0; ti < 8; ++ti) { const int tt = (wave & 1) * 8 + ti, mt = tt >> 2, nt = tt & 3, lr = mt * 16 + (lane & 15), p0 = nt * 16 + (lane >> 4) * 4;
        const float ea = __expf(acsS[h * 64 + lr]);
        f32x4 gv;
        gv.x = (bflo(ry[ti].x) + ea * acc[ti][0]) * silu(bflo(rz[ti].x)); gv.y = (bfhi(ry[ti].x) + ea * acc[ti][1]) * silu(bfhi(rz[ti].x));
        gv.z = (bflo(ry[ti].y) + ea * acc[ti][2]) * silu(bflo(rz[ti].y)); gv.w = (bfhi(ry[ti].y) + ea * acc[ti][3]) * silu(bfhi(rz[ti].y));
        *(LAS f32x4*)(Gb + lr * 260 + h * 64 + p0) = gv; }
    __syncthreads();
    {
        const int lr = tid >> 3, part = tid & 7;
        const f32x4* nwp = (const f32x4*)(p.snorm_w + (size_t)l * 512 + g * 256 + part * 32);
        f32x4 nw[8], v[8]; float ss = 0.f;
#pragma unroll
        for (int k = 0; k < 8; ++k) nw[k] = nwp[k];
#pragma unroll
        for (int k = 0; k < 8; ++k) { v[k] = *(const LAS f32x4*)(Gb + lr * 260 + part * 32 + k * 4); ss += (v[k].x * v[k].x + v[k].y * v[k].y) + (v[k].z * v[k].z + v[k].w * v[k].w); }
        ss = red8_sum(ss);
        const float rstd = rsqrtf(ss * (1.0f / 256.0f) + EPS);
        bf16* dst = MIX + (t0 + lr) * DM + 256 + g * 256 + part * 32;
#pragma unroll
        for (int k = 0; k < 4; ++k) { const f32x4 a = v[2 * k] * rstd * nw[2 * k], bq = v[2 * k + 1] * rstd * nw[2 * k + 1];
            u32x4 o; o.x = pk2(a.x, a.y); o.y = pk2(a.z, a.w); o.z = pk2(bq.x, bq.y); o.w = pk2(bq.z, bq.w);
            *(u32x4*)(dst + 8 * k) = o; }
    }
    __syncthreads();
}

DEV void gdn_pre_unit(const Params& p, int l, int u, LAS unsigned char* lds, int tid) {
    asm volatile("" : "+v"(tid));
    const int b = u >> 8, c = (u >> 2) & 63, hg = u & 3, wave = tid >> 6, lane = tid & 63;
    const int ub = (b * 4 + hg) * 64 + c;
    const bf16* PROJ = (const bf16*)(p.ws + WS_PROJ); const float* SMALL = (const float*)(p.ws + WS_SMALL);
    bf16* GU = (bf16*)(p.ws + WS_GU) + (size_t)ub * 4096; bf16* GW = (bf16*)(p.ws + WS_GW) + (size_t)ub * 4096; bf16* GQE = (bf16*)(p.ws + WS_GQE) + (size_t)ub * 4096;
    bf16* GQK = (bf16*)(p.ws + WS_GQK) + (size_t)ub * 4096; bf16* GKDT = (bf16*)(p.ws + WS_GKDT) + (size_t)ub * 4096; float* EGL = (float*)(p.ws + WS_EGL);
    LAS bf16* Raw = (LAS bf16*)lds;
    LAS float* Xn = (LAS float*)lds;
    LAS float* Qs = (LAS float*)(lds + 25728);
    LAS float* Ks = Qs + 64 * 65;
    LAS float* Vs = Ks + 64 * 65;
    LAS float* Am = Vs + 64 * 65;
    LAS float* betaS = Am + 64 * 64;
    LAS float* gcS = betaS + 64;
    LAS float* scwS = gcS + 64;
    LAS float* egS = scwS + 64;
    LAS float* kdS = egS + 64;
    LAS float* R = kdS + 64;
    LAS float* At = R + 64 * 128;
    LAS float* Dv = At + 64 * 64;
    const size_t t0 = (size_t)b * SEQ + (size_t)c * CH;
    u32x4 rr[4];
#pragma unroll
    for (int k = 0; k < 4; ++k) { const int idx = tid + k * 512, row = idx / 24, rem = idx % 24, seg = rem >> 3, v = rem & 7;
        rr[k] = (u32x4){0u, 0u, 0u, 0u};
        if (idx < 67 * 24 && (c > 0 || row >= 3)) rr[k] = *(const u32x4*)(PROJ + (size_t)((long)t0 - 3 + row) * NPROJ + 2048 + seg * 256 + hg * 64 + v * 8); }
    if (wave == 0) {
        const float beta = frcp(1.0f + expf(-SMALL[(t0 + lane) * 16 + 8 + hg]));
        const float gg = -expf(p.gA_log[l * 4 + hg]) * softplus(SMALL[(t0 + lane) * 16 + 12 + hg] + p.gdt_bias[l * 4 + hg]);
        const float gc = wave_incl_scan(gg, lane);
        const float glast = rdlane(gc, 63), eg = expf(gc);
        betaS[lane] = beta; gcS[lane] = gc; scwS[lane] = beta * eg; egS[lane] = eg; kdS[lane] = expf(glast - gc);
        if (lane == 63) EGL[ub] = eg;
    }
#pragma unroll
    for (int k = 0; k < 4; ++k) { const int idx = tid + k * 512, row = idx / 24, rem = idx % 24;
        if (idx < 67 * 24) *(LAS u32x4*)(Raw + row * 192 + rem * 8) = rr[k]; }
    __syncthreads();
    for (int rq_ = 0; rq_ < RG_CONV; ++rq_)
#pragma unroll
    for (int seg = 0; seg < 3; ++seg) {
        const float* cw = p.gconv_w + (size_t)l * 3072 + seg * 256 + hg * 64 + lane; const float w0 = cw[0], w1 = cw[768], w2 = cw[1536], w3 = cw[2304];
        LAS float* dst = seg == 0 ? Qs : (seg == 1 ? Ks : Vs);
        const int r0 = wave * 8;
        float x0 = bf2f(Raw[(r0 + 0) * 192 + seg * 64 + lane]), x1 = bf2f(Raw[(r0 + 1) * 192 + seg * 64 + lane]), x2 = bf2f(Raw[(r0 + 2) * 192 + seg * 64 + lane]);
#pragma unroll
        for (int r = 0; r < 8; ++r) { const float x3 = bf2f(Raw[(r0 + r + 3) * 192 + seg * 64 + lane]);
            float y = silu(w0 * x0 + w1 * x1 + w2 * x2 + w3 * x3);
            if (seg < 2) { const float ss = wave_sum(y * y); y *= rsqrtf(ss + EPS); if (seg == 0) y *= 0.125f; }
            dst[(r0 + r) * 65 + lane] = y; x0 = x1; x1 = x2; x2 = x3; }
    }
    __syncthreads();
    for (int rq_ = 0; rq_ < RG_KK; ++rq_)
    {
        for (int t = wave; t < 20; t += 8) {
            const bool isqk = t >= 10; const int idx = isqk ? t - 10 : t;
            const int mt = idx >= 6 ? 3 : (idx >= 3 ? 2 : (idx >= 1 ? 1 : 0)), nt = idx - mt * (mt + 1) / 2;
            const LAS float* ap = (isqk ? Qs : Ks) + (mt * 16 + (lane & 15)) * 65 + (lane >> 4);
            const LAS float* bp = Ks + (nt * 16 + (lane & 15)) * 65 + (lane >> 4);
            f32x4 acc = (f32x4){0.f, 0.f, 0.f, 0.f};
#pragma unroll
            for (int ks = 0; ks < 16; ++ks) acc = __builtin_amdgcn_mfma_f32_16x16x4f32(ap[ks * 4], bp[ks * 4], acc, 0, 0, 0);
            const int j = nt * 16 + (lane & 15), i0 = mt * 16 + (lane >> 4) * 4; const float gj = gcS[j];
            float v[4];
#pragma unroll
            for (int jj = 0; jj < 4; ++jj) { const int i = i0 + jj; const float dec = (j <= i) ? __expf(gcS[i] - gj) : 0.f;
                v[jj] = isqk ? acc[jj] * dec : ((j < i) ? betaS[i] * acc[jj] * dec : 0.f); }
            if (!isqk) {
#pragma unroll
                for (int jj = 0; jj < 4; ++jj) Am[(i0 + jj) * 64 + j] = v[jj];
                *(LAS f32x4*)(At + j * 64 + i0) = (f32x4){v[0], v[1], v[2], v[3]};
            } else {
#pragma unroll
                for (int jj = 0; jj < 4; ++jj) GQK[(i0 + jj) * 64 + j] = (bf16)f2bf(v[jj]);
            }
        }
        { const int e0 = tid * 8, i = e0 >> 6, j = e0 & 63; if ((j >> 4) > (i >> 4)) *(u32x4*)(GQK + e0) = (u32x4){0u, 0u, 0u, 0u}; }
    }
    __syncthreads();
    for (int rq_ = 0; rq_ < RG_SOLVE; ++rq_) {
    if (wave == 7) {
        const int bb = lane >> 4, cc = lane & 15;
        float x[16];
#pragma unroll
        for (int i = 0; i < 16; ++i) {
            float acc = (i == cc) ? 1.f : 0.f;
#pragma unroll
            for (int q4 = 0; q4 < 4; ++q4) if (q4 * 4 < i) { const f32x4 a = *(const LAS f32x4*)(Am + (bb * 16 + i) * 64 + bb * 16 + q4 * 4);
                if (q4 * 4 + 0 < i) acc -= a.x * x[q4 * 4 + 0];
                if (q4 * 4 + 1 < i) acc -= a.y * x[q4 * 4 + 1];
                if (q4 * 4 + 2 < i) acc -= a.z * x[q4 * 4 + 2];
                if (q4 * 4 + 3 < i) acc -= a.w * x[q4 * 4 + 3]; }
            x[i] = acc;
            Dv[bb * 256 + i * 16 + cc] = acc;
        }
    } else {
#pragma unroll 4
        for (int e = tid; e < 8192; e += 448) { const int i = e >> 7, col = e & 127;
            R[e] = (col < 64) ? Vs[i * 65 + col] * betaS[i] : Ks[i * 65 + col - 64] * scwS[i]; }
#pragma unroll 4
        for (int e = tid; e < 4096; e += 448) { const int r = e >> 6, d = e & 63;
            GQE[e] = (bf16)f2bf(Qs[r * 65 + d] * egS[r]);
            GKDT[e] = (bf16)f2bf(Ks[d * 65 + r] * kdS[d]); }
    }
    __syncthreads();
    {
        const int col = tid & 127, q = tid >> 7;
        bf16* dstg = (col >= 64 ? GW : GU) + (col & 63);
#pragma unroll 1
        for (int rb = 0; rb < 4; ++rb) {
            if (rb > 0) {
                LAS float* rp = R + (16 * rb + 4 * q) * 128 + col;
                float r0 = rp[0], r1 = rp[128], r2 = rp[256], r3 = rp[384];
                const LAS float* xp = Xn + col; const LAS float* ap = At + 16 * rb + 4 * q;
#pragma unroll 8
                for (int j = 0; j < 16 * rb; ++j) { const float xj = xp[j * 128]; const f32x4 a = *(const LAS f32x4*)(ap + j * 64);
                    r0 -= a.x * xj; r1 -= a.y * xj; r2 -= a.z * xj; r3 -= a.w * xj; }
                rp[0] = r0; rp[128] = r1; rp[256] = r2; rp[384] = r3;
                __syncthreads();
            }
            float rv[16];
#pragma unroll
            for (int jj = 0; jj < 16; ++jj) rv[jj] = R[(16 * rb + jj) * 128 + col];
#pragma unroll
            for (int k = 0; k < 4; ++k) { const int ii = 4 * q + k; const LAS f32x4* dp = (const LAS f32x4*)(Dv + rb * 256 + ii * 16);
                const f32x4 d0 = dp[0], d1 = dp[1], d2 = dp[2], d3 = dp[3];
                const float acc = ((d0.x * rv[0] + d0.y * rv[1]) + (d0.z * rv[2] + d0.w * rv[3])) + ((d1.x * rv[4] + d1.y * rv[5]) + (d1.z * rv[6] + d1.w * rv[7]))
                                + ((d2.x * rv[8] + d2.y * rv[9]) + (d2.z * rv[10] + d2.w * rv[11])) + ((d3.x * rv[12] + d3.y * rv[13]) + (d3.z * rv[14] + d3.w * rv[15]));
                Xn[(16 * rb + ii) * 128 + col] = acc; dstg[(16 * rb + ii) * 64] = (bf16)f2bf(acc); }
            __syncthreads();
        }
    }
    }
}
DEV void gdn_scan_block(const Params& p, int bh2, LAS unsigned char* lds, int tid) {
    asm volatile("" : "+v"(tid));
    const int bh = bh2 >> 1, half = bh2 & 1;
    const int b = bh >> 2, hg = bh & 3, wave = tid >> 6, lane = tid & 63;
    const size_t ub0 = (size_t)bh * 64;
    const bf16* GM0 = (const bf16*)(p.ws + WS_GW) + ub0 * 4096; const bf16* GM1 = (const bf16*)(p.ws + WS_GQE) + ub0 * 4096;
    const bf16* GM2 = (const bf16*)(p.ws + WS_GQK) + ub0 * 4096; const bf16* GM3 = (const bf16*)(p.ws + WS_GKDT) + ub0 * 4096;
    const bf16* GM4 = (const bf16*)(p.ws + WS_GU) + ub0 * 4096;
    const float* EGL = (const float*)(p.ws + WS_EGL) + ub0;
    bf16* MIX = (bf16*)(p.ws + WS_MIX);
    LAS bf16* OPS = (LAS bf16*)lds;
    LAS bf16* PRV = OPS + 2 * 5 * 4608;
    LAS float* egS = (LAS float*)(PRV + 4 * 2 * 1152);
    if (tid < 64) egS[tid] = EGL[tid];
    if (wave >= 2 && wave < 4) {
        __syncthreads();
        for (int c = 0; c < NCH; ++c) __syncthreads();
    } else if (wave < 2) {
        const int es = half * 2 + wave, fr = lane & 15, fq = lane >> 4;
        LAS bf16* Stp = PRV + wave * 2304; LAS bf16* Vtp = Stp + 1152;
        for (int i = lane; i < 1152; i += 64) Stp[i] = 0;
        f32x4 Sacc[4];
#pragma unroll
        for (int mt = 0; mt < 4; ++mt) Sacc[mt] = (f32x4){0.f, 0.f, 0.f, 0.f};
        bf16* obase = MIX + ((size_t)b * SEQ + fr) * DM + 768 + hg * 64 + es * 16 + fq * 4;
        __syncthreads();
#pragma unroll 2
        for (int c = 0; c < NCH; ++c) {
            const LAS bf16* Wb = OPS + (c & 1) * 5 * 4608;
            const int fo = fr * 72 + fq * 8;
            const bf16x8 fS0 = *(const LAS bf16x8*)(Stp + fo), fS1 = *(const LAS bf16x8*)(Stp + fo + 32);
            bf16x8 fW[4][2], fQE[4][2], fQK[4][2], fKD[4][2]; u32x2 uw[4];
#pragma unroll
            for (int mt = 0; mt < 4; ++mt)
#pragma unroll
                for (int ks = 0; ks < 2; ++ks) fW[mt][ks] = *(const LAS bf16x8*)(Wb + mt * 16 * 72 + fo + ks * 32);
#pragma unroll
            for (int mt = 0; mt < 4; ++mt) uw[mt] = *(const LAS u32x2*)(Wb + 4 * 4608 + (mt * 16 + fr) * 72 + es * 16 + fq * 4);
#pragma unroll
            for (int mt = 0; mt < 4; ++mt)
#pragma unroll
                for (int ks = 0; ks < 2; ++ks) fQE[mt][ks] = *(const LAS bf16x8*)(Wb + 4608 + mt * 16 * 72 + fo + ks * 32);
#pragma unroll
            for (int mt = 0; mt < 4; ++mt)
#pragma unroll
                for (int ks = 0; ks < 2; ++ks) fKD[mt][ks] = *(const LAS bf16x8*)(Wb + 3 * 4608 + mt * 16 * 72 + fo + ks * 32);
#pragma unroll
            for (int mt = 0; mt < 4; ++mt)
#pragma unroll
                for (int ks = 0; ks < 2; ++ks) fQK[mt][ks] = *(const LAS bf16x8*)(Wb + 2 * 4608 + mt * 16 * 72 + fo + ks * 32);
            const float egl = egS[c];
            f32x4 av[4], ov[4];
#pragma unroll
            for (int mt = 0; mt < 4; ++mt) {
                av[mt] = __builtin_amdgcn_mfma_f32_16x16x32_bf16(fS0, fW[mt][0], (f32x4){0.f, 0.f, 0.f, 0.f}, 0, 0, 0);
                av[mt] = __builtin_amdgcn_mfma_f32_16x16x32_bf16(fS1, fW[mt][1], av[mt], 0, 0, 0); }
#pragma unroll
            for (int mt = 0; mt < 4; ++mt) {
                ov[mt] = __builtin_amdgcn_mfma_f32_16x16x32_bf16(fS0, fQE[mt][0], (f32x4){0.f, 0.f, 0.f, 0.f}, 0, 0, 0);
                ov[mt] = __builtin_amdgcn_mfma_f32_16x16x32_bf16(fS1, fQE[mt][1], ov[mt], 0, 0, 0); }
#pragma unroll
            for (int mt = 0; mt < 4; ++mt) {
                LAS bf16* vp = Vtp + (fq * 4) * 72 + mt * 16 + fr;
                vp[0] = (bf16)f2bf(bflo(uw[mt].x) - av[mt][0]); vp[72] = (bf16)f2bf(bfhi(uw[mt].x) - av[mt][1]);
                vp[144] = (bf16)f2bf(bflo(uw[mt].y) - av[mt][2]); vp[216] = (bf16)f2bf(bfhi(uw[mt].y) - av[mt][3]); }
            const bf16x8 fV0 = *(const LAS bf16x8*)(Vtp + fo), fV1 = *(const LAS bf16x8*)(Vtp + fo + 32);
#pragma unroll
            for (int mt = 0; mt < 4; ++mt) {
                f32x4 sa = Sacc[mt] * egl;
                sa = __builtin_amdgcn_mfma_f32_16x16x32_bf16(fKD[mt][0], fV0, sa, 0, 0, 0);
                sa = __builtin_amdgcn_mfma_f32_16x16x32_bf16(fKD[mt][1], fV1, sa, 0, 0, 0);
                Sacc[mt] = sa;
                u32x2 sw; sw.x = pk2(sa[0], sa[1]); sw.y = pk2(sa[2], sa[3]);
                *(LAS u32x2*)(Stp + fr * 72 + mt * 16 + fq * 4) = sw; }
#pragma unroll
            for (int mt = 0; mt < 4; ++mt) {
                f32x4 o = __builtin_amdgcn_mfma_f32_16x16x32_bf16(fV0, fQK[mt][0], ov[mt], 0, 0, 0);
                o = __builtin_amdgcn_mfma_f32_16x16x32_bf16(fV1, fQK[mt][1], o, 0, 0, 0);
                u32x2 ow; ow.x = pk2(o[0], o[1]); ow.y = pk2(o[2], o[3]);
                *(u32x2*)(obase + ((size_t)c * CH + mt * 16) * DM) = ow; }
            __syncthreads();
        }
    } else {
        const int lt = tid - 256;
        u32x4 rg[4][10];
#define GDN_ISSUE(k, ch) { const size_t co = (size_t)((ch) < NCH ? (ch) : NCH - 1) * 4096; \
            _Pragma("unroll") for (int h2 = 0; h2 < 2; ++h2) { const int idx = lt + h2 * 256, row = idx >> 3, v = idx & 7; \
                rg[k][0 + h2] = *(const u32x4*)(GM0 + co + row * 64 + v * 8); rg[k][2 + h2] = *(const u32x4*)(GM1 + co + row * 64 + v * 8); \
                rg[k][4 + h2] = *(const u32x4*)(GM2 + co + row * 64 + v * 8); rg[k][6 + h2] = *(const u32x4*)(GM3 + co + row * 64 + v * 8); \
                rg[k][8 + h2] = *(const u32x4*)(GM4 + co + row * 64 + v * 8); } }
#define GDN_COMMIT(k, set) { LAS bf16* sb = OPS + (set) * 5 * 4608; \
            _Pragma("unroll") for (int m = 0; m < 5; ++m) _Pragma("unroll") for (int h2 = 0; h2 < 2; ++h2) { const int idx = lt + h2 * 256, row = idx >> 3, v = idx & 7; \
                *(LAS u32x4*)(sb + m * 4608 + row * 72 + v * 8) = rg[k][m * 2 + h2]; } }
        GDN_ISSUE(0, 0) GDN_ISSUE(1, 1) GDN_ISSUE(2, 2) GDN_ISSUE(3, 3)
        GDN_COMMIT(0, 0)
        __syncthreads();
        for (int c = 0; c < NCH; c += 4) {
            GDN_COMMIT(1, 1) GDN_ISSUE(0, c + 4) __syncthreads();
            GDN_COMMIT(2, 0) GDN_ISSUE(1, c + 5) __syncthreads();
            GDN_COMMIT(3, 1) GDN_ISSUE(2, c + 6) __syncthreads();
            GDN_COMMIT(0, 0) GDN_ISSUE(3, c + 7) __syncthreads();
        }
#undef GDN_ISSUE
#undef GDN_COMMIT
    }
}
DEV void gdn_post(const Params& p, int l, int gw, int NGW, int lane) {
    bf16* MIX = (bf16*)(p.ws + WS_MIX); const bf16* PROJ = (const bf16*)(p.ws + WS_PROJ);
    const f32x4 nw = *((const f32x4*)(p.gnorm_w + (size_t)l * 64) + (lane & 15));
    for (int m = gw; m < MTOK; m += NGW) {
        bf16* op = MIX + (size_t)m * DM + 768 + lane * 4;
        const u32x2 ow = *(const u32x2*)op; const u32x2 zw = *(const u32x2*)(PROJ + (size_t)m * NPROJ + 2816 + lane * 4);
        const float o0 = bflo(ow.x), o1 = bfhi(ow.x), o2 = bflo(ow.y), o3 = bfhi(ow.y);
        float ss = (o0 * o0 + o1 * o1) + (o2 * o2 + o3 * o3);
        ss = red16_sum(ss);
        const float rstd = rsqrtf(ss * (1.0f / 64.0f) + EPS);
        u32x2 r; r.x = pk2(o0 * rstd * nw.x * silu(bflo(zw.x)), o1 * rstd * nw.y * silu(bfhi(zw.x))); r.y = pk2(o2 * rstd * nw.z * silu(bflo(zw.y)), o3 * rstd * nw.w * silu(bfhi(zw.y)));
        *(u32x2*)op = r;
    }
}

#define XB_TMO      128
#define XB_XCNT(j)  (256  + 64 * (j))
#define XB_XSUB(j)  (1280 + 64 * (j))
#define XB_XGEN(j)  (2304 + 64 * (j))
#define XB_TOP      3328
#define XB_TOPGEN   3392
#define XCD_BAR_WORDS 3456
#define XB_SPIN_CAP (1u << 18)

__device__ __forceinline__ unsigned xb_ld(unsigned* p)              { return __hip_atomic_load(p, __ATOMIC_RELAXED, __HIP_MEMORY_SCOPE_AGENT); }
__device__ __forceinline__ unsigned xb_add(unsigned* p, unsigned v) { return __hip_atomic_fetch_add(p, v, __ATOMIC_RELAXED, __HIP_MEMORY_SCOPE_AGENT); }
__device__ __forceinline__ unsigned xb_xcc_id() { return (unsigned)__builtin_amdgcn_s_getreg((3 << 11) | 20) & 0xFu; }
#define XB_SPIN(cond, bar) do { unsigned _sp = 0; while (cond) { __builtin_amdgcn_s_sleep(1); \
    if ((++_sp & 255u) == 0u) { if (xb_ld(&(bar)[XB_TMO])) break; if (_sp > XB_SPIN_CAP) { atomicAdd(&(bar)[XB_TMO], 1u); break; } } } } while (0)

struct XcdBarrier {
    unsigned* bar; unsigned x;
    volatile LAS unsigned* st;
};

__device__ __forceinline__ XcdBarrier xcd_barrier_post(unsigned* bar, volatile LAS unsigned* st) {
    XcdBarrier b; b.bar = bar; b.x = xb_xcc_id(); b.st = st;
    if (threadIdx.x == 0) (void)xb_add(&bar[XB_XCNT(b.x)], 1u);
    return b;
}
__device__ __forceinline__ void xcd_barrier_complete(unsigned* bar, unsigned x, unsigned& nloc, unsigned& nx) {
    const unsigned G = gridDim.x * gridDim.y * gridDim.z;
    unsigned sum, cnt, mine, sp = 0u;
    for (;;) {
        sum = 0u; cnt = 0u; mine = 0u;
#pragma unroll
        for (unsigned j = 0; j < 16; ++j) { const unsigned c = xb_ld(&bar[XB_XCNT(j)]); sum += c; cnt += (c > 0u) ? 1u : 0u; mine = (j == x) ? c : mine; }
        if (sum == G) break;
        __builtin_amdgcn_s_sleep(1);
        if ((++sp & 255u) == 0u) { if (xb_ld(&bar[XB_TMO])) break; if (sp > XB_SPIN_CAP) { atomicAdd(&bar[XB_TMO], 1u); break; } }
    }
    nloc = mine > 0u ? mine : 1u; nx = cnt > 0u ? cnt : 1u;
}

__device__ __forceinline__ void xcd_barrier(const XcdBarrier& b) {
    asm volatile("s_waitcnt vmcnt(0)" ::: "memory");
    __syncthreads();
    if (threadIdx.x == 0) {
        unsigned* bar = b.bar;
        __builtin_amdgcn_s_waitcnt(0);
        unsigned nloc = b.st[0], nx = b.st[1];
        if (nloc == 0u) { xcd_barrier_complete(bar, b.x, nloc, nx); b.st[0] = nloc; b.st[1] = nx; }
        const unsigned old = xb_add(&bar[XB_XSUB(b.x)], 1u);
        const unsigned gen = old / nloc;
        if (old + 1u == (gen + 1u) * nloc) {
            __builtin_amdgcn_fence(__ATOMIC_RELEASE, "agent");
            asm volatile("s_waitcnt vmcnt(0)" ::: "memory");
            const unsigned og = xb_add(&bar[XB_TOP], 1u);
            const unsigned tg = og / nx;
            if (og + 1u == (tg + 1u) * nx) xb_add(&bar[XB_TOPGEN], 1u);
            else XB_SPIN(xb_ld(&bar[XB_TOPGEN]) == tg, bar);
            __builtin_amdgcn_fence(__ATOMIC_ACQUIRE, "agent");
            xb_add(&bar[XB_XGEN(b.x)], 1u);
            asm volatile("s_waitcnt vmcnt(0)" ::: "memory");
        } else {
            XB_SPIN(xb_ld(&bar[XB_XGEN(b.x)]) == gen, bar);
            __builtin_amdgcn_fence(__ATOMIC_ACQUIRE, "agent");
            asm volatile("s_waitcnt vmcnt(0)" ::: "memory");
        }
    }
    __syncthreads();
}
__global__ void __launch_bounds__(512, 2) fwd_megakernel(Params p) {
    extern __shared__ __attribute__((aligned(16))) unsigned char lds_raw[];
    cg::grid_group grid = cg::this_grid();
    LAS unsigned char* lds = (LAS unsigned char*)lds_raw;
    const int tid = threadIdx.x, lane = tid & 63, wave = __builtin_amdgcn_readfirstlane(tid >> 6);
    const int G = gridDim.x, bx = blockIdx.x, gw = bx * 8 + wave, NGW = G * 8;
    bf16* XN = (bf16*)(p.ws + WS_XN); float* SMALL = (float*)(p.ws + WS_SMALL); bf16* TMP = (bf16*)(p.ws + WS_TMP);
    bf16* PROJ = (bf16*)(p.ws + WS_PROJ); bf16* MIX = (bf16*)(p.ws + WS_MIX); bf16* HB = (bf16*)(p.ws + WS_H);
    LAS float* wsT = (LAS float*)(lds + 69632);
    volatile LAS unsigned* misc = (volatile LAS unsigned*)(lds + 147200);
    if (tid < 4) misc[tid] = 0u;
    __syncthreads();
    XcdBarrier xbar = xcd_barrier_post((unsigned*)p.ws, misc);
#define GSYNC() xcd_barrier(xbar)

#define PHASE_IDS() int tidp = threadIdx.x; int lq = l; asm volatile("" : "+v"(tidp), "+s"(lq)); const int lanep = tidp & 63; const int wavep = __builtin_amdgcn_readfirstlane(tidp >> 6); const int gwp = bx * 8 + wavep; (void)lanep; (void)gwp; (void)lq
#pragma unroll 1
    for (int l = 0; l < DEPTH; ++l) {
        {
            PHASE_IDS();
            convert_weights(p, lq, lds, gwp, NGW, wavep, lanep);
            if (lq == 0) {
                stage_small(p, 0, wsT, tidp);
                __syncthreads();
                rowpass<0>(p.x, nullptr, nullptr, p.pre_mix, nullptr, XN, SMALL, wsT, gwp, NGW, lanep);
            }
        }
        if (l == 0) grid.sync(); else GSYNC();
#ifdef REP_SYNC
        for (int rep = 0; rep < REP_SYNC; ++rep) GSYNC();
#endif
        {
            pg8::Gemm g{XN, (const bf16*)(p.ws + WS_WIN), MTOK, NPROJ, DM}; pg8::StaticOrder S; S.init(MTOK, NPROJ, G, bx);
            pg8::EpiStoreBf16 E{PROJ, NPROJ};
            for (int rg_ = 0; rg_ < REP_GEMM; ++rg_) { if (rg_) GSYNC(); pg8::gemm_phase<pg8::EpiStoreBf16, pg8::StaticOrder, true, true>(lds, g, S, E); }
        }
        GSYNC();
        {
            PHASE_IDS();
            for (int rep = 0; rep < REP_C; ++rep) { if (rep) GSYNC(); for (int u = bx; u < 1024; u += G) gdn_pre_unit(p, lq, u, lds, tidp); }
        }
        GSYNC();
        {
            PHASE_IDS();
            for (int rep = 0; rep < REP_D; ++rep) { if (rep) GSYNC();
            if (bx < 32) { for (int r2 = 0; r2 < REP_DS; ++r2) gdn_scan_block(p, bx, lds, tidp); }
            else { for (int u = bx - 32; u < 1024; u += G - 32) { if (u < 512) { for (int r2 = 0; r2 < REP_P1; ++r2) ssd_p1_unit(p, lq, u, lds, tidp); } else { for (int r2 = 0; r2 < REP_ATT; ++r2) attn_unit(p, lq, u - 512, lds, tidp); } } } }
        }
        GSYNC();
        {
            PHASE_IDS();
            for (int vb = bx; vb < 256; vb += G) ssd_scan_all(p, vb, lds, tidp);
        }
        GSYNC();
        {
            PHASE_IDS();
            for (int rep = 0; rep < REP_E; ++rep) {
                if (rep) GSYNC();
                for (int u = bx; u < 512; u += G) ssd_p3_unit(p, lq, u, lds, tidp);
            }
            gdn_post(p, lq, gwp, NGW, lanep);
        }
        GSYNC();
        {
            pg8::Gemm g{MIX, (const bf16*)(p.ws + WS_WOUT), MTOK, DM, DM}; pg8::StaticOrder S; S.init(MTOK, DM, G, bx);
            pg8::EpiStoreBf16 E{TMP, DM};
            for (int rg_ = 0; rg_ < REP_GEMM; ++rg_) { if (rg_) GSYNC(); pg8::gemm_phase<pg8::EpiStoreBf16, pg8::StaticOrder, true, true>(lds, g, S, E); }
        }
        GSYNC();
        {
            PHASE_IDS();
            rowpass<1>(lq == 0 ? p.x : p.out, TMP, p.post_mix + (size_t)lq * DM, p.pre_ffn + (size_t)lq * DM, p.out, XN, nullptr, wsT, gwp, NGW, lanep);
        }
        GSYNC();
        {
            pg8::Gemm g{XN, (const bf16*)(p.ws + WS_WGU), MTOK, 2 * FF, DM}; pg8::StaticOrder S; S.init(MTOK, 2 * FF, G, bx);
            pg8::EpiSwiGLU E{HB, FF};
            for (int rg_ = 0; rg_ < REP_GEMM; ++rg_) { if (rg_) GSYNC(); pg8::gemm_phase<pg8::EpiSwiGLU, pg8::StaticOrder, true, true>(lds, g, S, E); }
        }
        GSYNC();
        {
            pg8::Gemm g{HB, (const bf16*)(p.ws + WS_WDN), MTOK, DM, FF}; pg8::StaticOrder S; S.init(MTOK, DM, G, bx);
            pg8::EpiStoreBf16 E{TMP, DM};
            for (int rg_ = 0; rg_ < REP_GEMM; ++rg_) { if (rg_) GSYNC(); pg8::gemm_phase<pg8::EpiStoreBf16, pg8::StaticOrder, true, true>(lds, g, S, E); }
        }
        GSYNC();
        {
            PHASE_IDS();
            if (lq + 1 < DEPTH) {
                stage_small(p, lq + 1, wsT, tidp);
                __syncthreads();
                rowpass<2>(p.out, TMP, p.post_ffn + (size_t)lq * DM, p.pre_mix + (size_t)(lq + 1) * DM, p.out, XN, SMALL, wsT, gwp, NGW, lanep);
                __syncthreads();
            } else {
                rowpass<3>(p.out, TMP, p.post_ffn + (size_t)lq * DM, nullptr, p.out, nullptr, nullptr, wsT, gwp, NGW, lanep);
            }
        }
    }
}

extern "C" void kernel_launch(void* const* d_in, const int* in_sizes, int n_in, void* d_out, int out_size, void* d_ws, size_t ws_size, hipStream_t stream) {
    static int grid = 0;
    if (grid == 0) {
        if (n_in != 21 || out_size != MTOK * DM || ws_size < WS_END) { fprintf(stderr, "kernel_launch: unexpected shapes (n_in %d out %d ws %zu)\n", n_in, out_size, ws_size); grid = -1; return; }
        int dev = 0, cus = 0, per_cu = 0;
        hipGetDevice(&dev); hipDeviceGetAttribute(&cus, hipDeviceAttributeMultiprocessorCount, dev);
        if (hipFuncSetAttribute((const void*)fwd_megakernel, hipFuncAttributeMaxDynamicSharedMemorySize, LDS_BYTES) != hipSuccess) { fprintf(stderr, "kernel_launch: hipFuncSetAttribute failed\n"); grid = -1; return; }
        hipOccupancyMaxActiveBlocksPerMultiprocessor(&per_cu, (const void*)fwd_megakernel, 512, LDS_BYTES);
        if (per_cu < 1) { fprintf(stderr, "kernel_launch: occupancy query says %d blocks per CU\n", per_cu); per_cu = 1; }
        (void)hipGetLastError();
        grid = cus;
    }
    if (grid < 0) return;
    if (hipMemsetAsync(d_ws, 0, 16384, stream) != hipSuccess) { fprintf(stderr, "kernel_launch: memset of the barrier words failed\n"); return; }
    Params p{};
    const float** pp = (const float**)&p;
    for (int i = 0; i < 21; ++i) pp[i] = (const float*)d_in[i];
    p.out = (float*)d_out; p.ws = (unsigned char*)d_ws;
    void* args[] = {&p};
    hipError_t e = hipLaunchCooperativeKernel((const void*)fwd_megakernel, dim3(grid), dim3(512), args, LDS_BYTES, stream);
    if (e != hipSuccess) fprintf(stderr, "cooperative launch failed: %s (grid %d)\n", hipGetErrorString(e), grid);
}
```

```cpp
#include <hip/hip_runtime.h>
#include <hip/hip_cooperative_groups.h>
#include <cstdio>
#include <cstdint>
namespace cg = cooperative_groups;
namespace pg8 {
#define PG8_LAS __attribute__((address_space(3)))
typedef unsigned short bf16_t;
typedef short bf16x8 __attribute__((ext_vector_type(8)));
typedef float f32x4 __attribute__((ext_vector_type(4)));
typedef unsigned u32x4 __attribute__((ext_vector_type(4)));
constexpr int BM = 256, BK = 64, HALF = 128, HTB = HALF * BK * 2  , STAGE_BYTES = 8 * HTB, NXCD = 8, WGM = 8;

__host__ __device__ __forceinline__ int lds_byte(int r, int c) { const int st = (r >> 4) * 2 + (c >> 5), rr = r & 15, cc = c & 31, ob = rr * 64 + cc * 2; return st * 1024 + (ob ^ (((ob >> 9) & 1) << 5)); }
__host__ __device__ __forceinline__ void stage_rc(int b, int& R, int& C) { const int st = b / 1024, sb = b % 1024, swz = sb ^ (((sb >> 9) & 1) << 5); R = (st >> 1) * 16 + swz / 64; C = (st & 1) * 32 + (swz % 64) / 2; }
__host__ __device__ __forceinline__ int perm32(int rho) { const int n = rho >> 4, i = rho & 15; return 8 * (i >> 2) + 4 * n + (i & 3); }

struct Unit { int pm, pn; };
struct Gemm { const bf16_t* A; const bf16_t* Bt; int M, N, K; };

struct StaticOrder {
    int nM, nN, nwg, G, c;
    __host__ __device__ void init(int M, int N, int G_, int c_) { nM = M / BM; nN = N / BM; nwg = nM * nN; G = G_; c = c_; }
    __host__ __device__ bool next(int i, Unit& u) const {
        const long L = (long)i * G + c; if (L >= nwg) return false;
        int wgid = (int)L; { const int q = nwg / NXCD, r = nwg % NXCD, xcd = wgid % NXCD, off = wgid / NXCD; wgid = (xcd < r ? xcd * (q + 1) : r * (q + 1) + (xcd - r) * q) + off; }
        const int nig = WGM * nN, gid = wgid / nig, fm = gid * WGM, gsz = (nM - fm) < WGM ? (nM - fm) : WGM;
        u.pm = fm + ((wgid % nig) % gsz); u.pn = (wgid % nig) / gsz; return true;
    }
    __device__ __forceinline__ void a_ready(const Unit&) const {}
    __device__ __forceinline__ void done(const Unit&) const {}
};

typedef float f32x2c __attribute__((ext_vector_type(2))); typedef __bf16 bf16x2c __attribute__((ext_vector_type(2)));
__device__ __forceinline__ unsigned cvt_pk_bf16(float lo, float hi) { const f32x2c v = {lo, hi}; const bf16x2c b = __builtin_convertvector(v, bf16x2c); return __builtin_bit_cast(unsigned, b); }
typedef float f32x2 __attribute__((ext_vector_type(2)));
typedef unsigned u32x2 __attribute__((ext_vector_type(2)));
__device__ __forceinline__ float silu_f(float x) { return x * __builtin_amdgcn_rcpf(1.0f + __expf(-x)); }
struct EpiStoreBf16 {
    static constexpr bool PERM = true, AFTER_DRAIN = false;
    bf16_t* O; int ldc;
    __device__ __forceinline__ void operator()(const f32x4 (&acc)[2][2][4][2], const Unit& u, int wr, int wc, int fr, int fq) const {
        const int row0 = u.pm * BM + wr * 64 + fr, col0 = u.pn * BM + wc * 32 + 8 * fq;
#pragma unroll
        for (int ai = 0; ai < 2; ++ai)
#pragma unroll
            for (int m = 0; m < 4; ++m) { bf16_t* rowp = O + (size_t)(row0 + ai * HALF + m * 16) * ldc + col0;
#pragma unroll
                for (int bj = 0; bj < 2; ++bj) { const f32x4 v0 = acc[ai][bj][m][0], v1 = acc[ai][bj][m][1];
                    u32x4 w; w.x = cvt_pk_bf16(v0[0], v0[1]); w.y = cvt_pk_bf16(v0[2], v0[3]); w.z = cvt_pk_bf16(v1[0], v1[1]); w.w = cvt_pk_bf16(v1[2], v1[3]);
                    *(u32x4*)(rowp + bj * HALF) = w; } }
    }
};
struct EpiStoreF32 {
    static constexpr bool PERM = true, AFTER_DRAIN = false;
    float* O; int ldc;
    __device__ __forceinline__ void operator()(const f32x4 (&acc)[2][2][4][2], const Unit& u, int wr, int wc, int fr, int fq) const {
        const int row0 = u.pm * BM + wr * 64 + fr, col0 = u.pn * BM + wc * 32 + 8 * fq;
#pragma unroll
        for (int ai = 0; ai < 2; ++ai)
#pragma unroll
            for (int m = 0; m < 4; ++m) { float* rowp = O + (size_t)(row0 + ai * HALF + m * 16) * ldc + col0;
#pragma unroll
                for (int bj = 0; bj < 2; ++bj) { *(f32x4*)(rowp + bj * HALF) = acc[ai][bj][m][0]; *(f32x4*)(rowp + bj * HALF + 4) = acc[ai][bj][m][1]; } }
    }
};
struct EpiSwiGLU {
    static constexpr bool PERM = true, AFTER_DRAIN = false;
    bf16_t* H; int ldh;
    __device__ __forceinline__ void operator()(const f32x4 (&acc)[2][2][4][2], const Unit& u, int wr, int wc, int fr, int fq) const {
        const int row0 = u.pm * BM + wr * 64 + fr, col0 = u.pn * (BM / 2) + wc * 16 + 4 * fq;
#pragma unroll
        for (int ai = 0; ai < 2; ++ai)
#pragma unroll
            for (int m = 0; m < 4; ++m) { bf16_t* rowp = H + (size_t)(row0 + ai * HALF + m * 16) * ldh + col0;
#pragma unroll
                for (int bj = 0; bj < 2; ++bj) { const f32x4 v0 = acc[ai][bj][m][0], v1 = acc[ai][bj][m][1];
                    u32x2 w; w.x = cvt_pk_bf16(silu_f(v0[0]) * v0[1], silu_f(v0[2]) * v0[3]); w.y = cvt_pk_bf16(silu_f(v1[0]) * v1[1], silu_f(v1[2]) * v1[3]);
                    *(u32x2*)(rowp + bj * (HALF / 2)) = w; } }
    }
};
template <class Epi, class Sched, bool ALIGN_EPI = false, bool SP2 = false>
__device__ __forceinline__ void gemm_phase(PG8_LAS unsigned char* lds, const Gemm g, const Sched& S, const Epi& E) {
    int tid_l = threadIdx.x; asm volatile("" : "+v"(tid_l));
    const int tid = tid_l, wid = __builtin_amdgcn_readfirstlane(tid >> 6), lane = tid & 63, wr = wid >> 2, wc = wid & 3, fr = lane & 15, fq = lane >> 4;
    const int K = g.K, nt = K / BK;
    unsigned voffA[2], voffB[2];
#pragma unroll
    for (int i = 0; i < 2; ++i) { int R, C; stage_rc(tid * 16 + i * 8192, R, C); const int Rb = Epi::PERM ? ((R & ~31) + perm32(R & 31)) : R;
        voffA[i] = (unsigned)(R * K + C) * 2u; voffB[i] = (unsigned)(Rb * K + C) * 2u; }
    const size_t kstep = (size_t)(BK * 2);
    const size_t hstep = (size_t)HALF * K * 2;
    const size_t tstep = 2 * hstep;
    const unsigned ldsw = (unsigned)wid * 1024u;
    const int aoff = lds_byte(wr * 64 + fr, fq * 8), boff = lds_byte(wc * 32 + fr, fq * 8);
#define PG8_SA(b, h) (((b) * 2 + (h)) * HTB)
#define PG8_SB(b, h) ((4 + (b) * 2 + (h)) * HTB)
#define PG8_STAGE(bufoff, gbase, voff) do { _Pragma("unroll") for (int _i = 0; _i < 2; ++_i) \
        __builtin_amdgcn_global_load_lds((const unsigned*)((const char*)(gbase) + (voff)[_i]), (PG8_LAS unsigned*)(lds + (bufoff) + ldsw + _i * 8192), 16, 0, 0); } while (0)
#define PG8_LDA(dst, b, h) do { _Pragma("unroll") for (int m = 0; m < 4; ++m) _Pragma("unroll") for (int k = 0; k < 2; ++k) dst[m][k] = *(const PG8_LAS bf16x8*)(lds + PG8_SA(b, h) + aoff + m * 2048 + k * 1024); } while (0)
#define PG8_LDB(dst, b, h) do { _Pragma("unroll") for (int n = 0; n < 2; ++n) _Pragma("unroll") for (int k = 0; k < 2; ++k) dst[n][k] = *(const PG8_LAS bf16x8*)(lds + PG8_SB(b, h) + boff + n * 2048 + k * 1024); } while (0)
#define PG8_MMA(ai, bj, At, Bt) do { __builtin_amdgcn_s_setprio(1); _Pragma("unroll") for (int m = 0; m < 4; ++m) _Pragma("unroll") for (int n = 0; n < 2; ++n) _Pragma("unroll") for (int k = 0; k < 2; ++k) \
        acc[ai][bj][m][n] = __builtin_amdgcn_mfma_f32_16x16x32_bf16(Bt[n][k], At[m][k], acc[ai][bj][m][n], 0, 0, 0); __builtin_amdgcn_s_setprio(0); } while (0)
#define PG8_WAIT_V(n) asm volatile("s_waitcnt vmcnt(" #n ")" ::: "memory")
#define PG8_WAIT_L(n) asm volatile("s_waitcnt lgkmcnt(" #n ")" ::: "memory")
#define PG8_BAR __builtin_amdgcn_s_barrier()
#define PG8_SCHED __builtin_amdgcn_sched_barrier(0)
    Unit cur, nxt; int ui = 0;
    if (!S.next(0, cur)) return;
    f32x4 acc[2][2][4][2];
#pragma unroll
    for (int a = 0; a < 2; ++a)
#pragma unroll
        for (int b = 0; b < 2; ++b)
#pragma unroll
            for (int m = 0; m < 4; ++m)
#pragma unroll
                for (int n = 0; n < 2; ++n) acc[a][b][m][n] = (f32x4){0.f, 0.f, 0.f, 0.f};
    bf16x8 At[4][2], B0[2][2], B1[2][2];
    const char* cA = (const char*)g.A + (size_t)cur.pm * tstep; const char* cB = (const char*)g.Bt + (size_t)cur.pn * tstep;
    S.a_ready(cur);
    if constexpr (SP2) {
        PG8_STAGE(PG8_SB(0, 0), cB, voffB); PG8_STAGE(PG8_SB(0, 1), cB + hstep, voffB); PG8_STAGE(PG8_SA(0, 0), cA, voffA); PG8_STAGE(PG8_SA(0, 1), cA + hstep, voffA);
        if (wr == 1) PG8_BAR;
        PG8_WAIT_V(2); PG8_BAR;
        PG8_STAGE(PG8_SB(1, 0), cB + kstep, voffB); PG8_STAGE(PG8_SA(1, 0), cA + kstep, voffA); PG8_STAGE(PG8_SB(1, 1), cB + hstep + kstep, voffB);
        PG8_WAIT_V(6); PG8_BAR;
    } else {
        PG8_STAGE(PG8_SB(0, 0), cB, voffB); PG8_STAGE(PG8_SA(0, 0), cA, voffA); PG8_STAGE(PG8_SB(0, 1), cB + hstep, voffB); PG8_STAGE(PG8_SA(0, 1), cA + hstep, voffA);
        if (wr == 1) PG8_BAR;
        PG8_WAIT_V(4); PG8_BAR;
        PG8_STAGE(PG8_SB(1, 0), cB + kstep, voffB); PG8_STAGE(PG8_SA(1, 0), cA + kstep, voffA); PG8_STAGE(PG8_SB(1, 1), cB + hstep + kstep, voffB);
        PG8_WAIT_V(6); PG8_BAR;
    }
    for (;;) {
        const bool has_next = S.next(ui + 1, nxt);
        const char* nA = has_next ? (const char*)g.A + (size_t)nxt.pm * tstep : cA; const char* nB = has_next ? (const char*)g.Bt + (size_t)nxt.pn * tstep : cB;
        for (int t = 0; t < nt; t += 2) {
            const bool last = (t == nt - 2);
            const char* a1 = cA + (size_t)(t + 1) * kstep;
            const char* a2 = last ? nA : cA + (size_t)(t + 2) * kstep; const char* b2 = last ? nB : cB + (size_t)(t + 2) * kstep;
            const char* a3 = a2 + kstep; const char* b3 = b2 + kstep;
            if (last && has_next) S.a_ready(nxt);
            if constexpr (SP2) {
            PG8_LDB(B0, 0, 0); PG8_LDB(B1, 0, 1); PG8_SCHED; PG8_LDA(At, 0, 0); PG8_STAGE(PG8_SA(1, 1), a1 + hstep, voffA);
            PG8_WAIT_V(8); PG8_WAIT_L(0); PG8_BAR; PG8_MMA(0, 0, At, B0); PG8_MMA(0, 1, At, B1); PG8_BAR; PG8_SCHED;
            PG8_LDA(At, 0, 1); PG8_STAGE(PG8_SB(0, 0), b2, voffB); PG8_STAGE(PG8_SB(0, 1), b2 + hstep, voffB); PG8_STAGE(PG8_SA(0, 0), a2, voffA);
            PG8_WAIT_V(8); PG8_WAIT_L(0); PG8_BAR; PG8_MMA(1, 0, At, B0); PG8_MMA(1, 1, At, B1); PG8_BAR; PG8_SCHED;
            PG8_LDB(B0, 1, 0); PG8_LDB(B1, 1, 1); PG8_SCHED; PG8_LDA(At, 1, 0); PG8_STAGE(PG8_SA(0, 1), a2 + hstep, voffA);
            PG8_WAIT_V(8); PG8_WAIT_L(0); PG8_BAR; PG8_MMA(0, 0, At, B0); PG8_MMA(0, 1, At, B1); PG8_BAR; PG8_SCHED;
            PG8_LDA(At, 1, 1); PG8_STAGE(PG8_SB(1, 0), b3, voffB); PG8_STAGE(PG8_SB(1, 1), b3 + hstep, voffB); PG8_STAGE(PG8_SA(1, 0), a3, voffA);
            PG8_WAIT_V(8); PG8_WAIT_L(0); PG8_BAR; PG8_MMA(1, 0, At, B0); PG8_MMA(1, 1, At, B1); PG8_BAR; PG8_SCHED;
            } else {
            PG8_LDB(B0, 0, 0); PG8_SCHED; PG8_LDA(At, 0, 0); PG8_STAGE(PG8_SA(1, 1), a1 + hstep, voffA);
            PG8_WAIT_L(8); PG8_BAR; PG8_WAIT_L(0); PG8_MMA(0, 0, At, B0); PG8_BAR; PG8_SCHED;
            PG8_LDB(B1, 0, 1); PG8_STAGE(PG8_SB(0, 0), b2, voffB);
            PG8_BAR; PG8_WAIT_L(0); PG8_MMA(0, 1, At, B1); PG8_BAR;
            PG8_LDA(At, 0, 1); PG8_STAGE(PG8_SA(0, 0), a2, voffA);
            PG8_BAR; PG8_WAIT_L(0); PG8_MMA(1, 0, At, B0); PG8_BAR; PG8_SCHED;
            PG8_STAGE(PG8_SB(0, 1), b2 + hstep, voffB);
            PG8_WAIT_V(6); PG8_BAR; PG8_MMA(1, 1, At, B1); PG8_BAR;
            PG8_LDB(B0, 1, 0); PG8_SCHED; PG8_LDA(At, 1, 0); PG8_STAGE(PG8_SA(0, 1), a2 + hstep, voffA);
            PG8_WAIT_L(8); PG8_BAR; PG8_WAIT_L(0); PG8_MMA(0, 0, At, B0); PG8_BAR; PG8_SCHED;
            PG8_LDB(B1, 1, 1); PG8_STAGE(PG8_SB(1, 0), b3, voffB);
            PG8_BAR; PG8_WAIT_L(0); PG8_MMA(0, 1, At, B1); PG8_BAR;
            PG8_LDA(At, 1, 1); PG8_STAGE(PG8_SA(1, 0), a3, voffA);
            PG8_BAR; PG8_WAIT_L(0); PG8_MMA(1, 0, At, B0); PG8_BAR; PG8_SCHED;
            PG8_STAGE(PG8_SB(1, 1), b3 + hstep, voffB);
            PG8_WAIT_V(6); PG8_BAR; PG8_MMA(1, 1, At, B1); PG8_BAR;
            }
        }
        if constexpr (ALIGN_EPI) { if (wr == 0) PG8_BAR; }
        if constexpr (!Epi::AFTER_DRAIN) { E(acc, cur, wr, wc, fr, fq); S.done(cur); }
        if (!has_next) break;
#pragma unroll
        for (int a = 0; a < 2; ++a)
#pragma unroll
            for (int b = 0; b < 2; ++b)
#pragma unroll
                for (int m = 0; m < 4; ++m)
#pragma unroll
                    for (int n = 0; n < 2; ++n) acc[a][b][m][n] = (f32x4){0.f, 0.f, 0.f, 0.f};
        cur = nxt; cA = nA; cB = nB; ++ui;
        if constexpr (ALIGN_EPI) { if (wr == 1) PG8_BAR; }
    }
    PG8_WAIT_V(0);
    if constexpr (!ALIGN_EPI) { if (wr == 0) PG8_BAR; }
    PG8_BAR;
    if constexpr (Epi::AFTER_DRAIN) { E.fused(acc, cur, wr, wc, fr, fq, lds, wid, lane); S.done(cur); }
#undef PG8_SA
#undef PG8_SB
#undef PG8_STAGE
#undef PG8_LDA
#undef PG8_LDB
#undef PG8_MMA
#undef PG8_WAIT_V
#undef PG8_WAIT_L
#undef PG8_BAR
#undef PG8_SCHED
}
}
constexpr int BATCH = 4, SEQ = 4096, DM = 1024, NCH = 64, CH = 64, MTOK = BATCH * SEQ, DEPTH = 2;
constexpr int NPROJ = 3072, IN_COLS = 3088, FF = 2816;
constexpr float EPS = 1e-6f;
constexpr size_t MiB = 1u << 20;
constexpr size_t WS_SMALL = 1 * MiB, WS_ACS = 2 * MiB, WS_CDEC = 2 * MiB + 512 * 1024, WS_EGL = 2 * MiB + 768 * 1024;
constexpr size_t WS_WIN = 3 * MiB, WS_WOUT = 9 * MiB, WS_WGU = 11 * MiB, WS_WDN = 22 * MiB;
constexpr size_t WS_XN = 28 * MiB;
constexpr size_t WS_GU = 28 * MiB, WS_GW = 36 * MiB, WS_GQE = 44 * MiB, WS_GQK = 52 * MiB, WS_GKDT = 244 * MiB;
constexpr size_t WS_PROJ = 60 * MiB, WS_H = 60 * MiB;
constexpr size_t WS_MIX = 156 * MiB;
constexpr size_t WS_STATES = 188 * MiB, WS_YPART = 220 * MiB, WS_CCONV = 236 * MiB, WS_TMP = 188 * MiB;
constexpr size_t WS_X1 = 220 * MiB;
constexpr size_t WS_END = 252 * MiB;
constexpr int LDS_BYTES = 147456;
#ifndef REP_C
#define REP_C 1
#endif
#ifndef REP_P1
#define REP_P1 1
#endif
#ifndef REP_DS
#define REP_DS 1
#endif
#ifndef RP3_MMA
#define RP3_MMA 1
#endif
#ifndef REP_GEMM
#define REP_GEMM 1
#endif
#ifndef REP_ATT
#define REP_ATT 1
#endif
#ifndef RG_CONV
#define RG_CONV 1
#endif
#ifndef RG_KK
#define RG_KK 1
#endif
#ifndef RG_SOLVE
#define RG_SOLVE 1
#endif
#ifndef REP_C1
#define REP_C1 1
#endif
#ifndef REP_C2
#define REP_C2 1
#endif
#ifndef REP_D
#define REP_D 1
#endif
#ifndef REP_E
#define REP_E 1
#endif

#define LAS __attribute__((address_space(3)))
#define DEV __device__ __forceinline__
typedef unsigned short bf16;
typedef short bf16x8 __attribute__((ext_vector_type(8)));
typedef float f32x4 __attribute__((ext_vector_type(4)));
typedef unsigned u32x4 __attribute__((ext_vector_type(4)));
typedef unsigned u32x2 __attribute__((ext_vector_type(2)));

typedef float f32x2_t __attribute__((ext_vector_type(2)));
typedef __bf16 bf16x2_t __attribute__((ext_vector_type(2)));
DEV unsigned pk2(float lo, float hi) { const f32x2_t v = {lo, hi}; const bf16x2_t b = __builtin_convertvector(v, bf16x2_t); return __builtin_bit_cast(unsigned, b); }
DEV unsigned f2bf(float f) { return pk2(f, 0.f) & 0xffffu; }
DEV float bf2f(unsigned b) { return __builtin_bit_cast(float, b << 16); }
DEV float bflo(unsigned w) { return __builtin_bit_cast(float, w << 16); }
DEV float bfhi(unsigned w) { return __builtin_bit_cast(float, w & 0xffff0000u); }
DEV float silu(float x) { return x * __builtin_amdgcn_rcpf(1.0f + __expf(-x)); }
DEV float softplus(float x) { return fmaxf(x, 0.f) + log1pf(expf(-fabsf(x))); }
template <int CTRL> DEV float dpp_f(float v) { return __builtin_bit_cast(float, __builtin_amdgcn_update_dpp(0, __builtin_bit_cast(int, v), CTRL, 0xF, 0xF, true)); }
DEV float red4_sum(float v) { v += dpp_f<0xB1>(v); v += dpp_f<0x4E>(v); return v; }
DEV float red8_sum(float v) { v = red4_sum(v); v += dpp_f<0x141>(v); return v; }
DEV float red16_sum(float v) { v = red8_sum(v); v += dpp_f<0x140>(v); return v; }
DEV float red16_max(float v) { v = fmaxf(v, dpp_f<0xB1>(v)); v = fmaxf(v, dpp_f<0x4E>(v)); v = fmaxf(v, dpp_f<0x141>(v)); v = fmaxf(v, dpp_f<0x140>(v)); return v; }
DEV float rdlane(float v, int l) { return __builtin_bit_cast(float, __builtin_amdgcn_readlane(__builtin_bit_cast(int, v), l)); }
DEV float wave_sum(float v) { v = red16_sum(v); return (rdlane(v, 0) + rdlane(v, 16)) + (rdlane(v, 32) + rdlane(v, 48)); }
DEV float wave_incl_scan(float v, int lane) {
    v += dpp_f<0x111>(v); v += dpp_f<0x112>(v); v += dpp_f<0x114>(v); v += dpp_f<0x118>(v);
    const float t0 = rdlane(v, 15), t1 = rdlane(v, 31), t2 = rdlane(v, 47);
    const int r = lane >> 4;
    return v + (r > 0 ? t0 : 0.f) + (r > 1 ? t1 : 0.f) + (r > 2 ? t2 : 0.f);
}
DEV float frcp(float x) { return __builtin_amdgcn_rcpf(x); }
DEV f32x4 mma_tile(const LAS bf16* A, int lda, const LAS bf16* B, int ldb, int K, int lane, f32x4 acc) {
    const LAS bf16* ap = A + (lane & 15) * lda + (lane >> 4) * 8;
    const LAS bf16* bp = B + (lane & 15) * ldb + (lane >> 4) * 8;
    for (int k = 0; k < K; k += 32) {
        const bf16x8 a = *(const LAS bf16x8*)(ap + k), b = *(const LAS bf16x8*)(bp + k);
        acc = __builtin_amdgcn_mfma_f32_16x16x32_bf16(a, b, acc, 0, 0, 0);
    }
    return acc;
}

struct Params {
    const float *x, *pre_mix, *post_mix, *pre_ffn, *post_ffn, *w_in, *w_out, *sinks, *sconv_w, *sconv_b, *sdt_bias, *sA_log, *sD, *snorm_w,
                *gconv_w, *gdt_bias, *gA_log, *gnorm_w, *w_gate, *w_up, *w_down;
    float* out; unsigned char* ws;
};

DEV void tr_item(const float* W, int ldw, int col0, bf16* WT, int K, int drow0, int rs, LAS float* scr, int kb, int nb, int lane) {
    const int k0 = 64 * kb, n0 = 32 * nb;
#pragma unroll 8
    for (int i = 0; i < 32; ++i) { const int kk = 2 * i + (lane >> 5); scr[kk * 33 + (lane & 31)] = W[(size_t)(k0 + kk) * ldw + col0 + n0 + (lane & 31)]; }
    asm volatile("s_waitcnt lgkmcnt(0)" ::: "memory");
    const int c = lane & 7;
#pragma unroll
    for (int j = 0; j < 4; ++j) { const int n = (lane >> 3) + 8 * j; const LAS float* s = scr + (8 * c) * 33 + n;
        u32x4 o; o.x = pk2(s[0 * 33], s[1 * 33]); o.y = pk2(s[2 * 33], s[3 * 33]); o.z = pk2(s[4 * 33], s[5 * 33]); o.w = pk2(s[6 * 33], s[7 * 33]);
        *(u32x4*)(WT + (size_t)(drow0 + (n0 + n) * rs) * K + k0 + 8 * c) = o; }
    asm volatile("s_waitcnt lgkmcnt(0)" ::: "memory");
}
DEV void convert_weights(const Params& p, int l, LAS unsigned char* lds, int gw, int NGW, int wave, int lane) {
    LAS float* scr = (LAS float*)(lds + wave * 8448);
    const float* win = p.w_in + (size_t)l * DM * IN_COLS; const float* wout = p.w_out + (size_t)l * DM * DM;
    const float* wg = p.w_gate + (size_t)l * DM * FF; const float* wu = p.w_up + (size_t)l * DM * FF; const float* wd = p.w_down + (size_t)l * FF * DM;
    bf16* WIN = (bf16*)(p.ws + WS_WIN); bf16* WOUT = (bf16*)(p.ws + WS_WOUT); bf16* WGU = (bf16*)(p.ws + WS_WGU); bf16* WDN = (bf16*)(p.ws + WS_WDN);
    constexpr int I_IN = 16 * 96, I_OUT = 16 * 32, I_G = 16 * 88, I_D = 44 * 32;
    constexpr int NIT = I_IN + I_OUT + 2 * I_G + I_D;
    for (int it = gw; it < NIT; it += NGW) {
        int r = it;
        if (r < I_IN) { const int kb = r / 96, nb = r % 96;
            if (nb < 64) tr_item(win, IN_COLS, 0, WIN, DM, 0, 1, scr, kb, nb, lane); else tr_item(win, IN_COLS, 2056, WIN, DM, 2048, 1, scr, kb, nb - 64, lane);
            continue; } r -= I_IN;
        if (r < I_OUT) { tr_item(wout, DM, 0, WOUT, DM, 0, 1, scr, r / 32, r % 32, lane); continue; } r -= I_OUT;
        if (r < I_G) { tr_item(wg, FF, 0, WGU, DM, 0, 2, scr, r / 88, r % 88, lane); continue; } r -= I_G;
        if (r < I_G) { tr_item(wu, FF, 0, WGU, DM, 1, 2, scr, r / 88, r % 88, lane); continue; } r -= I_G;
        tr_item(wd, DM, 0, WDN, FF, 0, 1, scr, r / 32, r % 32, lane);
    }
}
DEV void stage_small(const Params& p, int l, LAS float* wsT, int tid) {
    const float* win = p.w_in + (size_t)l * DM * IN_COLS;
    for (int idx = tid; idx < 16 * DM; idx += 512) { const int k = idx >> 4, c = idx & 15; const int sc = c < 8 ? 2048 + c : 3072 + c; wsT[c * DM + k] = win[(size_t)k * IN_COLS + sc]; }
}
template <int MODE, bool RB = false, bool OB = false>
DEV void rowpass(const void* res_, const bf16* tmp, const float* wpost, const float* wnext, void* xout_, bf16* XN, float* SMALL, const LAS float* wsT, int gw, int NGW, int lane) {
    const float* res = (const float*)res_; const bf16* res16 = (const bf16*)res_; float* xout = (float*)xout_; bf16* xout16 = (bf16*)xout_;
    f32x4 wp[4], wn[4];
#pragma unroll
    for (int j = 0; j < 4; ++j) {
        if (MODE != 0) wp[j] = *((const f32x4*)wpost + lane + 64 * j);
        if (MODE != 3) wn[j] = *((const f32x4*)wnext + lane + 64 * j);
    }
    f32x4 nv[4]; u32x2 nv16[4]; u32x2 ntw[4];
#pragma unroll
    for (int j = 0; j < 4; ++j) { if (RB) nv16[j] = *((const u32x2*)(res16 + (size_t)gw * DM) + lane + 64 * j); else nv[j] = *((const f32x4*)(res + (size_t)gw * DM) + lane + 64 * j);
        if (MODE != 0) ntw[j] = *((const u32x2*)(tmp + (size_t)gw * DM) + lane + 64 * j); }
    for (int m = gw; m < MTOK; m += NGW) {
        f32x4 v[4]; u32x2 ctw[4];
#pragma unroll
        for (int j = 0; j < 4; ++j) { if (RB) v[j] = (f32x4){bflo(nv16[j].x), bfhi(nv16[j].x), bflo(nv16[j].y), bfhi(nv16[j].y)}; else v[j] = nv[j]; if (MODE != 0) ctw[j] = ntw[j]; }
        { const int mn = (m + NGW < MTOK) ? m + NGW : m;
#pragma unroll
            for (int j = 0; j < 4; ++j) { if (RB) nv16[j] = *((const u32x2*)(res16 + (size_t)mn * DM) + lane + 64 * j); else nv[j] = *((const f32x4*)(res + (size_t)mn * DM) + lane + 64 * j);
                if (MODE != 0) ntw[j] = *((const u32x2*)(tmp + (size_t)mn * DM) + lane + 64 * j); } }
        if (MODE != 0) {
            f32x4 t[4]; float ss = 0.f;
#pragma unroll
            for (int j = 0; j < 4; ++j) { const u32x2 tw = ctw[j]; t[j] = (f32x4){bflo(tw.x), bfhi(tw.x), bflo(tw.y), bfhi(tw.y)}; ss += (t[j].x * t[j].x + t[j].y * t[j].y) + (t[j].z * t[j].z + t[j].w * t[j].w); }
            const float rstd = rsqrtf(wave_sum(ss) * (1.0f / DM) + EPS);
#pragma unroll
            for (int j = 0; j < 4; ++j) { v[j] = v[j] + t[j] * rstd * wp[j];
                if (OB) { u32x2 o; o.x = pk2(v[j].x, v[j].y); o.y = pk2(v[j].z, v[j].w); *((u32x2*)(xout16 + (size_t)m * DM) + lane + 64 * j) = o; }
                else *((f32x4*)(xout + (size_t)m * DM) + lane + 64 * j) = v[j]; }
        }
        if (MODE != 3) {
            float ss = 0.f;
#pragma unroll
            for (int j = 0; j < 4; ++j) ss += (v[j].x * v[j].x + v[j].y * v[j].y) + (v[j].z * v[j].z + v[j].w * v[j].w);
            const float rstd = rsqrtf(wave_sum(ss) * (1.0f / DM) + EPS);
#pragma unroll
            for (int j = 0; j < 4; ++j) { v[j] = v[j] * rstd * wn[j];
                u32x2 o; o.x = pk2(v[j].x, v[j].y); o.y = pk2(v[j].z, v[j].w); *((u32x2*)(XN + (size_t)m * DM) + lane + 64 * j) = o; }
            if (MODE == 0 || MODE == 2) {
                float mine = 0.f;
#pragma unroll
                for (int c = 0; c < 16; ++c) { float s = 0.f; asm volatile("" ::: "memory");
#pragma unroll
                    for (int j = 0; j < 4; ++j) { const f32x4 w = *((const LAS f32x4*)(wsT + c * DM) + lane + 64 * j); s += (v[j].x * w.x + v[j].y * w.y) + (v[j].z * w.z + v[j].w * w.w); }
                    s = red16_sum(s); mine = ((lane & 15) == c) ? s : mine; }
                mine += __shfl_xor(mine, 16); mine += __shfl_xor(mine, 32);
                if (lane < 16) SMALL[(size_t)m * 16 + lane] = mine;
            }
        }
    }
}

DEV void attn_unit(const Params& p, int l, int u, LAS unsigned char* lds, int tid) {
    asm volatile("" : "+v"(tid));
    const int b = u >> 7, c = (u >> 1) & 63, kvh = u & 1, wave = tid >> 6, lane = tid & 63;
    const bf16* PROJ = (const bf16*)(p.ws + WS_PROJ); bf16* MIX = (bf16*)(p.ws + WS_MIX);
    LAS bf16* Qs = (LAS bf16*)lds;
    LAS bf16* Ks = Qs + 128 * 72;
    LAS bf16* Vt = Ks + 192 * 72;
    LAS bf16* Ps = Vt + 64 * 200;
    const size_t t0 = (size_t)b * SEQ + (size_t)c * CH;
    {
        u32x4 rq[2], rk[3], rv[3];
#pragma unroll
        for (int k = 0; k < 2; ++k) { const int idx = tid + k * 512, r = idx >> 3, v = idx & 7, g = r >> 6, i = r & 63;
            rq[k] = *(const u32x4*)(PROJ + (t0 + i) * NPROJ + kvh * 128 + g * 64 + v * 8); }
#pragma unroll
        for (int k = 0; k < 3; ++k) { const int idx = tid + k * 512, j = idx >> 3, v = idx & 7; const bool valid = (c - 2 + (j >> 6)) >= 0;
            rk[k] = (u32x4){0u, 0u, 0u, 0u}; rv[k] = rk[k];
            if (valid) { const bf16* rowp = PROJ + (size_t)((long)t0 - 128 + j) * NPROJ; rk[k] = *(const u32x4*)(rowp + 256 + kvh * 64 + v * 8); rv[k] = *(const u32x4*)(rowp + 384 + kvh * 64 + v * 8); } }
#pragma unroll
        for (int k = 0; k < 2; ++k) { const int idx = tid + k * 512, r = idx >> 3, v = idx & 7; *(LAS u32x4*)(Qs + r * 72 + v * 8) = rq[k]; }
#pragma unroll
        for (int k = 0; k < 3; ++k) { const int idx = tid + k * 512, j = idx >> 3, v = idx & 7; const u32x4 vv = rv[k];
            *(LAS u32x4*)(Ks + j * 72 + v * 8) = rk[k];
            LAS bf16* vt = Vt + (v * 8) * 200 + j;
            vt[0 * 200] = (bf16)(vv.x & 0xffffu); vt[1 * 200] = (bf16)(vv.x >> 16); vt[2 * 200] = (bf16)(vv.y & 0xffffu); vt[3 * 200] = (bf16)(vv.y >> 16);
            vt[4 * 200] = (bf16)(vv.z & 0xffffu); vt[5 * 200] = (bf16)(vv.z >> 16); vt[6 * 200] = (bf16)(vv.w & 0xffffu); vt[7 * 200] = (bf16)(vv.w >> 16); }
    }
    __syncthreads();
    {
        const int g = wave >> 2, h = kvh * 2 + g;
        const float slope = exp2f(-2.0f * (float)(h + 1)), sink = p.sinks[l * 4 + h];
        f32x4 s[12];
#pragma unroll
        for (int nt = 0; nt < 12; ++nt) s[nt] = mma_tile(Qs + wave * 16 * 72, 72, Ks + nt * 16 * 72, 72, 64, lane, (f32x4){0.f, 0.f, 0.f, 0.f});
#pragma unroll
        for (int j = 0; j < 4; ++j) {
            const int r = wave * 16 + (lane >> 4) * 4 + j, i = r & 63;
            float mx = sink;
#pragma unroll
            for (int nt = 0; nt < 12; ++nt) { const int jj = nt * 16 + (lane & 15);
                float val = s[nt][j] * 0.125f - slope * fabsf((float)(i + 128 - jj));
                if (c - 2 + (nt >> 2) < 0) val = -INFINITY;
                s[nt][j] = val; mx = fmaxf(mx, val); }
            mx = red16_max(mx);
            float sum = 0.f;
#pragma unroll
            for (int nt = 0; nt < 12; ++nt) { const float e = __expf(s[nt][j] - mx); s[nt][j] = e; sum += e; }
            sum = red16_sum(sum);
            sum += __expf(sink - mx);
            const float inv = frcp(sum);
#pragma unroll
            for (int nt = 0; nt < 12; ++nt) Ps[r * 200 + nt * 16 + (lane & 15)] = (bf16)f2bf(s[nt][j] * inv);
        }
    }
    __syncthreads();
#pragma unroll
    for (int nt = 0; nt < 4; ++nt) {
        const f32x4 acc = mma_tile(Vt + nt * 16 * 200, 200, Ps + wave * 16 * 200, 200, 192, lane, (f32x4){0.f, 0.f, 0.f, 0.f});
        const int r = wave * 16 + (lane & 15), g = r >> 6, i = r & 63, d0 = nt * 16 + (lane >> 4) * 4;
        u32x2 o; o.x = pk2(acc[0], acc[1]); o.y = pk2(acc[2], acc[3]);
        *(u32x2*)(MIX + (t0 + i) * DM + (kvh * 2 + g) * 64 + d0) = o;
    }
    __syncthreads();
}

template <int NCOLS> struct RawTile {
    static constexpr int VPR = NCOLS / 8, NV = 67 * VPR, NIT = (NV + 511) / 512;
    u32x4 r[NIT];
    DEV void issue(const bf16* PROJ, size_t t0, int c, int col0, int tid) {
#pragma unroll
        for (int k = 0; k < NIT; ++k) { const int idx = tid + k * 512, row = idx / VPR, v = idx % VPR;
            r[k] = (u32x4){0u, 0u, 0u, 0u};
            if (idx < NV && (c > 0 || row >= 3)) r[k] = *(const u32x4*)(PROJ + (size_t)((long)t0 - 3 + row) * NPROJ + col0 + v * 8); }
    }
    DEV void commit(LAS bf16* Raw, int rawld, int dcol0, int tid) const {
#pragma unroll
        for (int k = 0; k < NIT; ++k) { const int idx = tid + k * 512, row = idx / VPR, v = idx % VPR;
            if (idx < NV) *(LAS u32x4*)(Raw + row * rawld + dcol0 + v * 8) = r[k]; }
    }
};
DEV void ssd_p1_unit(const Params& p, int l, int u, LAS unsigned char* lds, int tid) {
    asm volatile("" : "+v"(tid));
    const int b = u >> 7, c = (u >> 1) & 63, g = u & 1, wave = tid >> 6, lane = tid & 63;
    const bf16* PROJ = (const bf16*)(p.ws + WS_PROJ);
    const float* SMALL = (const float*)(p.ws + WS_SMALL);
    float* ACS = (float*)(p.ws + WS_ACS); float* CDEC = (float*)(p.ws + WS_CDEC);
    bf16* STATES = (bf16*)(p.ws + WS_STATES); bf16* YPART = (bf16*)(p.ws + WS_YPART); bf16* CCONV = (bf16*)(p.ws + WS_CCONV);
    LAS bf16* XsT = (LAS bf16*)lds;
    LAS bf16* Bm = XsT + 4 * 64 * 72;
    LAS bf16* Cm = Bm + 64 * 136;
    LAS bf16* BmT = Cm + 64 * 136;
    LAS bf16* Sc = BmT + 128 * 72;
    LAS bf16* Raw = Sc;
    LAS float* dtS = (LAS float*)(Sc + 4 * 64 * 72);
    LAS float* acsS = dtS + 256;
    LAS float* fS = acsS + 256;
    const size_t t0 = (size_t)b * SEQ + (size_t)c * CH;
    RawTile<256> R1; RawTile<128> R2b, R2c;
    R1.issue(PROJ, t0, c, 1024 + g * 256, tid); R2b.issue(PROJ, t0, c, 1024 + 512 + g * 128, tid); R2c.issue(PROJ, t0, c, 1024 + 768 + g * 128, tid);
    if (tid < 256) {
        const int h = tid >> 6, hh = g * 4 + h;
        const float dt = softplus(SMALL[(t0 + lane) * 16 + hh] + p.sdt_bias[l * 8 + hh]);
        const float a = -expf(p.sA_log[l * 8 + hh]);
        const float acs = wave_incl_scan(dt * a, lane);
        const float alast = rdlane(acs, 63);
        dtS[tid] = dt; acsS[tid] = acs; fS[tid] = dt * expf(alast - acs);
        ACS[(t0 + lane) * 8 + hh] = acs;
        if (lane == 63) CDEC[((size_t)b * NCH + c) * 8 + hh] = expf(acs);
    }
    R1.commit(Raw, 256, 0, tid);
    __syncthreads();
    {
        const int ch = tid & 255, half = tid >> 8, chg = g * 256 + ch, h = ch >> 6, pp = ch & 63;
        const float* cw = p.sconv_w + (size_t)l * 4096 + chg; const float w0 = cw[0], w1 = cw[1024], w2 = cw[2048], w3 = cw[3072], bias = p.sconv_b[l * 1024 + chg];
        const int r0 = half * 32;
        float x0 = bf2f(Raw[(r0 + 0) * 256 + ch]), x1 = bf2f(Raw[(r0 + 1) * 256 + ch]), x2 = bf2f(Raw[(r0 + 2) * 256 + ch]);
        LAS bf16* dst = XsT + h * 64 * 72 + pp * 72 + r0;
        for (int r = 0; r < 32; ++r) { const float x3 = bf2f(Raw[(r0 + r + 3) * 256 + ch]);
            const float y = silu(w0 * x0 + w1 * x1 + w2 * x2 + w3 * x3 + bias);
            dst[r] = (bf16)f2bf(y); x0 = x1; x1 = x2; x2 = x3; }
    }
    __syncthreads();
    R2b.commit(Raw, 256, 0, tid); R2c.commit(Raw, 256, 128, tid);
    __syncthreads();
    {
        const int ch = tid & 255, half = tid >> 8, isC = ch >> 7, n = ch & 127, chg = 512 + isC * 256 + g * 128 + n;
        const float* cw = p.sconv_w + (size_t)l * 4096 + chg; const float w0 = cw[0], w1 = cw[1024], w2 = cw[2048], w3 = cw[3072], bias = p.sconv_b[l * 1024 + chg];
        const int r0 = half * 32;
        float x0 = bf2f(Raw[(r0 + 0) * 256 + ch]), x1 = bf2f(Raw[(r0 + 1) * 256 + ch]), x2 = bf2f(Raw[(r0 + 2) * 256 + ch]);
        for (int r = 0; r < 32; ++r) { const float x3 = bf2f(Raw[(r0 + r + 3) * 256 + ch]);
            const bf16 y = (bf16)f2bf(silu(w0 * x0 + w1 * x1 + w2 * x2 + w3 * x3 + bias));
            if (isC) Cm[(r0 + r) * 136 + n] = y; else { Bm[(r0 + r) * 136 + n] = y; BmT[n * 72 + r0 + r] = y; }
            x0 = x1; x1 = x2; x2 = x3; }
    }
    __syncthreads();
    for (int idx = tid; idx < 1024; idx += 512) { const int r = idx >> 4, v = idx & 15; *(u32x4*)(CCONV + (t0 + r) * 256 + g * 128 + v * 8) = *(const LAS u32x4*)(Cm + r * 136 + v * 8); }
#pragma unroll
    for (int ti = 0; ti < 2; ++ti) {
        const int tt = wave * 2 + ti, mt = tt >> 2, nt = tt & 3;
        f32x4 acc = (f32x4){0.f, 0.f, 0.f, 0.f};
        if (nt <= mt) acc = mma_tile(Bm + nt * 16 * 136, 136, Cm + mt * 16 * 136, 136, 128, lane, acc);
        const int lr = mt * 16 + (lane & 15), s0 = nt * 16 + (lane >> 4) * 4;
#pragma unroll
        for (int h = 0; h < 4; ++h) { const f32x4 as = *(const LAS f32x4*)(acsS + h * 64 + s0), ds = *(const LAS f32x4*)(dtS + h * 64 + s0); const float al = acsS[h * 64 + lr];
            float v[4];
#pragma unroll
            for (int j = 0; j < 4; ++j) v[j] = (s0 + j <= lr) ? acc[j] * __expf(al - as[j]) * ds[j] : 0.f;
            u32x2 o; o.x = pk2(v[0], v[1]); o.y = pk2(v[2], v[3]);
            *(LAS u32x2*)(Sc + h * 64 * 72 + lr * 72 + s0) = o; }
    }
    __syncthreads();
    {
        const int h = wave >> 1, hh = g * 4 + h; const float Dh = p.sD[l * 8 + hh];
#pragma unroll 2
        for (int ti = 0; ti < 8; ++ti) { const int tt = (wave & 1) * 8 + ti, mt = tt >> 2, nt = tt & 3;
            const f32x4 acc = mma_tile(XsT + h * 64 * 72 + nt * 16 * 72, 72, Sc + h * 64 * 72 + mt * 16 * 72, 72, 64, lane, (f32x4){0.f, 0.f, 0.f, 0.f});
            const int lr = mt * 16 + (lane & 15), p0 = nt * 16 + (lane >> 4) * 4;
            const LAS bf16* xp = XsT + h * 64 * 72 + p0 * 72 + lr;
            u32x2 o; o.x = pk2(acc[0] + Dh * bf2f(xp[0]), acc[1] + Dh * bf2f(xp[72])); o.y = pk2(acc[2] + Dh * bf2f(xp[144]), acc[3] + Dh * bf2f(xp[216]));
            *(u32x2*)(YPART + (t0 + lr) * 512 + hh * 64 + p0) = o; }
#pragma unroll
        for (int pi = 0; pi < 2; ++pi) { const int pt = (wave & 1) * 2 + pi;
            bf16x8 xf[2];
#pragma unroll
            for (int k = 0; k < 2; ++k) { const int l0 = k * 32 + (lane >> 4) * 8;
                const u32x4 xw = *(const LAS u32x4*)(XsT + h * 64 * 72 + (pt * 16 + (lane & 15)) * 72 + l0);
                const f32x4 f0 = *(const LAS f32x4*)(fS + h * 64 + l0), f1 = *(const LAS f32x4*)(fS + h * 64 + l0 + 4);
                u32x4 o; o.x = pk2(bflo(xw.x) * f0.x, bfhi(xw.x) * f0.y); o.y = pk2(bflo(xw.y) * f0.z, bfhi(xw.y) * f0.w);
                o.z = pk2(bflo(xw.z) * f1.x, bfhi(xw.z) * f1.y); o.w = pk2(bflo(xw.w) * f1.z, bfhi(xw.w) * f1.w);
                xf[k] = __builtin_bit_cast(bf16x8, o); }
            for (int nt = 0; nt < 8; ++nt) {
                f32x4 acc = (f32x4){0.f, 0.f, 0.f, 0.f};
#pragma unroll
                for (int k = 0; k < 2; ++k) { const bf16x8 bfr = *(const LAS bf16x8*)(BmT + (nt * 16 + (lane & 15)) * 72 + k * 32 + (lane >> 4) * 8);
                    acc = __builtin_amdgcn_mfma_f32_16x16x32_bf16(bfr, xf[k], acc, 0, 0, 0); }
                u32x2 o; o.x = pk2(acc[0], acc[1]); o.y = pk2(acc[2], acc[3]);
                *(u32x2*)(STATES + ((((size_t)b * NCH + c) * 8 + hh) * 64 + pt * 16 + (lane & 15)) * 128 + nt * 16 + (lane >> 4) * 4) = o; } }
    }
    __syncthreads();
}
DEV void ssd_scan_all(const Params& p, int bx, LAS unsigned char* lds, int tid) {
    asm volatile("" : "+v"(tid));
    bf16* STATES = (bf16*)(p.ws + WS_STATES); const float* CDEC = (const float*)(p.ws + WS_CDEC);
    LAS float* decS = (LAS float*)lds;
    const int idx = bx * 512 + tid, b = idx >> 15, rem = idx & 32767, hh = rem >> 12, pn2 = rem & 4095;
    if (tid < 64) decS[tid] = CDEC[((size_t)b * NCH + tid) * 8 + hh];
    unsigned* base = (unsigned*)(STATES + ((size_t)b * NCH * 8 + hh) * 8192) + pn2;
    unsigned nw[NCH];
#pragma unroll
    for (int c = 0; c < NCH; ++c) nw[c] = base[(size_t)c * 8 * 4096];
    __syncthreads();
    float s0 = 0.f, s1 = 0.f;
#pragma unroll
    for (int c = 0; c < NCH; ++c) { const float d = decS[c];
        base[(size_t)c * 8 * 4096] = pk2(s0, s1);
        s0 = s0 * d + bflo(nw[c]); s1 = s1 * d + bfhi(nw[c]); }
    __syncthreads();
}
DEV void ssd_p3_unit(const Params& p, int l, int u, LAS unsigned char* lds, int tid) {
    asm volatile("" : "+v"(tid));
    const int b = u >> 7, c = (u >> 1) & 63, g = u & 1, wave = tid >> 6, lane = tid & 63;
    const bf16* PROJ = (const bf16*)(p.ws + WS_PROJ); const float* ACS = (const float*)(p.ws + WS_ACS);
    const bf16* STATES = (const bf16*)(p.ws + WS_STATES); const bf16* YPART = (const bf16*)(p.ws + WS_YPART); const bf16* CCONV = (const bf16*)(p.ws + WS_CCONV);
    bf16* MIX = (bf16*)(p.ws + WS_MIX);
    LAS bf16* Cm = (LAS bf16*)lds;
    LAS bf16* Prev = Cm + 64 * 136;
    LAS float* Gb = (LAS float*)Prev;
    LAS float* acsS = (LAS float*)(Prev + 4 * 64 * 136);
    const size_t t0 = (size_t)b * SEQ + (size_t)c * CH;
    const int h = wave >> 1, hh = g * 4 + h;
    u32x4 rc[2], rp[8]; u32x2 ry[8], rz[8]; float racs = 0.f;
#pragma unroll
    for (int k = 0; k < 2; ++k) { const int idx = tid + k * 512, r = idx >> 4, v = idx & 15; rc[k] = *(const u32x4*)(CCONV + (t0 + r) * 256 + g * 128 + v * 8); }
#pragma unroll
    for (int k = 0; k < 8; ++k) { const int idx = tid + k * 512, hq = idx >> 10, r = (idx >> 4) & 63, v = idx & 15;
        rp[k] = *(const u32x4*)(STATES + ((((size_t)b * NCH + c) * 8 + g * 4 + hq) * 64 + r) * 128 + v * 8); }
    if (tid < 256) racs = ACS[(t0 + (tid & 63)) * 8 + g * 4 + (tid >> 6)];
#pragma unroll
    for (int ti = 0; ti < 8; ++ti) { const int tt = (wave & 1) * 8 + ti, mt = tt >> 2, nt = tt & 3, lr = mt * 16 + (lane & 15), p0 = nt * 16 + (lane >> 4) * 4;
        ry[ti] = *(const u32x2*)(YPART + (t0 + lr) * 512 + hh * 64 + p0); rz[ti] = *(const u32x2*)(PROJ + (t0 + lr) * NPROJ + 512 + hh * 64 + p0); }
#pragma unroll
    for (int k = 0; k < 2; ++k) { const int idx = tid + k * 512, r = idx >> 4, v = idx & 15; *(LAS u32x4*)(Cm + r * 136 + v * 8) = rc[k]; }
#pragma unroll
    for (int k = 0; k < 8; ++k) { const int idx = tid + k * 512, hq = idx >> 10, r = (idx >> 4) & 63, v = idx & 15; *(LAS u32x4*)(Prev + hq * 64 * 136 + r * 136 + v * 8) = rp[k]; }
    if (tid < 256) acsS[tid] = racs;
    __syncthreads();
    f32x4 acc[8];
    for (int rq_ = 0; rq_ < RP3_MMA; ++rq_) {
#pragma unroll
    for (int ti = 0; ti < 8; ++ti) { const int tt = (wave & 1) * 8 + ti, mt = tt >> 2, nt = tt & 3;
        acc[ti] = mma_tile(Prev + h * 64 * 136 + nt * 16 * 136, 136, Cm + mt * 16 * 136, 136, 128, lane, (f32x4){0.f, 0.f, 0.f, 0.f}); }
    asm volatile("" ::: "memory"); }
    __syncthreads();
#pragma unroll
    for (int ti = 0; ti < 8; ++ti) { const int tt = (wave & 1) * 8 + ti, mt = tt >> 2, nt = tt & 3, lr = mt * 16 + (lane & 15), p0 = nt * 16 + (lane >> 4) * 4;
        const float ea = __expf(acsS[h * 64 + lr]);
        f32x4 gv;
        gv.x = (bflo(ry[ti].x) + ea * acc[ti][0]) * silu(bflo(rz[ti].x)); gv.y = (bfhi(ry[ti].x) + ea * acc[ti][1]) * silu(bfhi(rz[ti].x));
        gv.z = (bflo(ry[ti].y) + ea * acc[ti][2]) * silu(bflo(rz[ti].y)); gv.w = (bfhi(ry[ti].y) + ea * acc[ti][3]) * silu(bfhi(rz[ti].y));
        *(LAS f32x4*)(Gb + lr * 260 + h * 64 + p0) = gv; }
    __syncthreads();
    {
        const int lr = tid >> 3, part = tid & 7;
        const f32x4* nwp = (const f32x4*)(p.snorm_w + (size_t)l * 512 + g * 256 + part * 32);
        f32x4 nw[8], v[8]; float ss = 0.f;
#pragma unroll
        for (int k = 0; k < 8; ++k) nw[k] = nwp[k];
#pragma unroll
        for (int k = 0; k < 8; ++k) { v[k] = *(const LAS f32x4*)(Gb + lr * 260 + part * 32 + k * 4); ss += (v[k].x * v[k].x + v[k].y * v[k].y) + (v[k].z * v[k].z + v[k].w * v[k].w); }
        ss = red8_sum(ss);
        const float rstd = rsqrtf(ss * (1.0f / 256.0f) + EPS);
        bf16* dst = MIX + (t0 + lr) * DM + 256 + g * 256 + part * 32;
#pragma unroll
        for (int k = 0; k < 4; ++k) { const f32x4 a = v[2 * k] * rstd * nw[2 * k], bq = v[2 * k + 1] * rstd * nw[2 * k + 1];
            u32x4 o; o.x = pk2(a.x, a.y); o.y = pk2(a.z, a.w); o.z = pk2(bq.x, bq.y); o.w = pk2(bq.z, bq.w);
            *(u32x4*)(dst + 8 * k) = o; }
    }
    __syncthreads();
}

struct GdnPF { u32x4 rr[4]; float sb, sa; };
DEV void gdn_pre_issue(const Params& p, int u, int tid, GdnPF& pf) {
    const int b = u >> 8, c = (u >> 2) & 63, hg = u & 3, lane = tid & 63;
    const bf16* PROJ = (const bf16*)(p.ws + WS_PROJ); const float* SMALL = (const float*)(p.ws + WS_SMALL);
    const size_t t0 = (size_t)b * SEQ + (size_t)c * CH;
#pragma unroll
    for (int k = 0; k < 4; ++k) { const int idx = tid + k * 512, row = idx / 24, rem = idx % 24, seg = rem >> 3, v = rem & 7;
        pf.rr[k] = (u32x4){0u, 0u, 0u, 0u};
        if (idx < 67 * 24 && (c > 0 || row >= 3)) pf.rr[k] = *(const u32x4*)(PROJ + (size_t)((long)t0 - 3 + row) * NPROJ + 2048 + seg * 256 + hg * 64 + v * 8); }
    pf.sb = 0.f; pf.sa = 0.f;
    if ((tid >> 6) == 0) { pf.sb = SMALL[(t0 + lane) * 16 + 8 + hg]; pf.sa = SMALL[(t0 + lane) * 16 + 12 + hg]; }
}
DEV void gdn_pre_unit(const Params& p, int l, int u, int unext, LAS unsigned char* lds, int tid, GdnPF& pf) {
    asm volatile("" : "+v"(tid));
    const int b = u >> 8, c = (u >> 2) & 63, hg = u & 3, wave = tid >> 6, lane = tid & 63;
    const int ub = (b * 4 + hg) * 64 + c;
    const bf16* PROJ = (const bf16*)(p.ws + WS_PROJ); const float* SMALL = (const float*)(p.ws + WS_SMALL);
    bf16* GU = (bf16*)(p.ws + WS_GU) + (size_t)ub * 4096; bf16* GW = (bf16*)(p.ws + WS_GW) + (size_t)ub * 4096; bf16* GQE = (bf16*)(p.ws + WS_GQE) + (size_t)ub * 4096;
    bf16* GQK = (bf16*)(p.ws + WS_GQK) + (size_t)ub * 4096; bf16* GKDT = (bf16*)(p.ws + WS_GKDT) + (size_t)ub * 4096; float* EGL = (float*)(p.ws + WS_EGL);
    LAS bf16* Raw = (LAS bf16*)lds;
    LAS float* Xn = (LAS float*)lds;
    LAS float* Qs = (LAS float*)(lds + 25728);
    LAS float* Ks = Qs + 64 * 65;
    LAS float* Vs = Ks + 64 * 65;
    LAS float* Am = Vs + 64 * 65;
    LAS float* betaS = Am + 64 * 64;
    LAS float* gcS = betaS + 64;
    LAS float* scwS = gcS + 64;
    LAS float* egS = scwS + 64;
    LAS float* kdS = egS + 64;
    LAS float* R = kdS + 64;
    LAS float* At = R + 64 * 128;
    LAS float* Dv = At + 64 * 64;
    const size_t t0 = (size_t)b * SEQ + (size_t)c * CH;
    if (wave == 0) {
        const float beta = frcp(1.0f + expf(-pf.sb));
        const float gg = -expf(p.gA_log[l * 4 + hg]) * softplus(pf.sa + p.gdt_bias[l * 4 + hg]);
        const float gc = wave_incl_scan(gg, lane);
        const float glast = rdlane(gc, 63), eg = expf(gc);
        betaS[lane] = beta; gcS[lane] = gc; scwS[lane] = beta * eg; egS[lane] = eg; kdS[lane] = expf(glast - gc);
        if (lane == 63) EGL[ub] = eg;
    }
#pragma unroll
    for (int k = 0; k < 4; ++k) { const int idx = tid + k * 512, row = idx / 24, rem = idx % 24;
        if (idx < 67 * 24) *(LAS u32x4*)(Raw + row * 192 + rem * 8) = pf.rr[k]; }
    __syncthreads();
    for (int rq_ = 0; rq_ < RG_CONV; ++rq_)
#pragma unroll
    for (int seg = 0; seg < 3; ++seg) {
        const float* cw = p.gconv_w + (size_t)l * 3072 + seg * 256 + hg * 64 + lane; const float w0 = cw[0], w1 = cw[768], w2 = cw[1536], w3 = cw[2304];
        LAS float* dst = seg == 0 ? Qs : (seg == 1 ? Ks : Vs);
        const int r0 = wave * 8;
        float x0 = bf2f(Raw[(r0 + 0) * 192 + seg * 64 + lane]), x1 = bf2f(Raw[(r0 + 1) * 192 + seg * 64 + lane]), x2 = bf2f(Raw[(r0 + 2) * 192 + seg * 64 + lane]);
#pragma unroll
        for (int r = 0; r < 8; ++r) { const float x3 = bf2f(Raw[(r0 + r + 3) * 192 + seg * 64 + lane]);
            float y = silu(w0 * x0 + w1 * x1 + w2 * x2 + w3 * x3);
            if (seg < 2) { const float ss = wave_sum(y * y); y *= rsqrtf(ss + EPS); if (seg == 0) y *= 0.125f; }
            dst[(r0 + r) * 65 + lane] = y; x0 = x1; x1 = x2; x2 = x3; }
    }
    __syncthreads();
    for (int rq_ = 0; rq_ < RG_KK; ++rq_)
    {
        for (int t = wave; t < 20; t += 8) {
            const bool isqk = t >= 10; const int idx = isqk ? t - 10 : t;
            const int mt = idx >= 6 ? 3 : (idx >= 3 ? 2 : (idx >= 1 ? 1 : 0)), nt = idx - mt * (mt + 1) / 2;
            const LAS float* ap = (isqk ? Qs : Ks) + (mt * 16 + (lane & 15)) * 65 + (lane >> 4);
            const LAS float* bp = Ks + (nt * 16 + (lane & 15)) * 65 + (lane >> 4);
            f32x4 acc = (f32x4){0.f, 0.f, 0.f, 0.f};
#pragma unroll
            for (int ks = 0; ks < 16; ++ks) acc = __builtin_amdgcn_mfma_f32_16x16x4f32(ap[ks * 4], bp[ks * 4], acc, 0, 0, 0);
            const int j = nt * 16 + (lane & 15), i0 = mt * 16 + (lane >> 4) * 4; const float gj = gcS[j];
            float v[4];
#pragma unroll
            for (int jj = 0; jj < 4; ++jj) { const int i = i0 + jj; const float dec = (j <= i) ? __expf(gcS[i] - gj) : 0.f;
                v[jj] = isqk ? acc[jj] * dec : ((j < i) ? betaS[i] * acc[jj] * dec : 0.f); }
            if (!isqk) {
#pragma unroll
                for (int jj = 0; jj < 4; ++jj) Am[(i0 + jj) * 64 + j] = v[jj];
                *(LAS f32x4*)(At + j * 64 + i0) = (f32x4){v[0], v[1], v[2], v[3]};
            } else {
#pragma unroll
                for (int jj = 0; jj < 4; ++jj) GQK[(i0 + jj) * 64 + j] = (bf16)f2bf(v[jj]);
            }
        }
        { const int e0 = tid * 8, i = e0 >> 6, j = e0 & 63; if ((j >> 4) > (i >> 4)) *(u32x4*)(GQK + e0) = (u32x4){0u, 0u, 0u, 0u}; }
    }
    __syncthreads();
    if (unext >= 0) gdn_pre_issue(p, unext, tid, pf);
    for (int rq_ = 0; rq_ < RG_SOLVE; ++rq_) {
    if (wave == 7) {
        const int bb = lane >> 4, cc = lane & 15;
        float x[16];
#pragma unroll
        for (int i = 0; i < 16; ++i) {
            float acc = (i == cc) ? 1.f : 0.f;
#pragma unroll
            for (int q4 = 0; q4 < 4; ++q4) if (q4 * 4 < i) { const f32x4 a = *(const LAS f32x4*)(Am + (bb * 16 + i) * 64 + bb * 16 + q4 * 4);
                if (q4 * 4 + 0 < i) acc -= a.x * x[q4 * 4 + 0];
                if (q4 * 4 + 1 < i) acc -= a.y * x[q4 * 4 + 1];
                if (q4 * 4 + 2 < i) acc -= a.z * x[q4 * 4 + 2];
                if (q4 * 4 + 3 < i) acc -= a.w * x[q4 * 4 + 3]; }
            x[i] = acc;
            Dv[bb * 256 + i * 16 + cc] = acc;
        }
    } else {
#pragma unroll 4
        for (int e = tid; e < 8192; e += 448) { const int i = e >> 7, col = e & 127;
            R[e] = (col < 64) ? Vs[i * 65 + col] * betaS[i] : Ks[i * 65 + col - 64] * scwS[i]; }
#pragma unroll 4
        for (int e = tid; e < 4096; e += 448) { const int r = e >> 6, d = e & 63;
            if (rq_ == 0) GQE[e] = (bf16)f2bf(Qs[r * 65 + d] * egS[r]);
            GKDT[e] = (bf16)f2bf(Ks[d * 65 + r] * kdS[d]); }
    }
    __syncthreads();
    {
        const int col = tid & 127, q = tid >> 7;
        bf16* dstg = (col >= 64 ? GW : GU) + (col & 63);
#pragma unroll 1
        for (int rb = 0; rb < 4; ++rb) {
            if (rb > 0) {
                LAS float* rp = R + (16 * rb + 4 * q) * 128 + col;
                float r0 = rp[0], r1 = rp[128], r2 = rp[256], r3 = rp[384];
                const LAS float* xp = Xn + col; const LAS float* ap = At + 16 * rb + 4 * q;
#pragma unroll 8
                for (int j = 0; j < 16 * rb; ++j) { const float xj = xp[j * 128]; const f32x4 a = *(const LAS f32x4*)(ap + j * 64);
                    r0 -= a.x * xj; r1 -= a.y * xj; r2 -= a.z * xj; r3 -= a.w * xj; }
                rp[0] = r0; rp[128] = r1; rp[256] = r2; rp[384] = r3;
                __syncthreads();
            }
            float rv[16];
#pragma unroll
            for (int jj = 0; jj < 16; ++jj) rv[jj] = R[(16 * rb + jj) * 128 + col];
#pragma unroll
            for (int k = 0; k < 4; ++k) { const int ii = 4 * q + k; const LAS f32x4* dp = (const LAS f32x4*)(Dv + rb * 256 + ii * 16);
                const f32x4 d0 = dp[0], d1 = dp[1], d2 = dp[2], d3 = dp[3];
                const float acc = ((d0.x * rv[0] + d0.y * rv[1]) + (d0.z * rv[2] + d0.w * rv[3])) + ((d1.x * rv[4] + d1.y * rv[5]) + (d1.z * rv[6] + d1.w * rv[7]))
                                + ((d2.x * rv[8] + d2.y * rv[9]) + (d2.z * rv[10] + d2.w * rv[11])) + ((d3.x * rv[12] + d3.y * rv[13]) + (d3.z * rv[14] + d3.w * rv[15]));
                Xn[(16 * rb + ii) * 128 + col] = acc; dstg[(16 * rb + ii) * 64] = (bf16)f2bf(acc); }
            __syncthreads();
        }
    }
    }
}
DEV void gdn_scan_block(const Params& p, int bh2, LAS unsigned char* lds, int tid) {
    asm volatile("" : "+v"(tid));
    const int bh = bh2 >> 1, half = bh2 & 1;
    const int b = bh >> 2, hg = bh & 3, wave = tid >> 6, lane = tid & 63;
    const size_t ub0 = (size_t)bh * 64;
    const bf16* GM0 = (const bf16*)(p.ws + WS_GW) + ub0 * 4096; const bf16* GM1 = (const bf16*)(p.ws + WS_GQE) + ub0 * 4096;
    const bf16* GM2 = (const bf16*)(p.ws + WS_GQK) + ub0 * 4096; const bf16* GM3 = (const bf16*)(p.ws + WS_GKDT) + ub0 * 4096;
    const bf16* GM4 = (const bf16*)(p.ws + WS_GU) + ub0 * 4096;
    const float* EGL = (const float*)(p.ws + WS_EGL) + ub0;
    bf16* MIX = (bf16*)(p.ws + WS_MIX);
    LAS bf16* OPS = (LAS bf16*)lds;
    LAS bf16* PRV = OPS + 2 * 5 * 4608;
    LAS float* egS = (LAS float*)(PRV + 4 * 2 * 1152);
    if (tid < 64) egS[tid] = EGL[tid];
    if (wave >= 2 && wave < 4) {
        __syncthreads();
        for (int c = 0; c < NCH; ++c) __syncthreads();
    } else if (wave < 2) {
        const int es = half * 2 + wave, fr = lane & 15, fq = lane >> 4;
        LAS bf16* Stp = PRV + wave * 2304; LAS bf16* Vtp = Stp + 1152;
        for (int i = lane; i < 1152; i += 64) Stp[i] = 0;
        f32x4 Sacc[4];
#pragma unroll
        for (int mt = 0; mt < 4; ++mt) Sacc[mt] = (f32x4){0.f, 0.f, 0.f, 0.f};
        bf16* obase = MIX + ((size_t)b * SEQ + fr) * DM + 768 + hg * 64 + es * 16 + fq * 4;
        __syncthreads();
#pragma unroll 2
        for (int c = 0; c < NCH; ++c) {
            const LAS bf16* Wb = OPS + (c & 1) * 5 * 4608;
            const int fo = fr * 72 + fq * 8;
            const bf16x8 fS0 = *(const LAS bf16x8*)(Stp + fo), fS1 = *(const LAS bf16x8*)(Stp + fo + 32);
            bf16x8 fW[4][2], fQE[4][2], fQK[4][2], fKD[4][2]; u32x2 uw[4];
#pragma unroll
            for (int mt = 0; mt < 4; ++mt)
#pragma unroll
                for (int ks = 0; ks < 2; ++ks) fW[mt][ks] = *(const LAS bf16x8*)(Wb + mt * 16 * 72 + fo + ks * 32);
#pragma unroll
            for (int mt = 0; mt < 4; ++mt) uw[mt] = *(const LAS u32x2*)(Wb + 4 * 4608 + (mt * 16 + fr) * 72 + es * 16 + fq * 4);
#pragma unroll
            for (int mt = 0; mt < 4; ++mt)
#pragma unroll
                for (int ks = 0; ks < 2; ++ks) fQE[mt][ks] = *(const LAS bf16x8*)(Wb + 4608 + mt * 16 * 72 + fo + ks * 32);
#pragma unroll
            for (int mt = 0; mt < 4; ++mt)
#pragma unroll
                for (int ks = 0; ks < 2; ++ks) fKD[mt][ks] = *(const LAS bf16x8*)(Wb + 3 * 4608 + mt * 16 * 72 + fo + ks * 32);
#pragma unroll
            for (int mt = 0; mt < 4; ++mt)
#pragma unroll
                for (int ks = 0; ks < 2; ++ks) fQK[mt][ks] = *(const LAS bf16x8*)(Wb + 2 * 4608 + mt * 16 * 72 + fo + ks * 32);
            const float egl = egS[c];
            f32x4 av[4], ov[4];
#pragma unroll
            for (int mt = 0; mt < 4; ++mt) {
                av[mt] = __builtin_amdgcn_mfma_f32_16x16x32_bf16(fS0, fW[mt][0], (f32x4){0.f, 0.f, 0.f, 0.f}, 0, 0, 0);
                av[mt] = __builtin_amdgcn_mfma_f32_16x16x32_bf16(fS1, fW[mt][1], av[mt], 0, 0, 0); }
#pragma unroll
            for (int mt = 0; mt < 4; ++mt) {
                ov[mt] = __builtin_amdgcn_mfma_f32_16x16x32_bf16(fS0, fQE[mt][0], (f32x4){0.f, 0.f, 0.f, 0.f}, 0, 0, 0);
                ov[mt] = __builtin_amdgcn_mfma_f32_16x16x32_bf16(fS1, fQE[mt][1], ov[mt], 0, 0, 0); }
#pragma unroll
            for (int mt = 0; mt < 4; ++mt) {
                LAS bf16* vp = Vtp + (fq * 4) * 72 + mt * 16 + fr;
                vp[0] = (bf16)f2bf(bflo(uw[mt].x) - av[mt][0]); vp[72] = (bf16)f2bf(bfhi(uw[mt].x) - av[mt][1]);
                vp[144] = (bf16)f2bf(bflo(uw[mt].y) - av[mt][2]); vp[216] = (bf16)f2bf(bfhi(uw[mt].y) - av[mt][3]); }
            const bf16x8 fV0 = *(const LAS bf16x8*)(Vtp + fo), fV1 = *(const LAS bf16x8*)(Vtp + fo + 32);
#pragma unroll
            for (int mt = 0; mt < 4; ++mt) {
                f32x4 sa = Sacc[mt] * egl;
                sa = __builtin_amdgcn_mfma_f32_16x16x32_bf16(fKD[mt][0], fV0, sa, 0, 0, 0);
                sa = __builtin_amdgcn_mfma_f32_16x16x32_bf16(fKD[mt][1], fV1, sa, 0, 0, 0);
                Sacc[mt] = sa;
                u32x2 sw; sw.x = pk2(sa[0], sa[1]); sw.y = pk2(sa[2], sa[3]);
                *(LAS u32x2*)(Stp + fr * 72 + mt * 16 + fq * 4) = sw; }
#pragma unroll
            for (int mt = 0; mt < 4; ++mt) {
                f32x4 o = __builtin_amdgcn_mfma_f32_16x16x32_bf16(fV0, fQK[mt][0], ov[mt], 0, 0, 0);
                o = __builtin_amdgcn_mfma_f32_16x16x32_bf16(fV1, fQK[mt][1], o, 0, 0, 0);
                u32x2 ow; ow.x = pk2(o[0], o[1]); ow.y = pk2(o[2], o[3]);
                *(u32x2*)(obase + ((size_t)c * CH + mt * 16) * DM) = ow; }
            __syncthreads();
        }
    } else {
        const int lt = tid - 256;
        u32x4 rg[4][10];
#define GDN_ISSUE(k, ch) { const size_t co = (size_t)((ch) < NCH ? (ch) : NCH - 1) * 4096; \
            _Pragma("unroll") for (int h2 = 0; h2 < 2; ++h2) { const int idx = lt + h2 * 256, row = idx >> 3, v = idx & 7; \
                rg[k][0 + h2] = *(const u32x4*)(GM0 + co + row * 64 + v * 8); rg[k][2 + h2] = *(const u32x4*)(GM1 + co + row * 64 + v * 8); \
                rg[k][4 + h2] = *(const u32x4*)(GM2 + co + row * 64 + v * 8); rg[k][6 + h2] = *(const u32x4*)(GM3 + co + row * 64 + v * 8); \
                rg[k][8 + h2] = *(const u32x4*)(GM4 + co + row * 64 + v * 8); } }
#define GDN_COMMIT(k, set) { LAS bf16* sb = OPS + (set) * 5 * 4608; \
            _Pragma("unroll") for (int m = 0; m < 5; ++m) _Pragma("unroll") for (int h2 = 0; h2 < 2; ++h2) { const int idx = lt + h2 * 256, row = idx >> 3, v = idx & 7; \
                *(LAS u32x4*)(sb + m * 4608 + row * 72 + v * 8) = rg[k][m * 2 + h2]; } }
        GDN_ISSUE(0, 0) GDN_ISSUE(1, 1) GDN_ISSUE(2, 2) GDN_ISSUE(3, 3)
        GDN_COMMIT(0, 0)
        __syncthreads();
        for (int c = 0; c < NCH; c += 4) {
            GDN_COMMIT(1, 1) GDN_ISSUE(0, c + 4) __syncthreads();
            GDN_COMMIT(2, 0) GDN_ISSUE(1, c + 5) __syncthreads();
            GDN_COMMIT(3, 1) GDN_ISSUE(2, c + 6) __syncthreads();
            GDN_COMMIT(0, 0) GDN_ISSUE(3, c + 7) __syncthreads();
        }
#undef GDN_ISSUE
#undef GDN_COMMIT
    }
}
DEV void gdn_post(const Params& p, int l, int gw, int NGW, int lane) {
    bf16* MIX = (bf16*)(p.ws + WS_MIX); const bf16* PROJ = (const bf16*)(p.ws + WS_PROJ);
    const f32x4 nw = *((const f32x4*)(p.gnorm_w + (size_t)l * 64) + (lane & 15));
    for (int m = gw; m < MTOK; m += NGW) {
        bf16* op = MIX + (size_t)m * DM + 768 + lane * 4;
        const u32x2 ow = *(const u32x2*)op; const u32x2 zw = *(const u32x2*)(PROJ + (size_t)m * NPROJ + 2816 + lane * 4);
        const float o0 = bflo(ow.x), o1 = bfhi(ow.x), o2 = bflo(ow.y), o3 = bfhi(ow.y);
        float ss = (o0 * o0 + o1 * o1) + (o2 * o2 + o3 * o3);
        ss = red16_sum(ss);
        const float rstd = rsqrtf(ss * (1.0f / 64.0f) + EPS);
        u32x2 r; r.x = pk2(o0 * rstd * nw.x * silu(bflo(zw.x)), o1 * rstd * nw.y * silu(bfhi(zw.x))); r.y = pk2(o2 * rstd * nw.z * silu(bflo(zw.y)), o3 * rstd * nw.w * silu(bfhi(zw.y)));
        *(u32x2*)op = r;
    }
}

#define XB_TMO      128
#define XB_XCNT(j)  (256  + 64 * (j))
#define XB_XSUB(j)  (1280 + 64 * (j))
#define XB_XGEN(j)  (2304 + 64 * (j))
#define XB_TOP      3328
#define XB_TOPGEN   3392
#define XCD_BAR_WORDS 3456
#define XB_SPIN_CAP (1u << 18)

__device__ __forceinline__ unsigned xb_ld(unsigned* p)              { return __hip_atomic_load(p, __ATOMIC_RELAXED, __HIP_MEMORY_SCOPE_AGENT); }
__device__ __forceinline__ unsigned xb_add(unsigned* p, unsigned v) { return __hip_atomic_fetch_add(p, v, __ATOMIC_RELAXED, __HIP_MEMORY_SCOPE_AGENT); }
__device__ __forceinline__ unsigned xb_xcc_id() { return (unsigned)__builtin_amdgcn_s_getreg((3 << 11) | 20) & 0xFu; }
#define XB_SPIN(cond, bar) do { unsigned _sp = 0; while (cond) { __builtin_amdgcn_s_sleep(1); \
    if ((++_sp & 255u) == 0u) { if (xb_ld(&(bar)[XB_TMO])) break; if (_sp > XB_SPIN_CAP) { atomicAdd(&(bar)[XB_TMO], 1u); break; } } } } while (0)

struct XcdBarrier {
    unsigned* bar; unsigned x;
    volatile LAS unsigned* st;
};

__device__ __forceinline__ XcdBarrier xcd_barrier_post(unsigned* bar, volatile LAS unsigned* st) {
    XcdBarrier b; b.bar = bar; b.x = xb_xcc_id(); b.st = st;
    if (threadIdx.x == 0) (void)xb_add(&bar[XB_XCNT(b.x)], 1u);
    return b;
}
__device__ __forceinline__ void xcd_barrier_complete(unsigned* bar, unsigned x, unsigned& nloc, unsigned& nx) {
    const unsigned G = gridDim.x * gridDim.y * gridDim.z;
    unsigned sum, cnt, mine, sp = 0u;
    for (;;) {
        sum = 0u; cnt = 0u; mine = 0u;
#pragma unroll
        for (unsigned j = 0; j < 16; ++j) { const unsigned c = xb_ld(&bar[XB_XCNT(j)]); sum += c; cnt += (c > 0u) ? 1u : 0u; mine = (j == x) ? c : mine; }
        if (sum == G) break;
        __builtin_amdgcn_s_sleep(1);
        if ((++sp & 255u) == 0u) { if (xb_ld(&bar[XB_TMO])) break; if (sp > XB_SPIN_CAP) { atomicAdd(&bar[XB_TMO], 1u); break; } }
    }
    nloc = mine > 0u ? mine : 1u; nx = cnt > 0u ? cnt : 1u;
}

__device__ __forceinline__ void xcd_barrier(const XcdBarrier& b) {
    asm volatile("s_waitcnt vmcnt(0)" ::: "memory");
    __syncthreads();
    if (threadIdx.x == 0) {
        unsigned* bar = b.bar;
        __builtin_amdgcn_s_waitcnt(0);
        unsigned nloc = b.st[0], nx = b.st[1];
        if (nloc == 0u) { xcd_barrier_complete(bar, b.x, nloc, nx); b.st[0] = nloc; b.st[1] = nx; }
        const unsigned old = xb_add(&bar[XB_XSUB(b.x)], 1u);
        const unsigned gen = old / nloc;
        if (old + 1u == (gen + 1u) * nloc) {
            __builtin_amdgcn_fence(__ATOMIC_RELEASE, "agent");
            asm volatile("s_waitcnt vmcnt(0)" ::: "memory");
            const unsigned og = xb_add(&bar[XB_TOP], 1u);
            const unsigned tg = og / nx;
            if (og + 1u == (tg + 1u) * nx) xb_add(&bar[XB_TOPGEN], 1u);
            else XB_SPIN(xb_ld(&bar[XB_TOPGEN]) == tg, bar);
            __builtin_amdgcn_fence(__ATOMIC_ACQUIRE, "agent");
            xb_add(&bar[XB_XGEN(b.x)], 1u);
            asm volatile("s_waitcnt vmcnt(0)" ::: "memory");
        } else {
            XB_SPIN(xb_ld(&bar[XB_XGEN(b.x)]) == gen, bar);
            __builtin_amdgcn_fence(__ATOMIC_ACQUIRE, "agent");
            asm volatile("s_waitcnt vmcnt(0)" ::: "memory");
        }
    }
    __syncthreads();
}
__global__ void __launch_bounds__(512, 2) fwd_megakernel(Params p) {
    extern __shared__ __attribute__((aligned(16))) unsigned char lds_raw[];
    cg::grid_group grid = cg::this_grid();
    LAS unsigned char* lds = (LAS unsigned char*)lds_raw;
    const int tid = threadIdx.x, lane = tid & 63, wave = __builtin_amdgcn_readfirstlane(tid >> 6);
    const int G = gridDim.x, bx = blockIdx.x, gw = bx * 8 + wave, NGW = G * 8;
    bf16* XN = (bf16*)(p.ws + WS_XN); float* SMALL = (float*)(p.ws + WS_SMALL); bf16* TMP = (bf16*)(p.ws + WS_TMP);
    bf16* PROJ = (bf16*)(p.ws + WS_PROJ); bf16* MIX = (bf16*)(p.ws + WS_MIX); bf16* HB = (bf16*)(p.ws + WS_H);
    LAS float* wsT = (LAS float*)(lds + 69632);
    volatile LAS unsigned* misc = (volatile LAS unsigned*)(lds + 147200);
    if (tid < 4) misc[tid] = 0u;
    __syncthreads();
    XcdBarrier xbar = xcd_barrier_post((unsigned*)p.ws, misc);
#define GSYNC() xcd_barrier(xbar)

#define PHASE_IDS() int tidp = threadIdx.x; int lq = l; asm volatile("" : "+v"(tidp), "+s"(lq)); const int lanep = tidp & 63; const int wavep = __builtin_amdgcn_readfirstlane(tidp >> 6); const int gwp = bx * 8 + wavep; (void)lanep; (void)gwp; (void)lq
#pragma unroll 1
    for (int l = 0; l < DEPTH; ++l) {
        {
            PHASE_IDS();
            convert_weights(p, lq, lds, gwp, NGW, wavep, lanep);
            if (lq == 0) {
                stage_small(p, 0, wsT, tidp);
                __syncthreads();
                rowpass<0>(p.x, nullptr, nullptr, p.pre_mix, nullptr, XN, SMALL, wsT, gwp, NGW, lanep);
            }
        }
        if (l == 0) grid.sync(); else GSYNC();
#ifdef REP_SYNC
        for (int rep = 0; rep < REP_SYNC; ++rep) GSYNC();
#endif
        {
            pg8::Gemm g{XN, (const bf16*)(p.ws + WS_WIN), MTOK, NPROJ, DM}; pg8::StaticOrder S; S.init(MTOK, NPROJ, G, bx);
            pg8::EpiStoreBf16 E{PROJ, NPROJ};
            for (int rg_ = 0; rg_ < REP_GEMM; ++rg_) { if (rg_) GSYNC(); pg8::gemm_phase<pg8::EpiStoreBf16, pg8::StaticOrder, true, true>(lds, g, S, E); }
        }
        GSYNC();
        {
            PHASE_IDS();
            for (int rep = 0; rep < REP_C; ++rep) { if (rep) GSYNC();
            GdnPF pf; if (bx < 1024) gdn_pre_issue(p, bx, tidp, pf);
            for (int u = bx; u < 1024; u += G) gdn_pre_unit(p, lq, u, (u + G < 1024) ? u + G : -1, lds, tidp, pf); }
        }
        GSYNC();
        {
            PHASE_IDS();
            for (int rep = 0; rep < REP_D; ++rep) { if (rep) GSYNC();
            if (bx < 32) { for (int r2 = 0; r2 < REP_DS; ++r2) gdn_scan_block(p, bx, lds, tidp); }
            else { for (int u = bx - 32; u < 1024; u += G - 32) { if (u < 512) { for (int r2 = 0; r2 < REP_P1; ++r2) ssd_p1_unit(p, lq, u, lds, tidp); } else { for (int r2 = 0; r2 < REP_ATT; ++r2) attn_unit(p, lq, u - 512, lds, tidp); } } } }
        }
        GSYNC();
        {
            PHASE_IDS();
            for (int vb = bx; vb < 256; vb += G) ssd_scan_all(p, vb, lds, tidp);
            gdn_post(p, lq, gwp, NGW, lanep);
        }
        GSYNC();
        {
            PHASE_IDS();
            for (int rep = 0; rep < REP_E; ++rep) {
                if (rep) GSYNC();
                for (int u = bx; u < 512; u += G) ssd_p3_unit(p, lq, u, lds, tidp);
            }
        }
        GSYNC();
        {
            pg8::Gemm g{MIX, (const bf16*)(p.ws + WS_WOUT), MTOK, DM, DM}; pg8::StaticOrder S; S.init(MTOK, DM, G, bx);
            pg8::EpiStoreBf16 E{TMP, DM};
            for (int rg_ = 0; rg_ < REP_GEMM; ++rg_) { if (rg_) GSYNC(); pg8::gemm_phase<pg8::EpiStoreBf16, pg8::StaticOrder, true, true>(lds, g, S, E); }
        }
        GSYNC();
        {
            PHASE_IDS();
            rowpass<1, false, true>(lq == 0 ? p.x : p.out, TMP, p.post_mix + (size_t)lq * DM, p.pre_ffn + (size_t)lq * DM, p.ws + WS_X1, XN, nullptr, wsT, gwp, NGW, lanep);
        }
        GSYNC();
        {
            pg8::Gemm g{XN, (const bf16*)(p.ws + WS_WGU), MTOK, 2 * FF, DM}; pg8::StaticOrder S; S.init(MTOK, 2 * FF, G, bx);
            pg8::EpiSwiGLU E{HB, FF};
            for (int rg_ = 0; rg_ < REP_GEMM; ++rg_) { if (rg_) GSYNC(); pg8::gemm_phase<pg8::EpiSwiGLU, pg8::StaticOrder, true, true>(lds, g, S, E); }
        }
        GSYNC();
        {
            pg8::Gemm g{HB, (const bf16*)(p.ws + WS_WDN), MTOK, DM, FF}; pg8::StaticOrder S; S.init(MTOK, DM, G, bx);
            pg8::EpiStoreBf16 E{TMP, DM};
            for (int rg_ = 0; rg_ < REP_GEMM; ++rg_) { if (rg_) GSYNC(); pg8::gemm_phase<pg8::EpiStoreBf16, pg8::StaticOrder, true, true>(lds, g, S, E); }
        }
        GSYNC();
        {
            PHASE_IDS();
            if (lq + 1 < DEPTH) {
                stage_small(p, lq + 1, wsT, tidp);
                __syncthreads();
                rowpass<2, true, false>(p.ws + WS_X1, TMP, p.post_ffn + (size_t)lq * DM, p.pre_mix + (size_t)(lq + 1) * DM, p.out, XN, SMALL, wsT, gwp, NGW, lanep);
                __syncthreads();
            } else {
                rowpass<3, true, false>(p.ws + WS_X1, TMP, p.post_ffn + (size_t)lq * DM, nullptr, p.out, nullptr, nullptr, wsT, gwp, NGW, lanep);
            }
        }
    }
}

extern "C" void kernel_launch(void* const* d_in, const int* in_sizes, int n_in, void* d_out, int out_size, void* d_ws, size_t ws_size, hipStream_t stream) {
    static int grid = 0;
    if (grid == 0) {
        if (n_in != 21 || out_size != MTOK * DM || ws_size < WS_END) { fprintf(stderr, "kernel_launch: unexpected shapes (n_in %d out %d ws %zu)\n", n_in, out_size, ws_size); grid = -1; return; }
        int dev = 0, cus = 0, per_cu = 0;
        hipGetDevice(&dev); hipDeviceGetAttribute(&cus, hipDeviceAttributeMultiprocessorCount, dev);
        if (hipFuncSetAttribute((const void*)fwd_megakernel, hipFuncAttributeMaxDynamicSharedMemorySize, LDS_BYTES) != hipSuccess) { fprintf(stderr, "kernel_launch: hipFuncSetAttribute failed\n"); grid = -1; return; }
        hipOccupancyMaxActiveBlocksPerMultiprocessor(&per_cu, (const void*)fwd_megakernel, 512, LDS_BYTES);
        if (per_cu < 1) { fprintf(stderr, "kernel_launch: occupancy query says %d blocks per CU\n", per_cu); per_cu = 1; }
        (void)hipGetLastError();
        grid = cus;
    }
    if (grid < 0) return;
    if (hipMemsetAsync(d_ws, 0, 16384, stream) != hipSuccess) { fprintf(stderr, "kernel_launch: memset of the barrier words failed\n"); return; }
    Params p{};
    const float** pp = (const float**)&p;
    for (int i = 0; i < 21; ++i) pp[i] = (const float*)d_in[i];
    p.out = (float*)d_out; p.ws = (unsigned char*)d_ws;
    void* args[] = {&p};
    hipError_t e = hipLaunchCooperativeKernel((const void*)fwd_megakernel, dim3(grid), dim3(512), args, LDS_BYTES, stream);
    if (e != hipSuccess) fprintf(stderr, "cooperative launch failed: %s (grid %d)\n", hipGetErrorString(e), grid);
}
```

```cpp
#include <hip/hip_runtime.h>
#include <hip/hip_cooperative_groups.h>
#include <cstdio>
#include <cstdint>
namespace cg = cooperative_groups;
namespace pg8 {
#define PG8_LAS __attribute__((address_space(3)))
typedef unsigned short bf16_t;
typedef short bf16x8 __attribute__((ext_vector_type(8)));
typedef float f32x4 __attribute__((ext_vector_type(4)));
typedef unsigned u32x4 __attribute__((ext_vector_type(4)));
constexpr int BM = 256, BK = 64, HALF = 128, HTB = HALF * BK * 2  , STAGE_BYTES = 8 * HTB, NXCD = 8, WGM = 8;

__host__ __device__ __forceinline__ int lds_byte(int r, int c) { const int st = (r >> 4) * 2 + (c >> 5), rr = r & 15, cc = c & 31, ob = rr * 64 + cc * 2; return st * 1024 + (ob ^ (((ob >> 9) & 1) << 5)); }
__host__ __device__ __forceinline__ void stage_rc(int b, int& R, int& C) { const int st = b / 1024, sb = b % 1024, swz = sb ^ (((sb >> 9) & 1) << 5); R = (st >> 1) * 16 + swz / 64; C = (st & 1) * 32 + (swz % 64) / 2; }
__host__ __device__ __forceinline__ int perm32(int rho) { const int n = rho >> 4, i = rho & 15; return 8 * (i >> 2) + 4 * n + (i & 3); }

struct Unit { int pm, pn; };
struct Gemm { const bf16_t* A; const bf16_t* Bt; int M, N, K; };

struct StaticOrder {
    int nM, nN, nwg, G, c;
    __host__ __device__ void init(int M, int N, int G_, int c_) { nM = M / BM; nN = N / BM; nwg = nM * nN; G = G_; c = c_; }
    __host__ __device__ bool next(int i, Unit& u) const {
        const long L = (long)i * G + c; if (L >= nwg) return false;
        int wgid = (int)L; { const int q = nwg / NXCD, r = nwg % NXCD, xcd = wgid % NXCD, off = wgid / NXCD; wgid = (xcd < r ? xcd * (q + 1) : r * (q + 1) + (xcd - r) * q) + off; }
        const int nig = WGM * nN, gid = wgid / nig, fm = gid * WGM, gsz = (nM - fm) < WGM ? (nM - fm) : WGM;
        u.pm = fm + ((wgid % nig) % gsz); u.pn = (wgid % nig) / gsz; return true;
    }
    __device__ __forceinline__ void a_ready(const Unit&) const {}
    __device__ __forceinline__ void done(const Unit&) const {}
};

typedef float f32x2c __attribute__((ext_vector_type(2))); typedef __bf16 bf16x2c __attribute__((ext_vector_type(2)));
__device__ __forceinline__ unsigned cvt_pk_bf16(float lo, float hi) { const f32x2c v = {lo, hi}; const bf16x2c b = __builtin_convertvector(v, bf16x2c); return __builtin_bit_cast(unsigned, b); }
typedef float f32x2 __attribute__((ext_vector_type(2)));
typedef unsigned u32x2 __attribute__((ext_vector_type(2)));
__device__ __forceinline__ float silu_f(float x) { return x * __builtin_amdgcn_rcpf(1.0f + __expf(-x)); }
struct EpiStoreBf16 {
    static constexpr bool PERM = true, AFTER_DRAIN = false;
    bf16_t* O; int ldc;
    __device__ __forceinline__ void operator()(const f32x4 (&acc)[2][2][4][2], const Unit& u, int wr, int wc, int fr, int fq) const {
        const int row0 = u.pm * BM + wr * 64 + fr, col0 = u.pn * BM + wc * 32 + 8 * fq;
#pragma unroll
        for (int ai = 0; ai < 2; ++ai)
#pragma unroll
            for (int m = 0; m < 4; ++m) { bf16_t* rowp = O + (size_t)(row0 + ai * HALF + m * 16) * ldc + col0;
#pragma unroll
                for (int bj = 0; bj < 2; ++bj) { const f32x4 v0 = acc[ai][bj][m][0], v1 = acc[ai][bj][m][1];
                    u32x4 w; w.x = cvt_pk_bf16(v0[0], v0[1]); w.y = cvt_pk_bf16(v0[2], v0[3]); w.z = cvt_pk_bf16(v1[0], v1[1]); w.w = cvt_pk_bf16(v1[2], v1[3]);
                    *(u32x4*)(rowp + bj * HALF) = w; } }
    }
};
struct EpiStoreF32 {
    static constexpr bool PERM = true, AFTER_DRAIN = false;
    float* O; int ldc;
    __device__ __forceinline__ void operator()(const f32x4 (&acc)[2][2][4][2], const Unit& u, int wr, int wc, int fr, int fq) const {
        const int row0 = u.pm * BM + wr * 64 + fr, col0 = u.pn * BM + wc * 32 + 8 * fq;
#pragma unroll
        for (int ai = 0; ai < 2; ++ai)
#pragma unroll
            for (int m = 0; m < 4; ++m) { float* rowp = O + (size_t)(row0 + ai * HALF + m * 16) * ldc + col0;
#pragma unroll
                for (int bj = 0; bj < 2; ++bj) { *(f32x4*)(rowp + bj * HALF) = acc[ai][bj][m][0]; *(f32x4*)(rowp + bj * HALF + 4) = acc[ai][bj][m][1]; } }
    }
};
struct EpiSwiGLU {
    static constexpr bool PERM = true, AFTER_DRAIN = false;
    bf16_t* H; int ldh;
    __device__ __forceinline__ void operator()(const f32x4 (&acc)[2][2][4][2], const Unit& u, int wr, int wc, int fr, int fq) const {
        const int row0 = u.pm * BM + wr * 64 + fr, col0 = u.pn * (BM / 2) + wc * 16 + 4 * fq;
#pragma unroll
        for (int ai = 0; ai < 2; ++ai)
#pragma unroll
            for (int m = 0; m < 4; ++m) { bf16_t* rowp = H + (size_t)(row0 + ai * HALF + m * 16) * ldh + col0;
#pragma unroll
                for (int bj = 0; bj < 2; ++bj) { const f32x4 v0 = acc[ai][bj][m][0], v1 = acc[ai][bj][m][1];
                    u32x2 w; w.x = cvt_pk_bf16(silu_f(v0[0]) * v0[1], silu_f(v0[2]) * v0[3]); w.y = cvt_pk_bf16(silu_f(v1[0]) * v1[1], silu_f(v1[2]) * v1[3]);
                    *(u32x2*)(rowp + bj * (HALF / 2)) = w; } }
    }
};
template <class Epi, class Sched, bool ALIGN_EPI = false, bool SP2 = false>
__device__ __forceinline__ void gemm_phase(PG8_LAS unsigned char* lds, const Gemm g, const Sched& S, const Epi& E) {
    int tid_l = threadIdx.x; asm volatile("" : "+v"(tid_l));
    const int tid = tid_l, wid = __builtin_amdgcn_readfirstlane(tid >> 6), lane = tid & 63, wr = wid >> 2, wc = wid & 3, fr = lane & 15, fq = lane >> 4;
    const int K = g.K, nt = K / BK;
    unsigned voffA[2], voffB[2];
#pragma unroll
    for (int i = 0; i < 2; ++i) { int R, C; stage_rc(tid * 16 + i * 8192, R, C); const int Rb = Epi::PERM ? ((R & ~31) + perm32(R & 31)) : R;
        voffA[i] = (unsigned)(R * K + C) * 2u; voffB[i] = (unsigned)(Rb * K + C) * 2u; }
    const size_t kstep = (size_t)(BK * 2);
    const size_t hstep = (size_t)HALF * K * 2;
    const size_t tstep = 2 * hstep;
    const unsigned ldsw = (unsigned)wid * 1024u;
    const int aoff = lds_byte(wr * 64 + fr, fq * 8), boff = lds_byte(wc * 32 + fr, fq * 8);
#define PG8_SA(b, h) (((b) * 2 + (h)) * HTB)
#define PG8_SB(b, h) ((4 + (b) * 2 + (h)) * HTB)
#define PG8_STAGE(bufoff, gbase, voff) do { _Pragma("unroll") for (int _i = 0; _i < 2; ++_i) \
        __builtin_amdgcn_global_load_lds((const unsigned*)((const char*)(gbase) + (voff)[_i]), (PG8_LAS unsigned*)(lds + (bufoff) + ldsw + _i * 8192), 16, 0, 0); } while (0)
#define PG8_LDA(dst, b, h) do { _Pragma("unroll") for (int m = 0; m < 4; ++m) _Pragma("unroll") for (int k = 0; k < 2; ++k) dst[m][k] = *(const PG8_LAS bf16x8*)(lds + PG8_SA(b, h) + aoff + m * 2048 + k * 1024); } while (0)
#define PG8_LDB(dst, b, h) do { _Pragma("unroll") for (int n = 0; n < 2; ++n) _Pragma("unroll") for (int k = 0; k < 2; ++k) dst[n][k] = *(const PG8_LAS bf16x8*)(lds + PG8_SB(b, h) + boff + n * 2048 + k * 1024); } while (0)
#define PG8_MMA(ai, bj, At, Bt) do { __builtin_amdgcn_s_setprio(1); _Pragma("unroll") for (int m = 0; m < 4; ++m) _Pragma("unroll") for (int n = 0; n < 2; ++n) _Pragma("unroll") for (int k = 0; k < 2; ++k) \
        acc[ai][bj][m][n] = __builtin_amdgcn_mfma_f32_16x16x32_bf16(Bt[n][k], At[m][k], acc[ai][bj][m][n], 0, 0, 0); __builtin_amdgcn_s_setprio(0); } while (0)
#define PG8_WAIT_V(n) asm volatile("s_waitcnt vmcnt(" #n ")" ::: "memory")
#define PG8_WAIT_L(n) asm volatile("s_waitcnt lgkmcnt(" #n ")" ::: "memory")
#define PG8_BAR __builtin_amdgcn_s_barrier()
#define PG8_SCHED __builtin_amdgcn_sched_barrier(0)
    Unit cur, nxt; int ui = 0;
    if (!S.next(0, cur)) return;
    f32x4 acc[2][2][4][2];
#pragma unroll
    for (int a = 0; a < 2; ++a)
#pragma unroll
        for (int b = 0; b < 2; ++b)
#pragma unroll
            for (int m = 0; m < 4; ++m)
#pragma unroll
                for (int n = 0; n < 2; ++n) acc[a][b][m][n] = (f32x4){0.f, 0.f, 0.f, 0.f};
    bf16x8 At[4][2], B0[2][2], B1[2][2];
    const char* cA = (const char*)g.A + (size_t)cur.pm * tstep; const char* cB = (const char*)g.Bt + (size_t)cur.pn * tstep;
    S.a_ready(cur);
    if constexpr (SP2) {
        PG8_STAGE(PG8_SB(0, 0), cB, voffB); PG8_STAGE(PG8_SB(0, 1), cB + hstep, voffB); PG8_STAGE(PG8_SA(0, 0), cA, voffA); PG8_STAGE(PG8_SA(0, 1), cA + hstep, voffA);
        if (wr == 1) PG8_BAR;
        PG8_WAIT_V(2); PG8_BAR;
        PG8_STAGE(PG8_SB(1, 0), cB + kstep, voffB); PG8_STAGE(PG8_SA(1, 0), cA + kstep, voffA); PG8_STAGE(PG8_SB(1, 1), cB + hstep + kstep, voffB);
        PG8_WAIT_V(6); PG8_BAR;
    } else {
        PG8_STAGE(PG8_SB(0, 0), cB, voffB); PG8_STAGE(PG8_SA(0, 0), cA, voffA); PG8_STAGE(PG8_SB(0, 1), cB + hstep, voffB); PG8_STAGE(PG8_SA(0, 1), cA + hstep, voffA);
        if (wr == 1) PG8_BAR;
        PG8_WAIT_V(4); PG8_BAR;
        PG8_STAGE(PG8_SB(1, 0), cB + kstep, voffB); PG8_STAGE(PG8_SA(1, 0), cA + kstep, voffA); PG8_STAGE(PG8_SB(1, 1), cB + hstep + kstep, voffB);
        PG8_WAIT_V(6); PG8_BAR;
    }
    for (;;) {
        const bool has_next = S.next(ui + 1, nxt);
        const char* nA = has_next ? (const char*)g.A + (size_t)nxt.pm * tstep : cA; const char* nB = has_next ? (const char*)g.Bt + (size_t)nxt.pn * tstep : cB;
        for (int t = 0; t < nt; t += 2) {
            const bool last = (t == nt - 2);
            const char* a1 = cA + (size_t)(t + 1) * kstep;
            const char* a2 = last ? nA : cA + (size_t)(t + 2) * kstep; const char* b2 = last ? nB : cB + (size_t)(t + 2) * kstep;
            const char* a3 = a2 + kstep; const char* b3 = b2 + kstep;
            if (last && has_next) S.a_ready(nxt);
            if constexpr (SP2) {
            PG8_LDB(B0, 0, 0); PG8_LDB(B1, 0, 1); PG8_SCHED; PG8_LDA(At, 0, 0); PG8_STAGE(PG8_SA(1, 1), a1 + hstep, voffA);
            PG8_WAIT_V(8); PG8_WAIT_L(0); PG8_BAR; PG8_MMA(0, 0, At, B0); PG8_MMA(0, 1, At, B1); PG8_BAR; PG8_SCHED;
            PG8_LDA(At, 0, 1); PG8_STAGE(PG8_SB(0, 0), b2, voffB); PG8_STAGE(PG8_SB(0, 1), b2 + hstep, voffB); PG8_STAGE(PG8_SA(0, 0), a2, voffA);
            PG8_WAIT_V(8); PG8_WAIT_L(0); PG8_BAR; PG8_MMA(1, 0, At, B0); PG8_MMA(1, 1, At, B1); PG8_BAR; PG8_SCHED;
            PG8_LDB(B0, 1, 0); PG8_LDB(B1, 1, 1); PG8_SCHED; PG8_LDA(At, 1, 0); PG8_STAGE(PG8_SA(0, 1), a2 + hstep, voffA);
            PG8_WAIT_V(8); PG8_WAIT_L(0); PG8_BAR; PG8_MMA(0, 0, At, B0); PG8_MMA(0, 1, At, B1); PG8_BAR; PG8_SCHED;
            PG8_LDA(At, 1, 1); PG8_STAGE(PG8_SB(1, 0), b3, voffB); PG8_STAGE(PG8_SB(1, 1), b3 + hstep, voffB); PG8_STAGE(PG8_SA(1, 0), a3, voffA);
            PG8_WAIT_V(8); PG8_WAIT_L(0); PG8_BAR; PG8_MMA(1, 0, At, B0); PG8_MMA(1, 1, At, B1); PG8_BAR; PG8_SCHED;
            } else {
            PG8_LDB(B0, 0, 0); PG8_SCHED; PG8_LDA(At, 0, 0); PG8_STAGE(PG8_SA(1, 1), a1 + hstep, voffA);
            PG8_WAIT_L(8); PG8_BAR; PG8_WAIT_L(0); PG8_MMA(0, 0, At, B0); PG8_BAR; PG8_SCHED;
            PG8_LDB(B1, 0, 1); PG8_STAGE(PG8_SB(0, 0), b2, voffB);
            PG8_BAR; PG8_WAIT_L(0); PG8_MMA(0, 1, At, B1); PG8_BAR;
            PG8_LDA(At, 0, 1); PG8_STAGE(PG8_SA(0, 0), a2, voffA);
            PG8_BAR; PG8_WAIT_L(0); PG8_MMA(1, 0, At, B0); PG8_BAR; PG8_SCHED;
            PG8_STAGE(PG8_SB(0, 1), b2 + hstep, voffB);
            PG8_WAIT_V(6); PG8_BAR; PG8_MMA(1, 1, At, B1); PG8_BAR;
            PG8_LDB(B0, 1, 0); PG8_SCHED; PG8_LDA(At, 1, 0); PG8_STAGE(PG8_SA(0, 1), a2 + hstep, voffA);
            PG8_WAIT_L(8); PG8_BAR; PG8_WAIT_L(0); PG8_MMA(0, 0, At, B0); PG8_BAR; PG8_SCHED;
            PG8_LDB(B1, 1, 1); PG8_STAGE(PG8_SB(1, 0), b3, voffB);
            PG8_BAR; PG8_WAIT_L(0); PG8_MMA(0, 1, At, B1); PG8_BAR;
            PG8_LDA(At, 1, 1); PG8_STAGE(PG8_SA(1, 0), a3, voffA);
            PG8_BAR; PG8_WAIT_L(0); PG8_MMA(1, 0, At, B0); PG8_BAR; PG8_SCHED;
            PG8_STAGE(PG8_SB(1, 1), b3 + hstep, voffB);
            PG8_WAIT_V(6); PG8_BAR; PG8_MMA(1, 1, At, B1); PG8_BAR;
            }
        }
        if constexpr (ALIGN_EPI) { if (wr == 0) PG8_BAR; }
        if constexpr (!Epi::AFTER_DRAIN) { E(acc, cur, wr, wc, fr, fq); S.done(cur); }
        if (!has_next) break;
#pragma unroll
        for (int a = 0; a < 2; ++a)
#pragma unroll
            for (int b = 0; b < 2; ++b)
#pragma unroll
                for (int m = 0; m < 4; ++m)
#pragma unroll
                    for (int n = 0; n < 2; ++n) acc[a][b][m][n] = (f32x4){0.f, 0.f, 0.f, 0.f};
        cur = nxt; cA = nA; cB = nB; ++ui;
        if constexpr (ALIGN_EPI) { if (wr == 1) PG8_BAR; }
    }
    PG8_WAIT_V(0);
    if constexpr (!ALIGN_EPI) { if (wr == 0) PG8_BAR; }
    PG8_BAR;
    if constexpr (Epi::AFTER_DRAIN) { E.fused(acc, cur, wr, wc, fr, fq, lds, wid, lane); S.done(cur); }
#undef PG8_SA
#undef PG8_SB
#undef PG8_STAGE
#undef PG8_LDA
#undef PG8_LDB
#undef PG8_MMA
#undef PG8_WAIT_V
#undef PG8_WAIT_L
#undef PG8_BAR
#undef PG8_SCHED
}
}
constexpr int BATCH = 4, SEQ = 4096, DM = 1024, NCH = 64, CH = 64, MTOK = BATCH * SEQ, DEPTH = 2;
constexpr int NPROJ = 3072, IN_COLS = 3088, FF = 2816;
constexpr float EPS = 1e-6f;
constexpr size_t MiB = 1u << 20;
constexpr size_t WS_SMALL = 1 * MiB, WS_ACS = 2 * MiB, WS_CDEC = 2 * MiB + 512 * 1024, WS_EGL = 2 * MiB + 768 * 1024;
constexpr size_t WS_WIN = 3 * MiB, WS_WOUT = 9 * MiB, WS_WGU = 11 * MiB, WS_WDN = 22 * MiB;
constexpr size_t WS_XN = 28 * MiB;
constexpr size_t WS_GU = 28 * MiB, WS_GW = 36 * MiB, WS_GQE = 44 * MiB, WS_GQK = 52 * MiB, WS_GKDT = 244 * MiB;
constexpr size_t WS_PROJ = 60 * MiB, WS_H = 60 * MiB;
constexpr size_t WS_MIX = 156 * MiB;
constexpr size_t WS_STATES = 188 * MiB, WS_YPART = 220 * MiB, WS_CCONV = 236 * MiB, WS_TMP = 188 * MiB;
constexpr size_t WS_X1 = 220 * MiB;
constexpr size_t WS_END = 252 * MiB;
constexpr int LDS_BYTES = 147456;
#ifndef REP_C
#define REP_C 1
#endif
#ifndef REP_P1
#define REP_P1 1
#endif
#ifndef REP_DS
#define REP_DS 1
#endif
#ifndef RP3_MMA
#define RP3_MMA 1
#endif
#ifndef REP_GEMM
#define REP_GEMM 1
#endif
#ifndef REP_ATT
#define REP_ATT 1
#endif
#ifndef RG_CONV
#define RG_CONV 1
#endif
#ifndef RG_KK
#define RG_KK 1
#endif
#ifndef RG_SOLVE
#define RG_SOLVE 1
#endif
#ifndef REP_C1
#define REP_C1 1
#endif
#ifndef REP_C2
#define REP_C2 1
#endif
#ifndef REP_D
#define REP_D 1
#endif
#ifndef REP_E
#define REP_E 1
#endif

#define LAS __attribute__((address_space(3)))
#define DEV __device__ __forceinline__
typedef unsigned short bf16;
typedef short bf16x8 __attribute__((ext_vector_type(8)));
typedef float f32x4 __attribute__((ext_vector_type(4)));
typedef unsigned u32x4 __attribute__((ext_vector_type(4)));
typedef unsigned u32x2 __attribute__((ext_vector_type(2)));

typedef float f32x2_t __attribute__((ext_vector_type(2)));
typedef __bf16 bf16x2_t __attribute__((ext_vector_type(2)));
DEV unsigned pk2(float lo, float hi) { const f32x2_t v = {lo, hi}; const bf16x2_t b = __builtin_convertvector(v, bf16x2_t); return __builtin_bit_cast(unsigned, b); }
DEV unsigned f2bf(float f) { return pk2(f, 0.f) & 0xffffu; }
DEV float bf2f(unsigned b) { return __builtin_bit_cast(float, b << 16); }
DEV float bflo(unsigned w) { return __builtin_bit_cast(float, w << 16); }
DEV float bfhi(unsigned w) { return __builtin_bit_cast(float, w & 0xffff0000u); }
DEV float silu(float x) { return x * __builtin_amdgcn_rcpf(1.0f + __expf(-x)); }
DEV float softplus(float x) { return fmaxf(x, 0.f) + log1pf(expf(-fabsf(x))); }
template <int CTRL> DEV float dpp_f(float v) { return __builtin_bit_cast(float, __builtin_amdgcn_update_dpp(0, __builtin_bit_cast(int, v), CTRL, 0xF, 0xF, true)); }
DEV float red4_sum(float v) { v += dpp_f<0xB1>(v); v += dpp_f<0x4E>(v); return v; }
DEV float red8_sum(float v) { v = red4_sum(v); v += dpp_f<0x141>(v); return v; }
DEV float red16_sum(float v) { v = red8_sum(v); v += dpp_f<0x140>(v); return v; }
DEV float red16_max(float v) { v = fmaxf(v, dpp_f<0xB1>(v)); v = fmaxf(v, dpp_f<0x4E>(v)); v = fmaxf(v, dpp_f<0x141>(v)); v = fmaxf(v, dpp_f<0x140>(v)); return v; }
DEV float rdlane(float v, int l) { return __builtin_bit_cast(float, __builtin_amdgcn_readlane(__builtin_bit_cast(int, v), l)); }
DEV float wave_sum(float v) { v = red16_sum(v); return (rdlane(v, 0) + rdlane(v, 16)) + (rdlane(v, 32) + rdlane(v, 48)); }
DEV float wave_incl_scan(float v, int lane) {
    v += dpp_f<0x111>(v); v += dpp_f<0x112>(v); v += dpp_f<0x114>(v); v += dpp_f<0x118>(v);
    const float t0 = rdlane(v, 15), t1 = rdlane(v, 31), t2 = rdlane(v, 47);
    const int r = lane >> 4;
    return v + (r > 0 ? t0 : 0.f) + (r > 1 ? t1 : 0.f) + (r > 2 ? t2 : 0.f);
}
DEV float frcp(float x) { return __builtin_amdgcn_rcpf(x); }
DEV f32x4 mma_tile(const LAS bf16* A, int lda, const LAS bf16* B, int ldb, int K, int lane, f32x4 acc) {
    const LAS bf16* ap = A + (lane & 15) * lda + (lane >> 4) * 8;
    const LAS bf16* bp = B + (lane & 15) * ldb + (lane >> 4) * 8;
    for (int k = 0; k < K; k += 32) {
        const bf16x8 a = *(const LAS bf16x8*)(ap + k), b = *(const LAS bf16x8*)(bp + k);
        acc = __builtin_amdgcn_mfma_f32_16x16x32_bf16(a, b, acc, 0, 0, 0);
    }
    return acc;
}

struct Params {
    const float *x, *pre_mix, *post_mix, *pre_ffn, *post_ffn, *w_in, *w_out, *sinks, *sconv_w, *sconv_b, *sdt_bias, *sA_log, *sD, *snorm_w,
                *gconv_w, *gdt_bias, *gA_log, *gnorm_w, *w_gate, *w_up, *w_down;
    float* out; unsigned char* ws;
};

DEV void tr_item(const float* W, int ldw, int col0, bf16* WT, int K, int drow0, int rs, LAS float* scr, int kb, int nb, int lane) {
    const int k0 = 64 * kb, n0 = 32 * nb;
#pragma unroll 8
    for (int i = 0; i < 32; ++i) { const int kk = 2 * i + (lane >> 5); scr[kk * 33 + (lane & 31)] = W[(size_t)(k0 + kk) * ldw + col0 + n0 + (lane & 31)]; }
    asm volatile("s_waitcnt lgkmcnt(0)" ::: "memory");
    const int c = lane & 7;
#pragma unroll
    for (int j = 0; j < 4; ++j) { const int n = (lane >> 3) + 8 * j; const LAS float* s = scr + (8 * c) * 33 + n;
        u32x4 o; o.x = pk2(s[0 * 33], s[1 * 33]); o.y = pk2(s[2 * 33], s[3 * 33]); o.z = pk2(s[4 * 33], s[5 * 33]); o.w = pk2(s[6 * 33], s[7 * 33]);
        *(u32x4*)(WT + (size_t)(drow0 + (n0 + n) * rs) * K + k0 + 8 * c) = o; }
    asm volatile("s_waitcnt lgkmcnt(0)" ::: "memory");
}
DEV void convert_weights(const Params& p, int l, LAS unsigned char* lds, int gw, int NGW, int wave, int lane) {
    LAS float* scr = (LAS float*)(lds + wave * 8448);
    const float* win = p.w_in + (size_t)l * DM * IN_COLS; const float* wout = p.w_out + (size_t)l * DM * DM;
    const float* wg = p.w_gate + (size_t)l * DM * FF; const float* wu = p.w_up + (size_t)l * DM * FF; const float* wd = p.w_down + (size_t)l * FF * DM;
    bf16* WIN = (bf16*)(p.ws + WS_WIN); bf16* WOUT = (bf16*)(p.ws + WS_WOUT); bf16* WGU = (bf16*)(p.ws + WS_WGU); bf16* WDN = (bf16*)(p.ws + WS_WDN);
    constexpr int I_IN = 16 * 96, I_OUT = 16 * 32, I_G = 16 * 88, I_D = 44 * 32;
    constexpr int NIT = I_IN + I_OUT + 2 * I_G + I_D;
    for (int it = gw; it < NIT; it += NGW) {
        int r = it;
        if (r < I_IN) { const int kb = r / 96, nb = r % 96;
            if (nb < 64) tr_item(win, IN_COLS, 0, WIN, DM, 0, 1, scr, kb, nb, lane); else tr_item(win, IN_COLS, 2056, WIN, DM, 2048, 1, scr, kb, nb - 64, lane);
            continue; } r -= I_IN;
        if (r < I_OUT) { tr_item(wout, DM, 0, WOUT, DM, 0, 1, scr, r / 32, r % 32, lane); continue; } r -= I_OUT;
        if (r < I_G) { tr_item(wg, FF, 0, WGU, DM, 0, 2, scr, r / 88, r % 88, lane); continue; } r -= I_G;
        if (r < I_G) { tr_item(wu, FF, 0, WGU, DM, 1, 2, scr, r / 88, r % 88, lane); continue; } r -= I_G;
        tr_item(wd, DM, 0, WDN, FF, 0, 1, scr, r / 32, r % 32, lane);
    }
}
DEV void stage_small(const Params& p, int l, LAS float* wsT, int tid) {
    const float* win = p.w_in + (size_t)l * DM * IN_COLS;
    for (int idx = tid; idx < 16 * DM; idx += 512) { const int k = idx >> 4, c = idx & 15; const int sc = c < 8 ? 2048 + c : 3072 + c; wsT[c * DM + k] = win[(size_t)k * IN_COLS + sc]; }
}
template <int MODE, bool RB = false, bool OB = false>
DEV void rowpass(const void* res_, const bf16* tmp, const float* wpost, const float* wnext, void* xout_, bf16* XN, float* SMALL, const LAS float* wsT, int gw, int NGW, int lane) {
    const float* res = (const float*)res_; const bf16* res16 = (const bf16*)res_; float* xout = (float*)xout_; bf16* xout16 = (bf16*)xout_;
    f32x4 wp[4], wn[4];
#pragma unroll
    for (int j = 0; j < 4; ++j) {
        if (MODE != 0) wp[j] = *((const f32x4*)wpost + lane + 64 * j);
        if (MODE != 3) wn[j] = *((const f32x4*)wnext + lane + 64 * j);
    }
    f32x4 nv[4]; u32x2 nv16[4]; u32x2 ntw[4];
#pragma unroll
    for (int j = 0; j < 4; ++j) { if (RB) nv16[j] = *((const u32x2*)(res16 + (size_t)gw * DM) + lane + 64 * j); else nv[j] = *((const f32x4*)(res + (size_t)gw * DM) + lane + 64 * j);
        if (MODE != 0) ntw[j] = *((const u32x2*)(tmp + (size_t)gw * DM) + lane + 64 * j); }
    for (int m = gw; m < MTOK; m += NGW) {
        f32x4 v[4]; u32x2 ctw[4];
#pragma unroll
        for (int j = 0; j < 4; ++j) { if (RB) v[j] = (f32x4){bflo(nv16[j].x), bfhi(nv16[j].x), bflo(nv16[j].y), bfhi(nv16[j].y)}; else v[j] = nv[j]; if (MODE != 0) ctw[j] = ntw[j]; }
        { const int mn = (m + NGW < MTOK) ? m + NGW : m;
#pragma unroll
            for (int j = 0; j < 4; ++j) { if (RB) nv16[j] = *((const u32x2*)(res16 + (size_t)mn * DM) + lane + 64 * j); else nv[j] = *((const f32x4*)(res + (size_t)mn * DM) + lane + 64 * j);
                if (MODE != 0) ntw[j] = *((const u32x2*)(tmp + (size_t)mn * DM) + lane + 64 * j); } }
        if (MODE != 0) {
            f32x4 t[4]; float ss = 0.f;
#pragma unroll
            for (int j = 0; j < 4; ++j) { const u32x2 tw = ctw[j]; t[j] = (f32x4){bflo(tw.x), bfhi(tw.x), bflo(tw.y), bfhi(tw.y)}; ss += (t[j].x * t[j].x + t[j].y * t[j].y) + (t[j].z * t[j].z + t[j].w * t[j].w); }
            const float rstd = rsqrtf(wave_sum(ss) * (1.0f / DM) + EPS);
#pragma unroll
            for (int j = 0; j < 4; ++j) { v[j] = v[j] + t[j] * rstd * wp[j];
                if (OB) { u32x2 o; o.x = pk2(v[j].x, v[j].y); o.y = pk2(v[j].z, v[j].w); *((u32x2*)(xout16 + (size_t)m * DM) + lane + 64 * j) = o; }
                else *((f32x4*)(xout + (size_t)m * DM) + lane + 64 * j) = v[j]; }
        }
        if (MODE != 3) {
            float ss = 0.f;
#pragma unroll
            for (int j = 0; j < 4; ++j) ss += (v[j].x * v[j].x + v[j].y * v[j].y) + (v[j].z * v[j].z + v[j].w * v[j].w);
            const float rstd = rsqrtf(wave_sum(ss) * (1.0f / DM) + EPS);
#pragma unroll
            for (int j = 0; j < 4; ++j) { v[j] = v[j] * rstd * wn[j];
                u32x2 o; o.x = pk2(v[j].x, v[j].y); o.y = pk2(v[j].z, v[j].w); *((u32x2*)(XN + (size_t)m * DM) + lane + 64 * j) = o; }
            if (MODE == 0 || MODE == 2) {
                float mine = 0.f;
#pragma unroll
                for (int c = 0; c < 16; ++c) { float s = 0.f; asm volatile("" ::: "memory");
#pragma unroll
                    for (int j = 0; j < 4; ++j) { const f32x4 w = *((const LAS f32x4*)(wsT + c * DM) + lane + 64 * j); s += (v[j].x * w.x + v[j].y * w.y) + (v[j].z * w.z + v[j].w * w.w); }
                    s = red16_sum(s); mine = ((lane & 15) == c) ? s : mine; }
                mine += __shfl_xor(mine, 16); mine += __shfl_xor(mine, 32);
                if (lane < 16) SMALL[(size_t)m * 16 + lane] = mine;
            }
        }
    }
}

DEV void attn_unit(const Params& p, int l, int u, LAS unsigned char* lds, int tid) {
    asm volatile("" : "+v"(tid));
    const int b = u >> 7, c = (u >> 1) & 63, kvh = u & 1, wave = tid >> 6, lane = tid & 63;
    const bf16* PROJ = (const bf16*)(p.ws + WS_PROJ); bf16* MIX = (bf16*)(p.ws + WS_MIX);
    LAS bf16* Qs = (LAS bf16*)lds;
    LAS bf16* Ks = Qs + 128 * 72;
    LAS bf16* Vt = Ks + 192 * 72;
    LAS bf16* Ps = Vt + 64 * 200;
    const size_t t0 = (size_t)b * SEQ + (size_t)c * CH;
    {
        u32x4 rq[2], rk[3], rv[3];
#pragma unroll
        for (int k = 0; k < 2; ++k) { const int idx = tid + k * 512, r = idx >> 3, v = idx & 7, g = r >> 6, i = r & 63;
            rq[k] = *(const u32x4*)(PROJ + (t0 + i) * NPROJ + kvh * 128 + g * 64 + v * 8); }
#pragma unroll
        for (int k = 0; k < 3; ++k) { const int idx = tid + k * 512, j = idx >> 3, v = idx & 7; const bool valid = (c - 2 + (j >> 6)) >= 0;
            rk[k] = (u32x4){0u, 0u, 0u, 0u}; rv[k] = rk[k];
            if (valid) { const bf16* rowp = PROJ + (size_t)((long)t0 - 128 + j) * NPROJ; rk[k] = *(const u32x4*)(rowp + 256 + kvh * 64 + v * 8); rv[k] = *(const u32x4*)(rowp + 384 + kvh * 64 + v * 8); } }
#pragma unroll
        for (int k = 0; k < 2; ++k) { const int idx = tid + k * 512, r = idx >> 3, v = idx & 7; *(LAS u32x4*)(Qs + r * 72 + v * 8) = rq[k]; }
#pragma unroll
        for (int k = 0; k < 3; ++k) { const int idx = tid + k * 512, j = idx >> 3, v = idx & 7; const u32x4 vv = rv[k];
            *(LAS u32x4*)(Ks + j * 72 + v * 8) = rk[k];
            LAS bf16* vt = Vt + (v * 8) * 200 + j;
            vt[0 * 200] = (bf16)(vv.x & 0xffffu); vt[1 * 200] = (bf16)(vv.x >> 16); vt[2 * 200] = (bf16)(vv.y & 0xffffu); vt[3 * 200] = (bf16)(vv.y >> 16);
            vt[4 * 200] = (bf16)(vv.z & 0xffffu); vt[5 * 200] = (bf16)(vv.z >> 16); vt[6 * 200] = (bf16)(vv.w & 0xffffu); vt[7 * 200] = (bf16)(vv.w >> 16); }
    }
    __syncthreads();
    {
        const int g = wave >> 2, h = kvh * 2 + g;
        const float slope = exp2f(-2.0f * (float)(h + 1)), sink = p.sinks[l * 4 + h];
        f32x4 s[12];
#pragma unroll
        for (int nt = 0; nt < 12; ++nt) s[nt] = mma_tile(Qs + wave * 16 * 72, 72, Ks + nt * 16 * 72, 72, 64, lane, (f32x4){0.f, 0.f, 0.f, 0.f});
#pragma unroll
        for (int j = 0; j < 4; ++j) {
            const int r = wave * 16 + (lane >> 4) * 4 + j, i = r & 63;
            float mx = sink;
#pragma unroll
            for (int nt = 0; nt < 12; ++nt) { const int jj = nt * 16 + (lane & 15);
                float val = s[nt][j] * 0.125f - slope * fabsf((float)(i + 128 - jj));
                if (c - 2 + (nt >> 2) < 0) val = -INFINITY;
                s[nt][j] = val; mx = fmaxf(mx, val); }
            mx = red16_max(mx);
            float sum = 0.f;
#pragma unroll
            for (int nt = 0; nt < 12; ++nt) { const float e = __expf(s[nt][j] - mx); s[nt][j] = e; sum += e; }
            sum = red16_sum(sum);
            sum += __expf(sink - mx);
            const float inv = frcp(sum);
#pragma unroll
            for (int nt = 0; nt < 12; ++nt) Ps[r * 200 + nt * 16 + (lane & 15)] = (bf16)f2bf(s[nt][j] * inv);
        }
    }
    __syncthreads();
#pragma unroll
    for (int nt = 0; nt < 4; ++nt) {
        const f32x4 acc = mma_tile(Vt + nt * 16 * 200, 200, Ps + wave * 16 * 200, 200, 192, lane, (f32x4){0.f, 0.f, 0.f, 0.f});
        const int r = wave * 16 + (lane & 15), g = r >> 6, i = r & 63, d0 = nt * 16 + (lane >> 4) * 4;
        u32x2 o; o.x = pk2(acc[0], acc[1]); o.y = pk2(acc[2], acc[3]);
        *(u32x2*)(MIX + (t0 + i) * DM + (kvh * 2 + g) * 64 + d0) = o;
    }
    __syncthreads();
}

template <int NCOLS> struct RawTile {
    static constexpr int VPR = NCOLS / 8, NV = 67 * VPR, NIT = (NV + 511) / 512;
    u32x4 r[NIT];
    DEV void issue(const bf16* PROJ, size_t t0, int c, int col0, int tid) {
#pragma unroll
        for (int k = 0; k < NIT; ++k) { const int idx = tid + k * 512, row = idx / VPR, v = idx % VPR;
            r[k] = (u32x4){0u, 0u, 0u, 0u};
            if (idx < NV && (c > 0 || row >= 3)) r[k] = *(const u32x4*)(PROJ + (size_t)((long)t0 - 3 + row) * NPROJ + col0 + v * 8); }
    }
    DEV void commit(LAS bf16* Raw, int rawld, int dcol0, int tid) const {
#pragma unroll
        for (int k = 0; k < NIT; ++k) { const int idx = tid + k * 512, row = idx / VPR, v = idx % VPR;
            if (idx < NV) *(LAS u32x4*)(Raw + row * rawld + dcol0 + v * 8) = r[k]; }
    }
};
DEV void ssd_p1_unit(const Params& p, int l, int u, LAS unsigned char* lds, int tid) {
    asm volatile("" : "+v"(tid));
    const int b = u >> 7, c = (u >> 1) & 63, g = u & 1, wave = tid >> 6, lane = tid & 63;
    const bf16* PROJ = (const bf16*)(p.ws + WS_PROJ);
    const float* SMALL = (const float*)(p.ws + WS_SMALL);
    float* ACS = (float*)(p.ws + WS_ACS); float* CDEC = (float*)(p.ws + WS_CDEC);
    bf16* STATES = (bf16*)(p.ws + WS_STATES); bf16* YPART = (bf16*)(p.ws + WS_YPART); bf16* CCONV = (bf16*)(p.ws + WS_CCONV);
    LAS bf16* XsT = (LAS bf16*)lds;
    LAS bf16* Bm = XsT + 4 * 64 * 72;
    LAS bf16* Cm = Bm + 64 * 136;
    LAS bf16* BmT = Cm + 64 * 136;
    LAS bf16* Sc = BmT + 128 * 72;
    LAS bf16* Raw = Sc;
    LAS float* dtS = (LAS float*)(Sc + 4 * 64 * 72);
    LAS float* acsS = dtS + 256;
    LAS float* fS = acsS + 256;
    const size_t t0 = (size_t)b * SEQ + (size_t)c * CH;
    RawTile<256> R1; RawTile<128> R2b, R2c;
    R1.issue(PROJ, t0, c, 1024 + g * 256, tid); R2b.issue(PROJ, t0, c, 1024 + 512 + g * 128, tid); R2c.issue(PROJ, t0, c, 1024 + 768 + g * 128, tid);
    if (tid < 256) {
        const int h = tid >> 6, hh = g * 4 + h;
        const float dt = softplus(SMALL[(t0 + lane) * 16 + hh] + p.sdt_bias[l * 8 + hh]);
        const float a = -expf(p.sA_log[l * 8 + hh]);
        const float acs = wave_incl_scan(dt * a, lane);
        const float alast = rdlane(acs, 63);
        dtS[tid] = dt; acsS[tid] = acs; fS[tid] = dt * expf(alast - acs);
        ACS[(t0 + lane) * 8 + hh] = acs;
        if (lane == 63) CDEC[((size_t)b * NCH + c) * 8 + hh] = expf(acs);
    }
    R1.commit(Raw, 256, 0, tid);
    __syncthreads();
    {
        const int ch = tid & 255, half = tid >> 8, chg = g * 256 + ch, h = ch >> 6, pp = ch & 63;
        const float* cw = p.sconv_w + (size_t)l * 4096 + chg; const float w0 = cw[0], w1 = cw[1024], w2 = cw[2048], w3 = cw[3072], bias = p.sconv_b[l * 1024 + chg];
        const int r0 = half * 32;
        float x0 = bf2f(Raw[(r0 + 0) * 256 + ch]), x1 = bf2f(Raw[(r0 + 1) * 256 + ch]), x2 = bf2f(Raw[(r0 + 2) * 256 + ch]);
        LAS bf16* dst = XsT + h * 64 * 72 + pp * 72 + r0;
        for (int r = 0; r < 32; ++r) { const float x3 = bf2f(Raw[(r0 + r + 3) * 256 + ch]);
            const float y = silu(w0 * x0 + w1 * x1 + w2 * x2 + w3 * x3 + bias);
            dst[r] = (bf16)f2bf(y); x0 = x1; x1 = x2; x2 = x3; }
    }
    __syncthreads();
    R2b.commit(Raw, 256, 0, tid); R2c.commit(Raw, 256, 128, tid);
    __syncthreads();
    {
        const int ch = tid & 255, half = tid >> 8, isC = ch >> 7, n = ch & 127, chg = 512 + isC * 256 + g * 128 + n;
        const float* cw = p.sconv_w + (size_t)l * 4096 + chg; const float w0 = cw[0], w1 = cw[1024], w2 = cw[2048], w3 = cw[3072], bias = p.sconv_b[l * 1024 + chg];
        const int r0 = half * 32;
        float x0 = bf2f(Raw[(r0 + 0) * 256 + ch]), x1 = bf2f(Raw[(r0 + 1) * 256 + ch]), x2 = bf2f(Raw[(r0 + 2) * 256 + ch]);
        for (int r = 0; r < 32; ++r) { const float x3 = bf2f(Raw[(r0 + r + 3) * 256 + ch]);
            const bf16 y = (bf16)f2bf(silu(w0 * x0 + w1 * x1 + w2 * x2 + w3 * x3 + bias));
            if (isC) Cm[(r0 + r) * 136 + n] = y; else { Bm[(r0 + r) * 136 + n] = y; BmT[n * 72 + r0 + r] = y; }
            x0 = x1; x1 = x2; x2 = x3; }
    }
    __syncthreads();
    for (int idx = tid; idx < 1024; idx += 512) { const int r = idx >> 4, v = idx & 15; *(u32x4*)(CCONV + (t0 + r) * 256 + g * 128 + v * 8) = *(const LAS u32x4*)(Cm + r * 136 + v * 8); }
#pragma unroll
    for (int ti = 0; ti < 2; ++ti) {
        const int tt = wave * 2 + ti, mt = tt >> 2, nt = tt & 3;
        f32x4 acc = (f32x4){0.f, 0.f, 0.f, 0.f};
        if (nt <= mt) acc = mma_tile(Bm + nt * 16 * 136, 136, Cm + mt * 16 * 136, 136, 128, lane, acc);
        const int lr = mt * 16 + (lane & 15), s0 = nt * 16 + (lane >> 4) * 4;
#pragma unroll
        for (int h = 0; h < 4; ++h) { const f32x4 as = *(const LAS f32x4*)(acsS + h * 64 + s0), ds = *(const LAS f32x4*)(dtS + h * 64 + s0); const float al = acsS[h * 64 + lr];
            float v[4];
#pragma unroll
            for (int j = 0; j < 4; ++j) v[j] = (s0 + j <= lr) ? acc[j] * __expf(al - as[j]) * ds[j] : 0.f;
            u32x2 o; o.x = pk2(v[0], v[1]); o.y = pk2(v[2], v[3]);
            *(LAS u32x2*)(Sc + h * 64 * 72 + lr * 72 + s0) = o; }
    }
    __syncthreads();
    {
        const int h = wave >> 1, hh = g * 4 + h; const float Dh = p.sD[l * 8 + hh];
#pragma unroll 2
        for (int ti = 0; ti < 8; ++ti) { const int tt = (wave & 1) * 8 + ti, mt = tt >> 2, nt = tt & 3;
            const f32x4 acc = mma_tile(XsT + h * 64 * 72 + nt * 16 * 72, 72, Sc + h * 64 * 72 + mt * 16 * 72, 72, 64, lane, (f32x4){0.f, 0.f, 0.f, 0.f});
            const int lr = mt * 16 + (lane & 15), p0 = nt * 16 + (lane >> 4) * 4;
            const LAS bf16* xp = XsT + h * 64 * 72 + p0 * 72 + lr;
            u32x2 o; o.x = pk2(acc[0] + Dh * bf2f(xp[0]), acc[1] + Dh * bf2f(xp[72])); o.y = pk2(acc[2] + Dh * bf2f(xp[144]), acc[3] + Dh * bf2f(xp[216]));
            *(u32x2*)(YPART + (t0 + lr) * 512 + hh * 64 + p0) = o; }
#pragma unroll
        for (int pi = 0; pi < 2; ++pi) { const int pt = (wave & 1) * 2 + pi;
            bf16x8 xf[2];
#pragma unroll
            for (int k = 0; k < 2; ++k) { const int l0 = k * 32 + (lane >> 4) * 8;
                const u32x4 xw = *(const LAS u32x4*)(XsT + h * 64 * 72 + (pt * 16 + (lane & 15)) * 72 + l0);
                const f32x4 f0 = *(const LAS f32x4*)(fS + h * 64 + l0), f1 = *(const LAS f32x4*)(fS + h * 64 + l0 + 4);
                u32x4 o; o.x = pk2(bflo(xw.x) * f0.x, bfhi(xw.x) * f0.y); o.y = pk2(bflo(xw.y) * f0.z, bfhi(xw.y) * f0.w);
                o.z = pk2(bflo(xw.z) * f1.x, bfhi(xw.z) * f1.y); o.w = pk2(bflo(xw.w) * f1.z, bfhi(xw.w) * f1.w);
                xf[k] = __builtin_bit_cast(bf16x8, o); }
            for (int nt = 0; nt < 8; ++nt) {
                f32x4 acc = (f32x4){0.f, 0.f, 0.f, 0.f};
#pragma unroll
                for (int k = 0; k < 2; ++k) { const bf16x8 bfr = *(const LAS bf16x8*)(BmT + (nt * 16 + (lane & 15)) * 72 + k * 32 + (lane >> 4) * 8);
                    acc = __builtin_amdgcn_mfma_f32_16x16x32_bf16(bfr, xf[k], acc, 0, 0, 0); }
                u32x2 o; o.x = pk2(acc[0], acc[1]); o.y = pk2(acc[2], acc[3]);
                *(u32x2*)(STATES + ((((size_t)b * NCH + c) * 8 + hh) * 64 + pt * 16 + (lane & 15)) * 128 + nt * 16 + (lane >> 4) * 4) = o; } }
    }
    __syncthreads();
}
DEV void ssd_scan_all(const Params& p, int bx, LAS unsigned char* lds, int tid) {
    asm volatile("" : "+v"(tid));
    bf16* STATES = (bf16*)(p.ws + WS_STATES); const float* CDEC = (const float*)(p.ws + WS_CDEC);
    LAS float* decS = (LAS float*)lds;
    const int idx = bx * 512 + tid, b = idx >> 15, rem = idx & 32767, hh = rem >> 12, pn2 = rem & 4095;
    if (tid < 64) decS[tid] = CDEC[((size_t)b * NCH + tid) * 8 + hh];
    unsigned* base = (unsigned*)(STATES + ((size_t)b * NCH * 8 + hh) * 8192) + pn2;
    unsigned nw[NCH];
#pragma unroll
    for (int c = 0; c < NCH; ++c) nw[c] = base[(size_t)c * 8 * 4096];
    __syncthreads();
    float s0 = 0.f, s1 = 0.f;
#pragma unroll
    for (int c = 0; c < NCH; ++c) { const float d = decS[c];
        base[(size_t)c * 8 * 4096] = pk2(s0, s1);
        s0 = s0 * d + bflo(nw[c]); s1 = s1 * d + bfhi(nw[c]); }
    __syncthreads();
}
DEV void ssd_p3_unit(const Params& p, int l, int u, LAS unsigned char* lds, int tid) {
    asm volatile("" : "+v"(tid));
    const int b = u >> 7, c = (u >> 1) & 63, g = u & 1, wave = tid >> 6, lane = tid & 63;
    const bf16* PROJ = (const bf16*)(p.ws + WS_PROJ); const float* ACS = (const float*)(p.ws + WS_ACS);
    const bf16* STATES = (const bf16*)(p.ws + WS_STATES); const bf16* YPART = (const bf16*)(p.ws + WS_YPART); const bf16* CCONV = (const bf16*)(p.ws + WS_CCONV);
    bf16* MIX = (bf16*)(p.ws + WS_MIX);
    LAS bf16* Cm = (LAS bf16*)lds;
    LAS bf16* Prev = Cm + 64 * 136;
    LAS float* Gb = (LAS float*)Prev;
    LAS float* acsS = (LAS float*)(Prev + 4 * 64 * 136);
    const size_t t0 = (size_t)b * SEQ + (size_t)c * CH;
    const int h = wave >> 1, hh = g * 4 + h;
    u32x4 rc[2], rp[8]; u32x2 ry[8], rz[8]; float racs = 0.f;
#pragma unroll
    for (int k = 0; k < 2; ++k) { const int idx = tid + k * 512, r = idx >> 4, v = idx & 15; rc[k] = *(const u32x4*)(CCONV + (t0 + r) * 256 + g * 128 + v * 8); }
#pragma unroll
    for (int k = 0; k < 8; ++k) { const int idx = tid + k * 512, hq = idx >> 10, r = (idx >> 4) & 63, v = idx & 15;
        rp[k] = *(const u32x4*)(STATES + ((((size_t)b * NCH + c) * 8 + g * 4 + hq) * 64 + r) * 128 + v * 8); }
    if (tid < 256) racs = ACS[(t0 + (tid & 63)) * 8 + g * 4 + (tid >> 6)];
#pragma unroll
    for (int ti = 0; ti < 8; ++ti) { const int tt = (wave & 1) * 8 + ti, mt = tt >> 2, nt = tt & 3, lr = mt * 16 + (lane & 15), p0 = nt * 16 + (lane >> 4) * 4;
        ry[ti] = *(const u32x2*)(YPART + (t0 + lr) * 512 + hh * 64 + p0); rz[ti] = *(const u32x2*)(PROJ + (t0 + lr) * NPROJ + 512 + hh * 64 + p0); }
#pragma unroll
    for (int k = 0; k < 2; ++k) { const int idx = tid + k * 512, r = idx >> 4, v = idx & 15; *(LAS u32x4*)(Cm + r * 136 + v * 8) = rc[k]; }
#pragma unroll
    for (int k = 0; k < 8; ++k) { const int idx = tid + k * 512, hq = idx >> 10, r = (idx >> 4) & 63, v = idx & 15; *(LAS u32x4*)(Prev + hq * 64 * 136 + r * 136 + v * 8) = rp[k]; }
    if (tid < 256) acsS[tid] = racs;
    __syncthreads();
    f32x4 acc[8];
    for (int rq_ = 0; rq_ < RP3_MMA; ++rq_) {
#pragma unroll
    for (int ti = 0; ti < 8; ++ti) { const int tt = (wave & 1) * 8 + ti, mt = tt >> 2, nt = tt & 3;
        acc[ti] = mma_tile(Prev + h * 64 * 136 + nt * 16 * 136, 136, Cm + mt * 16 * 136, 136, 128, lane, (f32x4){0.f, 0.f, 0.f, 0.f}); }
    asm volatile("" ::: "memory"); }
    __syncthreads();
#pragma unroll
    for (int ti = 0; ti < 8; ++ti) { const int tt = (wave & 1) * 8 + ti, mt = tt >> 2, nt = tt & 3, lr = mt * 16 + (lane & 15), p0 = nt * 16 + (lane >> 4) * 4;
        const float ea = __expf(acsS[h * 64 + lr]);
        f32x4 gv;
        gv.x = (bflo(ry[ti].x) + ea * acc[ti][0]) * silu(bflo(rz[ti].x)); gv.y = (bfhi(ry[ti].x) + ea * acc[ti][1]) * silu(bfhi(rz[ti].x));
        gv.z = (bflo(ry[ti].y) + ea * acc[ti][2]) * silu(bflo(rz[ti].y)); gv.w = (bfhi(ry[ti].y) + ea * acc[ti][3]) * silu(bfhi(rz[ti].y));
        *(LAS f32x4*)(Gb + lr * 260 + h * 64 + p0) = gv; }
    __syncthreads();
    {
        const int lr = tid >> 3, part = tid & 7;
        const f32x4* nwp = (const f32x4*)(p.snorm_w + (size_t)l * 512 + g * 256 + part * 32);
        f32x4 nw[8], v[8]; float ss = 0.f;
#pragma unroll
        for (int k = 0; k < 8; ++k) nw[k] = nwp[k];
#pragma unroll
        for (int k = 0; k < 8; ++k) { v[k] = *(const LAS f32x4*)(Gb + lr * 260 + part * 32 + k * 4); ss += (v[k].x * v[k].x + v[k].y * v[k].y) + (v[k].z * v[k].z + v[k].w * v[k].w); }
        ss = red8_sum(ss);
        const float rstd = rsqrtf(ss * (1.0f / 256.0f) + EPS);
        bf16* dst = MIX + (t0 + lr) * DM + 256 + g * 256 + part * 32;
#pragma unroll
        for (int k = 0; k < 4; ++k) { const f32x4 a = v[2 * k] * rstd * nw[2 * k], bq = v[2 * k + 1] * rstd * nw[2 * k + 1];
            u32x4 o; o.x = pk2(a.x, a.y); o.y = pk2(a.z, a.w); o.z = pk2(bq.x, bq.y); o.w = pk2(bq.z, bq.w);
            *(u32x4*)(dst + 8 * k) = o; }
    }
    __syncthreads();
}

struct GdnPF { u32x4 rr[4]; float sb, sa; };
DEV void gdn_pre_issue(const Params& p, int u, int tid, GdnPF& pf) {
    const int b = u >> 8, c = (u >> 2) & 63, hg = u & 3, lane = tid & 63;
    const bf16* PROJ = (const bf16*)(p.ws + WS_PROJ); const float* SMALL = (const float*)(p.ws + WS_SMALL);
    const size_t t0 = (size_t)b * SEQ + (size_t)c * CH;
#pragma unroll
    for (int k = 0; k < 4; ++k) { const int idx = tid + k * 512, row = idx / 24, rem = idx % 24, seg = rem >> 3, v = rem & 7;
        pf.rr[k] = (u32x4){0u, 0u, 0u, 0u};
        if (idx < 67 * 24 && (c > 0 || row >= 3)) pf.rr[k] = *(const u32x4*)(PROJ + (size_t)((long)t0 - 3 + row) * NPROJ + 2048 + seg * 256 + hg * 64 + v * 8); }
    pf.sb = 0.f; pf.sa = 0.f;
    if ((tid >> 6) == 0) { pf.sb = SMALL[(t0 + lane) * 16 + 8 + hg]; pf.sa = SMALL[(t0 + lane) * 16 + 12 + hg]; }
}
DEV void gdn_pre_unit(const Params& p, int l, int u, int unext, LAS unsigned char* lds, int tid, GdnPF& pf) {
    asm volatile("" : "+v"(tid));
    const int b = u >> 8, c = (u >> 2) & 63, hg = u & 3, wave = tid >> 6, lane = tid & 63;
    const int ub = (b * 4 + hg) * 64 + c;
    const bf16* PROJ = (const bf16*)(p.ws + WS_PROJ); const float* SMALL = (const float*)(p.ws + WS_SMALL);
    bf16* GU = (bf16*)(p.ws + WS_GU) + (size_t)ub * 4096; bf16* GW = (bf16*)(p.ws + WS_GW) + (size_t)ub * 4096; bf16* GQE = (bf16*)(p.ws + WS_GQE) + (size_t)ub * 4096;
    bf16* GQK = (bf16*)(p.ws + WS_GQK) + (size_t)ub * 4096; bf16* GKDT = (bf16*)(p.ws + WS_GKDT) + (size_t)ub * 4096; float* EGL = (float*)(p.ws + WS_EGL);
    LAS bf16* Raw = (LAS bf16*)lds;
    LAS float* Xn = (LAS float*)lds;
    LAS float* Qs = (LAS float*)(lds + 25728);
    LAS float* Ks = Qs + 64 * 65;
    LAS float* Vs = Ks + 64 * 65;
    LAS float* Am = Vs + 64 * 65;
    LAS float* betaS = Am + 64 * 64;
    LAS float* gcS = betaS + 64;
    LAS float* scwS = gcS + 64;
    LAS float* egS = scwS + 64;
    LAS float* kdS = egS + 64;
    LAS float* R = kdS + 64;
    LAS float* At = R + 64 * 128;
    LAS float* Dv = At + 64 * 64;
    const size_t t0 = (size_t)b * SEQ + (size_t)c * CH;
    if (wave == 0) {
        const float beta = frcp(1.0f + expf(-pf.sb));
        const float gg = -expf(p.gA_log[l * 4 + hg]) * softplus(pf.sa + p.gdt_bias[l * 4 + hg]);
        const float gc = wave_incl_scan(gg, lane);
        const float glast = rdlane(gc, 63), eg = expf(gc);
        betaS[lane] = beta; gcS[lane] = gc; scwS[lane] = beta * eg; egS[lane] = eg; kdS[lane] = expf(glast - gc);
        if (lane == 63) EGL[ub] = eg;
    }
#pragma unroll
    for (int k = 0; k < 4; ++k) { const int idx = tid + k * 512, row = idx / 24, rem = idx % 24;
        if (idx < 67 * 24) *(LAS u32x4*)(Raw + row * 192 + rem * 8) = pf.rr[k]; }
    __syncthreads();
    for (int rq_ = 0; rq_ < RG_CONV; ++rq_)
#pragma unroll
    for (int seg = 0; seg < 3; ++seg) {
        const float* cw = p.gconv_w + (size_t)l * 3072 + seg * 256 + hg * 64 + lane; const float w0 = cw[0], w1 = cw[768], w2 = cw[1536], w3 = cw[2304];
        LAS float* dst = seg == 0 ? Qs : (seg == 1 ? Ks : Vs);
        const int r0 = wave * 8;
        float x0 = bf2f(Raw[(r0 + 0) * 192 + seg * 64 + lane]), x1 = bf2f(Raw[(r0 + 1) * 192 + seg * 64 + lane]), x2 = bf2f(Raw[(r0 + 2) * 192 + seg * 64 + lane]);
#pragma unroll
        for (int r = 0; r < 8; ++r) { const float x3 = bf2f(Raw[(r0 + r + 3) * 192 + seg * 64 + lane]);
            float y = silu(w0 * x0 + w1 * x1 + w2 * x2 + w3 * x3);
            if (seg < 2) { const float ss = wave_sum(y * y); y *= rsqrtf(ss + EPS); if (seg == 0) y *= 0.125f; }
            dst[(r0 + r) * 65 + lane] = y; x0 = x1; x1 = x2; x2 = x3; }
    }
    __syncthreads();
    for (int rq_ = 0; rq_ < RG_KK; ++rq_)
    {
        for (int t = wave; t < 20; t += 8) {
            const bool isqk = t >= 10; const int idx = isqk ? t - 10 : t;
            const int mt = idx >= 6 ? 3 : (idx >= 3 ? 2 : (idx >= 1 ? 1 : 0)), nt = idx - mt * (mt + 1) / 2;
            const LAS float* ap = (isqk ? Qs : Ks) + (mt * 16 + (lane & 15)) * 65 + (lane >> 4);
            const LAS float* bp = Ks + (nt * 16 + (lane & 15)) * 65 + (lane >> 4);
            f32x4 acc = (f32x4){0.f, 0.f, 0.f, 0.f};
#pragma unroll
            for (int ks = 0; ks < 16; ++ks) acc = __builtin_amdgcn_mfma_f32_16x16x4f32(ap[ks * 4], bp[ks * 4], acc, 0, 0, 0);
            const int j = nt * 16 + (lane & 15), i0 = mt * 16 + (lane >> 4) * 4; const float gj = gcS[j];
            float v[4];
#pragma unroll
            for (int jj = 0; jj < 4; ++jj) { const int i = i0 + jj; const float dec = (j <= i) ? __expf(gcS[i] - gj) : 0.f;
                v[jj] = isqk ? acc[jj] * dec : ((j < i) ? betaS[i] * acc[jj] * dec : 0.f); }
            if (!isqk) {
#pragma unroll
                for (int jj = 0; jj < 4; ++jj) Am[(i0 + jj) * 64 + j] = v[jj];
                *(LAS f32x4*)(At + j * 64 + i0) = (f32x4){v[0], v[1], v[2], v[3]};
            } else {
#pragma unroll
                for (int jj = 0; jj < 4; ++jj) GQK[(i0 + jj) * 64 + j] = (bf16)f2bf(v[jj]);
            }
        }
        { const int e0 = tid * 8, i = e0 >> 6, j = e0 & 63; if ((j >> 4) > (i >> 4)) *(u32x4*)(GQK + e0) = (u32x4){0u, 0u, 0u, 0u}; }
    }
    __syncthreads();
    if (unext >= 0) gdn_pre_issue(p, unext, tid, pf);
    for (int rq_ = 0; rq_ < RG_SOLVE; ++rq_) {
    if (wave == 7) {
        const int bb = lane >> 4, cc = lane & 15;
        f32x4 ar[16][4];
#pragma unroll
        for (int i = 1; i < 16; ++i)
#pragma unroll
            for (int q4 = 0; q4 < 4; ++q4) if (q4 * 4 < i) ar[i][q4] = *(const LAS f32x4*)(Am + (bb * 16 + i) * 64 + bb * 16 + q4 * 4);
        float x[16];
#pragma unroll
        for (int i = 0; i < 16; ++i) {
            float acc = (i == cc) ? 1.f : 0.f;
#pragma unroll
            for (int q4 = 0; q4 < 4; ++q4) if (q4 * 4 < i) { const f32x4 a = ar[i][q4];
                if (q4 * 4 + 0 < i) acc -= a.x * x[q4 * 4 + 0];
                if (q4 * 4 + 1 < i) acc -= a.y * x[q4 * 4 + 1];
                if (q4 * 4 + 2 < i) acc -= a.z * x[q4 * 4 + 2];
                if (q4 * 4 + 3 < i) acc -= a.w * x[q4 * 4 + 3]; }
            x[i] = acc;
            Dv[bb * 256 + i * 16 + cc] = acc;
        }
    } else {
#pragma unroll 4
        for (int e = tid; e < 4096; e += 448) { const int r = e >> 6, d = e & 63;
            if (rq_ == 0) GQE[e] = (bf16)f2bf(Qs[r * 65 + d] * egS[r]);
            GKDT[e] = (bf16)f2bf(Ks[d * 65 + r] * kdS[d]); }
    }
    __syncthreads();
    {
        const int col = wave * 16 + (lane & 15), q = lane >> 4;
        bf16* dstg = (col >= 64 ? GW : GU) + (col & 63);
        const int fr = lane & 15;
#pragma unroll
        for (int rb = 0; rb < 4; ++rb) {
            LAS float* rp = R + (16 * rb + 4 * q) * 128 + col;
            float rh[4];
#pragma unroll
            for (int k = 0; k < 4; ++k) { const int i = 16 * rb + 4 * q + k; rh[k] = (col < 64) ? Vs[i * 65 + col] * betaS[i] : Ks[i * 65 + col - 64] * scwS[i]; }
            if (rb > 0) {
                float af[12], xf[12];
#pragma unroll
                for (int ks = 0; ks < 4 * rb; ++ks) { af[ks] = Am[(16 * rb + fr) * 64 + 4 * ks + q]; xf[ks] = Xn[(4 * ks + q) * 128 + col]; }
                f32x4 pacc = (f32x4){0.f, 0.f, 0.f, 0.f};
#pragma unroll
                for (int ks = 0; ks < 4 * rb; ++ks) pacc = __builtin_amdgcn_mfma_f32_16x16x4f32(af[ks], xf[ks], pacc, 0, 0, 0);
                rh[0] -= pacc[0]; rh[1] -= pacc[1]; rh[2] -= pacc[2]; rh[3] -= pacc[3];
            }
            rp[0] = rh[0]; rp[128] = rh[1]; rp[256] = rh[2]; rp[384] = rh[3];
            asm volatile("s_waitcnt lgkmcnt(0)" ::: "memory");
            float df[4], rf[4];
#pragma unroll
            for (int ks = 0; ks < 4; ++ks) { df[ks] = Dv[rb * 256 + fr * 16 + 4 * ks + q]; rf[ks] = R[(16 * rb + 4 * ks + q) * 128 + col]; }
            f32x4 xacc = (f32x4){0.f, 0.f, 0.f, 0.f};
#pragma unroll
            for (int ks = 0; ks < 4; ++ks) xacc = __builtin_amdgcn_mfma_f32_16x16x4f32(df[ks], rf[ks], xacc, 0, 0, 0);
#pragma unroll
            for (int k = 0; k < 4; ++k) { const int ii = 4 * q + k; Xn[(16 * rb + ii) * 128 + col] = xacc[k]; dstg[(16 * rb + ii) * 64] = (bf16)f2bf(xacc[k]); }
            asm volatile("s_waitcnt lgkmcnt(0)" ::: "memory");
        }
    }
    __syncthreads();
    }
}
DEV void gdn_scan_block(const Params& p, int bh2, LAS unsigned char* lds, int tid) {
    asm volatile("" : "+v"(tid));
    const int bh = bh2 >> 1, half = bh2 & 1;
    const int b = bh >> 2, hg = bh & 3, wave = tid >> 6, lane = tid & 63;
    const size_t ub0 = (size_t)bh * 64;
    const bf16* GM0 = (const bf16*)(p.ws + WS_GW) + ub0 * 4096; const bf16* GM1 = (const bf16*)(p.ws + WS_GQE) + ub0 * 4096;
    const bf16* GM2 = (const bf16*)(p.ws + WS_GQK) + ub0 * 4096; const bf16* GM3 = (const bf16*)(p.ws + WS_GKDT) + ub0 * 4096;
    const bf16* GM4 = (const bf16*)(p.ws + WS_GU) + ub0 * 4096;
    const float* EGL = (const float*)(p.ws + WS_EGL) + ub0;
    bf16* MIX = (bf16*)(p.ws + WS_MIX);
    LAS bf16* OPS = (LAS bf16*)lds;
    LAS bf16* PRV = OPS + 2 * 5 * 4608;
    LAS float* egS = (LAS float*)(PRV + 4 * 2 * 1152);
    if (tid < 64) egS[tid] = EGL[tid];
    if (wave >= 2 && wave < 4) {
        __syncthreads();
        for (int c = 0; c < NCH; ++c) __syncthreads();
    } else if (wave < 2) {
        const int es = half * 2 + wave, fr = lane & 15, fq = lane >> 4;
        LAS bf16* Stp = PRV + wave * 2304; LAS bf16* Vtp = Stp + 1152;
        for (int i = lane; i < 1152; i += 64) Stp[i] = 0;
        f32x4 Sacc[4];
#pragma unroll
        for (int mt = 0; mt < 4; ++mt) Sacc[mt] = (f32x4){0.f, 0.f, 0.f, 0.f};
        bf16* obase = MIX + ((size_t)b * SEQ + fr) * DM + 768 + hg * 64 + es * 16 + fq * 4;
        __syncthreads();
#pragma unroll 2
        for (int c = 0; c < NCH; ++c) {
            const LAS bf16* Wb = OPS + (c & 1) * 5 * 4608;
            const int fo = fr * 72 + fq * 8;
            const bf16x8 fS0 = *(const LAS bf16x8*)(Stp + fo), fS1 = *(const LAS bf16x8*)(Stp + fo + 32);
            bf16x8 fW[4][2], fQE[4][2], fQK[4][2], fKD[4][2]; u32x2 uw[4];
#pragma unroll
            for (int mt = 0; mt < 4; ++mt)
#pragma unroll
                for (int ks = 0; ks < 2; ++ks) fW[mt][ks] = *(const LAS bf16x8*)(Wb + mt * 16 * 72 + fo + ks * 32);
#pragma unroll
            for (int mt = 0; mt < 4; ++mt) uw[mt] = *(const LAS u32x2*)(Wb + 4 * 4608 + (mt * 16 + fr) * 72 + es * 16 + fq * 4);
#pragma unroll
            for (int mt = 0; mt < 4; ++mt)
#pragma unroll
                for (int ks = 0; ks < 2; ++ks) fQE[mt][ks] = *(const LAS bf16x8*)(Wb + 4608 + mt * 16 * 72 + fo + ks * 32);
#pragma unroll
            for (int mt = 0; mt < 4; ++mt)
#pragma unroll
                for (int ks = 0; ks < 2; ++ks) fKD[mt][ks] = *(const LAS bf16x8*)(Wb + 3 * 4608 + mt * 16 * 72 + fo + ks * 32);
#pragma unroll
            for (int mt = 0; mt < 4; ++mt)
#pragma unroll
                for (int ks = 0; ks < 2; ++ks) fQK[mt][ks] = *(const LAS bf16x8*)(Wb + 2 * 4608 + mt * 16 * 72 + fo + ks * 32);
            const float egl = egS[c];
            f32x4 av[4], ov[4];
#pragma unroll
            for (int mt = 0; mt < 4; ++mt) {
                av[mt] = __builtin_amdgcn_mfma_f32_16x16x32_bf16(fS0, fW[mt][0], (f32x4){0.f, 0.f, 0.f, 0.f}, 0, 0, 0);
                av[mt] = __builtin_amdgcn_mfma_f32_16x16x32_bf16(fS1, fW[mt][1], av[mt], 0, 0, 0); }
#pragma unroll
            for (int mt = 0; mt < 4; ++mt) {
                ov[mt] = __builtin_amdgcn_mfma_f32_16x16x32_bf16(fS0, fQE[mt][0], (f32x4){0.f, 0.f, 0.f, 0.f}, 0, 0, 0);
                ov[mt] = __builtin_amdgcn_mfma_f32_16x16x32_bf16(fS1, fQE[mt][1], ov[mt], 0, 0, 0); }
#pragma unroll
            for (int mt = 0; mt < 4; ++mt) {
                LAS bf16* vp = Vtp + (fq * 4) * 72 + mt * 16 + fr;
                vp[0] = (bf16)f2bf(bflo(uw[mt].x) - av[mt][0]); vp[72] = (bf16)f2bf(bfhi(uw[mt].x) - av[mt][1]);
                vp[144] = (bf16)f2bf(bflo(uw[mt].y) - av[mt][2]); vp[216] = (bf16)f2bf(bfhi(uw[mt].y) - av[mt][3]); }
            const bf16x8 fV0 = *(const LAS bf16x8*)(Vtp + fo), fV1 = *(const LAS bf16x8*)(Vtp + fo + 32);
#pragma unroll
            for (int mt = 0; mt < 4; ++mt) {
                f32x4 sa = Sacc[mt] * egl;
                sa = __builtin_amdgcn_mfma_f32_16x16x32_bf16(fKD[mt][0], fV0, sa, 0, 0, 0);
                sa = __builtin_amdgcn_mfma_f32_16x16x32_bf16(fKD[mt][1], fV1, sa, 0, 0, 0);
                Sacc[mt] = sa;
                u32x2 sw; sw.x = pk2(sa[0], sa[1]); sw.y = pk2(sa[2], sa[3]);
                *(LAS u32x2*)(Stp + fr * 72 + mt * 16 + fq * 4) = sw; }
#pragma unroll
            for (int mt = 0; mt < 4; ++mt) {
                f32x4 o = __builtin_amdgcn_mfma_f32_16x16x32_bf16(fV0, fQK[mt][0], ov[mt], 0, 0, 0);
                o = __builtin_amdgcn_mfma_f32_16x16x32_bf16(fV1, fQK[mt][1], o, 0, 0, 0);
                u32x2 ow; ow.x = pk2(o[0], o[1]); ow.y = pk2(o[2], o[3]);
                *(u32x2*)(obase + ((size_t)c * CH + mt * 16) * DM) = ow; }
            __syncthreads();
        }
    } else {
        const int lt = tid - 256;
        u32x4 rg[4][10];
#define GDN_ISSUE(k, ch) { const size_t co = (size_t)((ch) < NCH ? (ch) : NCH - 1) * 4096; \
            _Pragma("unroll") for (int h2 = 0; h2 < 2; ++h2) { const int idx = lt + h2 * 256, row = idx >> 3, v = idx & 7; \
                rg[k][0 + h2] = *(const u32x4*)(GM0 + co + row * 64 + v * 8); rg[k][2 + h2] = *(const u32x4*)(GM1 + co + row * 64 + v * 8); \
                rg[k][4 + h2] = *(const u32x4*)(GM2 + co + row * 64 + v * 8); rg[k][6 + h2] = *(const u32x4*)(GM3 + co + row * 64 + v * 8); \
                rg[k][8 + h2] = *(const u32x4*)(GM4 + co + row * 64 + v * 8); } }
#define GDN_COMMIT(k, set) { LAS bf16* sb = OPS + (set) * 5 * 4608; \
            _Pragma("unroll") for (int m = 0; m < 5; ++m) _Pragma("unroll") for (int h2 = 0; h2 < 2; ++h2) { const int idx = lt + h2 * 256, row = idx >> 3, v = idx & 7; \
                *(LAS u32x4*)(sb + m * 4608 + row * 72 + v * 8) = rg[k][m * 2 + h2]; } }
        GDN_ISSUE(0, 0) GDN_ISSUE(1, 1) GDN_ISSUE(2, 2) GDN_ISSUE(3, 3)
        GDN_COMMIT(0, 0)
        __syncthreads();
        for (int c = 0; c < NCH; c += 4) {
            GDN_COMMIT(1, 1) GDN_ISSUE(0, c + 4) __syncthreads();
            GDN_COMMIT(2, 0) GDN_ISSUE(1, c + 5) __syncthreads();
            GDN_COMMIT(3, 1) GDN_ISSUE(2, c + 6) __syncthreads();
            GDN_COMMIT(0, 0) GDN_ISSUE(3, c + 7) __syncthreads();
        }
#undef GDN_ISSUE
#undef GDN_COMMIT
    }
}
DEV void gdn_post(const Params& p, int l, int gw, int NGW, int lane) {
    bf16* MIX = (bf16*)(p.ws + WS_MIX); const bf16* PROJ = (const bf16*)(p.ws + WS_PROJ);
    const f32x4 nw = *((const f32x4*)(p.gnorm_w + (size_t)l * 64) + (lane & 15));
    for (int m = gw; m < MTOK; m += NGW) {
        bf16* op = MIX + (size_t)m * DM + 768 + lane * 4;
        const u32x2 ow = *(const u32x2*)op; const u32x2 zw = *(const u32x2*)(PROJ + (size_t)m * NPROJ + 2816 + lane * 4);
        const float o0 = bflo(ow.x), o1 = bfhi(ow.x), o2 = bflo(ow.y), o3 = bfhi(ow.y);
        float ss = (o0 * o0 + o1 * o1) + (o2 * o2 + o3 * o3);
        ss = red16_sum(ss);
        const float rstd = rsqrtf(ss * (1.0f / 64.0f) + EPS);
        u32x2 r; r.x = pk2(o0 * rstd * nw.x * silu(bflo(zw.x)), o1 * rstd * nw.y * silu(bfhi(zw.x))); r.y = pk2(o2 * rstd * nw.z * silu(bflo(zw.y)), o3 * rstd * nw.w * silu(bfhi(zw.y)));
        *(u32x2*)op = r;
    }
}

#define XB_TMO      128
#define XB_XCNT(j)  (256  + 64 * (j))
#define XB_XSUB(j)  (1280 + 64 * (j))
#define XB_XGEN(j)  (2304 + 64 * (j))
#define XB_TOP      3328
#define XB_TOPGEN   3392
#define XCD_BAR_WORDS 3456
#define XB_SPIN_CAP (1u << 18)

__device__ __forceinline__ unsigned xb_ld(unsigned* p)              { return __hip_atomic_load(p, __ATOMIC_RELAXED, __HIP_MEMORY_SCOPE_AGENT); }
__device__ __forceinline__ unsigned xb_add(unsigned* p, unsigned v) { return __hip_atomic_fetch_add(p, v, __ATOMIC_RELAXED, __HIP_MEMORY_SCOPE_AGENT); }
__device__ __forceinline__ unsigned xb_xcc_id() { return (unsigned)__builtin_amdgcn_s_getreg((3 << 11) | 20) & 0xFu; }
#define XB_SPIN(cond, bar) do { unsigned _sp = 0; while (cond) { __builtin_amdgcn_s_sleep(1); \
    if ((++_sp & 255u) == 0u) { if (xb_ld(&(bar)[XB_TMO])) break; if (_sp > XB_SPIN_CAP) { atomicAdd(&(bar)[XB_TMO], 1u); break; } } } } while (0)

struct XcdBarrier {
    unsigned* bar; unsigned x;
    volatile LAS unsigned* st;
};

__device__ __forceinline__ XcdBarrier xcd_barrier_post(unsigned* bar, volatile LAS unsigned* st) {
    XcdBarrier b; b.bar = bar; b.x = xb_xcc_id(); b.st = st;
    if (threadIdx.x == 0) (void)xb_add(&bar[XB_XCNT(b.x)], 1u);
    return b;
}
__device__ __forceinline__ void xcd_barrier_complete(unsigned* bar, unsigned x, unsigned& nloc, unsigned& nx) {
    const unsigned G = gridDim.x * gridDim.y * gridDim.z;
    unsigned sum, cnt, mine, sp = 0u;
    for (;;) {
        sum = 0u; cnt = 0u; mine = 0u;
#pragma unroll
        for (unsigned j = 0; j < 16; ++j) { const unsigned c = xb_ld(&bar[XB_XCNT(j)]); sum += c; cnt += (c > 0u) ? 1u : 0u; mine = (j == x) ? c : mine; }
        if (sum == G) break;
        __builtin_amdgcn_s_sleep(1);
        if ((++sp & 255u) == 0u) { if (xb_ld(&bar[XB_TMO])) break; if (sp > XB_SPIN_CAP) { atomicAdd(&bar[XB_TMO], 1u); break; } }
    }
    nloc = mine > 0u ? mine : 1u; nx = cnt > 0u ? cnt : 1u;
}

__device__ __forceinline__ void xcd_barrier(const XcdBarrier& b) {
    asm volatile("s_waitcnt vmcnt(0)" ::: "memory");
    __syncthreads();
    if (threadIdx.x == 0) {
        unsigned* bar = b.bar;
        __builtin_amdgcn_s_waitcnt(0);
        unsigned nloc = b.st[0], nx = b.st[1];
        if (nloc == 0u) { xcd_barrier_complete(bar, b.x, nloc, nx); b.st[0] = nloc; b.st[1] = nx; }
        const unsigned old = xb_add(&bar[XB_XSUB(b.x)], 1u);
        const unsigned gen = old / nloc;
        if (old + 1u == (gen + 1u) * nloc) {
            __builtin_amdgcn_fence(__ATOMIC_RELEASE, "agent");
            asm volatile("s_waitcnt vmcnt(0)" ::: "memory");
            const unsigned og = xb_add(&bar[XB_TOP], 1u);
            const unsigned tg = og / nx;
            if (og + 1u == (tg + 1u) * nx) xb_add(&bar[XB_TOPGEN], 1u);
            else XB_SPIN(xb_ld(&bar[XB_TOPGEN]) == tg, bar);
            __builtin_amdgcn_fence(__ATOMIC_ACQUIRE, "agent");
            xb_add(&bar[XB_XGEN(b.x)], 1u);
            asm volatile("s_waitcnt vmcnt(0)" ::: "memory");
        } else {
            XB_SPIN(xb_ld(&bar[XB_XGEN(b.x)]) == gen, bar);
            __builtin_amdgcn_fence(__ATOMIC_ACQUIRE, "agent");
            asm volatile("s_waitcnt vmcnt(0)" ::: "memory");
        }
    }
    __syncthreads();
}
__global__ void __launch_bounds__(512, 2) fwd_megakernel(Params p) {
    extern __shared__ __attribute__((aligned(16))) unsigned char lds_raw[];
    cg::grid_group grid = cg::this_grid();
    LAS unsigned char* lds = (LAS unsigned char*)lds_raw;
    const int tid = threadIdx.x, lane = tid & 63, wave = __builtin_amdgcn_readfirstlane(tid >> 6);
    const int G = gridDim.x, bx = blockIdx.x, gw = bx * 8 + wave, NGW = G * 8;
    bf16* XN = (bf16*)(p.ws + WS_XN); float* SMALL = (float*)(p.ws + WS_SMALL); bf16* TMP = (bf16*)(p.ws + WS_TMP);
    bf16* PROJ = (bf16*)(p.ws + WS_PROJ); bf16* MIX = (bf16*)(p.ws + WS_MIX); bf16* HB = (bf16*)(p.ws + WS_H);
    LAS float* wsT = (LAS float*)(lds + 69632);
    volatile LAS unsigned* misc = (volatile LAS unsigned*)(lds + 147200);
    if (tid < 4) misc[tid] = 0u;
    __syncthreads();
    XcdBarrier xbar = xcd_barrier_post((unsigned*)p.ws, misc);
#define GSYNC() xcd_barrier(xbar)

#define PHASE_IDS() int tidp = threadIdx.x; int lq = l; asm volatile("" : "+v"(tidp), "+s"(lq)); const int lanep = tidp & 63; const int wavep = __builtin_amdgcn_readfirstlane(tidp >> 6); const int gwp = bx * 8 + wavep; (void)lanep; (void)gwp; (void)lq
#pragma unroll 1
    for (int l = 0; l < DEPTH; ++l) {
        {
            PHASE_IDS();
            convert_weights(p, lq, lds, gwp, NGW, wavep, lanep);
            if (lq == 0) {
                stage_small(p, 0, wsT, tidp);
                __syncthreads();
                rowpass<0>(p.x, nullptr, nullptr, p.pre_mix, nullptr, XN, SMALL, wsT, gwp, NGW, lanep);
            }
        }
        if (l == 0) grid.sync(); else GSYNC();
#ifdef REP_SYNC
        for (int rep = 0; rep < REP_SYNC; ++rep) GSYNC();
#endif
        {
            pg8::Gemm g{XN, (const bf16*)(p.ws + WS_WIN), MTOK, NPROJ, DM}; pg8::StaticOrder S; S.init(MTOK, NPROJ, G, bx);
            pg8::EpiStoreBf16 E{PROJ, NPROJ};
            for (int rg_ = 0; rg_ < REP_GEMM; ++rg_) { if (rg_) GSYNC(); pg8::gemm_phase<pg8::EpiStoreBf16, pg8::StaticOrder, true, true>(lds, g, S, E); }
        }
        GSYNC();
        {
            PHASE_IDS();
            for (int rep = 0; rep < REP_C; ++rep) { if (rep) GSYNC();
            GdnPF pf; if (bx < 1024) gdn_pre_issue(p, bx, tidp, pf);
            for (int u = bx; u < 1024; u += G) gdn_pre_unit(p, lq, u, (u + G < 1024) ? u + G : -1, lds, tidp, pf); }
        }
        GSYNC();
        {
            PHASE_IDS();
            for (int rep = 0; rep < REP_D; ++rep) { if (rep) GSYNC();
            if (bx < 32) { for (int r2 = 0; r2 < REP_DS; ++r2) gdn_scan_block(p, bx, lds, tidp); }
            else { for (int u = bx - 32; u < 1024; u += G - 32) { if (u < 512) { for (int r2 = 0; r2 < REP_P1; ++r2) ssd_p1_unit(p, lq, u, lds, tidp); } else { for (int r2 = 0; r2 < REP_ATT; ++r2) attn_unit(p, lq, u - 512, lds, tidp); } } } }
        }
        GSYNC();
        {
            PHASE_IDS();
            for (int vb = bx; vb < 256; vb += G) ssd_scan_all(p, vb, lds, tidp);
            gdn_post(p, lq, gwp, NGW, lanep);
        }
        GSYNC();
        {
            PHASE_IDS();
            for (int rep = 0; rep < REP_E; ++rep) {
                if (rep) GSYNC();
                for (int u = bx; u < 512; u += G) ssd_p3_unit(p, lq, u, lds, tidp);
            }
        }
        GSYNC();
        {
            pg8::Gemm g{MIX, (const bf16*)(p.ws + WS_WOUT), MTOK, DM, DM}; pg8::StaticOrder S; S.init(MTOK, DM, G, bx);
            pg8::EpiStoreBf16 E{TMP, DM};
            for (int rg_ = 0; rg_ < REP_GEMM; ++rg_) { if (rg_) GSYNC(); pg8::gemm_phase<pg8::EpiStoreBf16, pg8::StaticOrder, true, true>(lds, g, S, E); }
        }
        GSYNC();
        {
            PHASE_IDS();
            rowpass<1, false, true>(lq == 0 ? p.x : p.out, TMP, p.post_mix + (size_t)lq * DM, p.pre_ffn + (size_t)lq * DM, p.ws + WS_X1, XN, nullptr, wsT, gwp, NGW, lanep);
        }
        GSYNC();
        {
            pg8::Gemm g{XN, (const bf16*)(p.ws + WS_WGU), MTOK, 2 * FF, DM}; pg8::StaticOrder S; S.init(MTOK, 2 * FF, G, bx);
            pg8::EpiSwiGLU E{HB, FF};
            for (int rg_ = 0; rg_ < REP_GEMM; ++rg_) { if (rg_) GSYNC(); pg8::gemm_phase<pg8::EpiSwiGLU, pg8::StaticOrder, true, true>(lds, g, S, E); }
        }
        GSYNC();
        {
            pg8::Gemm g{HB, (const bf16*)(p.ws + WS_WDN), MTOK, DM, FF}; pg8::StaticOrder S; S.init(MTOK, DM, G, bx);
            pg8::EpiStoreBf16 E{TMP, DM};
            for (int rg_ = 0; rg_ < REP_GEMM; ++rg_) { if (rg_) GSYNC(); pg8::gemm_phase<pg8::EpiStoreBf16, pg8::StaticOrder, true, true>(lds, g, S, E); }
        }
        GSYNC();
        {
            PHASE_IDS();
            if (lq + 1 < DEPTH) {
                stage_small(p, lq + 1, wsT, tidp);
                __syncthreads();
                rowpass<2, true, false>(p.ws + WS_X1, TMP, p.post_ffn + (size_t)lq * DM, p.pre_mix + (size_t)(lq + 1) * DM, p.out, XN, SMALL, wsT, gwp, NGW, lanep);
                __syncthreads();
            } else {
                rowpass<3, true, false>(p.ws + WS_X1, TMP, p.post_ffn + (size_t)lq * DM, nullptr, p.out, nullptr, nullptr, wsT, gwp, NGW, lanep);
            }
        }
    }
}

extern "C" void kernel_launch(void* const* d_in, const int* in_sizes, int n_in, void* d_out, int out_size, void* d_ws, size_t ws_size, hipStream_t stream) {
    static int grid = 0;
    if (grid == 0) {
        if (n_in != 21 || out_size != MTOK * DM || ws_size < WS_END) { fprintf(stderr, "kernel_launch: unexpected shapes (n_in %d out %d ws %zu)\n", n_in, out_size, ws_size); grid = -1; return; }
        int dev = 0, cus = 0, per_cu = 0;
        hipGetDevice(&dev); hipDeviceGetAttribute(&cus, hipDeviceAttributeMultiprocessorCount, dev);
        if (hipFuncSetAttribute((const void*)fwd_megakernel, hipFuncAttributeMaxDynamicSharedMemorySize, LDS_BYTES) != hipSuccess) { fprintf(stderr, "kernel_launch: hipFuncSetAttribute failed\n"); grid = -1; return; }
        hipOccupancyMaxActiveBlocksPerMultiprocessor(&per_cu, (const void*)fwd_megakernel, 512, LDS_BYTES);
        if (per_cu < 1) { fprintf(stderr, "kernel_launch: occupancy query says %d blocks per CU\n", per_cu); per_cu = 1; }
        (void)hipGetLastError();
        grid = cus;
    }
    if (grid < 0) return;
    if (hipMemsetAsync(d_ws, 0, 16384, stream) != hipSuccess) { fprintf(stderr, "kernel_launch: memset of the barrier words failed\n"); return; }
    Params p{};
    const float** pp = (const float**)&p;
    for (int i = 0; i < 21; ++i) pp[i] = (const float*)d_in[i];
    p.out = (float*)d_out; p.ws = (unsigned char*)d_ws;
    void* args[] = {&p};
    hipError_t e = hipLaunchCooperativeKernel((const void*)fwd_megakernel, dim3(grid), dim3(512), args, LDS_BYTES, stream);
    if (e != hipSuccess) fprintf(stderr, "cooperative launch failed: %s (grid %d)\n", hipGetErrorString(e), grid);
}
```

```cpp
#include <hip/hip_runtime.h>
#include <hip/hip_cooperative_groups.h>
#include <cstdio>
#include <cstdint>
namespace cg = cooperative_groups;
namespace pg8 {
#define PG8_LAS __attribute__((address_space(3)))
typedef unsigned short bf16_t;
typedef short bf16x8 __attribute__((ext_vector_type(8)));
typedef float f32x4 __attribute__((ext_vector_type(4)));
typedef unsigned u32x4 __attribute__((ext_vector_type(4)));
constexpr int BM = 256, BK = 64, HALF = 128, HTB = HALF * BK * 2  , STAGE_BYTES = 8 * HTB, NXCD = 8, WGM = 8;

__host__ __device__ __forceinline__ int lds_byte(int r, int c) { const int st = (r >> 4) * 2 + (c >> 5), rr = r & 15, cc = c & 31, ob = rr * 64 + cc * 2; return st * 1024 + (ob ^ (((ob >> 9) & 1) << 5)); }
__host__ __device__ __forceinline__ void stage_rc(int b, int& R, int& C) { const int st = b / 1024, sb = b % 1024, swz = sb ^ (((sb >> 9) & 1) << 5); R = (st >> 1) * 16 + swz / 64; C = (st & 1) * 32 + (swz % 64) / 2; }
__host__ __device__ __forceinline__ int perm32(int rho) { const int n = rho >> 4, i = rho & 15; return 8 * (i >> 2) + 4 * n + (i & 3); }

struct Unit { int pm, pn; };
struct Gemm { const bf16_t* A; const bf16_t* Bt; int M, N, K; };

struct StaticOrder {
    int nM, nN, nwg, G, c;
    __host__ __device__ void init(int M, int N, int G_, int c_) { nM = M / BM; nN = N / BM; nwg = nM * nN; G = G_; c = c_; }
    __host__ __device__ bool next(int i, Unit& u) const {
        const long L = (long)i * G + c; if (L >= nwg) return false;
        int wgid = (int)L; { const int q = nwg / NXCD, r = nwg % NXCD, xcd = wgid % NXCD, off = wgid / NXCD; wgid = (xcd < r ? xcd * (q + 1) : r * (q + 1) + (xcd - r) * q) + off; }
        const int nig = WGM * nN, gid = wgid / nig, fm = gid * WGM, gsz = (nM - fm) < WGM ? (nM - fm) : WGM;
        u.pm = fm + ((wgid % nig) % gsz); u.pn = (wgid % nig) / gsz; return true;
    }
    __device__ __forceinline__ void a_ready(const Unit&) const {}
    __device__ __forceinline__ void done(const Unit&) const {}
};

typedef float f32x2c __attribute__((ext_vector_type(2))); typedef __bf16 bf16x2c __attribute__((ext_vector_type(2)));
__device__ __forceinline__ unsigned cvt_pk_bf16(float lo, float hi) { const f32x2c v = {lo, hi}; const bf16x2c b = __builtin_convertvector(v, bf16x2c); return __builtin_bit_cast(unsigned, b); }
typedef float f32x2 __attribute__((ext_vector_type(2)));
typedef unsigned u32x2 __attribute__((ext_vector_type(2)));
__device__ __forceinline__ float silu_f(float x) { return x * __builtin_amdgcn_rcpf(1.0f + __expf(-x)); }
struct EpiStoreBf16 {
    static constexpr bool PERM = true, AFTER_DRAIN = false;
    bf16_t* O; int ldc;
    __device__ __forceinline__ void operator()(const f32x4 (&acc)[2][2][4][2], const Unit& u, int wr, int wc, int fr, int fq) const {
        const int row0 = u.pm * BM + wr * 64 + fr, col0 = u.pn * BM + wc * 32 + 8 * fq;
#pragma unroll
        for (int ai = 0; ai < 2; ++ai)
#pragma unroll
            for (int m = 0; m < 4; ++m) { bf16_t* rowp = O + (size_t)(row0 + ai * HALF + m * 16) * ldc + col0;
#pragma unroll
                for (int bj = 0; bj < 2; ++bj) { const f32x4 v0 = acc[ai][bj][m][0], v1 = acc[ai][bj][m][1];
                    u32x4 w; w.x = cvt_pk_bf16(v0[0], v0[1]); w.y = cvt_pk_bf16(v0[2], v0[3]); w.z = cvt_pk_bf16(v1[0], v1[1]); w.w = cvt_pk_bf16(v1[2], v1[3]);
                    *(u32x4*)(rowp + bj * HALF) = w; } }
    }
};
struct EpiStoreF32 {
    static constexpr bool PERM = true, AFTER_DRAIN = false;
    float* O; int ldc;
    __device__ __forceinline__ void operator()(const f32x4 (&acc)[2][2][4][2], const Unit& u, int wr, int wc, int fr, int fq) const {
        const int row0 = u.pm * BM + wr * 64 + fr, col0 = u.pn * BM + wc * 32 + 8 * fq;
#pragma unroll
        for (int ai = 0; ai < 2; ++ai)
#pragma unroll
            for (int m = 0; m < 4; ++m) { float* rowp = O + (size_t)(row0 + ai * HALF + m * 16) * ldc + col0;
#pragma unroll
                for (int bj = 0; bj < 2; ++bj) { *(f32x4*)(rowp + bj * HALF) = acc[ai][bj][m][0]; *(f32x4*)(rowp + bj * HALF + 4) = acc[ai][bj][m][1]; } }
    }
};
struct EpiSwiGLU {
    static constexpr bool PERM = true, AFTER_DRAIN = false;
    bf16_t* H; int ldh;
    __device__ __forceinline__ void operator()(const f32x4 (&acc)[2][2][4][2], const Unit& u, int wr, int wc, int fr, int fq) const {
        const int row0 = u.pm * BM + wr * 64 + fr, col0 = u.pn * (BM / 2) + wc * 16 + 4 * fq;
#pragma unroll
        for (int ai = 0; ai < 2; ++ai)
#pragma unroll
            for (int m = 0; m < 4; ++m) { bf16_t* rowp = H + (size_t)(row0 + ai * HALF + m * 16) * ldh + col0;
#pragma unroll
                for (int bj = 0; bj < 2; ++bj) { const f32x4 v0 = acc[ai][bj][m][0], v1 = acc[ai][bj][m][1];
                    u32x2 w; w.x = cvt_pk_bf16(silu_f(v0[0]) * v0[1], silu_f(v0[2]) * v0[3]); w.y = cvt_pk_bf16(silu_f(v1[0]) * v1[1], silu_f(v1[2]) * v1[3]);
                    *(u32x2*)(rowp + bj * (HALF / 2)) = w; } }
    }
};
template <class Epi, class Sched, bool ALIGN_EPI = false, bool SP2 = false>
__device__ __forceinline__ void gemm_phase(PG8_LAS unsigned char* lds, const Gemm g, const Sched& S, const Epi& E) {
    int tid_l = threadIdx.x; asm volatile("" : "+v"(tid_l));
    const int tid = tid_l, wid = __builtin_amdgcn_readfirstlane(tid >> 6), lane = tid & 63, wr = wid >> 2, wc = wid & 3, fr = lane & 15, fq = lane >> 4;
    const int K = g.K, nt = K / BK;
    unsigned voffA[2], voffB[2];
#pragma unroll
    for (int i = 0; i < 2; ++i) { int R, C; stage_rc(tid * 16 + i * 8192, R, C); const int Rb = Epi::PERM ? ((R & ~31) + perm32(R & 31)) : R;
        voffA[i] = (unsigned)(R * K + C) * 2u; voffB[i] = (unsigned)(Rb * K + C) * 2u; }
    const size_t kstep = (size_t)(BK * 2);
    const size_t hstep = (size_t)HALF * K * 2;
    const size_t tstep = 2 * hstep;
    const unsigned ldsw = (unsigned)wid * 1024u;
    const int aoff = lds_byte(wr * 64 + fr, fq * 8), boff = lds_byte(wc * 32 + fr, fq * 8);
#define PG8_SA(b, h) (((b) * 2 + (h)) * HTB)
#define PG8_SB(b, h) ((4 + (b) * 2 + (h)) * HTB)
#define PG8_STAGE(bufoff, gbase, voff) do { _Pragma("unroll") for (int _i = 0; _i < 2; ++_i) \
        __builtin_amdgcn_global_load_lds((const unsigned*)((const char*)(gbase) + (voff)[_i]), (PG8_LAS unsigned*)(lds + (bufoff) + ldsw + _i * 8192), 16, 0, 0); } while (0)
#define PG8_LDA(dst, b, h) do { _Pragma("unroll") for (int m = 0; m < 4; ++m) _Pragma("unroll") for (int k = 0; k < 2; ++k) dst[m][k] = *(const PG8_LAS bf16x8*)(lds + PG8_SA(b, h) + aoff + m * 2048 + k * 1024); } while (0)
#define PG8_LDB(dst, b, h) do { _Pragma("unroll") for (int n = 0; n < 2; ++n) _Pragma("unroll") for (int k = 0; k < 2; ++k) dst[n][k] = *(const PG8_LAS bf16x8*)(lds + PG8_SB(b, h) + boff + n * 2048 + k * 1024); } while (0)
#define PG8_MMA(ai, bj, At, Bt) do { __builtin_amdgcn_s_setprio(1); _Pragma("unroll") for (int m = 0; m < 4; ++m) _Pragma("unroll") for (int n = 0; n < 2; ++n) _Pragma("unroll") for (int k = 0; k < 2; ++k) \
        acc[ai][bj][m][n] = __builtin_amdgcn_mfma_f32_16x16x32_bf16(Bt[n][k], At[m][k], acc[ai][bj][m][n], 0, 0, 0); __builtin_amdgcn_s_setprio(0); } while (0)
#define PG8_WAIT_V(n) asm volatile("s_waitcnt vmcnt(" #n ")" ::: "memory")
#define PG8_WAIT_L(n) asm volatile("s_waitcnt lgkmcnt(" #n ")" ::: "memory")
#define PG8_BAR __builtin_amdgcn_s_barrier()
#define PG8_SCHED __builtin_amdgcn_sched_barrier(0)
    Unit cur, nxt; int ui = 0;
    if (!S.next(0, cur)) return;
    f32x4 acc[2][2][4][2];
#pragma unroll
    for (int a = 0; a < 2; ++a)
#pragma unroll
        for (int b = 0; b < 2; ++b)
#pragma unroll
            for (int m = 0; m < 4; ++m)
#pragma unroll
                for (int n = 0; n < 2; ++n) acc[a][b][m][n] = (f32x4){0.f, 0.f, 0.f, 0.f};
    bf16x8 At[4][2], B0[2][2], B1[2][2];
    const char* cA = (const char*)g.A + (size_t)cur.pm * tstep; const char* cB = (const char*)g.Bt + (size_t)cur.pn * tstep;
    S.a_ready(cur);
    if constexpr (SP2) {
        PG8_STAGE(PG8_SB(0, 0), cB, voffB); PG8_STAGE(PG8_SB(0, 1), cB + hstep, voffB); PG8_STAGE(PG8_SA(0, 0), cA, voffA); PG8_STAGE(PG8_SA(0, 1), cA + hstep, voffA);
        if (wr == 1) PG8_BAR;
        PG8_WAIT_V(2); PG8_BAR;
        PG8_STAGE(PG8_SB(1, 0), cB + kstep, voffB); PG8_STAGE(PG8_SA(1, 0), cA + kstep, voffA); PG8_STAGE(PG8_SB(1, 1), cB + hstep + kstep, voffB);
        PG8_WAIT_V(6); PG8_BAR;
    } else {
        PG8_STAGE(PG8_SB(0, 0), cB, voffB); PG8_STAGE(PG8_SA(0, 0), cA, voffA); PG8_STAGE(PG8_SB(0, 1), cB + hstep, voffB); PG8_STAGE(PG8_SA(0, 1), cA + hstep, voffA);
        if (wr == 1) PG8_BAR;
        PG8_WAIT_V(4); PG8_BAR;
        PG8_STAGE(PG8_SB(1, 0), cB + kstep, voffB); PG8_STAGE(PG8_SA(1, 0), cA + kstep, voffA); PG8_STAGE(PG8_SB(1, 1), cB + hstep + kstep, voffB);
        PG8_WAIT_V(6); PG8_BAR;
    }
    for (;;) {
        const bool has_next = S.next(ui + 1, nxt);
        const char* nA = has_next ? (const char*)g.A + (size_t)nxt.pm * tstep : cA; const char* nB = has_next ? (const char*)g.Bt + (size_t)nxt.pn * tstep : cB;
        for (int t = 0; t < nt; t += 2) {
            const bool last = (t == nt - 2);
            const char* a1 = cA + (size_t)(t + 1) * kstep;
            const char* a2 = last ? nA : cA + (size_t)(t + 2) * kstep; const char* b2 = last ? nB : cB + (size_t)(t + 2) * kstep;
            const char* a3 = a2 + kstep; const char* b3 = b2 + kstep;
            if (last && has_next) S.a_ready(nxt);
            if constexpr (SP2) {
            PG8_LDB(B0, 0, 0); PG8_LDB(B1, 0, 1); PG8_SCHED; PG8_LDA(At, 0, 0); PG8_STAGE(PG8_SA(1, 1), a1 + hstep, voffA);
            PG8_WAIT_V(8); PG8_WAIT_L(0); PG8_BAR; PG8_MMA(0, 0, At, B0); PG8_MMA(0, 1, At, B1); PG8_BAR; PG8_SCHED;
            PG8_LDA(At, 0, 1); PG8_STAGE(PG8_SB(0, 0), b2, voffB); PG8_STAGE(PG8_SB(0, 1), b2 + hstep, voffB); PG8_STAGE(PG8_SA(0, 0), a2, voffA);
            PG8_WAIT_V(8); PG8_WAIT_L(0); PG8_BAR; PG8_MMA(1, 0, At, B0); PG8_MMA(1, 1, At, B1); PG8_BAR; PG8_SCHED;
            PG8_LDB(B0, 1, 0); PG8_LDB(B1, 1, 1); PG8_SCHED; PG8_LDA(At, 1, 0); PG8_STAGE(PG8_SA(0, 1), a2 + hstep, voffA);
            PG8_WAIT_V(8); PG8_WAIT_L(0); PG8_BAR; PG8_MMA(0, 0, At, B0); PG8_MMA(0, 1, At, B1); PG8_BAR; PG8_SCHED;
            PG8_LDA(At, 1, 1); PG8_STAGE(PG8_SB(1, 0), b3, voffB); PG8_STAGE(PG8_SB(1, 1), b3 + hstep, voffB); PG8_STAGE(PG8_SA(1, 0), a3, voffA);
            PG8_WAIT_V(8); PG8_WAIT_L(0); PG8_BAR; PG8_MMA(1, 0, At, B0); PG8_MMA(1, 1, At, B1); PG8_BAR; PG8_SCHED;
            } else {
            PG8_LDB(B0, 0, 0); PG8_SCHED; PG8_LDA(At, 0, 0); PG8_STAGE(PG8_SA(1, 1), a1 + hstep, voffA);
            PG8_WAIT_L(8); PG8_BAR; PG8_WAIT_L(0); PG8_MMA(0, 0, At, B0); PG8_BAR; PG8_SCHED;
            PG8_LDB(B1, 0, 1); PG8_STAGE(PG8_SB(0, 0), b2, voffB);
            PG8_BAR; PG8_WAIT_L(0); PG8_MMA(0, 1, At, B1); PG8_BAR;
            PG8_LDA(At, 0, 1); PG8_STAGE(PG8_SA(0, 0), a2, voffA);
            PG8_BAR; PG8_WAIT_L(0); PG8_MMA(1, 0, At, B0); PG8_BAR; PG8_SCHED;
            PG8_STAGE(PG8_SB(0, 1), b2 + hstep, voffB);
            PG8_WAIT_V(6); PG8_BAR; PG8_MMA(1, 1, At, B1); PG8_BAR;
            PG8_LDB(B0, 1, 0); PG8_SCHED; PG8_LDA(At, 1, 0); PG8_STAGE(PG8_SA(0, 1), a2 + hstep, voffA);
            PG8_WAIT_L(8); PG8_BAR; PG8_WAIT_L(0); PG8_MMA(0, 0, At, B0); PG8_BAR; PG8_SCHED;
            PG8_LDB(B1, 1, 1); PG8_STAGE(PG8_SB(1, 0), b3, voffB);
            PG8_BAR; PG8_WAIT_L(0); PG8_MMA(0, 1, At, B1); PG8_BAR;
            PG8_LDA(At, 1, 1); PG8_STAGE(PG8_SA(1, 0), a3, voffA);
            PG8_BAR; PG8_WAIT_L(0); PG8_MMA(1, 0, At, B0); PG8_BAR; PG8_SCHED;
            PG8_STAGE(PG8_SB(1, 1), b3 + hstep, voffB);
            PG8_WAIT_V(6); PG8_BAR; PG8_MMA(1, 1, At, B1); PG8_BAR;
            }
        }
        if constexpr (ALIGN_EPI) { if (wr == 0) PG8_BAR; }
        if constexpr (!Epi::AFTER_DRAIN) { E(acc, cur, wr, wc, fr, fq); S.done(cur); }
        if (!has_next) break;
#pragma unroll
        for (int a = 0; a < 2; ++a)
#pragma unroll
            for (int b = 0; b < 2; ++b)
#pragma unroll
                for (int m = 0; m < 4; ++m)
#pragma unroll
                    for (int n = 0; n < 2; ++n) acc[a][b][m][n] = (f32x4){0.f, 0.f, 0.f, 0.f};
        cur = nxt; cA = nA; cB = nB; ++ui;
        if constexpr (ALIGN_EPI) { if (wr == 1) PG8_BAR; }
    }
    PG8_WAIT_V(0);
    if constexpr (!ALIGN_EPI) { if (wr == 0) PG8_BAR; }
    PG8_BAR;
    if constexpr (Epi::AFTER_DRAIN) { E.fused(acc, cur, wr, wc, fr, fq, lds, wid, lane); S.done(cur); }
#undef PG8_SA
#undef PG8_SB
#undef PG8_STAGE
#undef PG8_LDA
#undef PG8_LDB
#undef PG8_MMA
#undef PG8_WAIT_V
#undef PG8_WAIT_L
#undef PG8_BAR
#undef PG8_SCHED
}
}
constexpr int BATCH = 4, SEQ = 4096, DM = 1024, NCH = 64, CH = 64, MTOK = BATCH * SEQ, DEPTH = 2;
constexpr int NPROJ = 3072, IN_COLS = 3088, FF = 2816;
constexpr float EPS = 1e-6f;
constexpr size_t MiB = 1u << 20;
constexpr size_t WS_SMALL = 1 * MiB, WS_ACS = 2 * MiB, WS_CDEC = 2 * MiB + 512 * 1024, WS_EGL = 2 * MiB + 768 * 1024;
constexpr size_t WS_WIN = 3 * MiB, WS_WOUT = 9 * MiB, WS_WGU = 11 * MiB, WS_WDN = 22 * MiB;
constexpr size_t WS_XN = 28 * MiB;
constexpr size_t WS_GU = 28 * MiB, WS_GW = 36 * MiB, WS_GQE = 44 * MiB, WS_GQK = 52 * MiB, WS_GKDT = 244 * MiB;
constexpr size_t WS_PROJ = 60 * MiB, WS_H = 60 * MiB;
constexpr size_t WS_MIX = 156 * MiB;
constexpr size_t WS_STATES = 188 * MiB, WS_YPART = 220 * MiB, WS_CCONV = 236 * MiB, WS_TMP = 188 * MiB;
constexpr size_t WS_X1 = 220 * MiB;
constexpr size_t WS_END = 252 * MiB;
constexpr int LDS_BYTES = 147456;
#ifndef REP_C
#define REP_C 1
#endif
#ifndef REP_P1
#define REP_P1 1
#endif
#ifndef REP_DS
#define REP_DS 1
#endif
#ifndef RP3_MMA
#define RP3_MMA 1
#endif
#ifndef REP_GEMM
#define REP_GEMM 1
#endif
#ifndef REP_ATT
#define REP_ATT 1
#endif
#ifndef RG_CONV
#define RG_CONV 1
#endif
#ifndef RG_KK
#define RG_KK 1
#endif
#ifndef RG_SOLVE
#define RG_SOLVE 1
#endif
#ifndef REP_C1
#define REP_C1 1
#endif
#ifndef REP_C2
#define REP_C2 1
#endif
#ifndef REP_D
#define REP_D 1
#endif
#ifndef REP_E
#define REP_E 1
#endif

#define LAS __attribute__((address_space(3)))
#define DEV __device__ __forceinline__
typedef unsigned short bf16;
typedef short bf16x8 __attribute__((ext_vector_type(8)));
typedef float f32x4 __attribute__((ext_vector_type(4)));
typedef unsigned u32x4 __attribute__((ext_vector_type(4)));
typedef unsigned u32x2 __attribute__((ext_vector_type(2)));

typedef float f32x2_t __attribute__((ext_vector_type(2)));
typedef __bf16 bf16x2_t __attribute__((ext_vector_type(2)));
DEV unsigned pk2(float lo, float hi) { const f32x2_t v = {lo, hi}; const bf16x2_t b = __builtin_convertvector(v, bf16x2_t); return __builtin_bit_cast(unsigned, b); }
DEV unsigned f2bf(float f) { return pk2(f, 0.f) & 0xffffu; }
DEV float bf2f(unsigned b) { return __builtin_bit_cast(float, b << 16); }
DEV float bflo(unsigned w) { return __builtin_bit_cast(float, w << 16); }
DEV float bfhi(unsigned w) { return __builtin_bit_cast(float, w & 0xffff0000u); }
DEV float silu(float x) { return x * __builtin_amdgcn_rcpf(1.0f + __expf(-x)); }
DEV float softplus(float x) { return fmaxf(x, 0.f) + log1pf(expf(-fabsf(x))); }
template <int CTRL> DEV float dpp_f(float v) { return __builtin_bit_cast(float, __builtin_amdgcn_update_dpp(0, __builtin_bit_cast(int, v), CTRL, 0xF, 0xF, true)); }
DEV float red4_sum(float v) { v += dpp_f<0xB1>(v); v += dpp_f<0x4E>(v); return v; }
DEV float red8_sum(float v) { v = red4_sum(v); v += dpp_f<0x141>(v); return v; }
DEV float red16_sum(float v) { v = red8_sum(v); v += dpp_f<0x140>(v); return v; }
DEV float red16_max(float v) { v = fmaxf(v, dpp_f<0xB1>(v)); v = fmaxf(v, dpp_f<0x4E>(v)); v = fmaxf(v, dpp_f<0x141>(v)); v = fmaxf(v, dpp_f<0x140>(v)); return v; }
DEV float rdlane(float v, int l) { return __builtin_bit_cast(float, __builtin_amdgcn_readlane(__builtin_bit_cast(int, v), l)); }
DEV float wave_sum(float v) { v = red16_sum(v); return (rdlane(v, 0) + rdlane(v, 16)) + (rdlane(v, 32) + rdlane(v, 48)); }
DEV float wave_incl_scan(float v, int lane) {
    v += dpp_f<0x111>(v); v += dpp_f<0x112>(v); v += dpp_f<0x114>(v); v += dpp_f<0x118>(v);
    const float t0 = rdlane(v, 15), t1 = rdlane(v, 31), t2 = rdlane(v, 47);
    const int r = lane >> 4;
    return v + (r > 0 ? t0 : 0.f) + (r > 1 ? t1 : 0.f) + (r > 2 ? t2 : 0.f);
}
DEV float frcp(float x) { return __builtin_amdgcn_rcpf(x); }
DEV f32x4 mma_tile(const LAS bf16* A, int lda, const LAS bf16* B, int ldb, int K, int lane, f32x4 acc) {
    const LAS bf16* ap = A + (lane & 15) * lda + (lane >> 4) * 8;
    const LAS bf16* bp = B + (lane & 15) * ldb + (lane >> 4) * 8;
    for (int k = 0; k < K; k += 32) {
        const bf16x8 a = *(const LAS bf16x8*)(ap + k), b = *(const LAS bf16x8*)(bp + k);
        acc = __builtin_amdgcn_mfma_f32_16x16x32_bf16(a, b, acc, 0, 0, 0);
    }
    return acc;
}

struct Params {
    const float *x, *pre_mix, *post_mix, *pre_ffn, *post_ffn, *w_in, *w_out, *sinks, *sconv_w, *sconv_b, *sdt_bias, *sA_log, *sD, *snorm_w,
                *gconv_w, *gdt_bias, *gA_log, *gnorm_w, *w_gate, *w_up, *w_down;
    float* out; unsigned char* ws;
};

DEV void tr_item(const float* W, int ldw, int col0, bf16* WT, int K, int drow0, int rs, LAS float* scr, int kb, int nb, int lane) {
    const int k0 = 64 * kb, n0 = 32 * nb;
    float wv[32];
#pragma unroll
    for (int i = 0; i < 32; ++i) { const int kk = 2 * i + (lane >> 5); wv[i] = W[(size_t)(k0 + kk) * ldw + col0 + n0 + (lane & 31)]; }
#pragma unroll
    for (int i = 0; i < 32; ++i) { const int kk = 2 * i + (lane >> 5); scr[kk * 33 + (lane & 31)] = wv[i]; }
    asm volatile("s_waitcnt lgkmcnt(0)" ::: "memory");
    const int c = lane & 7;
#pragma unroll
    for (int j = 0; j < 4; ++j) { const int n = (lane >> 3) + 8 * j; const LAS float* s = scr + (8 * c) * 33 + n;
        u32x4 o; o.x = pk2(s[0 * 33], s[1 * 33]); o.y = pk2(s[2 * 33], s[3 * 33]); o.z = pk2(s[4 * 33], s[5 * 33]); o.w = pk2(s[6 * 33], s[7 * 33]);
        *(u32x4*)(WT + (size_t)(drow0 + (n0 + n) * rs) * K + k0 + 8 * c) = o; }
    asm volatile("s_waitcnt lgkmcnt(0)" ::: "memory");
}
DEV void convert_weights(const Params& p, int l, LAS unsigned char* lds, int gw, int NGW, int wave, int lane) {
    LAS float* scr = (LAS float*)(lds + wave * 8448);
    const float* win = p.w_in + (size_t)l * DM * IN_COLS; const float* wout = p.w_out + (size_t)l * DM * DM;
    const float* wg = p.w_gate + (size_t)l * DM * FF; const float* wu = p.w_up + (size_t)l * DM * FF; const float* wd = p.w_down + (size_t)l * FF * DM;
    bf16* WIN = (bf16*)(p.ws + WS_WIN); bf16* WOUT = (bf16*)(p.ws + WS_WOUT); bf16* WGU = (bf16*)(p.ws + WS_WGU); bf16* WDN = (bf16*)(p.ws + WS_WDN);
    constexpr int I_IN = 16 * 96, I_OUT = 16 * 32, I_G = 16 * 88, I_D = 44 * 32;
    constexpr int NIT = I_IN + I_OUT + 2 * I_G + I_D;
    for (int it = gw; it < NIT; it += NGW) {
        int r = it;
        if (r < I_IN) { const int kb = r / 96, nb = r % 96;
            if (nb < 64) tr_item(win, IN_COLS, 0, WIN, DM, 0, 1, scr, kb, nb, lane); else tr_item(win, IN_COLS, 2056, WIN, DM, 2048, 1, scr, kb, nb - 64, lane);
            continue; } r -= I_IN;
        if (r < I_OUT) { tr_item(wout, DM, 0, WOUT, DM, 0, 1, scr, r / 32, r % 32, lane); continue; } r -= I_OUT;
        if (r < I_G) { tr_item(wg, FF, 0, WGU, DM, 0, 2, scr, r / 88, r % 88, lane); continue; } r -= I_G;
        if (r < I_G) { tr_item(wu, FF, 0, WGU, DM, 1, 2, scr, r / 88, r % 88, lane); continue; } r -= I_G;
        tr_item(wd, DM, 0, WDN, FF, 0, 1, scr, r / 32, r % 32, lane);
    }
}
DEV void stage_small(const Params& p, int l, LAS float* wsT, int tid) {
    const float* win = p.w_in + (size_t)l * DM * IN_COLS;
    for (int idx = tid; idx < 16 * DM; idx += 512) { const int k = idx >> 4, c = idx & 15; const int sc = c < 8 ? 2048 + c : 3072 + c; wsT[c * DM + k] = win[(size_t)k * IN_COLS + sc]; }
}
template <int MODE, bool RB = false, bool OB = false>
DEV void rowpass(const void* res_, const bf16* tmp, const float* wpost, const float* wnext, void* xout_, bf16* XN, float* SMALL, const LAS float* wsT, int gw, int NGW, int lane) {
    const float* res = (const float*)res_; const bf16* res16 = (const bf16*)res_; float* xout = (float*)xout_; bf16* xout16 = (bf16*)xout_;
    f32x4 wp[4], wn[4];
#pragma unroll
    for (int j = 0; j < 4; ++j) {
        if (MODE != 0) wp[j] = *((const f32x4*)wpost + lane + 64 * j);
        if (MODE != 3) wn[j] = *((const f32x4*)wnext + lane + 64 * j);
    }
    f32x4 nv[4]; u32x2 nv16[4]; u32x2 ntw[4];
#pragma unroll
    for (int j = 0; j < 4; ++j) { if (RB) nv16[j] = *((const u32x2*)(res16 + (size_t)gw * DM) + lane + 64 * j); else nv[j] = *((const f32x4*)(res + (size_t)gw * DM) + lane + 64 * j);
        if (MODE != 0) ntw[j] = *((const u32x2*)(tmp + (size_t)gw * DM) + lane + 64 * j); }
    for (int m = gw; m < MTOK; m += NGW) {
        f32x4 v[4]; u32x2 ctw[4];
#pragma unroll
        for (int j = 0; j < 4; ++j) { if (RB) v[j] = (f32x4){bflo(nv16[j].x), bfhi(nv16[j].x), bflo(nv16[j].y), bfhi(nv16[j].y)}; else v[j] = nv[j]; if (MODE != 0) ctw[j] = ntw[j]; }
        { const int mn = (m + NGW < MTOK) ? m + NGW : m;
#pragma unroll
            for (int j = 0; j < 4; ++j) { if (RB) nv16[j] = *((const u32x2*)(res16 + (size_t)mn * DM) + lane + 64 * j); else nv[j] = *((const f32x4*)(res + (size_t)mn * DM) + lane + 64 * j);
                if (MODE != 0) ntw[j] = *((const u32x2*)(tmp + (size_t)mn * DM) + lane + 64 * j); } }
        if (MODE != 0) {
            f32x4 t[4]; float ss = 0.f;
#pragma unroll
            for (int j = 0; j < 4; ++j) { const u32x2 tw = ctw[j]; t[j] = (f32x4){bflo(tw.x), bfhi(tw.x), bflo(tw.y), bfhi(tw.y)}; ss += (t[j].x * t[j].x + t[j].y * t[j].y) + (t[j].z * t[j].z + t[j].w * t[j].w); }
            const float rstd = rsqrtf(wave_sum(ss) * (1.0f / DM) + EPS);
#pragma unroll
            for (int j = 0; j < 4; ++j) { v[j] = v[j] + t[j] * rstd * wp[j];
                if (OB) { u32x2 o; o.x = pk2(v[j].x, v[j].y); o.y = pk2(v[j].z, v[j].w); *((u32x2*)(xout16 + (size_t)m * DM) + lane + 64 * j) = o; }
                else *((f32x4*)(xout + (size_t)m * DM) + lane + 64 * j) = v[j]; }
        }
        if (MODE != 3) {
            float ss = 0.f;
#pragma unroll
            for (int j = 0; j < 4; ++j) ss += (v[j].x * v[j].x + v[j].y * v[j].y) + (v[j].z * v[j].z + v[j].w * v[j].w);
            const float rstd = rsqrtf(wave_sum(ss) * (1.0f / DM) + EPS);
#pragma unroll
            for (int j = 0; j < 4; ++j) { v[j] = v[j] * rstd * wn[j];
                u32x2 o; o.x = pk2(v[j].x, v[j].y); o.y = pk2(v[j].z, v[j].w); *((u32x2*)(XN + (size_t)m * DM) + lane + 64 * j) = o; }
            if (MODE == 0 || MODE == 2) {
                float mine = 0.f;
#pragma unroll
                for (int c = 0; c < 16; ++c) { float s = 0.f; asm volatile("" ::: "memory");
#pragma unroll
                    for (int j = 0; j < 4; ++j) { const f32x4 w = *((const LAS f32x4*)(wsT + c * DM) + lane + 64 * j); s += (v[j].x * w.x + v[j].y * w.y) + (v[j].z * w.z + v[j].w * w.w); }
                    s = red16_sum(s); mine = ((lane & 15) == c) ? s : mine; }
                mine += __shfl_xor(mine, 16); mine += __shfl_xor(mine, 32);
                if (lane < 16) SMALL[(size_t)m * 16 + lane] = mine;
            }
        }
    }
}

DEV void attn_unit(const Params& p, int l, int u, LAS unsigned char* lds, int tid) {
    asm volatile("" : "+v"(tid));
    const int b = u >> 7, c = (u >> 1) & 63, kvh = u & 1, wave = tid >> 6, lane = tid & 63;
    const bf16* PROJ = (const bf16*)(p.ws + WS_PROJ); bf16* MIX = (bf16*)(p.ws + WS_MIX);
    LAS bf16* Qs = (LAS bf16*)lds;
    LAS bf16* Ks = Qs + 128 * 72;
    LAS bf16* Vt = Ks + 192 * 72;
    LAS bf16* Ps = Vt + 64 * 200;
    const size_t t0 = (size_t)b * SEQ + (size_t)c * CH;
    {
        u32x4 rq[2], rk[3], rv[3];
#pragma unroll
        for (int k = 0; k < 2; ++k) { const int idx = tid + k * 512, r = idx >> 3, v = idx & 7, g = r >> 6, i = r & 63;
            rq[k] = *(const u32x4*)(PROJ + (t0 + i) * NPROJ + kvh * 128 + g * 64 + v * 8); }
#pragma unroll
        for (int k = 0; k < 3; ++k) { const int idx = tid + k * 512, j = idx >> 3, v = idx & 7; const bool valid = (c - 2 + (j >> 6)) >= 0;
            rk[k] = (u32x4){0u, 0u, 0u, 0u}; rv[k] = rk[k];
            if (valid) { const bf16* rowp = PROJ + (size_t)((long)t0 - 128 + j) * NPROJ; rk[k] = *(const u32x4*)(rowp + 256 + kvh * 64 + v * 8); rv[k] = *(const u32x4*)(rowp + 384 + kvh * 64 + v * 8); } }
#pragma unroll
        for (int k = 0; k < 2; ++k) { const int idx = tid + k * 512, r = idx >> 3, v = idx & 7; *(LAS u32x4*)(Qs + r * 72 + v * 8) = rq[k]; }
#pragma unroll
        for (int k = 0; k < 3; ++k) { const int idx = tid + k * 512, j = idx >> 3, v = idx & 7; const u32x4 vv = rv[k];
            *(LAS u32x4*)(Ks + j * 72 + v * 8) = rk[k];
            LAS bf16* vt = Vt + (v * 8) * 200 + j;
            vt[0 * 200] = (bf16)(vv.x & 0xffffu); vt[1 * 200] = (bf16)(vv.x >> 16); vt[2 * 200] = (bf16)(vv.y & 0xffffu); vt[3 * 200] = (bf16)(vv.y >> 16);
            vt[4 * 200] = (bf16)(vv.z & 0xffffu); vt[5 * 200] = (bf16)(vv.z >> 16); vt[6 * 200] = (bf16)(vv.w & 0xffffu); vt[7 * 200] = (bf16)(vv.w >> 16); }
    }
    __syncthreads();
    {
        const int g = wave >> 2, h = kvh * 2 + g;
        const float slope = exp2f(-2.0f * (float)(h + 1)), sink = p.sinks[l * 4 + h];
        f32x4 s[12];
#pragma unroll
        for (int nt = 0; nt < 12; ++nt) s[nt] = mma_tile(Qs + wave * 16 * 72, 72, Ks + nt * 16 * 72, 72, 64, lane, (f32x4){0.f, 0.f, 0.f, 0.f});
#pragma unroll
        for (int j = 0; j < 4; ++j) {
            const int r = wave * 16 + (lane >> 4) * 4 + j, i = r & 63;
            float mx = sink;
#pragma unroll
            for (int nt = 0; nt < 12; ++nt) { const int jj = nt * 16 + (lane & 15);
                float val = s[nt][j] * 0.125f - slope * fabsf((float)(i + 128 - jj));
                if (c - 2 + (nt >> 2) < 0) val = -INFINITY;
                s[nt][j] = val; mx = fmaxf(mx, val); }
            mx = red16_max(mx);
            float sum = 0.f;
#pragma unroll
            for (int nt = 0; nt < 12; ++nt) { const float e = __expf(s[nt][j] - mx); s[nt][j] = e; sum += e; }
            sum = red16_sum(sum);
            sum += __expf(sink - mx);
            const float inv = frcp(sum);
#pragma unroll
            for (int nt = 0; nt < 12; ++nt) Ps[r * 200 + nt * 16 + (lane & 15)] = (bf16)f2bf(s[nt][j] * inv);
        }
    }
    __syncthreads();
#pragma unroll
    for (int nt = 0; nt < 4; ++nt) {
        const f32x4 acc = mma_tile(Vt + nt * 16 * 200, 200, Ps + wave * 16 * 200, 200, 192, lane, (f32x4){0.f, 0.f, 0.f, 0.f});
        const int r = wave * 16 + (lane & 15), g = r >> 6, i = r & 63, d0 = nt * 16 + (lane >> 4) * 4;
        u32x2 o; o.x = pk2(acc[0], acc[1]); o.y = pk2(acc[2], acc[3]);
        *(u32x2*)(MIX + (t0 + i) * DM + (kvh * 2 + g) * 64 + d0) = o;
    }
    __syncthreads();
}

template <int NCOLS> struct RawTile {
    static constexpr int VPR = NCOLS / 8, NV = 67 * VPR, NIT = (NV + 511) / 512;
    u32x4 r[NIT];
    DEV void issue(const bf16* PROJ, size_t t0, int c, int col0, int tid) {
#pragma unroll
        for (int k = 0; k < NIT; ++k) { const int idx = tid + k * 512, row = idx / VPR, v = idx % VPR;
            r[k] = (u32x4){0u, 0u, 0u, 0u};
            if (idx < NV && (c > 0 || row >= 3)) r[k] = *(const u32x4*)(PROJ + (size_t)((long)t0 - 3 + row) * NPROJ + col0 + v * 8); }
    }
    DEV void commit(LAS bf16* Raw, int rawld, int dcol0, int tid) const {
#pragma unroll
        for (int k = 0; k < NIT; ++k) { const int idx = tid + k * 512, row = idx / VPR, v = idx % VPR;
            if (idx < NV) *(LAS u32x4*)(Raw + row * rawld + dcol0 + v * 8) = r[k]; }
    }
};
DEV void ssd_p1_unit(const Params& p, int l, int u, LAS unsigned char* lds, int tid) {
    asm volatile("" : "+v"(tid));
    const int b = u >> 7, c = (u >> 1) & 63, g = u & 1, wave = tid >> 6, lane = tid & 63;
    const bf16* PROJ = (const bf16*)(p.ws + WS_PROJ);
    const float* SMALL = (const float*)(p.ws + WS_SMALL);
    float* ACS = (float*)(p.ws + WS_ACS); float* CDEC = (float*)(p.ws + WS_CDEC);
    bf16* STATES = (bf16*)(p.ws + WS_STATES); bf16* YPART = (bf16*)(p.ws + WS_YPART); bf16* CCONV = (bf16*)(p.ws + WS_CCONV);
    LAS bf16* XsT = (LAS bf16*)lds;
    LAS bf16* Bm = XsT + 4 * 64 * 72;
    LAS bf16* Cm = Bm + 64 * 136;
    LAS bf16* BmT = Cm + 64 * 136;
    LAS bf16* Sc = BmT + 128 * 72;
    LAS bf16* Raw = Sc;
    LAS float* dtS = (LAS float*)(Sc + 4 * 64 * 72);
    LAS float* acsS = dtS + 256;
    LAS float* fS = acsS + 256;
    const size_t t0 = (size_t)b * SEQ + (size_t)c * CH;
    RawTile<256> R1; RawTile<128> R2b, R2c;
    R1.issue(PROJ, t0, c, 1024 + g * 256, tid); R2b.issue(PROJ, t0, c, 1024 + 512 + g * 128, tid); R2c.issue(PROJ, t0, c, 1024 + 768 + g * 128, tid);
    if (tid < 256) {
        const int h = tid >> 6, hh = g * 4 + h;
        const float dt = softplus(SMALL[(t0 + lane) * 16 + hh] + p.sdt_bias[l * 8 + hh]);
        const float a = -expf(p.sA_log[l * 8 + hh]);
        const float acs = wave_incl_scan(dt * a, lane);
        const float alast = rdlane(acs, 63);
        dtS[tid] = dt; acsS[tid] = acs; fS[tid] = dt * expf(alast - acs);
        ACS[(t0 + lane) * 8 + hh] = acs;
        if (lane == 63) CDEC[((size_t)b * NCH + c) * 8 + hh] = expf(acs);
    }
    R1.commit(Raw, 256, 0, tid);
    __syncthreads();
    {
        const int ch = tid & 255, half = tid >> 8, chg = g * 256 + ch, h = ch >> 6, pp = ch & 63;
        const float* cw = p.sconv_w + (size_t)l * 4096 + chg; const float w0 = cw[0], w1 = cw[1024], w2 = cw[2048], w3 = cw[3072], bias = p.sconv_b[l * 1024 + chg];
        const int r0 = half * 32;
        float x0 = bf2f(Raw[(r0 + 0) * 256 + ch]), x1 = bf2f(Raw[(r0 + 1) * 256 + ch]), x2 = bf2f(Raw[(r0 + 2) * 256 + ch]);
        LAS bf16* dst = XsT + h * 64 * 72 + pp * 72 + r0;
        for (int r = 0; r < 32; ++r) { const float x3 = bf2f(Raw[(r0 + r + 3) * 256 + ch]);
            const float y = silu(w0 * x0 + w1 * x1 + w2 * x2 + w3 * x3 + bias);
            dst[r] = (bf16)f2bf(y); x0 = x1; x1 = x2; x2 = x3; }
    }
    __syncthreads();
    R2b.commit(Raw, 256, 0, tid); R2c.commit(Raw, 256, 128, tid);
    __syncthreads();
    {
        const int ch = tid & 255, half = tid >> 8, isC = ch >> 7, n = ch & 127, chg = 512 + isC * 256 + g * 128 + n;
        const float* cw = p.sconv_w + (size_t)l * 4096 + chg; const float w0 = cw[0], w1 = cw[1024], w2 = cw[2048], w3 = cw[3072], bias = p.sconv_b[l * 1024 + chg];
        const int r0 = half * 32;
        float x0 = bf2f(Raw[(r0 + 0) * 256 + ch]), x1 = bf2f(Raw[(r0 + 1) * 256 + ch]), x2 = bf2f(Raw[(r0 + 2) * 256 + ch]);
        for (int r = 0; r < 32; ++r) { const float x3 = bf2f(Raw[(r0 + r + 3) * 256 + ch]);
            const bf16 y = (bf16)f2bf(silu(w0 * x0 + w1 * x1 + w2 * x2 + w3 * x3 + bias));
            if (isC) Cm[(r0 + r) * 136 + n] = y; else { Bm[(r0 + r) * 136 + n] = y; BmT[n * 72 + r0 + r] = y; }
            x0 = x1; x1 = x2; x2 = x3; }
    }
    __syncthreads();
    for (int idx = tid; idx < 1024; idx += 512) { const int r = idx >> 4, v = idx & 15; *(u32x4*)(CCONV + (t0 + r) * 256 + g * 128 + v * 8) = *(const LAS u32x4*)(Cm + r * 136 + v * 8); }
#pragma unroll
    for (int ti = 0; ti < 2; ++ti) {
        const int tt = wave * 2 + ti, mt = tt >> 2, nt = tt & 3;
        f32x4 acc = (f32x4){0.f, 0.f, 0.f, 0.f};
        if (nt <= mt) acc = mma_tile(Bm + nt * 16 * 136, 136, Cm + mt * 16 * 136, 136, 128, lane, acc);
        const int lr = mt * 16 + (lane & 15), s0 = nt * 16 + (lane >> 4) * 4;
#pragma unroll
        for (int h = 0; h < 4; ++h) { const f32x4 as = *(const LAS f32x4*)(acsS + h * 64 + s0), ds = *(const LAS f32x4*)(dtS + h * 64 + s0); const float al = acsS[h * 64 + lr];
            float v[4];
#pragma unroll
            for (int j = 0; j < 4; ++j) v[j] = (s0 + j <= lr) ? acc[j] * __expf(al - as[j]) * ds[j] : 0.f;
            u32x2 o; o.x = pk2(v[0], v[1]); o.y = pk2(v[2], v[3]);
            *(LAS u32x2*)(Sc + h * 64 * 72 + lr * 72 + s0) = o; }
    }
    __syncthreads();
    {
        const int h = wave >> 1, hh = g * 4 + h; const float Dh = p.sD[l * 8 + hh];
#pragma unroll 2
        for (int ti = 0; ti < 8; ++ti) { const int tt = (wave & 1) * 8 + ti, mt = tt >> 2, nt = tt & 3;
            const f32x4 acc = mma_tile(XsT + h * 64 * 72 + nt * 16 * 72, 72, Sc + h * 64 * 72 + mt * 16 * 72, 72, 64, lane, (f32x4){0.f, 0.f, 0.f, 0.f});
            const int lr = mt * 16 + (lane & 15), p0 = nt * 16 + (lane >> 4) * 4;
            const LAS bf16* xp = XsT + h * 64 * 72 + p0 * 72 + lr;
            u32x2 o; o.x = pk2(acc[0] + Dh * bf2f(xp[0]), acc[1] + Dh * bf2f(xp[72])); o.y = pk2(acc[2] + Dh * bf2f(xp[144]), acc[3] + Dh * bf2f(xp[216]));
            *(u32x2*)(YPART + (t0 + lr) * 512 + hh * 64 + p0) = o; }
#pragma unroll
        for (int pi = 0; pi < 2; ++pi) { const int pt = (wave & 1) * 2 + pi;
            bf16x8 xf[2];
#pragma unroll
            for (int k = 0; k < 2; ++k) { const int l0 = k * 32 + (lane >> 4) * 8;
                const u32x4 xw = *(const LAS u32x4*)(XsT + h * 64 * 72 + (pt * 16 + (lane & 15)) * 72 + l0);
                const f32x4 f0 = *(const LAS f32x4*)(fS + h * 64 + l0), f1 = *(const LAS f32x4*)(fS + h * 64 + l0 + 4);
                u32x4 o; o.x = pk2(bflo(xw.x) * f0.x, bfhi(xw.x) * f0.y); o.y = pk2(bflo(xw.y) * f0.z, bfhi(xw.y) * f0.w);
                o.z = pk2(bflo(xw.z) * f1.x, bfhi(xw.z) * f1.y); o.w = pk2(bflo(xw.w) * f1.z, bfhi(xw.w) * f1.w);
                xf[k] = __builtin_bit_cast(bf16x8, o); }
            for (int nt = 0; nt < 8; ++nt) {
                f32x4 acc = (f32x4){0.f, 0.f, 0.f, 0.f};
#pragma unroll
                for (int k = 0; k < 2; ++k) { const bf16x8 bfr = *(const LAS bf16x8*)(BmT + (nt * 16 + (lane & 15)) * 72 + k * 32 + (lane >> 4) * 8);
                    acc = __builtin_amdgcn_mfma_f32_16x16x32_bf16(bfr, xf[k], acc, 0, 0, 0); }
                u32x2 o; o.x = pk2(acc[0], acc[1]); o.y = pk2(acc[2], acc[3]);
                *(u32x2*)(STATES + ((((size_t)b * NCH + c) * 8 + hh) * 64 + pt * 16 + (lane & 15)) * 128 + nt * 16 + (lane >> 4) * 4) = o; } }
    }
    __syncthreads();
}
DEV void ssd_scan_all(const Params& p, int bx, LAS unsigned char* lds, int tid) {
    asm volatile("" : "+v"(tid));
    bf16* STATES = (bf16*)(p.ws + WS_STATES); const float* CDEC = (const float*)(p.ws + WS_CDEC);
    LAS float* decS = (LAS float*)lds;
    const int idx = bx * 512 + tid, b = idx >> 15, rem = idx & 32767, hh = rem >> 12, pn2 = rem & 4095;
    if (tid < 64) decS[tid] = CDEC[((size_t)b * NCH + tid) * 8 + hh];
    unsigned* base = (unsigned*)(STATES + ((size_t)b * NCH * 8 + hh) * 8192) + pn2;
    unsigned nw[NCH];
#pragma unroll
    for (int c = 0; c < NCH; ++c) nw[c] = base[(size_t)c * 8 * 4096];
    __syncthreads();
    float s0 = 0.f, s1 = 0.f;
#pragma unroll
    for (int c = 0; c < NCH; ++c) { const float d = decS[c];
        base[(size_t)c * 8 * 4096] = pk2(s0, s1);
        s0 = s0 * d + bflo(nw[c]); s1 = s1 * d + bfhi(nw[c]); }
    __syncthreads();
}
DEV void ssd_p3_unit(const Params& p, int l, int u, LAS unsigned char* lds, int tid) {
    asm volatile("" : "+v"(tid));
    const int b = u >> 7, c = (u >> 1) & 63, g = u & 1, wave = tid >> 6, lane = tid & 63;
    const bf16* PROJ = (const bf16*)(p.ws + WS_PROJ); const float* ACS = (const float*)(p.ws + WS_ACS);
    const bf16* STATES = (const bf16*)(p.ws + WS_STATES); const bf16* YPART = (const bf16*)(p.ws + WS_YPART); const bf16* CCONV = (const bf16*)(p.ws + WS_CCONV);
    bf16* MIX = (bf16*)(p.ws + WS_MIX);
    LAS bf16* Cm = (LAS bf16*)lds;
    LAS bf16* Prev = Cm + 64 * 136;
    LAS float* Gb = (LAS float*)Prev;
    LAS float* acsS = (LAS float*)(Prev + 4 * 64 * 136);
    const size_t t0 = (size_t)b * SEQ + (size_t)c * CH;
    const int h = wave >> 1, hh = g * 4 + h;
    u32x4 rc[2], rp[8]; u32x2 ry[8], rz[8]; float racs = 0.f;
    f32x4 nw[8];
    { const f32x4* nwp = (const f32x4*)(p.snorm_w + (size_t)l * 512 + g * 256 + (tid & 7) * 32);
#pragma unroll
        for (int k = 0; k < 8; ++k) nw[k] = nwp[k]; }
#pragma unroll
    for (int k = 0; k < 2; ++k) { const int idx = tid + k * 512, r = idx >> 4, v = idx & 15; rc[k] = *(const u32x4*)(CCONV + (t0 + r) * 256 + g * 128 + v * 8); }
#pragma unroll
    for (int k = 0; k < 8; ++k) { const int idx = tid + k * 512, hq = idx >> 10, r = (idx >> 4) & 63, v = idx & 15;
        rp[k] = *(const u32x4*)(STATES + ((((size_t)b * NCH + c) * 8 + g * 4 + hq) * 64 + r) * 128 + v * 8); }
    if (tid < 256) racs = ACS[(t0 + (tid & 63)) * 8 + g * 4 + (tid >> 6)];
#pragma unroll
    for (int ti = 0; ti < 8; ++ti) { const int tt = (wave & 1) * 8 + ti, mt = tt >> 2, nt = tt & 3, lr = mt * 16 + (lane & 15), p0 = nt * 16 + (lane >> 4) * 4;
        ry[ti] = *(const u32x2*)(YPART + (t0 + lr) * 512 + hh * 64 + p0); rz[ti] = *(const u32x2*)(PROJ + (t0 + lr) * NPROJ + 512 + hh * 64 + p0); }
#pragma unroll
    for (int k = 0; k < 2; ++k) { const int idx = tid + k * 512, r = idx >> 4, v = idx & 15; *(LAS u32x4*)(Cm + r * 136 + v * 8) = rc[k]; }
#pragma unroll
    for (int k = 0; k < 8; ++k) { const int idx = tid + k * 512, hq = idx >> 10, r = (idx >> 4) & 63, v = idx & 15; *(LAS u32x4*)(Prev + hq * 64 * 136 + r * 136 + v * 8) = rp[k]; }
    if (tid < 256) acsS[tid] = racs;
    __syncthreads();
    f32x4 acc[8];
    for (int rq_ = 0; rq_ < RP3_MMA; ++rq_) {
#pragma unroll
    for (int ti = 0; ti < 8; ++ti) { const int tt = (wave & 1) * 8 + ti, mt = tt >> 2, nt = tt & 3;
        acc[ti] = mma_tile(Prev + h * 64 * 136 + nt * 16 * 136, 136, Cm + mt * 16 * 136, 136, 128, lane, (f32x4){0.f, 0.f, 0.f, 0.f}); }
    asm volatile("" ::: "memory"); }
    __syncthreads();
#pragma unroll
    for (int ti = 0; ti < 8; ++ti) { const int tt = (wave & 1) * 8 + ti, mt = tt >> 2, nt = tt & 3, lr = mt * 16 + (lane & 15), p0 = nt * 16 + (lane >> 4) * 4;
        const float ea = __expf(acsS[h * 64 + lr]);
        f32x4 gv;
        gv.x = (bflo(ry[ti].x) + ea * acc[ti][0]) * silu(bflo(rz[ti].x)); gv.y = (bfhi(ry[ti].x) + ea * acc[ti][1]) * silu(bfhi(rz[ti].x));
        gv.z = (bflo(ry[ti].y) + ea * acc[ti][2]) * silu(bflo(rz[ti].y)); gv.w = (bfhi(ry[ti].y) + ea * acc[ti][3]) * silu(bfhi(rz[ti].y));
        *(LAS f32x4*)(Gb + lr * 260 + h * 64 + p0) = gv; }
    __syncthreads();
    {
        const int lr = tid >> 3, part = tid & 7;
        f32x4 v[8]; float ss = 0.f;
#pragma unroll
        for (int k = 0; k < 8; ++k) { v[k] = *(const LAS f32x4*)(Gb + lr * 260 + part * 32 + k * 4); ss += (v[k].x * v[k].x + v[k].y * v[k].y) + (v[k].z * v[k].z + v[k].w * v[k].w); }
        ss = red8_sum(ss);
        const float rstd = rsqrtf(ss * (1.0f / 256.0f) + EPS);
        bf16* dst = MIX + (t0 + lr) * DM + 256 + g * 256 + part * 32;
#pragma unroll
        for (int k = 0; k < 4; ++k) { const f32x4 a = v[2 * k] * rstd * nw[2 * k], bq = v[2 * k + 1] * rstd * nw[2 * k + 1];
            u32x4 o; o.x = pk2(a.x, a.y); o.y = pk2(a.z, a.w); o.z = pk2(bq.x, bq.y); o.w = pk2(bq.z, bq.w);
            *(u32x4*)(dst + 8 * k) = o; }
    }
    __syncthreads();
}

struct GdnPF { u32x4 rr[4]; float sb, sa; };
DEV void gdn_pre_issue(const Params& p, int u, int tid, GdnPF& pf) {
    const int b = u >> 8, c = (u >> 2) & 63, hg = u & 3, lane = tid & 63;
    const bf16* PROJ = (const bf16*)(p.ws + WS_PROJ); const float* SMALL = (const float*)(p.ws + WS_SMALL);
    const size_t t0 = (size_t)b * SEQ + (size_t)c * CH;
#pragma unroll
    for (int k = 0; k < 4; ++k) { const int idx = tid + k * 512, row = idx / 24, rem = idx % 24, seg = rem >> 3, v = rem & 7;
        pf.rr[k] = (u32x4){0u, 0u, 0u, 0u};
        if (idx < 67 * 24 && (c > 0 || row >= 3)) pf.rr[k] = *(const u32x4*)(PROJ + (size_t)((long)t0 - 3 + row) * NPROJ + 2048 + seg * 256 + hg * 64 + v * 8); }
    pf.sb = 0.f; pf.sa = 0.f;
    if ((tid >> 6) == 0) { pf.sb = SMALL[(t0 + lane) * 16 + 8 + hg]; pf.sa = SMALL[(t0 + lane) * 16 + 12 + hg]; }
}
DEV void gdn_pre_unit(const Params& p, int l, int u, int unext, LAS unsigned char* lds, int tid, GdnPF& pf) {
    asm volatile("" : "+v"(tid));
    const int b = u >> 8, c = (u >> 2) & 63, hg = u & 3, wave = tid >> 6, lane = tid & 63;
    const int ub = (b * 4 + hg) * 64 + c;
    const bf16* PROJ = (const bf16*)(p.ws + WS_PROJ); const float* SMALL = (const float*)(p.ws + WS_SMALL);
    bf16* GU = (bf16*)(p.ws + WS_GU) + (size_t)ub * 4096; bf16* GW = (bf16*)(p.ws + WS_GW) + (size_t)ub * 4096; bf16* GQE = (bf16*)(p.ws + WS_GQE) + (size_t)ub * 4096;
    bf16* GQK = (bf16*)(p.ws + WS_GQK) + (size_t)ub * 4096; bf16* GKDT = (bf16*)(p.ws + WS_GKDT) + (size_t)ub * 4096; float* EGL = (float*)(p.ws + WS_EGL);
    LAS bf16* Raw = (LAS bf16*)lds;
    LAS float* Xn = (LAS float*)lds;
    LAS float* Qs = (LAS float*)(lds + 25728);
    LAS float* Ks = Qs + 64 * 65;
    LAS float* Vs = Ks + 64 * 65;
    LAS float* Am = Vs + 64 * 65;
    LAS float* betaS = Am + 64 * 64;
    LAS float* gcS = betaS + 64;
    LAS float* scwS = gcS + 64;
    LAS float* egS = scwS + 64;
    LAS float* kdS = egS + 64;
    LAS float* R = kdS + 64;
    LAS float* At = R + 64 * 128;
    LAS float* Dv = At + 64 * 64;
    const size_t t0 = (size_t)b * SEQ + (size_t)c * CH;
    float cwv[3][4];
#pragma unroll
    for (int seg = 0; seg < 3; ++seg) { const float* cw = p.gconv_w + (size_t)l * 3072 + seg * 256 + hg * 64 + lane; cwv[seg][0] = cw[0]; cwv[seg][1] = cw[768]; cwv[seg][2] = cw[1536]; cwv[seg][3] = cw[2304]; }
    if (wave == 0) {
        const float beta = frcp(1.0f + expf(-pf.sb));
        const float gg = -expf(p.gA_log[l * 4 + hg]) * softplus(pf.sa + p.gdt_bias[l * 4 + hg]);
        const float gc = wave_incl_scan(gg, lane);
        const float glast = rdlane(gc, 63), eg = expf(gc);
        betaS[lane] = beta; gcS[lane] = gc; scwS[lane] = beta * eg; egS[lane] = eg; kdS[lane] = expf(glast - gc);
        if (lane == 63) EGL[ub] = eg;
    }
#pragma unroll
    for (int k = 0; k < 4; ++k) { const int idx = tid + k * 512, row = idx / 24, rem = idx % 24;
        if (idx < 67 * 24) *(LAS u32x4*)(Raw + row * 192 + rem * 8) = pf.rr[k]; }
    __syncthreads();
    for (int rq_ = 0; rq_ < RG_CONV; ++rq_)
#pragma unroll
    for (int seg = 0; seg < 3; ++seg) {
        const float w0 = cwv[seg][0], w1 = cwv[seg][1], w2 = cwv[seg][2], w3 = cwv[seg][3];
        LAS float* dst = seg == 0 ? Qs : (seg == 1 ? Ks : Vs);
        const int r0 = wave * 8;
        float x0 = bf2f(Raw[(r0 + 0) * 192 + seg * 64 + lane]), x1 = bf2f(Raw[(r0 + 1) * 192 + seg * 64 + lane]), x2 = bf2f(Raw[(r0 + 2) * 192 + seg * 64 + lane]);
#pragma unroll
        for (int r = 0; r < 8; ++r) { const float x3 = bf2f(Raw[(r0 + r + 3) * 192 + seg * 64 + lane]);
            float y = silu(w0 * x0 + w1 * x1 + w2 * x2 + w3 * x3);
            if (seg < 2) { const float ss = wave_sum(y * y); y *= rsqrtf(ss + EPS); if (seg == 0) y *= 0.125f; }
            dst[(r0 + r) * 65 + lane] = y; x0 = x1; x1 = x2; x2 = x3; }
    }
    __syncthreads();
    for (int rq_ = 0; rq_ < RG_KK; ++rq_)
    {
        for (int t = wave; t < 20; t += 8) {
            const bool isqk = t >= 10; const int idx = isqk ? t - 10 : t;
            const int mt = idx >= 6 ? 3 : (idx >= 3 ? 2 : (idx >= 1 ? 1 : 0)), nt = idx - mt * (mt + 1) / 2;
            const LAS float* ap = (isqk ? Qs : Ks) + (mt * 16 + (lane & 15)) * 65 + (lane >> 4);
            const LAS float* bp = Ks + (nt * 16 + (lane & 15)) * 65 + (lane >> 4);
            f32x4 acc = (f32x4){0.f, 0.f, 0.f, 0.f};
#pragma unroll
            for (int ks = 0; ks < 16; ++ks) acc = __builtin_amdgcn_mfma_f32_16x16x4f32(ap[ks * 4], bp[ks * 4], acc, 0, 0, 0);
            const int j = nt * 16 + (lane & 15), i0 = mt * 16 + (lane >> 4) * 4; const float gj = gcS[j];
            float v[4];
#pragma unroll
            for (int jj = 0; jj < 4; ++jj) { const int i = i0 + jj; const float dec = (j <= i) ? __expf(gcS[i] - gj) : 0.f;
                v[jj] = isqk ? acc[jj] * dec : ((j < i) ? betaS[i] * acc[jj] * dec : 0.f); }
            if (!isqk) {
#pragma unroll
                for (int jj = 0; jj < 4; ++jj) Am[(i0 + jj) * 64 + j] = v[jj];
                *(LAS f32x4*)(At + j * 64 + i0) = (f32x4){v[0], v[1], v[2], v[3]};
            } else {
#pragma unroll
                for (int jj = 0; jj < 4; ++jj) GQK[(i0 + jj) * 64 + j] = (bf16)f2bf(v[jj]);
            }
        }
        { const int e0 = tid * 8, i = e0 >> 6, j = e0 & 63; if ((j >> 4) > (i >> 4)) *(u32x4*)(GQK + e0) = (u32x4){0u, 0u, 0u, 0u}; }
    }
    __syncthreads();
    if (unext >= 0) gdn_pre_issue(p, unext, tid, pf);
    for (int rq_ = 0; rq_ < RG_SOLVE; ++rq_) {
    if (wave == 7) {
        const int bb = lane >> 4, cc = lane & 15;
        f32x4 ar[16][4];
#pragma unroll
        for (int i = 1; i < 16; ++i)
#pragma unroll
            for (int q4 = 0; q4 < 4; ++q4) if (q4 * 4 < i) ar[i][q4] = *(const LAS f32x4*)(Am + (bb * 16 + i) * 64 + bb * 16 + q4 * 4);
        float x[16];
#pragma unroll
        for (int i = 0; i < 16; ++i) {
            float acc = (i == cc) ? 1.f : 0.f;
#pragma unroll
            for (int q4 = 0; q4 < 4; ++q4) if (q4 * 4 < i) { const f32x4 a = ar[i][q4];
                if (q4 * 4 + 0 < i) acc -= a.x * x[q4 * 4 + 0];
                if (q4 * 4 + 1 < i) acc -= a.y * x[q4 * 4 + 1];
                if (q4 * 4 + 2 < i) acc -= a.z * x[q4 * 4 + 2];
                if (q4 * 4 + 3 < i) acc -= a.w * x[q4 * 4 + 3]; }
            x[i] = acc;
            Dv[bb * 256 + i * 16 + cc] = acc;
        }
    } else {
#pragma unroll 4
        for (int e = tid; e < 4096; e += 448) { const int r = e >> 6, d = e & 63;
            if (rq_ == 0) GQE[e] = (bf16)f2bf(Qs[r * 65 + d] * egS[r]);
            GKDT[e] = (bf16)f2bf(Ks[d * 65 + r] * kdS[d]); }
    }
    __syncthreads();
    {
        const int col = wave * 16 + (lane & 15), q = lane >> 4;
        bf16* dstg = (col >= 64 ? GW : GU) + (col & 63);
        const int fr = lane & 15;
#pragma unroll
        for (int rb = 0; rb < 4; ++rb) {
            LAS float* rp = R + (16 * rb + 4 * q) * 128 + col;
            float rh[4];
#pragma unroll
            for (int k = 0; k < 4; ++k) { const int i = 16 * rb + 4 * q + k; rh[k] = (col < 64) ? Vs[i * 65 + col] * betaS[i] : Ks[i * 65 + col - 64] * scwS[i]; }
            if (rb > 0) {
                float af[12], xf[12];
#pragma unroll
                for (int ks = 0; ks < 4 * rb; ++ks) { af[ks] = Am[(16 * rb + fr) * 64 + 4 * ks + q]; xf[ks] = Xn[(4 * ks + q) * 128 + col]; }
                f32x4 pacc = (f32x4){0.f, 0.f, 0.f, 0.f};
#pragma unroll
                for (int ks = 0; ks < 4 * rb; ++ks) pacc = __builtin_amdgcn_mfma_f32_16x16x4f32(af[ks], xf[ks], pacc, 0, 0, 0);
                rh[0] -= pacc[0]; rh[1] -= pacc[1]; rh[2] -= pacc[2]; rh[3] -= pacc[3];
            }
            rp[0] = rh[0]; rp[128] = rh[1]; rp[256] = rh[2]; rp[384] = rh[3];
            asm volatile("s_waitcnt lgkmcnt(0)" ::: "memory");
            float df[4], rf[4];
#pragma unroll
            for (int ks = 0; ks < 4; ++ks) { df[ks] = Dv[rb * 256 + fr * 16 + 4 * ks + q]; rf[ks] = R[(16 * rb + 4 * ks + q) * 128 + col]; }
            f32x4 xacc = (f32x4){0.f, 0.f, 0.f, 0.f};
#pragma unroll
            for (int ks = 0; ks < 4; ++ks) xacc = __builtin_amdgcn_mfma_f32_16x16x4f32(df[ks], rf[ks], xacc, 0, 0, 0);
#pragma unroll
            for (int k = 0; k < 4; ++k) { const int ii = 4 * q + k; Xn[(16 * rb + ii) * 128 + col] = xacc[k]; dstg[(16 * rb + ii) * 64] = (bf16)f2bf(xacc[k]); }
            asm volatile("s_waitcnt lgkmcnt(0)" ::: "memory");
        }
    }
    __syncthreads();
    }
}
DEV void gdn_scan_block(const Params& p, int bh2, LAS unsigned char* lds, int tid) {
    asm volatile("" : "+v"(tid));
    const int bh = bh2 >> 1, half = bh2 & 1;
    const int b = bh >> 2, hg = bh & 3, wave = tid >> 6, lane = tid & 63;
    const size_t ub0 = (size_t)bh * 64;
    const bf16* GM0 = (const bf16*)(p.ws + WS_GW) + ub0 * 4096; const bf16* GM1 = (const bf16*)(p.ws + WS_GQE) + ub0 * 4096;
    const bf16* GM2 = (const bf16*)(p.ws + WS_GQK) + ub0 * 4096; const bf16* GM3 = (const bf16*)(p.ws + WS_GKDT) + ub0 * 4096;
    const bf16* GM4 = (const bf16*)(p.ws + WS_GU) + ub0 * 4096;
    const float* EGL = (const float*)(p.ws + WS_EGL) + ub0;
    bf16* MIX = (bf16*)(p.ws + WS_MIX);
    LAS bf16* OPS = (LAS bf16*)lds;
    LAS bf16* PRV = OPS + 2 * 5 * 4608;
    LAS float* egS = (LAS float*)(PRV + 4 * 2 * 1152);
    if (tid < 64) egS[tid] = EGL[tid];
    if (wave >= 2 && wave < 4) {
        __syncthreads();
        for (int c = 0; c < NCH; ++c) __syncthreads();
    } else if (wave < 2) {
        const int es = half * 2 + wave, fr = lane & 15, fq = lane >> 4;
        LAS bf16* Stp = PRV + wave * 2304; LAS bf16* Vtp = Stp + 1152;
        for (int i = lane; i < 1152; i += 64) Stp[i] = 0;
        f32x4 Sacc[4];
#pragma unroll
        for (int mt = 0; mt < 4; ++mt) Sacc[mt] = (f32x4){0.f, 0.f, 0.f, 0.f};
        bf16* obase = MIX + ((size_t)b * SEQ + fr) * DM + 768 + hg * 64 + es * 16 + fq * 4;
        __syncthreads();
#pragma unroll 2
        for (int c = 0; c < NCH; ++c) {
            const LAS bf16* Wb = OPS + (c & 1) * 5 * 4608;
            const int fo = fr * 72 + fq * 8;
            const bf16x8 fS0 = *(const LAS bf16x8*)(Stp + fo), fS1 = *(const LAS bf16x8*)(Stp + fo + 32);
            bf16x8 fW[4][2], fQE[4][2], fQK[4][2], fKD[4][2]; u32x2 uw[4];
#pragma unroll
            for (int mt = 0; mt < 4; ++mt)
#pragma unroll
                for (int ks = 0; ks < 2; ++ks) fW[mt][ks] = *(const LAS bf16x8*)(Wb + mt * 16 * 72 + fo + ks * 32);
#pragma unroll
            for (int mt = 0; mt < 4; ++mt) uw[mt] = *(const LAS u32x2*)(Wb + 4 * 4608 + (mt * 16 + fr) * 72 + es * 16 + fq * 4);
#pragma unroll
            for (int mt = 0; mt < 4; ++mt)
#pragma unroll
                for (int ks = 0; ks < 2; ++ks) fQE[mt][ks] = *(const LAS bf16x8*)(Wb + 4608 + mt * 16 * 72 + fo + ks * 32);
#pragma unroll
            for (int mt = 0; mt < 4; ++mt)
#pragma unroll
                for (int ks = 0; ks < 2; ++ks) fKD[mt][ks] = *(const LAS bf16x8*)(Wb + 3 * 4608 + mt * 16 * 72 + fo + ks * 32);
#pragma unroll
            for (int mt = 0; mt < 4; ++mt)
#pragma unroll
                for (int ks = 0; ks < 2; ++ks) fQK[mt][ks] = *(const LAS bf16x8*)(Wb + 2 * 4608 + mt * 16 * 72 + fo + ks * 32);
            const float egl = egS[c];
            f32x4 av[4], ov[4];
#pragma unroll
            for (int mt = 0; mt < 4; ++mt) {
                av[mt] = __builtin_amdgcn_mfma_f32_16x16x32_bf16(fS0, fW[mt][0], (f32x4){0.f, 0.f, 0.f, 0.f}, 0, 0, 0);
                av[mt] = __builtin_amdgcn_mfma_f32_16x16x32_bf16(fS1, fW[mt][1], av[mt], 0, 0, 0); }
#pragma unroll
            for (int mt = 0; mt < 4; ++mt) {
                ov[mt] = __builtin_amdgcn_mfma_f32_16x16x32_bf16(fS0, fQE[mt][0], (f32x4){0.f, 0.f, 0.f, 0.f}, 0, 0, 0);
                ov[mt] = __builtin_amdgcn_mfma_f32_16x16x32_bf16(fS1, fQE[mt][1], ov[mt], 0, 0, 0); }
#pragma unroll
            for (int mt = 0; mt < 4; ++mt) {
                LAS bf16* vp = Vtp + (fq * 4) * 72 + mt * 16 + fr;
                vp[0] = (bf16)f2bf(bflo(uw[mt].x) - av[mt][0]); vp[72] = (bf16)f2bf(bfhi(uw[mt].x) - av[mt][1]);
                vp[144] = (bf16)f2bf(bflo(uw[mt].y) - av[mt][2]); vp[216] = (bf16)f2bf(bfhi(uw[mt].y) - av[mt][3]); }
            const bf16x8 fV0 = *(const LAS bf16x8*)(Vtp + fo), fV1 = *(const LAS bf16x8*)(Vtp + fo + 32);
#pragma unroll
            for (int mt = 0; mt < 4; ++mt) {
                f32x4 sa = Sacc[mt] * egl;
                sa = __builtin_amdgcn_mfma_f32_16x16x32_bf16(fKD[mt][0], fV0, sa, 0, 0, 0);
                sa = __builtin_amdgcn_mfma_f32_16x16x32_bf16(fKD[mt][1], fV1, sa, 0, 0, 0);
                Sacc[mt] = sa;
                u32x2 sw; sw.x = pk2(sa[0], sa[1]); sw.y = pk2(sa[2], sa[3]);
                *(LAS u32x2*)(Stp + fr * 72 + mt * 16 + fq * 4) = sw; }
#pragma unroll
            for (int mt = 0; mt < 4; ++mt) {
                f32x4 o = __builtin_amdgcn_mfma_f32_16x16x32_bf16(fV0, fQK[mt][0], ov[mt], 0, 0, 0);
                o = __builtin_amdgcn_mfma_f32_16x16x32_bf16(fV1, fQK[mt][1], o, 0, 0, 0);
                u32x2 ow; ow.x = pk2(o[0], o[1]); ow.y = pk2(o[2], o[3]);
                *(u32x2*)(obase + ((size_t)c * CH + mt * 16) * DM) = ow; }
            __syncthreads();
        }
    } else {
        const int lt = tid - 256;
        u32x4 rg[4][10];
#define GDN_ISSUE(k, ch) { const size_t co = (size_t)((ch) < NCH ? (ch) : NCH - 1) * 4096; \
            _Pragma("unroll") for (int h2 = 0; h2 < 2; ++h2) { const int idx = lt + h2 * 256, row = idx >> 3, v = idx & 7; \
                rg[k][0 + h2] = *(const u32x4*)(GM0 + co + row * 64 + v * 8); rg[k][2 + h2] = *(const u32x4*)(GM1 + co + row * 64 + v * 8); \
                rg[k][4 + h2] = *(const u32x4*)(GM2 + co + row * 64 + v * 8); rg[k][6 + h2] = *(const u32x4*)(GM3 + co + row * 64 + v * 8); \
                rg[k][8 + h2] = *(const u32x4*)(GM4 + co + row * 64 + v * 8); } }
#define GDN_COMMIT(k, set) { LAS bf16* sb = OPS + (set) * 5 * 4608; \
            _Pragma("unroll") for (int m = 0; m < 5; ++m) _Pragma("unroll") for (int h2 = 0; h2 < 2; ++h2) { const int idx = lt + h2 * 256, row = idx >> 3, v = idx & 7; \
                *(LAS u32x4*)(sb + m * 4608 + row * 72 + v * 8) = rg[k][m * 2 + h2]; } }
        GDN_ISSUE(0, 0) GDN_ISSUE(1, 1) GDN_ISSUE(2, 2) GDN_ISSUE(3, 3)
        GDN_COMMIT(0, 0)
        __syncthreads();
        for (int c = 0; c < NCH; c += 4) {
            GDN_COMMIT(1, 1) GDN_ISSUE(0, c + 4) __syncthreads();
            GDN_COMMIT(2, 0) GDN_ISSUE(1, c + 5) __syncthreads();
            GDN_COMMIT(3, 1) GDN_ISSUE(2, c + 6) __syncthreads();
            GDN_COMMIT(0, 0) GDN_ISSUE(3, c + 7) __syncthreads();
        }
#undef GDN_ISSUE
#undef GDN_COMMIT
    }
}
DEV void gdn_post(const Params& p, int l, int gw, int NGW, int lane) {
    bf16* MIX = (bf16*)(p.ws + WS_MIX); const bf16* PROJ = (const bf16*)(p.ws + WS_PROJ);
    const f32x4 nw = *((const f32x4*)(p.gnorm_w + (size_t)l * 64) + (lane & 15));
    for (int m = gw; m < MTOK; m += NGW) {
        bf16* op = MIX + (size_t)m * DM + 768 + lane * 4;
        const u32x2 ow = *(const u32x2*)op; const u32x2 zw = *(const u32x2*)(PROJ + (size_t)m * NPROJ + 2816 + lane * 4);
        const float o0 = bflo(ow.x), o1 = bfhi(ow.x), o2 = bflo(ow.y), o3 = bfhi(ow.y);
        float ss = (o0 * o0 + o1 * o1) + (o2 * o2 + o3 * o3);
        ss = red16_sum(ss);
        const float rstd = rsqrtf(ss * (1.0f / 64.0f) + EPS);
        u32x2 r; r.x = pk2(o0 * rstd * nw.x * silu(bflo(zw.x)), o1 * rstd * nw.y * silu(bfhi(zw.x))); r.y = pk2(o2 * rstd * nw.z * silu(bflo(zw.y)), o3 * rstd * nw.w * silu(bfhi(zw.y)));
        *(u32x2*)op = r;
    }
}

#define XB_TMO      128
#define XB_XCNT(j)  (256  + 64 * (j))
#define XB_XSUB(j)  (1280 + 64 * (j))
#define XB_XGEN(j)  (2304 + 64 * (j))
#define XB_TOP      3328
#define XB_TOPGEN   3392
#define XCD_BAR_WORDS 3456
#define XB_SPIN_CAP (1u << 18)

__device__ __forceinline__ unsigned xb_ld(unsigned* p)              { return __hip_atomic_load(p, __ATOMIC_RELAXED, __HIP_MEMORY_SCOPE_AGENT); }
__device__ __forceinline__ unsigned xb_add(unsigned* p, unsigned v) { return __hip_atomic_fetch_add(p, v, __ATOMIC_RELAXED, __HIP_MEMORY_SCOPE_AGENT); }
__device__ __forceinline__ unsigned xb_xcc_id() { return (unsigned)__builtin_amdgcn_s_getreg((3 << 11) | 20) & 0xFu; }
#define XB_SPIN(cond, bar) do { unsigned _sp = 0; while (cond) { __builtin_amdgcn_s_sleep(1); \
    if ((++_sp & 255u) == 0u) { if (xb_ld(&(bar)[XB_TMO])) break; if (_sp > XB_SPIN_CAP) { atomicAdd(&(bar)[XB_TMO], 1u); break; } } } } while (0)

struct XcdBarrier {
    unsigned* bar; unsigned x;
    volatile LAS unsigned* st;
};

__device__ __forceinline__ XcdBarrier xcd_barrier_post(unsigned* bar, volatile LAS unsigned* st) {
    XcdBarrier b; b.bar = bar; b.x = xb_xcc_id(); b.st = st;
    if (threadIdx.x == 0) (void)xb_add(&bar[XB_XCNT(b.x)], 1u);
    return b;
}
__device__ __forceinline__ void xcd_barrier_complete(unsigned* bar, unsigned x, unsigned& nloc, unsigned& nx) {
    const unsigned G = gridDim.x * gridDim.y * gridDim.z;
    unsigned sum, cnt, mine, sp = 0u;
    for (;;) {
        sum = 0u; cnt = 0u; mine = 0u;
#pragma unroll
        for (unsigned j = 0; j < 16; ++j) { const unsigned c = xb_ld(&bar[XB_XCNT(j)]); sum += c; cnt += (c > 0u) ? 1u : 0u; mine = (j == x) ? c : mine; }
        if (sum == G) break;
        __builtin_amdgcn_s_sleep(1);
        if ((++sp & 255u) == 0u) { if (xb_ld(&bar[XB_TMO])) break; if (sp > XB_SPIN_CAP) { atomicAdd(&bar[XB_TMO], 1u); break; } }
    }
    nloc = mine > 0u ? mine : 1u; nx = cnt > 0u ? cnt : 1u;
}

__device__ __forceinline__ void xcd_barrier(const XcdBarrier& b) {
    asm volatile("s_waitcnt vmcnt(0)" ::: "memory");
    __syncthreads();
    if (threadIdx.x == 0) {
        unsigned* bar = b.bar;
        __builtin_amdgcn_s_waitcnt(0);
        unsigned nloc = b.st[0], nx = b.st[1];
        if (nloc == 0u) { xcd_barrier_complete(bar, b.x, nloc, nx); b.st[0] = nloc; b.st[1] = nx; }
        const unsigned old = xb_add(&bar[XB_XSUB(b.x)], 1u);
        const unsigned gen = old / nloc;
        if (old + 1u == (gen + 1u) * nloc) {
            __builtin_amdgcn_fence(__ATOMIC_RELEASE, "agent");
            asm volatile("s_waitcnt vmcnt(0)" ::: "memory");
            const unsigned og = xb_add(&bar[XB_TOP], 1u);
            const unsigned tg = og / nx;
            if (og + 1u == (tg + 1u) * nx) xb_add(&bar[XB_TOPGEN], 1u);
            else XB_SPIN(xb_ld(&bar[XB_TOPGEN]) == tg, bar);
            __builtin_amdgcn_fence(__ATOMIC_ACQUIRE, "agent");
            xb_add(&bar[XB_XGEN(b.x)], 1u);
            asm volatile("s_waitcnt vmcnt(0)" ::: "memory");
        } else {
            XB_SPIN(xb_ld(&bar[XB_XGEN(b.x)]) == gen, bar);
            __builtin_amdgcn_fence(__ATOMIC_ACQUIRE, "agent");
            asm volatile("s_waitcnt vmcnt(0)" ::: "memory");
        }
    }
    __syncthreads();
}
__global__ void __launch_bounds__(512, 2) fwd_megakernel(Params p) {
    extern __shared__ __attribute__((aligned(16))) unsigned char lds_raw[];
    cg::grid_group grid = cg::this_grid();
    LAS unsigned char* lds = (LAS unsigned char*)lds_raw;
    const int tid = threadIdx.x, lane = tid & 63, wave = __builtin_amdgcn_readfirstlane(tid >> 6);
    const int G = gridDim.x, bx = blockIdx.x, gw = bx * 8 + wave, NGW = G * 8;
    bf16* XN = (bf16*)(p.ws + WS_XN); float* SMALL = (float*)(p.ws + WS_SMALL); bf16* TMP = (bf16*)(p.ws + WS_TMP);
    bf16* PROJ = (bf16*)(p.ws + WS_PROJ); bf16* MIX = (bf16*)(p.ws + WS_MIX); bf16* HB = (bf16*)(p.ws + WS_H);
    LAS float* wsT = (LAS float*)(lds + 69632);
    volatile LAS unsigned* misc = (volatile LAS unsigned*)(lds + 147200);
    if (tid < 4) misc[tid] = 0u;
    __syncthreads();
    XcdBarrier xbar = xcd_barrier_post((unsigned*)p.ws, misc);
#define GSYNC() xcd_barrier(xbar)

#define PHASE_IDS() int tidp = threadIdx.x; int lq = l; asm volatile("" : "+v"(tidp), "+s"(lq)); const int lanep = tidp & 63; const int wavep = __builtin_amdgcn_readfirstlane(tidp >> 6); const int gwp = bx * 8 + wavep; (void)lanep; (void)gwp; (void)lq
#pragma unroll 1
    for (int l = 0; l < DEPTH; ++l) {
        {
            PHASE_IDS();
            convert_weights(p, lq, lds, gwp, NGW, wavep, lanep);
            if (lq == 0) {
                stage_small(p, 0, wsT, tidp);
                __syncthreads();
                rowpass<0>(p.x, nullptr, nullptr, p.pre_mix, nullptr, XN, SMALL, wsT, gwp, NGW, lanep);
            }
        }
        if (l == 0) grid.sync(); else GSYNC();
#ifdef REP_SYNC
        for (int rep = 0; rep < REP_SYNC; ++rep) GSYNC();
#endif
        {
            pg8::Gemm g{XN, (const bf16*)(p.ws + WS_WIN), MTOK, NPROJ, DM}; pg8::StaticOrder S; S.init(MTOK, NPROJ, G, bx);
            pg8::EpiStoreBf16 E{PROJ, NPROJ};
            for (int rg_ = 0; rg_ < REP_GEMM; ++rg_) { if (rg_) GSYNC(); pg8::gemm_phase<pg8::EpiStoreBf16, pg8::StaticOrder, true, true>(lds, g, S, E); }
        }
        GSYNC();
        {
            PHASE_IDS();
            for (int rep = 0; rep < REP_C; ++rep) { if (rep) GSYNC();
            GdnPF pf; if (bx < 1024) gdn_pre_issue(p, bx, tidp, pf);
            for (int u = bx; u < 1024; u += G) gdn_pre_unit(p, lq, u, (u + G < 1024) ? u + G : -1, lds, tidp, pf); }
        }
        GSYNC();
        {
            PHASE_IDS();
            for (int rep = 0; rep < REP_D; ++rep) { if (rep) GSYNC();
            if (bx < 32) { for (int r2 = 0; r2 < REP_DS; ++r2) gdn_scan_block(p, bx, lds, tidp); }
            else { for (int u = bx - 32; u < 1024; u += G - 32) { if (u < 512) { for (int r2 = 0; r2 < REP_P1; ++r2) ssd_p1_unit(p, lq, u, lds, tidp); } else { for (int r2 = 0; r2 < REP_ATT; ++r2) attn_unit(p, lq, u - 512, lds, tidp); } } } }
        }
        GSYNC();
        {
            PHASE_IDS();
            for (int vb = bx; vb < 256; vb += G) ssd_scan_all(p, vb, lds, tidp);
            gdn_post(p, lq, gwp, NGW, lanep);
        }
        GSYNC();
        {
            PHASE_IDS();
            for (int rep = 0; rep < REP_E; ++rep) {
                if (rep) GSYNC();
                for (int u = bx; u < 512; u += G) ssd_p3_unit(p, lq, u, lds, tidp);
            }
        }
        GSYNC();
        {
            pg8::Gemm g{MIX, (const bf16*)(p.ws + WS_WOUT), MTOK, DM, DM}; pg8::StaticOrder S; S.init(MTOK, DM, G, bx);
            pg8::EpiStoreBf16 E{TMP, DM};
            for (int rg_ = 0; rg_ < REP_GEMM; ++rg_) { if (rg_) GSYNC(); pg8::gemm_phase<pg8::EpiStoreBf16, pg8::StaticOrder, true, true>(lds, g, S, E); }
        }
        GSYNC();
        {
            PHASE_IDS();
            rowpass<1, false, true>(lq == 0 ? p.x : p.out, TMP, p.post_mix + (size_t)lq * DM, p.pre_ffn + (size_t)lq * DM, p.ws + WS_X1, XN, nullptr, wsT, gwp, NGW, lanep);
        }
        GSYNC();
        {
            pg8::Gemm g{XN, (const bf16*)(p.ws + WS_WGU), MTOK, 2 * FF, DM}; pg8::StaticOrder S; S.init(MTOK, 2 * FF, G, bx);
            pg8::EpiSwiGLU E{HB, FF};
            for (int rg_ = 0; rg_ < REP_GEMM; ++rg_) { if (rg_) GSYNC(); pg8::gemm_phase<pg8::EpiSwiGLU, pg8::StaticOrder, true, true>(lds, g, S, E); }
        }
        GSYNC();
        {
            pg8::Gemm g{HB, (const bf16*)(p.ws + WS_WDN), MTOK, DM, FF}; pg8::StaticOrder S; S.init(MTOK, DM, G, bx);
            pg8::EpiStoreBf16 E{TMP, DM};
            for (int rg_ = 0; rg_ < REP_GEMM; ++rg_) { if (rg_) GSYNC(); pg8::gemm_phase<pg8::EpiStoreBf16, pg8::StaticOrder, true, true>(lds, g, S, E); }
        }
        GSYNC();
        {
            PHASE_IDS();
            if (lq + 1 < DEPTH) {
                stage_small(p, lq + 1, wsT, tidp);
                __syncthreads();
                rowpass<2, true, false>(p.ws + WS_X1, TMP, p.post_ffn + (size_t)lq * DM, p.pre_mix + (size_t)(lq + 1) * DM, p.out, XN, SMALL, wsT, gwp, NGW, lanep);
                __syncthreads();
            } else {
                rowpass<3, true, false>(p.ws + WS_X1, TMP, p.post_ffn + (size_t)lq * DM, nullptr, p.out, nullptr, nullptr, wsT, gwp, NGW, lanep);
            }
        }
    }
}

extern "C" void kernel_launch(void* const* d_in, const int* in_sizes, int n_in, void* d_out, int out_size, void* d_ws, size_t ws_size, hipStream_t stream) {
    static int grid = 0;
    if (grid == 0) {
        if (n_in != 21 || out_size != MTOK * DM || ws_size < WS_END) { fprintf(stderr, "kernel_launch: unexpected shapes (n_in %d out %d ws %zu)\n", n_in, out_size, ws_size); grid = -1; return; }
        int dev = 0, cus = 0, per_cu = 0;
        hipGetDevice(&dev); hipDeviceGetAttribute(&cus, hipDeviceAttributeMultiprocessorCount, dev);
        if (hipFuncSetAttribute((const void*)fwd_megakernel, hipFuncAttributeMaxDynamicSharedMemorySize, LDS_BYTES) != hipSuccess) { fprintf(stderr, "kernel_launch: hipFuncSetAttribute failed\n"); grid = -1; return; }
        hipOccupancyMaxActiveBlocksPerMultiprocessor(&per_cu, (const void*)fwd_megakernel, 512, LDS_BYTES);
        if (per_cu < 1) { fprintf(stderr, "kernel_launch: occupancy query says %d blocks per CU\n", per_cu); per_cu = 1; }
        (void)hipGetLastError();
        grid = cus;
    }
    if (grid < 0) return;
    if (hipMemsetAsync(d_ws, 0, 16384, stream) != hipSuccess) { fprintf(stderr, "kernel_launch: memset of the barrier words failed\n"); return; }
    Params p{};
    const float** pp = (const float**)&p;
    for (int i = 0; i < 21; ++i) pp[i] = (const float*)d_in[i];
    p.out = (float*)d_out; p.ws = (unsigned char*)d_ws;
    void* args[] = {&p};
    hipError_t e = hipLaunchCooperativeKernel((const void*)fwd_megakernel, dim3(grid), dim3(512), args, LDS_BYTES, stream);
    if (e != hipSuccess) fprintf(stderr, "cooperative launch failed: %s (grid %d)\n", hipGetErrorString(e), grid);
}
```

```cpp
#include <hip/hip_runtime.h>
#include <hip/hip_cooperative_groups.h>
#include <cstdio>
#include <cstdint>
namespace cg = cooperative_groups;
namespace pg8 {
#define PG8_LAS __attribute__((address_space(3)))
typedef unsigned short bf16_t;
typedef short bf16x8 __attribute__((ext_vector_type(8)));
typedef float f32x4 __attribute__((ext_vector_type(4)));
typedef unsigned u32x4 __attribute__((ext_vector_type(4)));
constexpr int BM = 256, BK = 64, HALF = 128, HTB = HALF * BK * 2  , STAGE_BYTES = 8 * HTB, NXCD = 8, WGM = 8;

__host__ __device__ __forceinline__ int lds_byte(int r, int c) { const int st = (r >> 4) * 2 + (c >> 5), rr = r & 15, cc = c & 31, ob = rr * 64 + cc * 2; return st * 1024 + (ob ^ (((ob >> 9) & 1) << 5)); }
__host__ __device__ __forceinline__ void stage_rc(int b, int& R, int& C) { const int st = b / 1024, sb = b % 1024, swz = sb ^ (((sb >> 9) & 1) << 5); R = (st >> 1) * 16 + swz / 64; C = (st & 1) * 32 + (swz % 64) / 2; }
__host__ __device__ __forceinline__ int perm32(int rho) { const int n = rho >> 4, i = rho & 15; return 8 * (i >> 2) + 4 * n + (i & 3); }

struct Unit { int pm, pn; };
struct Gemm { const bf16_t* A; const bf16_t* Bt; int M, N, K; };

struct StaticOrder {
    int nM, nN, nwg, G, c;
    __host__ __device__ void init(int M, int N, int G_, int c_) { nM = M / BM; nN = N / BM; nwg = nM * nN; G = G_; c = c_; }
    __host__ __device__ bool next(int i, Unit& u) const {
        const long L = (long)i * G + c; if (L >= nwg) return false;
        int wgid = (int)L; { const int q = nwg / NXCD, r = nwg % NXCD, xcd = wgid % NXCD, off = wgid / NXCD; wgid = (xcd < r ? xcd * (q + 1) : r * (q + 1) + (xcd - r) * q) + off; }
        const int nig = WGM * nN, gid = wgid / nig, fm = gid * WGM, gsz = (nM - fm) < WGM ? (nM - fm) : WGM;
        u.pm = fm + ((wgid % nig) % gsz); u.pn = (wgid % nig) / gsz; return true;
    }
    __device__ __forceinline__ void a_ready(const Unit&) const {}
    __device__ __forceinline__ void done(const Unit&) const {}
};

typedef float f32x2c __attribute__((ext_vector_type(2))); typedef __bf16 bf16x2c __attribute__((ext_vector_type(2)));
__device__ __forceinline__ unsigned cvt_pk_bf16(float lo, float hi) { const f32x2c v = {lo, hi}; const bf16x2c b = __builtin_convertvector(v, bf16x2c); return __builtin_bit_cast(unsigned, b); }
typedef float f32x2 __attribute__((ext_vector_type(2)));
typedef unsigned u32x2 __attribute__((ext_vector_type(2)));
__device__ __forceinline__ float silu_f(float x) { return x * __builtin_amdgcn_rcpf(1.0f + __expf(-x)); }
struct EpiStoreBf16 {
    static constexpr bool PERM = true, AFTER_DRAIN = false;
    bf16_t* O; int ldc;
    __device__ __forceinline__ void operator()(const f32x4 (&acc)[2][2][4][2], const Unit& u, int wr, int wc, int fr, int fq) const {
        const int row0 = u.pm * BM + wr * 64 + fr, col0 = u.pn * BM + wc * 32 + 8 * fq;
#pragma unroll
        for (int ai = 0; ai < 2; ++ai)
#pragma unroll
            for (int m = 0; m < 4; ++m) { bf16_t* rowp = O + (size_t)(row0 + ai * HALF + m * 16) * ldc + col0;
#pragma unroll
                for (int bj = 0; bj < 2; ++bj) { const f32x4 v0 = acc[ai][bj][m][0], v1 = acc[ai][bj][m][1];
                    u32x4 w; w.x = cvt_pk_bf16(v0[0], v0[1]); w.y = cvt_pk_bf16(v0[2], v0[3]); w.z = cvt_pk_bf16(v1[0], v1[1]); w.w = cvt_pk_bf16(v1[2], v1[3]);
                    *(u32x4*)(rowp + bj * HALF) = w; } }
    }
};
struct EpiStoreF32 {
    static constexpr bool PERM = true, AFTER_DRAIN = false;
    float* O; int ldc;
    __device__ __forceinline__ void operator()(const f32x4 (&acc)[2][2][4][2], const Unit& u, int wr, int wc, int fr, int fq) const {
        const int row0 = u.pm * BM + wr * 64 + fr, col0 = u.pn * BM + wc * 32 + 8 * fq;
#pragma unroll
        for (int ai = 0; ai < 2; ++ai)
#pragma unroll
            for (int m = 0; m < 4; ++m) { float* rowp = O + (size_t)(row0 + ai * HALF + m * 16) * ldc + col0;
#pragma unroll
                for (int bj = 0; bj < 2; ++bj) { *(f32x4*)(rowp + bj * HALF) = acc[ai][bj][m][0]; *(f32x4*)(rowp + bj * HALF + 4) = acc[ai][bj][m][1]; } }
    }
};
struct EpiSwiGLU {
    static constexpr bool PERM = true, AFTER_DRAIN = false;
    bf16_t* H; int ldh;
    __device__ __forceinline__ void operator()(const f32x4 (&acc)[2][2][4][2], const Unit& u, int wr, int wc, int fr, int fq) const {
        const int row0 = u.pm * BM + wr * 64 + fr, col0 = u.pn * (BM / 2) + wc * 16 + 4 * fq;
#pragma unroll
        for (int ai = 0; ai < 2; ++ai)
#pragma unroll
            for (int m = 0; m < 4; ++m) { bf16_t* rowp = H + (size_t)(row0 + ai * HALF + m * 16) * ldh + col0;
#pragma unroll
                for (int bj = 0; bj < 2; ++bj) { const f32x4 v0 = acc[ai][bj][m][0], v1 = acc[ai][bj][m][1];
                    u32x2 w; w.x = cvt_pk_bf16(silu_f(v0[0]) * v0[1], silu_f(v0[2]) * v0[3]); w.y = cvt_pk_bf16(silu_f(v1[0]) * v1[1], silu_f(v1[2]) * v1[3]);
                    *(u32x2*)(rowp + bj * (HALF / 2)) = w; } }
    }
};
template <class Epi, class Sched, bool ALIGN_EPI = false, bool SP2 = false>
__device__ __forceinline__ void gemm_phase(PG8_LAS unsigned char* lds, const Gemm g, const Sched& S, const Epi& E) {
    int tid_l = threadIdx.x; asm volatile("" : "+v"(tid_l));
    const int tid = tid_l, wid = __builtin_amdgcn_readfirstlane(tid >> 6), lane = tid & 63, wr = wid >> 2, wc = wid & 3, fr = lane & 15, fq = lane >> 4;
    const int K = g.K, nt = K / BK;
    unsigned voffA[2], voffB[2];
#pragma unroll
    for (int i = 0; i < 2; ++i) { int R, C; stage_rc(tid * 16 + i * 8192, R, C); const int Rb = Epi::PERM ? ((R & ~31) + perm32(R & 31)) : R;
        voffA[i] = (unsigned)(R * K + C) * 2u; voffB[i] = (unsigned)(Rb * K + C) * 2u; }
    const size_t kstep = (size_t)(BK * 2);
    const size_t hstep = (size_t)HALF * K * 2;
    const size_t tstep = 2 * hstep;
    const unsigned ldsw = (unsigned)wid * 1024u;
    const int aoff = lds_byte(wr * 64 + fr, fq * 8), boff = lds_byte(wc * 32 + fr, fq * 8);
#define PG8_SA(b, h) (((b) * 2 + (h)) * HTB)
#define PG8_SB(b, h) ((4 + (b) * 2 + (h)) * HTB)
#define PG8_STAGE(bufoff, gbase, voff) do { _Pragma("unroll") for (int _i = 0; _i < 2; ++_i) \
        __builtin_amdgcn_global_load_lds((const unsigned*)((const char*)(gbase) + (voff)[_i]), (PG8_LAS unsigned*)(lds + (bufoff) + ldsw + _i * 8192), 16, 0, 0); } while (0)
#define PG8_LDA(dst, b, h) do { _Pragma("unroll") for (int m = 0; m < 4; ++m) _Pragma("unroll") for (int k = 0; k < 2; ++k) dst[m][k] = *(const PG8_LAS bf16x8*)(lds + PG8_SA(b, h) + aoff + m * 2048 + k * 1024); } while (0)
#define PG8_LDB(dst, b, h) do { _Pragma("unroll") for (int n = 0; n < 2; ++n) _Pragma("unroll") for (int k = 0; k < 2; ++k) dst[n][k] = *(const PG8_LAS bf16x8*)(lds + PG8_SB(b, h) + boff + n * 2048 + k * 1024); } while (0)
#define PG8_MMA(ai, bj, At, Bt) do { __builtin_amdgcn_s_setprio(1); _Pragma("unroll") for (int m = 0; m < 4; ++m) _Pragma("unroll") for (int n = 0; n < 2; ++n) _Pragma("unroll") for (int k = 0; k < 2; ++k) \
        acc[ai][bj][m][n] = __builtin_amdgcn_mfma_f32_16x16x32_bf16(Bt[n][k], At[m][k], acc[ai][bj][m][n], 0, 0, 0); __builtin_amdgcn_s_setprio(0); } while (0)
#define PG8_WAIT_V(n) asm volatile("s_waitcnt vmcnt(" #n ")" ::: "memory")
#define PG8_WAIT_L(n) asm volatile("s_waitcnt lgkmcnt(" #n ")" ::: "memory")
#define PG8_BAR __builtin_amdgcn_s_barrier()
#define PG8_SCHED __builtin_amdgcn_sched_barrier(0)
    Unit cur, nxt; int ui = 0;
    if (!S.next(0, cur)) return;
    f32x4 acc[2][2][4][2];
#pragma unroll
    for (int a = 0; a < 2; ++a)
#pragma unroll
        for (int b = 0; b < 2; ++b)
#pragma unroll
            for (int m = 0; m < 4; ++m)
#pragma unroll
                for (int n = 0; n < 2; ++n) acc[a][b][m][n] = (f32x4){0.f, 0.f, 0.f, 0.f};
    bf16x8 At[4][2], B0[2][2], B1[2][2];
    const char* cA = (const char*)g.A + (size_t)cur.pm * tstep; const char* cB = (const char*)g.Bt + (size_t)cur.pn * tstep;
    S.a_ready(cur);
    if constexpr (SP2) {
        PG8_STAGE(PG8_SB(0, 0), cB, voffB); PG8_STAGE(PG8_SB(0, 1), cB + hstep, voffB); PG8_STAGE(PG8_SA(0, 0), cA, voffA); PG8_STAGE(PG8_SA(0, 1), cA + hstep, voffA);
        if (wr == 1) PG8_BAR;
        PG8_WAIT_V(2); PG8_BAR;
        PG8_STAGE(PG8_SB(1, 0), cB + kstep, voffB); PG8_STAGE(PG8_SA(1, 0), cA + kstep, voffA); PG8_STAGE(PG8_SB(1, 1), cB + hstep + kstep, voffB);
        PG8_WAIT_V(6); PG8_BAR;
    } else {
        PG8_STAGE(PG8_SB(0, 0), cB, voffB); PG8_STAGE(PG8_SA(0, 0), cA, voffA); PG8_STAGE(PG8_SB(0, 1), cB + hstep, voffB); PG8_STAGE(PG8_SA(0, 1), cA + hstep, voffA);
        if (wr == 1) PG8_BAR;
        PG8_WAIT_V(4); PG8_BAR;
        PG8_STAGE(PG8_SB(1, 0), cB + kstep, voffB); PG8_STAGE(PG8_SA(1, 0), cA + kstep, voffA); PG8_STAGE(PG8_SB(1, 1), cB + hstep + kstep, voffB);
        PG8_WAIT_V(6); PG8_BAR;
    }
    for (;;) {
        const bool has_next = S.next(ui + 1, nxt);
        const char* nA = has_next ? (const char*)g.A + (size_t)nxt.pm * tstep : cA; const char* nB = has_next ? (const char*)g.Bt + (size_t)nxt.pn * tstep : cB;
        for (int t = 0; t < nt; t += 2) {
            const bool last = (t == nt - 2);
            const char* a1 = cA + (size_t)(t + 1) * kstep;
            const char* a2 = last ? nA : cA + (size_t)(t + 2) * kstep; const char* b2 = last ? nB : cB + (size_t)(t + 2) * kstep;
            const char* a3 = a2 + kstep; const char* b3 = b2 + kstep;
            if (last && has_next) S.a_ready(nxt);
            if constexpr (SP2) {
            PG8_LDB(B0, 0, 0); PG8_LDB(B1, 0, 1); PG8_SCHED; PG8_LDA(At, 0, 0); PG8_STAGE(PG8_SA(1, 1), a1 + hstep, voffA);
            PG8_WAIT_V(8); PG8_WAIT_L(0); PG8_BAR; PG8_MMA(0, 0, At, B0); PG8_MMA(0, 1, At, B1); PG8_BAR; PG8_SCHED;
            PG8_LDA(At, 0, 1); PG8_STAGE(PG8_SB(0, 0), b2, voffB); PG8_STAGE(PG8_SB(0, 1), b2 + hstep, voffB); PG8_STAGE(PG8_SA(0, 0), a2, voffA);
            PG8_WAIT_V(8); PG8_WAIT_L(0); PG8_BAR; PG8_MMA(1, 0, At, B0); PG8_MMA(1, 1, At, B1); PG8_BAR; PG8_SCHED;
            PG8_LDB(B0, 1, 0); PG8_LDB(B1, 1, 1); PG8_SCHED; PG8_LDA(At, 1, 0); PG8_STAGE(PG8_SA(0, 1), a2 + hstep, voffA);
            PG8_WAIT_V(8); PG8_WAIT_L(0); PG8_BAR; PG8_MMA(0, 0, At, B0); PG8_MMA(0, 1, At, B1); PG8_BAR; PG8_SCHED;
            PG8_LDA(At, 1, 1); PG8_STAGE(PG8_SB(1, 0), b3, voffB); PG8_STAGE(PG8_SB(1, 1), b3 + hstep, voffB); PG8_STAGE(PG8_SA(1, 0), a3, voffA);
            PG8_WAIT_V(8); PG8_WAIT_L(0); PG8_BAR; PG8_MMA(1, 0, At, B0); PG8_MMA(1, 1, At, B1); PG8_BAR; PG8_SCHED;
            } else {
            PG8_LDB(B0, 0, 0); PG8_SCHED; PG8_LDA(At, 0, 0); PG8_STAGE(PG8_SA(1, 1), a1 + hstep, voffA);
            PG8_WAIT_L(8); PG8_BAR; PG8_WAIT_L(0); PG8_MMA(0, 0, At, B0); PG8_BAR; PG8_SCHED;
            PG8_LDB(B1, 0, 1); PG8_STAGE(PG8_SB(0, 0), b2, voffB);
            PG8_BAR; PG8_WAIT_L(0); PG8_MMA(0, 1, At, B1); PG8_BAR;
            PG8_LDA(At, 0, 1); PG8_STAGE(PG8_SA(0, 0), a2, voffA);
            PG8_BAR; PG8_WAIT_L(0); PG8_MMA(1, 0, At, B0); PG8_BAR; PG8_SCHED;
            PG8_STAGE(PG8_SB(0, 1), b2 + hstep, voffB);
            PG8_WAIT_V(6); PG8_BAR; PG8_MMA(1, 1, At, B1); PG8_BAR;
            PG8_LDB(B0, 1, 0); PG8_SCHED; PG8_LDA(At, 1, 0); PG8_STAGE(PG8_SA(0, 1), a2 + hstep, voffA);
            PG8_WAIT_L(8); PG8_BAR; PG8_WAIT_L(0); PG8_MMA(0, 0, At, B0); PG8_BAR; PG8_SCHED;
            PG8_LDB(B1, 1, 1); PG8_STAGE(PG8_SB(1, 0), b3, voffB);
            PG8_BAR; PG8_WAIT_L(0); PG8_MMA(0, 1, At, B1); PG8_BAR;
            PG8_LDA(At, 1, 1); PG8_STAGE(PG8_SA(1, 0), a3, voffA);
            PG8_BAR; PG8_WAIT_L(0); PG8_MMA(1, 0, At, B0); PG8_BAR; PG8_SCHED;
            PG8_STAGE(PG8_SB(1, 1), b3 + hstep, voffB);
            PG8_WAIT_V(6); PG8_BAR; PG8_MMA(1, 1, At, B1); PG8_BAR;
            }
        }
        if constexpr (ALIGN_EPI) { if (wr == 0) PG8_BAR; }
        if constexpr (!Epi::AFTER_DRAIN) { E(acc, cur, wr, wc, fr, fq); S.done(cur); }
        if (!has_next) break;
#pragma unroll
        for (int a = 0; a < 2; ++a)
#pragma unroll
            for (int b = 0; b < 2; ++b)
#pragma unroll
                for (int m = 0; m < 4; ++m)
#pragma unroll
                    for (int n = 0; n < 2; ++n) acc[a][b][m][n] = (f32x4){0.f, 0.f, 0.f, 0.f};
        cur = nxt; cA = nA; cB = nB; ++ui;
        if constexpr (ALIGN_EPI) { if (wr == 1) PG8_BAR; }
    }
    PG8_WAIT_V(0);
    if constexpr (!ALIGN_EPI) { if (wr == 0) PG8_BAR; }
    PG8_BAR;
    if constexpr (Epi::AFTER_DRAIN) { E.fused(acc, cur, wr, wc, fr, fq, lds, wid, lane); S.done(cur); }
#undef PG8_SA
#undef PG8_SB
#undef PG8_STAGE
#undef PG8_LDA
#undef PG8_LDB
#undef PG8_MMA
#undef PG8_WAIT_V
#undef PG8_WAIT_L
#undef PG8_BAR
#undef PG8_SCHED
}
}
constexpr int BATCH = 4, SEQ = 4096, DM = 1024, NCH = 64, CH = 64, MTOK = BATCH * SEQ, DEPTH = 2;
constexpr int NPROJ = 3072, IN_COLS = 3088, FF = 2816;
constexpr float EPS = 1e-6f;
constexpr size_t MiB = 1u << 20;
constexpr size_t WS_SMALL = 1 * MiB, WS_ACS = 2 * MiB, WS_CDEC = 2 * MiB + 512 * 1024, WS_EGL = 2 * MiB + 768 * 1024;
constexpr size_t WS_WIN = 3 * MiB, WS_WOUT = 9 * MiB, WS_WGU = 11 * MiB, WS_WDN = 22 * MiB;
constexpr size_t WS_XN = 28 * MiB;
constexpr size_t WS_GU = 28 * MiB, WS_GW = 36 * MiB, WS_GQE = 44 * MiB, WS_GQK = 52 * MiB, WS_GKDT = 244 * MiB;
constexpr size_t WS_PROJ = 60 * MiB, WS_H = 60 * MiB;
constexpr size_t WS_MIX = 156 * MiB;
constexpr size_t WS_STATES = 188 * MiB, WS_YPART = 220 * MiB, WS_CCONV = 236 * MiB, WS_TMP = 188 * MiB;
constexpr size_t WS_X1 = 220 * MiB;
constexpr size_t WS_END = 252 * MiB;
constexpr int LDS_BYTES = 147456;
#ifndef REP_C
#define REP_C 1
#endif
#ifndef REP_P1
#define REP_P1 1
#endif
#ifndef REP_DS
#define REP_DS 1
#endif
#ifndef RP3_MMA
#define RP3_MMA 1
#endif
#ifndef REP_GEMM
#define REP_GEMM 1
#endif
#ifndef REP_ATT
#define REP_ATT 1
#endif
#ifndef RG_CONV
#define RG_CONV 1
#endif
#ifndef RG_KK
#define RG_KK 1
#endif
#ifndef RG_SOLVE
#define RG_SOLVE 1
#endif
#ifndef REP_C1
#define REP_C1 1
#endif
#ifndef REP_C2
#define REP_C2 1
#endif
#ifndef REP_D
#define REP_D 1
#endif
#ifndef REP_E
#define REP_E 1
#endif

#define LAS __attribute__((address_space(3)))
#define DEV __device__ __forceinline__
typedef unsigned short bf16;
typedef short bf16x8 __attribute__((ext_vector_type(8)));
typedef float f32x4 __attribute__((ext_vector_type(4)));
typedef unsigned u32x4 __attribute__((ext_vector_type(4)));
typedef unsigned u32x2 __attribute__((ext_vector_type(2)));

typedef float f32x2_t __attribute__((ext_vector_type(2)));
typedef __bf16 bf16x2_t __attribute__((ext_vector_type(2)));
DEV unsigned pk2(float lo, float hi) { const f32x2_t v = {lo, hi}; const bf16x2_t b = __builtin_convertvector(v, bf16x2_t); return __builtin_bit_cast(unsigned, b); }
DEV unsigned f2bf(float f) { return pk2(f, 0.f) & 0xffffu; }
DEV float bf2f(unsigned b) { return __builtin_bit_cast(float, b << 16); }
DEV float bflo(unsigned w) { return __builtin_bit_cast(float, w << 16); }
DEV float bfhi(unsigned w) { return __builtin_bit_cast(float, w & 0xffff0000u); }
DEV float silu(float x) { return x * __builtin_amdgcn_rcpf(1.0f + __expf(-x)); }
DEV float softplus(float x) { return fmaxf(x, 0.f) + log1pf(expf(-fabsf(x))); }
template <int CTRL> DEV float dpp_f(float v) { return __builtin_bit_cast(float, __builtin_amdgcn_update_dpp(0, __builtin_bit_cast(int, v), CTRL, 0xF, 0xF, true)); }
DEV float red4_sum(float v) { v += dpp_f<0xB1>(v); v += dpp_f<0x4E>(v); return v; }
DEV float red8_sum(float v) { v = red4_sum(v); v += dpp_f<0x141>(v); return v; }
DEV float red16_sum(float v) { v = red8_sum(v); v += dpp_f<0x140>(v); return v; }
DEV float red16_max(float v) { v = fmaxf(v, dpp_f<0xB1>(v)); v = fmaxf(v, dpp_f<0x4E>(v)); v = fmaxf(v, dpp_f<0x141>(v)); v = fmaxf(v, dpp_f<0x140>(v)); return v; }
DEV float rdlane(float v, int l) { return __builtin_bit_cast(float, __builtin_amdgcn_readlane(__builtin_bit_cast(int, v), l)); }
DEV float wave_sum(float v) { v = red16_sum(v); return (rdlane(v, 0) + rdlane(v, 16)) + (rdlane(v, 32) + rdlane(v, 48)); }
DEV float wave_incl_scan(float v, int lane) {
    v += dpp_f<0x111>(v); v += dpp_f<0x112>(v); v += dpp_f<0x114>(v); v += dpp_f<0x118>(v);
    const float t0 = rdlane(v, 15), t1 = rdlane(v, 31), t2 = rdlane(v, 47);
    const int r = lane >> 4;
    return v + (r > 0 ? t0 : 0.f) + (r > 1 ? t1 : 0.f) + (r > 2 ? t2 : 0.f);
}
DEV float frcp(float x) { return __builtin_amdgcn_rcpf(x); }
DEV f32x4 mma_tile(const LAS bf16* A, int lda, const LAS bf16* B, int ldb, int K, int lane, f32x4 acc) {
    const LAS bf16* ap = A + (lane & 15) * lda + (lane >> 4) * 8;
    const LAS bf16* bp = B + (lane & 15) * ldb + (lane >> 4) * 8;
    for (int k = 0; k < K; k += 32) {
        const bf16x8 a = *(const LAS bf16x8*)(ap + k), b = *(const LAS bf16x8*)(bp + k);
        acc = __builtin_amdgcn_mfma_f32_16x16x32_bf16(a, b, acc, 0, 0, 0);
    }
    return acc;
}

struct Params {
    const float *x, *pre_mix, *post_mix, *pre_ffn, *post_ffn, *w_in, *w_out, *sinks, *sconv_w, *sconv_b, *sdt_bias, *sA_log, *sD, *snorm_w,
                *gconv_w, *gdt_bias, *gA_log, *gnorm_w, *w_gate, *w_up, *w_down;
    float* out; unsigned char* ws;
};

DEV void tr_item(const float* W, int ldw, int col0, bf16* WT, int K, int drow0, int rs, LAS float* scr, int kb, int nb, int lane) {
    const int k0 = 64 * kb, n0 = 32 * nb;
    float wv[32];
#pragma unroll
    for (int i = 0; i < 32; ++i) { const int kk = 2 * i + (lane >> 5); wv[i] = W[(size_t)(k0 + kk) * ldw + col0 + n0 + (lane & 31)]; }
#pragma unroll
    for (int i = 0; i < 32; ++i) { const int kk = 2 * i + (lane >> 5); scr[kk * 33 + (lane & 31)] = wv[i]; }
    asm volatile("s_waitcnt lgkmcnt(0)" ::: "memory");
    const int c = lane & 7;
#pragma unroll
    for (int j = 0; j < 4; ++j) { const int n = (lane >> 3) + 8 * j; const LAS float* s = scr + (8 * c) * 33 + n;
        u32x4 o; o.x = pk2(s[0 * 33], s[1 * 33]); o.y = pk2(s[2 * 33], s[3 * 33]); o.z = pk2(s[4 * 33], s[5 * 33]); o.w = pk2(s[6 * 33], s[7 * 33]);
        *(u32x4*)(WT + (size_t)(drow0 + (n0 + n) * rs) * K + k0 + 8 * c) = o; }
    asm volatile("s_waitcnt lgkmcnt(0)" ::: "memory");
}
DEV void convert_weights(const Params& p, int l, LAS unsigned char* lds, int gw, int NGW, int wave, int lane) {
    LAS float* scr = (LAS float*)(lds + wave * 8448);
    const float* win = p.w_in + (size_t)l * DM * IN_COLS; const float* wout = p.w_out + (size_t)l * DM * DM;
    const float* wg = p.w_gate + (size_t)l * DM * FF; const float* wu = p.w_up + (size_t)l * DM * FF; const float* wd = p.w_down + (size_t)l * FF * DM;
    bf16* WIN = (bf16*)(p.ws + WS_WIN); bf16* WOUT = (bf16*)(p.ws + WS_WOUT); bf16* WGU = (bf16*)(p.ws + WS_WGU); bf16* WDN = (bf16*)(p.ws + WS_WDN);
    constexpr int I_IN = 16 * 96, I_OUT = 16 * 32, I_G = 16 * 88, I_D = 44 * 32;
    constexpr int NIT = I_IN + I_OUT + 2 * I_G + I_D;
    for (int it = gw; it < NIT; it += NGW) {
        int r = it;
        if (r < I_IN) { const int kb = r / 96, nb = r % 96;
            if (nb < 64) tr_item(win, IN_COLS, 0, WIN, DM, 0, 1, scr, kb, nb, lane); else tr_item(win, IN_COLS, 2056, WIN, DM, 2048, 1, scr, kb, nb - 64, lane);
            continue; } r -= I_IN;
        if (r < I_OUT) { tr_item(wout, DM, 0, WOUT, DM, 0, 1, scr, r / 32, r % 32, lane); continue; } r -= I_OUT;
        if (r < I_G) { tr_item(wg, FF, 0, WGU, DM, 0, 2, scr, r / 88, r % 88, lane); continue; } r -= I_G;
        if (r < I_G) { tr_item(wu, FF, 0, WGU, DM, 1, 2, scr, r / 88, r % 88, lane); continue; } r -= I_G;
        tr_item(wd, DM, 0, WDN, FF, 0, 1, scr, r / 32, r % 32, lane);
    }
}
DEV void stage_small(const Params& p, int l, LAS float* wsT, int tid) {
    const float* win = p.w_in + (size_t)l * DM * IN_COLS;
    for (int idx = tid; idx < 16 * DM; idx += 512) { const int k = idx >> 4, c = idx & 15; const int sc = c < 8 ? 2048 + c : 3072 + c; wsT[c * DM + k] = win[(size_t)k * IN_COLS + sc]; }
}
template <int MODE, bool RB = false, bool OB = false>
DEV void rowpass(const void* res_, const bf16* tmp, const float* wpost, const float* wnext, void* xout_, bf16* XN, float* SMALL, const LAS float* wsT, int gw, int NGW, int lane) {
    const float* res = (const float*)res_; const bf16* res16 = (const bf16*)res_; float* xout = (float*)xout_; bf16* xout16 = (bf16*)xout_;
    f32x4 wp[4], wn[4];
#pragma unroll
    for (int j = 0; j < 4; ++j) {
        if (MODE != 0) wp[j] = *((const f32x4*)wpost + lane + 64 * j);
        if (MODE != 3) wn[j] = *((const f32x4*)wnext + lane + 64 * j);
    }
    f32x4 nv[4]; u32x2 nv16[4]; u32x2 ntw[4];
#pragma unroll
    for (int j = 0; j < 4; ++j) { if (RB) nv16[j] = *((const u32x2*)(res16 + (size_t)gw * DM) + lane + 64 * j); else nv[j] = *((const f32x4*)(res + (size_t)gw * DM) + lane + 64 * j);
        if (MODE != 0) ntw[j] = *((const u32x2*)(tmp + (size_t)gw * DM) + lane + 64 * j); }
    for (int m = gw; m < MTOK; m += NGW) {
        f32x4 v[4]; u32x2 ctw[4];
#pragma unroll
        for (int j = 0; j < 4; ++j) { if (RB) v[j] = (f32x4){bflo(nv16[j].x), bfhi(nv16[j].x), bflo(nv16[j].y), bfhi(nv16[j].y)}; else v[j] = nv[j]; if (MODE != 0) ctw[j] = ntw[j]; }
        { const int mn = (m + NGW < MTOK) ? m + NGW : m;
#pragma unroll
            for (int j = 0; j < 4; ++j) { if (RB) nv16[j] = *((const u32x2*)(res16 + (size_t)mn * DM) + lane + 64 * j); else nv[j] = *((const f32x4*)(res + (size_t)mn * DM) + lane + 64 * j);
                if (MODE != 0) ntw[j] = *((const u32x2*)(tmp + (size_t)mn * DM) + lane + 64 * j); } }
        if (MODE != 0) {
            f32x4 t[4]; float ss = 0.f;
#pragma unroll
            for (int j = 0; j < 4; ++j) { const u32x2 tw = ctw[j]; t[j] = (f32x4){bflo(tw.x), bfhi(tw.x), bflo(tw.y), bfhi(tw.y)}; ss += (t[j].x * t[j].x + t[j].y * t[j].y) + (t[j].z * t[j].z + t[j].w * t[j].w); }
            const float rstd = rsqrtf(wave_sum(ss) * (1.0f / DM) + EPS);
#pragma unroll
            for (int j = 0; j < 4; ++j) { v[j] = v[j] + t[j] * rstd * wp[j];
                if (OB) { u32x2 o; o.x = pk2(v[j].x, v[j].y); o.y = pk2(v[j].z, v[j].w); *((u32x2*)(xout16 + (size_t)m * DM) + lane + 64 * j) = o; }
                else *((f32x4*)(xout + (size_t)m * DM) + lane + 64 * j) = v[j]; }
        }
        if (MODE != 3) {
            float ss = 0.f;
#pragma unroll
            for (int j = 0; j < 4; ++j) ss += (v[j].x * v[j].x + v[j].y * v[j].y) + (v[j].z * v[j].z + v[j].w * v[j].w);
            const float rstd = rsqrtf(wave_sum(ss) * (1.0f / DM) + EPS);
#pragma unroll
            for (int j = 0; j < 4; ++j) { v[j] = v[j] * rstd * wn[j];
                u32x2 o; o.x = pk2(v[j].x, v[j].y); o.y = pk2(v[j].z, v[j].w); *((u32x2*)(XN + (size_t)m * DM) + lane + 64 * j) = o; }
            if (MODE == 0 || MODE == 2) {
                float mine = 0.f;
#pragma unroll
                for (int c = 0; c < 16; ++c) { float s = 0.f; asm volatile("" ::: "memory");
#pragma unroll
                    for (int j = 0; j < 4; ++j) { const f32x4 w = *((const LAS f32x4*)(wsT + c * DM) + lane + 64 * j); s += (v[j].x * w.x + v[j].y * w.y) + (v[j].z * w.z + v[j].w * w.w); }
                    s = red16_sum(s); mine = ((lane & 15) == c) ? s : mine; }
                mine += __shfl_xor(mine, 16); mine += __shfl_xor(mine, 32);
                if (lane < 16) SMALL[(size_t)m * 16 + lane] = mine;
            }
        }
    }
}

DEV void attn_unit(const Params& p, int l, int u, LAS unsigned char* lds, int tid) {
    asm volatile("" : "+v"(tid));
    const int b = u >> 7, c = (u >> 1) & 63, kvh = u & 1, wave = tid >> 6, lane = tid & 63;
    const bf16* PROJ = (const bf16*)(p.ws + WS_PROJ); bf16* MIX = (bf16*)(p.ws + WS_MIX);
    LAS bf16* Qs = (LAS bf16*)lds;
    LAS bf16* Ks = Qs + 128 * 72;
    LAS bf16* Vt = Ks + 192 * 72;
    LAS bf16* Ps = Vt + 64 * 200;
    const size_t t0 = (size_t)b * SEQ + (size_t)c * CH;
    const float sink = p.sinks[l * 4 + kvh * 2 + (wave >> 2)];
    {
        u32x4 rq[2], rk[3], rv[3];
#pragma unroll
        for (int k = 0; k < 2; ++k) { const int idx = tid + k * 512, r = idx >> 3, v = idx & 7, g = r >> 6, i = r & 63;
            rq[k] = *(const u32x4*)(PROJ + (t0 + i) * NPROJ + kvh * 128 + g * 64 + v * 8); }
#pragma unroll
        for (int k = 0; k < 3; ++k) { const int idx = tid + k * 512, j = idx >> 3, v = idx & 7; const bool valid = (c - 2 + (j >> 6)) >= 0;
            rk[k] = (u32x4){0u, 0u, 0u, 0u}; rv[k] = rk[k];
            if (valid) { const bf16* rowp = PROJ + (size_t)((long)t0 - 128 + j) * NPROJ; rk[k] = *(const u32x4*)(rowp + 256 + kvh * 64 + v * 8); rv[k] = *(const u32x4*)(rowp + 384 + kvh * 64 + v * 8); } }
#pragma unroll
        for (int k = 0; k < 2; ++k) { const int idx = tid + k * 512, r = idx >> 3, v = idx & 7; *(LAS u32x4*)(Qs + r * 72 + v * 8) = rq[k]; }
#pragma unroll
        for (int k = 0; k < 3; ++k) { const int idx = tid + k * 512, j = idx >> 3, v = idx & 7; const u32x4 vv = rv[k];
            *(LAS u32x4*)(Ks + j * 72 + v * 8) = rk[k];
            LAS bf16* vt = Vt + (v * 8) * 200 + j;
            vt[0 * 200] = (bf16)(vv.x & 0xffffu); vt[1 * 200] = (bf16)(vv.x >> 16); vt[2 * 200] = (bf16)(vv.y & 0xffffu); vt[3 * 200] = (bf16)(vv.y >> 16);
            vt[4 * 200] = (bf16)(vv.z & 0xffffu); vt[5 * 200] = (bf16)(vv.z >> 16); vt[6 * 200] = (bf16)(vv.w & 0xffffu); vt[7 * 200] = (bf16)(vv.w >> 16); }
    }
    __syncthreads();
    {
        const int g = wave >> 2, h = kvh * 2 + g;
        const float slope = exp2f(-2.0f * (float)(h + 1));
        f32x4 s[12];
#pragma unroll
        for (int nt = 0; nt < 12; ++nt) s[nt] = mma_tile(Qs + wave * 16 * 72, 72, Ks + nt * 16 * 72, 72, 64, lane, (f32x4){0.f, 0.f, 0.f, 0.f});
#pragma unroll
        for (int j = 0; j < 4; ++j) {
            const int r = wave * 16 + (lane >> 4) * 4 + j, i = r & 63;
            float mx = sink;
#pragma unroll
            for (int nt = 0; nt < 12; ++nt) { const int jj = nt * 16 + (lane & 15);
                float val = s[nt][j] * 0.125f - slope * fabsf((float)(i + 128 - jj));
                if (c - 2 + (nt >> 2) < 0) val = -INFINITY;
                s[nt][j] = val; mx = fmaxf(mx, val); }
            mx = red16_max(mx);
            float sum = 0.f;
#pragma unroll
            for (int nt = 0; nt < 12; ++nt) { const float e = __expf(s[nt][j] - mx); s[nt][j] = e; sum += e; }
            sum = red16_sum(sum);
            sum += __expf(sink - mx);
            const float inv = frcp(sum);
#pragma unroll
            for (int nt = 0; nt < 12; ++nt) Ps[r * 200 + nt * 16 + (lane & 15)] = (bf16)f2bf(s[nt][j] * inv);
        }
    }
    __syncthreads();
#pragma unroll
    for (int nt = 0; nt < 4; ++nt) {
        const f32x4 acc = mma_tile(Vt + nt * 16 * 200, 200, Ps + wave * 16 * 200, 200, 192, lane, (f32x4){0.f, 0.f, 0.f, 0.f});
        const int r = wave * 16 + (lane & 15), g = r >> 6, i = r & 63, d0 = nt * 16 + (lane >> 4) * 4;
        u32x2 o; o.x = pk2(acc[0], acc[1]); o.y = pk2(acc[2], acc[3]);
        *(u32x2*)(MIX + (t0 + i) * DM + (kvh * 2 + g) * 64 + d0) = o;
    }
    __syncthreads();
}

template <int NCOLS> struct RawTile {
    static constexpr int VPR = NCOLS / 8, NV = 67 * VPR, NIT = (NV + 511) / 512;
    u32x4 r[NIT];
    DEV void issue(const bf16* PROJ, size_t t0, int c, int col0, int tid) {
#pragma unroll
        for (int k = 0; k < NIT; ++k) { const int idx = tid + k * 512, row = idx / VPR, v = idx % VPR;
            r[k] = (u32x4){0u, 0u, 0u, 0u};
            if (idx < NV && (c > 0 || row >= 3)) r[k] = *(const u32x4*)(PROJ + (size_t)((long)t0 - 3 + row) * NPROJ + col0 + v * 8); }
    }
    DEV void commit(LAS bf16* Raw, int rawld, int dcol0, int tid) const {
#pragma unroll
        for (int k = 0; k < NIT; ++k) { const int idx = tid + k * 512, row = idx / VPR, v = idx % VPR;
            if (idx < NV) *(LAS u32x4*)(Raw + row * rawld + dcol0 + v * 8) = r[k]; }
    }
};
struct P1PF { RawTile<256> R1; float sm; };
DEV void ssd_p1_issue(const Params& p, int u, int tid, P1PF& pf) {
    const int b = u >> 7, c = (u >> 1) & 63, g = u & 1, lane = tid & 63;
    const bf16* PROJ = (const bf16*)(p.ws + WS_PROJ); const float* SMALL = (const float*)(p.ws + WS_SMALL);
    const size_t t0 = (size_t)b * SEQ + (size_t)c * CH;
    pf.R1.issue(PROJ, t0, c, 1024 + g * 256, tid);
    pf.sm = 0.f; if (tid < 256) pf.sm = SMALL[(t0 + lane) * 16 + g * 4 + (tid >> 6)];
}
DEV void ssd_p1_unit(const Params& p, int l, int u, int unext, LAS unsigned char* lds, int tid, P1PF& pf) {
    asm volatile("" : "+v"(tid));
    const int b = u >> 7, c = (u >> 1) & 63, g = u & 1, wave = tid >> 6, lane = tid & 63;
    const bf16* PROJ = (const bf16*)(p.ws + WS_PROJ);
    const float* SMALL = (const float*)(p.ws + WS_SMALL);
    float* ACS = (float*)(p.ws + WS_ACS); float* CDEC = (float*)(p.ws + WS_CDEC);
    bf16* STATES = (bf16*)(p.ws + WS_STATES); bf16* YPART = (bf16*)(p.ws + WS_YPART); bf16* CCONV = (bf16*)(p.ws + WS_CCONV);
    LAS bf16* XsT = (LAS bf16*)lds;
    LAS bf16* Bm = XsT + 4 * 64 * 72;
    LAS bf16* Cm = Bm + 64 * 136;
    LAS bf16* BmT = Cm + 64 * 136;
    LAS bf16* Sc = BmT + 128 * 72;
    LAS bf16* Raw = Sc;
    LAS float* dtS = (LAS float*)(Sc + 4 * 64 * 72);
    LAS float* acsS = dtS + 256;
    LAS float* fS = acsS + 256;
    const size_t t0 = (size_t)b * SEQ + (size_t)c * CH;
    RawTile<128> R2b, R2c;
    R2b.issue(PROJ, t0, c, 1024 + 512 + g * 128, tid); R2c.issue(PROJ, t0, c, 1024 + 768 + g * 128, tid);
    float cw1[5], cw2[5];
    { const int ch = tid & 255, chg1 = g * 256 + ch, chg2 = 512 + (ch >> 7) * 256 + g * 128 + (ch & 127);
      const float* c1 = p.sconv_w + (size_t)l * 4096 + chg1; const float* c2 = p.sconv_w + (size_t)l * 4096 + chg2;
      cw1[0] = c1[0]; cw1[1] = c1[1024]; cw1[2] = c1[2048]; cw1[3] = c1[3072]; cw1[4] = p.sconv_b[l * 1024 + chg1];
      cw2[0] = c2[0]; cw2[1] = c2[1024]; cw2[2] = c2[2048]; cw2[3] = c2[3072]; cw2[4] = p.sconv_b[l * 1024 + chg2]; }
    const float Dh = p.sD[l * 8 + g * 4 + (wave >> 1)];
    if (tid < 256) {
        const int h = tid >> 6, hh = g * 4 + h;
        const float dt = softplus(pf.sm + p.sdt_bias[l * 8 + hh]);
        const float a = -expf(p.sA_log[l * 8 + hh]);
        const float acs = wave_incl_scan(dt * a, lane);
        const float alast = rdlane(acs, 63);
        dtS[tid] = dt; acsS[tid] = acs; fS[tid] = dt * expf(alast - acs);
        ACS[(t0 + lane) * 8 + hh] = acs;
        if (lane == 63) CDEC[((size_t)b * NCH + c) * 8 + hh] = expf(acs);
    }
    pf.R1.commit(Raw, 256, 0, tid);
    __syncthreads();
    {
        const int ch = tid & 255, half = tid >> 8, chg = g * 256 + ch, h = ch >> 6, pp = ch & 63;
        const float w0 = cw1[0], w1 = cw1[1], w2 = cw1[2], w3 = cw1[3], bias = cw1[4]; (void)chg;
        const int r0 = half * 32;
        float x0 = bf2f(Raw[(r0 + 0) * 256 + ch]), x1 = bf2f(Raw[(r0 + 1) * 256 + ch]), x2 = bf2f(Raw[(r0 + 2) * 256 + ch]);
        LAS bf16* dst = XsT + h * 64 * 72 + pp * 72 + r0;
#pragma unroll 8
        for (int r = 0; r < 32; ++r) { const float x3 = bf2f(Raw[(r0 + r + 3) * 256 + ch]);
            const float y = silu(w0 * x0 + w1 * x1 + w2 * x2 + w3 * x3 + bias);
            dst[r] = (bf16)f2bf(y); x0 = x1; x1 = x2; x2 = x3; }
    }
    __syncthreads();
    R2b.commit(Raw, 256, 0, tid); R2c.commit(Raw, 256, 128, tid);
    if (unext >= 0) ssd_p1_issue(p, unext, tid, pf);
    __syncthreads();
    {
        const int ch = tid & 255, half = tid >> 8, isC = ch >> 7, n = ch & 127, chg = 512 + isC * 256 + g * 128 + n;
        const float w0 = cw2[0], w1 = cw2[1], w2 = cw2[2], w3 = cw2[3], bias = cw2[4]; (void)chg;
        const int r0 = half * 32;
        float x0 = bf2f(Raw[(r0 + 0) * 256 + ch]), x1 = bf2f(Raw[(r0 + 1) * 256 + ch]), x2 = bf2f(Raw[(r0 + 2) * 256 + ch]);
#pragma unroll 8
        for (int r = 0; r < 32; ++r) { const float x3 = bf2f(Raw[(r0 + r + 3) * 256 + ch]);
            const bf16 y = (bf16)f2bf(silu(w0 * x0 + w1 * x1 + w2 * x2 + w3 * x3 + bias));
            if (isC) Cm[(r0 + r) * 136 + n] = y; else { Bm[(r0 + r) * 136 + n] = y; BmT[n * 72 + r0 + r] = y; }
            x0 = x1; x1 = x2; x2 = x3; }
    }
    __syncthreads();
    for (int idx = tid; idx < 1024; idx += 512) { const int r = idx >> 4, v = idx & 15; *(u32x4*)(CCONV + (t0 + r) * 256 + g * 128 + v * 8) = *(const LAS u32x4*)(Cm + r * 136 + v * 8); }
#pragma unroll
    for (int ti = 0; ti < 2; ++ti) {
        const int tt = wave * 2 + ti, mt = tt >> 2, nt = tt & 3;
        f32x4 acc = (f32x4){0.f, 0.f, 0.f, 0.f};
        if (nt <= mt) acc = mma_tile(Bm + nt * 16 * 136, 136, Cm + mt * 16 * 136, 136, 128, lane, acc);
        const int lr = mt * 16 + (lane & 15), s0 = nt * 16 + (lane >> 4) * 4;
#pragma unroll
        for (int h = 0; h < 4; ++h) { const f32x4 as = *(const LAS f32x4*)(acsS + h * 64 + s0), ds = *(const LAS f32x4*)(dtS + h * 64 + s0); const float al = acsS[h * 64 + lr];
            float v[4];
#pragma unroll
            for (int j = 0; j < 4; ++j) v[j] = (s0 + j <= lr) ? acc[j] * __expf(al - as[j]) * ds[j] : 0.f;
            u32x2 o; o.x = pk2(v[0], v[1]); o.y = pk2(v[2], v[3]);
            *(LAS u32x2*)(Sc + h * 64 * 72 + lr * 72 + s0) = o; }
    }
    __syncthreads();
    {
        const int h = wave >> 1, hh = g * 4 + h;
#pragma unroll 2
        for (int ti = 0; ti < 8; ++ti) { const int tt = (wave & 1) * 8 + ti, mt = tt >> 2, nt = tt & 3;
            const f32x4 acc = mma_tile(XsT + h * 64 * 72 + nt * 16 * 72, 72, Sc + h * 64 * 72 + mt * 16 * 72, 72, 64, lane, (f32x4){0.f, 0.f, 0.f, 0.f});
            const int lr = mt * 16 + (lane & 15), p0 = nt * 16 + (lane >> 4) * 4;
            const LAS bf16* xp = XsT + h * 64 * 72 + p0 * 72 + lr;
            u32x2 o; o.x = pk2(acc[0] + Dh * bf2f(xp[0]), acc[1] + Dh * bf2f(xp[72])); o.y = pk2(acc[2] + Dh * bf2f(xp[144]), acc[3] + Dh * bf2f(xp[216]));
            *(u32x2*)(YPART + (t0 + lr) * 512 + hh * 64 + p0) = o; }
#pragma unroll
        for (int pi = 0; pi < 2; ++pi) { const int pt = (wave & 1) * 2 + pi;
            bf16x8 xf[2];
#pragma unroll
            for (int k = 0; k < 2; ++k) { const int l0 = k * 32 + (lane >> 4) * 8;
                const u32x4 xw = *(const LAS u32x4*)(XsT + h * 64 * 72 + (pt * 16 + (lane & 15)) * 72 + l0);
                const f32x4 f0 = *(const LAS f32x4*)(fS + h * 64 + l0), f1 = *(const LAS f32x4*)(fS + h * 64 + l0 + 4);
                u32x4 o; o.x = pk2(bflo(xw.x) * f0.x, bfhi(xw.x) * f0.y); o.y = pk2(bflo(xw.y) * f0.z, bfhi(xw.y) * f0.w);
                o.z = pk2(bflo(xw.z) * f1.x, bfhi(xw.z) * f1.y); o.w = pk2(bflo(xw.w) * f1.z, bfhi(xw.w) * f1.w);
                xf[k] = __builtin_bit_cast(bf16x8, o); }
#pragma unroll 2
            for (int nt = 0; nt < 8; ++nt) {
                f32x4 acc = (f32x4){0.f, 0.f, 0.f, 0.f};
#pragma unroll
                for (int k = 0; k < 2; ++k) { const bf16x8 bfr = *(const LAS bf16x8*)(BmT + (nt * 16 + (lane & 15)) * 72 + k * 32 + (lane >> 4) * 8);
                    acc = __builtin_amdgcn_mfma_f32_16x16x32_bf16(bfr, xf[k], acc, 0, 0, 0); }
                u32x2 o; o.x = pk2(acc[0], acc[1]); o.y = pk2(acc[2], acc[3]);
                *(u32x2*)(STATES + ((((size_t)b * NCH + c) * 8 + hh) * 64 + pt * 16 + (lane & 15)) * 128 + nt * 16 + (lane >> 4) * 4) = o; } }
    }
    __syncthreads();
}
DEV void ssd_scan_all(const Params& p, int bx, LAS unsigned char* lds, int tid) {
    asm volatile("" : "+v"(tid));
    bf16* STATES = (bf16*)(p.ws + WS_STATES); const float* CDEC = (const float*)(p.ws + WS_CDEC);
    LAS float* decS = (LAS float*)lds;
    const int idx = bx * 512 + tid, b = idx >> 15, rem = idx & 32767, hh = rem >> 12, pn2 = rem & 4095;
    if (tid < 64) decS[tid] = CDEC[((size_t)b * NCH + tid) * 8 + hh];
    unsigned* base = (unsigned*)(STATES + ((size_t)b * NCH * 8 + hh) * 8192) + pn2;
    unsigned nw[NCH];
#pragma unroll
    for (int c = 0; c < NCH; ++c) nw[c] = base[(size_t)c * 8 * 4096];
    __syncthreads();
    float s0 = 0.f, s1 = 0.f;
#pragma unroll
    for (int c = 0; c < NCH; ++c) { const float d = decS[c];
        base[(size_t)c * 8 * 4096] = pk2(s0, s1);
        s0 = s0 * d + bflo(nw[c]); s1 = s1 * d + bfhi(nw[c]); }
    __syncthreads();
}
DEV void ssd_p3_unit(const Params& p, int l, int u, LAS unsigned char* lds, int tid) {
    asm volatile("" : "+v"(tid));
    const int b = u >> 7, c = (u >> 1) & 63, g = u & 1, wave = tid >> 6, lane = tid & 63;
    const bf16* PROJ = (const bf16*)(p.ws + WS_PROJ); const float* ACS = (const float*)(p.ws + WS_ACS);
    const bf16* STATES = (const bf16*)(p.ws + WS_STATES); const bf16* YPART = (const bf16*)(p.ws + WS_YPART); const bf16* CCONV = (const bf16*)(p.ws + WS_CCONV);
    bf16* MIX = (bf16*)(p.ws + WS_MIX);
    LAS bf16* Cm = (LAS bf16*)lds;
    LAS bf16* Prev = Cm + 64 * 136;
    LAS float* Gb = (LAS float*)Prev;
    LAS float* acsS = (LAS float*)(Prev + 4 * 64 * 136);
    const size_t t0 = (size_t)b * SEQ + (size_t)c * CH;
    const int h = wave >> 1, hh = g * 4 + h;
    u32x4 rc[2], rp[8]; u32x2 ry[8], rz[8]; float racs = 0.f;
    f32x4 nw[8];
    { const f32x4* nwp = (const f32x4*)(p.snorm_w + (size_t)l * 512 + g * 256 + (tid & 7) * 32);
#pragma unroll
        for (int k = 0; k < 8; ++k) nw[k] = nwp[k]; }
#pragma unroll
    for (int k = 0; k < 2; ++k) { const int idx = tid + k * 512, r = idx >> 4, v = idx & 15; rc[k] = *(const u32x4*)(CCONV + (t0 + r) * 256 + g * 128 + v * 8); }
#pragma unroll
    for (int k = 0; k < 8; ++k) { const int idx = tid + k * 512, hq = idx >> 10, r = (idx >> 4) & 63, v = idx & 15;
        rp[k] = *(const u32x4*)(STATES + ((((size_t)b * NCH + c) * 8 + g * 4 + hq) * 64 + r) * 128 + v * 8); }
    if (tid < 256) racs = ACS[(t0 + (tid & 63)) * 8 + g * 4 + (tid >> 6)];
#pragma unroll
    for (int ti = 0; ti < 8; ++ti) { const int tt = (wave & 1) * 8 + ti, mt = tt >> 2, nt = tt & 3, lr = mt * 16 + (lane & 15), p0 = nt * 16 + (lane >> 4) * 4;
        ry[ti] = *(const u32x2*)(YPART + (t0 + lr) * 512 + hh * 64 + p0); rz[ti] = *(const u32x2*)(PROJ + (t0 + lr) * NPROJ + 512 + hh * 64 + p0); }
#pragma unroll
    for (int k = 0; k < 2; ++k) { const int idx = tid + k * 512, r = idx >> 4, v = idx & 15; *(LAS u32x4*)(Cm + r * 136 + v * 8) = rc[k]; }
#pragma unroll
    for (int k = 0; k < 8; ++k) { const int idx = tid + k * 512, hq = idx >> 10, r = (idx >> 4) & 63, v = idx & 15; *(LAS u32x4*)(Prev + hq * 64 * 136 + r * 136 + v * 8) = rp[k]; }
    if (tid < 256) acsS[tid] = racs;
    __syncthreads();
    f32x4 acc[8];
    for (int rq_ = 0; rq_ < RP3_MMA; ++rq_) {
#pragma unroll
    for (int ti = 0; ti < 8; ++ti) { const int tt = (wave & 1) * 8 + ti, mt = tt >> 2, nt = tt & 3;
        acc[ti] = mma_tile(Prev + h * 64 * 136 + nt * 16 * 136, 136, Cm + mt * 16 * 136, 136, 128, lane, (f32x4){0.f, 0.f, 0.f, 0.f}); }
    asm volatile("" ::: "memory"); }
    __syncthreads();
#pragma unroll
    for (int ti = 0; ti < 8; ++ti) { const int tt = (wave & 1) * 8 + ti, mt = tt >> 2, nt = tt & 3, lr = mt * 16 + (lane & 15), p0 = nt * 16 + (lane >> 4) * 4;
        const float ea = __expf(acsS[h * 64 + lr]);
        f32x4 gv;
        gv.x = (bflo(ry[ti].x) + ea * acc[ti][0]) * silu(bflo(rz[ti].x)); gv.y = (bfhi(ry[ti].x) + ea * acc[ti][1]) * silu(bfhi(rz[ti].x));
        gv.z = (bflo(ry[ti].y) + ea * acc[ti][2]) * silu(bflo(rz[ti].y)); gv.w = (bfhi(ry[ti].y) + ea * acc[ti][3]) * silu(bfhi(rz[ti].y));
        *(LAS f32x4*)(Gb + lr * 260 + h * 64 + p0) = gv; }
    __syncthreads();
    {
        const int lr = tid >> 3, part = tid & 7;
        f32x4 v[8]; float ss = 0.f;
#pragma unroll
        for (int k = 0; k < 8; ++k) { v[k] = *(const LAS f32x4*)(Gb + lr * 260 + part * 32 + k * 4); ss += (v[k].x * v[k].x + v[k].y * v[k].y) + (v[k].z * v[k].z + v[k].w * v[k].w); }
        ss = red8_sum(ss);
        const float rstd = rsqrtf(ss * (1.0f / 256.0f) + EPS);
        bf16* dst = MIX + (t0 + lr) * DM + 256 + g * 256 + part * 32;
#pragma unroll
        for (int k = 0; k < 4; ++k) { const f32x4 a = v[2 * k] * rstd * nw[2 * k], bq = v[2 * k + 1] * rstd * nw[2 * k + 1];
            u32x4 o; o.x = pk2(a.x, a.y); o.y = pk2(a.z, a.w); o.z = pk2(bq.x, bq.y); o.w = pk2(bq.z, bq.w);
            *(u32x4*)(dst + 8 * k) = o; }
    }
    __syncthreads();
}

struct GdnPF { u32x4 rr[4]; float sb, sa; };
DEV void gdn_pre_issue(const Params& p, int u, int tid, GdnPF& pf) {
    const int b = u >> 8, c = (u >> 2) & 63, hg = u & 3, lane = tid & 63;
    const bf16* PROJ = (const bf16*)(p.ws + WS_PROJ); const float* SMALL = (const float*)(p.ws + WS_SMALL);
    const size_t t0 = (size_t)b * SEQ + (size_t)c * CH;
#pragma unroll
    for (int k = 0; k < 4; ++k) { const int idx = tid + k * 512, row = idx / 24, rem = idx % 24, seg = rem >> 3, v = rem & 7;
        pf.rr[k] = (u32x4){0u, 0u, 0u, 0u};
        if (idx < 67 * 24 && (c > 0 || row >= 3)) pf.rr[k] = *(const u32x4*)(PROJ + (size_t)((long)t0 - 3 + row) * NPROJ + 2048 + seg * 256 + hg * 64 + v * 8); }
    pf.sb = 0.f; pf.sa = 0.f;
    if ((tid >> 6) == 0) { pf.sb = SMALL[(t0 + lane) * 16 + 8 + hg]; pf.sa = SMALL[(t0 + lane) * 16 + 12 + hg]; }
}
DEV void gdn_pre_unit(const Params& p, int l, int u, int unext, LAS unsigned char* lds, int tid, GdnPF& pf) {
    asm volatile("" : "+v"(tid));
    const int b = u >> 8, c = (u >> 2) & 63, hg = u & 3, wave = tid >> 6, lane = tid & 63;
    const int ub = (b * 4 + hg) * 64 + c;
    const bf16* PROJ = (const bf16*)(p.ws + WS_PROJ); const float* SMALL = (const float*)(p.ws + WS_SMALL);
    bf16* GU = (bf16*)(p.ws + WS_GU) + (size_t)ub * 4096; bf16* GW = (bf16*)(p.ws + WS_GW) + (size_t)ub * 4096; bf16* GQE = (bf16*)(p.ws + WS_GQE) + (size_t)ub * 4096;
    bf16* GQK = (bf16*)(p.ws + WS_GQK) + (size_t)ub * 4096; bf16* GKDT = (bf16*)(p.ws + WS_GKDT) + (size_t)ub * 4096; float* EGL = (float*)(p.ws + WS_EGL);
    LAS bf16* Raw = (LAS bf16*)lds;
    LAS float* Xn = (LAS float*)lds;
    LAS float* Qs = (LAS float*)(lds + 25728);
    LAS float* Ks = Qs + 64 * 65;
    LAS float* Vs = Ks + 64 * 65;
    LAS float* Am = Vs + 64 * 65;
    LAS float* betaS = Am + 64 * 64;
    LAS float* gcS = betaS + 64;
    LAS float* scwS = gcS + 64;
    LAS float* egS = scwS + 64;
    LAS float* kdS = egS + 64;
    LAS float* R = kdS + 64;
    LAS float* At = R + 64 * 128;
    LAS float* Dv = At + 64 * 64;
    const size_t t0 = (size_t)b * SEQ + (size_t)c * CH;
    float cwv[3][4];
#pragma unroll
    for (int seg = 0; seg < 3; ++seg) { const float* cw = p.gconv_w + (size_t)l * 3072 + seg * 256 + hg * 64 + lane; cwv[seg][0] = cw[0]; cwv[seg][1] = cw[768]; cwv[seg][2] = cw[1536]; cwv[seg][3] = cw[2304]; }
    if (wave == 0) {
        const float beta = frcp(1.0f + expf(-pf.sb));
        const float gg = -expf(p.gA_log[l * 4 + hg]) * softplus(pf.sa + p.gdt_bias[l * 4 + hg]);
        const float gc = wave_incl_scan(gg, lane);
        const float glast = rdlane(gc, 63), eg = expf(gc);
        betaS[lane] = beta; gcS[lane] = gc; scwS[lane] = beta * eg; egS[lane] = eg; kdS[lane] = expf(glast - gc);
        if (lane == 63) EGL[ub] = eg;
    }
#pragma unroll
    for (int k = 0; k < 4; ++k) { const int idx = tid + k * 512, row = idx / 24, rem = idx % 24;
        if (idx < 67 * 24) *(LAS u32x4*)(Raw + row * 192 + rem * 8) = pf.rr[k]; }
    __syncthreads();
    for (int rq_ = 0; rq_ < RG_CONV; ++rq_)
#pragma unroll
    for (int seg = 0; seg < 3; ++seg) {
        const float w0 = cwv[seg][0], w1 = cwv[seg][1], w2 = cwv[seg][2], w3 = cwv[seg][3];
        LAS float* dst = seg == 0 ? Qs : (seg == 1 ? Ks : Vs);
        const int r0 = wave * 8;
        float x0 = bf2f(Raw[(r0 + 0) * 192 + seg * 64 + lane]), x1 = bf2f(Raw[(r0 + 1) * 192 + seg * 64 + lane]), x2 = bf2f(Raw[(r0 + 2) * 192 + seg * 64 + lane]);
#pragma unroll
        for (int r = 0; r < 8; ++r) { const float x3 = bf2f(Raw[(r0 + r + 3) * 192 + seg * 64 + lane]);
            float y = silu(w0 * x0 + w1 * x1 + w2 * x2 + w3 * x3);
            if (seg < 2) { const float ss = wave_sum(y * y); y *= rsqrtf(ss + EPS); if (seg == 0) y *= 0.125f; }
            dst[(r0 + r) * 65 + lane] = y; x0 = x1; x1 = x2; x2 = x3; }
    }
    __syncthreads();
    for (int rq_ = 0; rq_ < RG_KK; ++rq_)
    {
        for (int t = wave; t < 20; t += 8) {
            const bool isqk = t >= 10; const int idx = isqk ? t - 10 : t;
            const int mt = idx >= 6 ? 3 : (idx >= 3 ? 2 : (idx >= 1 ? 1 : 0)), nt = idx - mt * (mt + 1) / 2;
            const LAS float* ap = (isqk ? Qs : Ks) + (mt * 16 + (lane & 15)) * 65 + (lane >> 4);
            const LAS float* bp = Ks + (nt * 16 + (lane & 15)) * 65 + (lane >> 4);
            f32x4 acc = (f32x4){0.f, 0.f, 0.f, 0.f};
#pragma unroll
            for (int ks = 0; ks < 16; ++ks) acc = __builtin_amdgcn_mfma_f32_16x16x4f32(ap[ks * 4], bp[ks * 4], acc, 0, 0, 0);
            const int j = nt * 16 + (lane & 15), i0 = mt * 16 + (lane >> 4) * 4; const float gj = gcS[j];
            float v[4];
#pragma unroll
            for (int jj = 0; jj < 4; ++jj) { const int i = i0 + jj; const float dec = (j <= i) ? __expf(gcS[i] - gj) : 0.f;
                v[jj] = isqk ? acc[jj] * dec : ((j < i) ? betaS[i] * acc[jj] * dec : 0.f); }
            if (!isqk) {
#pragma unroll
                for (int jj = 0; jj < 4; ++jj) Am[(i0 + jj) * 64 + j] = v[jj];
                *(LAS f32x4*)(At + j * 64 + i0) = (f32x4){v[0], v[1], v[2], v[3]};
            } else {
#pragma unroll
                for (int jj = 0; jj < 4; ++jj) GQK[(i0 + jj) * 64 + j] = (bf16)f2bf(v[jj]);
            }
        }
        { const int e0 = tid * 8, i = e0 >> 6, j = e0 & 63; const unsigned zz = (unsigned)tid >> 31;
          if ((j >> 4) > (i >> 4)) *(u32x4*)(GQK + e0) = (u32x4){zz, zz, zz, zz}; }
    }
    __syncthreads();
    if (unext >= 0) gdn_pre_issue(p, unext, tid, pf);
    for (int rq_ = 0; rq_ < RG_SOLVE; ++rq_) {
    if (wave == 7) {
        const int bb = lane >> 4, cc = lane & 15;
        f32x4 ar[16][4];
#pragma unroll
        for (int i = 1; i < 16; ++i)
#pragma unroll
            for (int q4 = 0; q4 < 4; ++q4) if (q4 * 4 < i) ar[i][q4] = *(const LAS f32x4*)(Am + (bb * 16 + i) * 64 + bb * 16 + q4 * 4);
        float x[16];
#pragma unroll
        for (int i = 0; i < 16; ++i) {
            float acc = (i == cc) ? 1.f : 0.f;
#pragma unroll
            for (int q4 = 0; q4 < 4; ++q4) if (q4 * 4 < i) { const f32x4 a = ar[i][q4];
                if (q4 * 4 + 0 < i) acc -= a.x * x[q4 * 4 + 0];
                if (q4 * 4 + 1 < i) acc -= a.y * x[q4 * 4 + 1];
                if (q4 * 4 + 2 < i) acc -= a.z * x[q4 * 4 + 2];
                if (q4 * 4 + 3 < i) acc -= a.w * x[q4 * 4 + 3]; }
            x[i] = acc;
            Dv[bb * 256 + i * 16 + cc] = acc;
        }
    } else {
#pragma unroll 4
        for (int e = tid; e < 4096; e += 448) { const int r = e >> 6, d = e & 63;
            if (rq_ == 0) GQE[e] = (bf16)f2bf(Qs[r * 65 + d] * egS[r]);
            GKDT[e] = (bf16)f2bf(Ks[d * 65 + r] * kdS[d]); }
    }
    __syncthreads();
    {
        const int col = wave * 16 + (lane & 15), q = lane >> 4;
        bf16* dstg = (col >= 64 ? GW : GU) + (col & 63);
        const int fr = lane & 15;
#pragma unroll
        for (int rb = 0; rb < 4; ++rb) {
            LAS float* rp = R + (16 * rb + 4 * q) * 128 + col;
            float rh[4];
#pragma unroll
            for (int k = 0; k < 4; ++k) { const int i = 16 * rb + 4 * q + k; rh[k] = (col < 64) ? Vs[i * 65 + col] * betaS[i] : Ks[i * 65 + col - 64] * scwS[i]; }
            if (rb > 0) {
                float af[12], xf[12];
#pragma unroll
                for (int ks = 0; ks < 4 * rb; ++ks) { af[ks] = Am[(16 * rb + fr) * 64 + 4 * ks + q]; xf[ks] = Xn[(4 * ks + q) * 128 + col]; }
                f32x4 pacc = (f32x4){0.f, 0.f, 0.f, 0.f};
#pragma unroll
                for (int ks = 0; ks < 4 * rb; ++ks) pacc = __builtin_amdgcn_mfma_f32_16x16x4f32(af[ks], xf[ks], pacc, 0, 0, 0);
                rh[0] -= pacc[0]; rh[1] -= pacc[1]; rh[2] -= pacc[2]; rh[3] -= pacc[3];
            }
            rp[0] = rh[0]; rp[128] = rh[1]; rp[256] = rh[2]; rp[384] = rh[3];
            asm volatile("s_waitcnt lgkmcnt(0)" ::: "memory");
            float df[4], rf[4];
#pragma unroll
            for (int ks = 0; ks < 4; ++ks) { df[ks] = Dv[rb * 256 + fr * 16 + 4 * ks + q]; rf[ks] = R[(16 * rb + 4 * ks + q) * 128 + col]; }
            f32x4 xacc = (f32x4){0.f, 0.f, 0.f, 0.f};
#pragma unroll
            for (int ks = 0; ks < 4; ++ks) xacc = __builtin_amdgcn_mfma_f32_16x16x4f32(df[ks], rf[ks], xacc, 0, 0, 0);
#pragma unroll
            for (int k = 0; k < 4; ++k) { const int ii = 4 * q + k; Xn[(16 * rb + ii) * 128 + col] = xacc[k]; dstg[(16 * rb + ii) * 64] = (bf16)f2bf(xacc[k]); }
            asm volatile("s_waitcnt lgkmcnt(0)" ::: "memory");
        }
    }
    __syncthreads();
    }
}
DEV void gdn_scan_block(const Params& p, int bh2, LAS unsigned char* lds, int tid) {
    asm volatile("" : "+v"(tid));
    const int bh = bh2 >> 1, half = bh2 & 1;
    const int b = bh >> 2, hg = bh & 3, wave = tid >> 6, lane = tid & 63;
    const size_t ub0 = (size_t)bh * 64;
    const bf16* GM0 = (const bf16*)(p.ws + WS_GW) + ub0 * 4096; const bf16* GM1 = (const bf16*)(p.ws + WS_GQE) + ub0 * 4096;
    const bf16* GM2 = (const bf16*)(p.ws + WS_GQK) + ub0 * 4096; const bf16* GM3 = (const bf16*)(p.ws + WS_GKDT) + ub0 * 4096;
    const bf16* GM4 = (const bf16*)(p.ws + WS_GU) + ub0 * 4096;
    const float* EGL = (const float*)(p.ws + WS_EGL) + ub0;
    bf16* MIX = (bf16*)(p.ws + WS_MIX);
    LAS bf16* OPS = (LAS bf16*)lds;
    LAS bf16* PRV = OPS + 2 * 5 * 4608;
    LAS float* egS = (LAS float*)(PRV + 4 * 2 * 1152);
    if (tid < 64) egS[tid] = EGL[tid];
    if (wave >= 2 && wave < 4) {
        __syncthreads();
        for (int c = 0; c < NCH; ++c) __syncthreads();
    } else if (wave < 2) {
        const int es = half * 2 + wave, fr = lane & 15, fq = lane >> 4;
        LAS bf16* Stp = PRV + wave * 2304; LAS bf16* Vtp = Stp + 1152;
        for (int i = lane; i < 1152; i += 64) Stp[i] = 0;
        f32x4 Sacc[4];
#pragma unroll
        for (int mt = 0; mt < 4; ++mt) Sacc[mt] = (f32x4){0.f, 0.f, 0.f, 0.f};
        bf16* obase = MIX + ((size_t)b * SEQ + fr) * DM + 768 + hg * 64 + es * 16 + fq * 4;
        __syncthreads();
#pragma unroll 2
        for (int c = 0; c < NCH; ++c) {
            const LAS bf16* Wb = OPS + (c & 1) * 5 * 4608;
            const int fo = fr * 72 + fq * 8;
            const bf16x8 fS0 = *(const LAS bf16x8*)(Stp + fo), fS1 = *(const LAS bf16x8*)(Stp + fo + 32);
            bf16x8 fW[4][2], fQE[4][2], fQK[4][2], fKD[4][2]; u32x2 uw[4];
#pragma unroll
            for (int mt = 0; mt < 4; ++mt)
#pragma unroll
                for (int ks = 0; ks < 2; ++ks) fW[mt][ks] = *(const LAS bf16x8*)(Wb + mt * 16 * 72 + fo + ks * 32);
#pragma unroll
            for (int mt = 0; mt < 4; ++mt) uw[mt] = *(const LAS u32x2*)(Wb + 4 * 4608 + (mt * 16 + fr) * 72 + es * 16 + fq * 4);
#pragma unroll
            for (int mt = 0; mt < 4; ++mt)
#pragma unroll
                for (int ks = 0; ks < 2; ++ks) fQE[mt][ks] = *(const LAS bf16x8*)(Wb + 4608 + mt * 16 * 72 + fo + ks * 32);
#pragma unroll
            for (int mt = 0; mt < 4; ++mt)
#pragma unroll
                for (int ks = 0; ks < 2; ++ks) fKD[mt][ks] = *(const LAS bf16x8*)(Wb + 3 * 4608 + mt * 16 * 72 + fo + ks * 32);
#pragma unroll
            for (int mt = 0; mt < 4; ++mt)
#pragma unroll
                for (int ks = 0; ks < 2; ++ks) fQK[mt][ks] = *(const LAS bf16x8*)(Wb + 2 * 4608 + mt * 16 * 72 + fo + ks * 32);
            const float egl = egS[c];
            f32x4 av[4], ov[4];
#pragma unroll
            for (int mt = 0; mt < 4; ++mt) {
                av[mt] = __builtin_amdgcn_mfma_f32_16x16x32_bf16(fS0, fW[mt][0], (f32x4){0.f, 0.f, 0.f, 0.f}, 0, 0, 0);
                av[mt] = __builtin_amdgcn_mfma_f32_16x16x32_bf16(fS1, fW[mt][1], av[mt], 0, 0, 0); }
#pragma unroll
            for (int mt = 0; mt < 4; ++mt) {
                ov[mt] = __builtin_amdgcn_mfma_f32_16x16x32_bf16(fS0, fQE[mt][0], (f32x4){0.f, 0.f, 0.f, 0.f}, 0, 0, 0);
                ov[mt] = __builtin_amdgcn_mfma_f32_16x16x32_bf16(fS1, fQE[mt][1], ov[mt], 0, 0, 0); }
#pragma unroll
            for (int mt = 0; mt < 4; ++mt) {
                LAS bf16* vp = Vtp + (fq * 4) * 72 + mt * 16 + fr;
                vp[0] = (bf16)f2bf(bflo(uw[mt].x) - av[mt][0]); vp[72] = (bf16)f2bf(bfhi(uw[mt].x) - av[mt][1]);
                vp[144] = (bf16)f2bf(bflo(uw[mt].y) - av[mt][2]); vp[216] = (bf16)f2bf(bfhi(uw[mt].y) - av[mt][3]); }
            const bf16x8 fV0 = *(const LAS bf16x8*)(Vtp + fo), fV1 = *(const LAS bf16x8*)(Vtp + fo + 32);
#pragma unroll
            for (int mt = 0; mt < 4; ++mt) {
                f32x4 sa = Sacc[mt] * egl;
                sa = __builtin_amdgcn_mfma_f32_16x16x32_bf16(fKD[mt][0], fV0, sa, 0, 0, 0);
                sa = __builtin_amdgcn_mfma_f32_16x16x32_bf16(fKD[mt][1], fV1, sa, 0, 0, 0);
                Sacc[mt] = sa;
                u32x2 sw; sw.x = pk2(sa[0], sa[1]); sw.y = pk2(sa[2], sa[3]);
                *(LAS u32x2*)(Stp + fr * 72 + mt * 16 + fq * 4) = sw; }
#pragma unroll
            for (int mt = 0; mt < 4; ++mt) {
                f32x4 o = __builtin_amdgcn_mfma_f32_16x16x32_bf16(fV0, fQK[mt][0], ov[mt], 0, 0, 0);
                o = __builtin_amdgcn_mfma_f32_16x16x32_bf16(fV1, fQK[mt][1], o, 0, 0, 0);
                u32x2 ow; ow.x = pk2(o[0], o[1]); ow.y = pk2(o[2], o[3]);
                *(u32x2*)(obase + ((size_t)c * CH + mt * 16) * DM) = ow; }
            __syncthreads();
        }
    } else {
        const int lt = tid - 256;
        u32x4 rg[4][10];
#define GDN_ISSUE(k, ch) { const size_t co = (size_t)((ch) < NCH ? (ch) : NCH - 1) * 4096; \
            _Pragma("unroll") for (int h2 = 0; h2 < 2; ++h2) { const int idx = lt + h2 * 256, row = idx >> 3, v = idx & 7; \
                rg[k][0 + h2] = *(const u32x4*)(GM0 + co + row * 64 + v * 8); rg[k][2 + h2] = *(const u32x4*)(GM1 + co + row * 64 + v * 8); \
                rg[k][4 + h2] = *(const u32x4*)(GM2 + co + row * 64 + v * 8); rg[k][6 + h2] = *(const u32x4*)(GM3 + co + row * 64 + v * 8); \
                rg[k][8 + h2] = *(const u32x4*)(GM4 + co + row * 64 + v * 8); } }
#define GDN_COMMIT(k, set) { LAS bf16* sb = OPS + (set) * 5 * 4608; \
            _Pragma("unroll") for (int m = 0; m < 5; ++m) _Pragma("unroll") for (int h2 = 0; h2 < 2; ++h2) { const int idx = lt + h2 * 256, row = idx >> 3, v = idx & 7; \
                *(LAS u32x4*)(sb + m * 4608 + row * 72 + v * 8) = rg[k][m * 2 + h2]; } }
        GDN_ISSUE(0, 0) GDN_ISSUE(1, 1) GDN_ISSUE(2, 2) GDN_ISSUE(3, 3)
        GDN_COMMIT(0, 0)
        __syncthreads();
        for (int c = 0; c < NCH; c += 4) {
            GDN_COMMIT(1, 1) GDN_ISSUE(0, c + 4) __syncthreads();
            GDN_COMMIT(2, 0) GDN_ISSUE(1, c + 5) __syncthreads();
            GDN_COMMIT(3, 1) GDN_ISSUE(2, c + 6) __syncthreads();
            GDN_COMMIT(0, 0) GDN_ISSUE(3, c + 7) __syncthreads();
        }
#undef GDN_ISSUE
#undef GDN_COMMIT
    }
}
DEV void gdn_post(const Params& p, int l, int gw, int NGW, int lane) {
    bf16* MIX = (bf16*)(p.ws + WS_MIX); const bf16* PROJ = (const bf16*)(p.ws + WS_PROJ);
    const f32x4 nw = *((const f32x4*)(p.gnorm_w + (size_t)l * 64) + (lane & 15));
    for (int m = gw; m < MTOK; m += NGW) {
        bf16* op = MIX + (size_t)m * DM + 768 + lane * 4;
        const u32x2 ow = *(const u32x2*)op; const u32x2 zw = *(const u32x2*)(PROJ + (size_t)m * NPROJ + 2816 + lane * 4);
        const float o0 = bflo(ow.x), o1 = bfhi(ow.x), o2 = bflo(ow.y), o3 = bfhi(ow.y);
        float ss = (o0 * o0 + o1 * o1) + (o2 * o2 + o3 * o3);
        ss = red16_sum(ss);
        const float rstd = rsqrtf(ss * (1.0f / 64.0f) + EPS);
        u32x2 r; r.x = pk2(o0 * rstd * nw.x * silu(bflo(zw.x)), o1 * rstd * nw.y * silu(bfhi(zw.x))); r.y = pk2(o2 * rstd * nw.z * silu(bflo(zw.y)), o3 * rstd * nw.w * silu(bfhi(zw.y)));
        *(u32x2*)op = r;
    }
}

#define XB_TMO      128
#define XB_XCNT(j)  (256  + 64 * (j))
#define XB_XSUB(j)  (1280 + 64 * (j))
#define XB_XGEN(j)  (2304 + 64 * (j))
#define XB_TOP      3328
#define XB_TOPGEN   3392
#define XCD_BAR_WORDS 3456
#define XB_SPIN_CAP (1u << 18)

__device__ __forceinline__ unsigned xb_ld(unsigned* p)              { return __hip_atomic_load(p, __ATOMIC_RELAXED, __HIP_MEMORY_SCOPE_AGENT); }
__device__ __forceinline__ unsigned xb_add(unsigned* p, unsigned v) { return __hip_atomic_fetch_add(p, v, __ATOMIC_RELAXED, __HIP_MEMORY_SCOPE_AGENT); }
__device__ __forceinline__ unsigned xb_xcc_id() { return (unsigned)__builtin_amdgcn_s_getreg((3 << 11) | 20) & 0xFu; }
#define XB_SPIN(cond, bar) do { unsigned _sp = 0; while (cond) { __builtin_amdgcn_s_sleep(1); \
    if ((++_sp & 255u) == 0u) { if (xb_ld(&(bar)[XB_TMO])) break; if (_sp > XB_SPIN_CAP) { atomicAdd(&(bar)[XB_TMO], 1u); break; } } } } while (0)

struct XcdBarrier {
    unsigned* bar; unsigned x;
    volatile LAS unsigned* st;
};

__device__ __forceinline__ XcdBarrier xcd_barrier_post(unsigned* bar, volatile LAS unsigned* st) {
    XcdBarrier b; b.bar = bar; b.x = xb_xcc_id(); b.st = st;
    if (threadIdx.x == 0) (void)xb_add(&bar[XB_XCNT(b.x)], 1u);
    return b;
}
__device__ __forceinline__ void xcd_barrier_complete(unsigned* bar, unsigned x, unsigned& nloc, unsigned& nx) {
    const unsigned G = gridDim.x * gridDim.y * gridDim.z;
    unsigned sum, cnt, mine, sp = 0u;
    for (;;) {
        sum = 0u; cnt = 0u; mine = 0u;
#pragma unroll
        for (unsigned j = 0; j < 16; ++j) { const unsigned c = xb_ld(&bar[XB_XCNT(j)]); sum += c; cnt += (c > 0u) ? 1u : 0u; mine = (j == x) ? c : mine; }
        if (sum == G) break;
        __builtin_amdgcn_s_sleep(1);
        if ((++sp & 255u) == 0u) { if (xb_ld(&bar[XB_TMO])) break; if (sp > XB_SPIN_CAP) { atomicAdd(&bar[XB_TMO], 1u); break; } }
    }
    nloc = mine > 0u ? mine : 1u; nx = cnt > 0u ? cnt : 1u;
}

__device__ __forceinline__ void xcd_barrier(const XcdBarrier& b) {
    asm volatile("s_waitcnt vmcnt(0)" ::: "memory");
    __syncthreads();
    if (threadIdx.x == 0) {
        unsigned* bar = b.bar;
        __builtin_amdgcn_s_waitcnt(0);
        unsigned nloc = b.st[0], nx = b.st[1];
        if (nloc == 0u) { xcd_barrier_complete(bar, b.x, nloc, nx); b.st[0] = nloc; b.st[1] = nx; }
        const unsigned old = xb_add(&bar[XB_XSUB(b.x)], 1u);
        const unsigned gen = old / nloc;
        if (old + 1u == (gen + 1u) * nloc) {
            __builtin_amdgcn_fence(__ATOMIC_RELEASE, "agent");
            asm volatile("s_waitcnt vmcnt(0)" ::: "memory");
            const unsigned og = xb_add(&bar[XB_TOP], 1u);
            const unsigned tg = og / nx;
            if (og + 1u == (tg + 1u) * nx) xb_add(&bar[XB_TOPGEN], 1u);
            else XB_SPIN(xb_ld(&bar[XB_TOPGEN]) == tg, bar);
            __builtin_amdgcn_fence(__ATOMIC_ACQUIRE, "agent");
            xb_add(&bar[XB_XGEN(b.x)], 1u);
            asm volatile("s_waitcnt vmcnt(0)" ::: "memory");
        } else {
            XB_SPIN(xb_ld(&bar[XB_XGEN(b.x)]) == gen, bar);
            __builtin_amdgcn_fence(__ATOMIC_ACQUIRE, "agent");
            asm volatile("s_waitcnt vmcnt(0)" ::: "memory");
        }
    }
    __syncthreads();
}
__global__ void __launch_bounds__(512, 2) fwd_megakernel(Params p) {
    extern __shared__ __attribute__((aligned(16))) unsigned char lds_raw[];
    cg::grid_group grid = cg::this_grid();
    LAS unsigned char* lds = (LAS unsigned char*)lds_raw;
    const int tid = threadIdx.x, lane = tid & 63, wave = __builtin_amdgcn_readfirstlane(tid >> 6);
    const int G = gridDim.x, bx = blockIdx.x, gw = bx * 8 + wave, NGW = G * 8;
    bf16* XN = (bf16*)(p.ws + WS_XN); float* SMALL = (float*)(p.ws + WS_SMALL); bf16* TMP = (bf16*)(p.ws + WS_TMP);
    bf16* PROJ = (bf16*)(p.ws + WS_PROJ); bf16* MIX = (bf16*)(p.ws + WS_MIX); bf16* HB = (bf16*)(p.ws + WS_H);
    LAS float* wsT = (LAS float*)(lds + 69632);
    volatile LAS unsigned* misc = (volatile LAS unsigned*)(lds + 147200);
    if (tid < 4) misc[tid] = 0u;
    __syncthreads();
    XcdBarrier xbar = xcd_barrier_post((unsigned*)p.ws, misc);
#define GSYNC() xcd_barrier(xbar)

#define PHASE_IDS() int tidp = threadIdx.x; int lq = l; asm volatile("" : "+v"(tidp), "+s"(lq)); const int lanep = tidp & 63; const int wavep = __builtin_amdgcn_readfirstlane(tidp >> 6); const int gwp = bx * 8 + wavep; (void)lanep; (void)gwp; (void)lq
#pragma unroll 1
    for (int l = 0; l < DEPTH; ++l) {
        {
            PHASE_IDS();
            convert_weights(p, lq, lds, gwp, NGW, wavep, lanep);
            if (lq == 0) {
                stage_small(p, 0, wsT, tidp);
                __syncthreads();
                rowpass<0>(p.x, nullptr, nullptr, p.pre_mix, nullptr, XN, SMALL, wsT, gwp, NGW, lanep);
            }
        }
        if (l == 0) grid.sync(); else GSYNC();
#ifdef REP_SYNC
        for (int rep = 0; rep < REP_SYNC; ++rep) GSYNC();
#endif
        {
            pg8::Gemm g{XN, (const bf16*)(p.ws + WS_WIN), MTOK, NPROJ, DM}; pg8::StaticOrder S; S.init(MTOK, NPROJ, G, bx);
            pg8::EpiStoreBf16 E{PROJ, NPROJ};
            for (int rg_ = 0; rg_ < REP_GEMM; ++rg_) { if (rg_) GSYNC(); pg8::gemm_phase<pg8::EpiStoreBf16, pg8::StaticOrder, true, true>(lds, g, S, E); }
        }
        GSYNC();
        {
            PHASE_IDS();
            for (int rep = 0; rep < REP_C; ++rep) { if (rep) GSYNC();
            GdnPF pf; if (bx < 1024) gdn_pre_issue(p, bx, tidp, pf);
            for (int u = bx; u < 1024; u += G) gdn_pre_unit(p, lq, u, (u + G < 1024) ? u + G : -1, lds, tidp, pf); }
        }
        GSYNC();
        {
            PHASE_IDS();
            for (int rep = 0; rep < REP_D; ++rep) { if (rep) GSYNC();
            if (bx < 32) { for (int r2 = 0; r2 < REP_DS; ++r2) gdn_scan_block(p, bx, lds, tidp); }
            else if (G == 256) {
                const int vb = bx - 32;
                { P1PF pf; ssd_p1_issue(p, vb, tidp, pf);
                  for (int u = vb; u < 512; u += 224) ssd_p1_unit(p, lq, u, (u + 224 < 512) ? u + 224 : -1, lds, tidp, pf); }
                if (vb < 64) attn_unit(p, lq, vb, lds, tidp);
                else { for (int a = vb; a < 512; a += 160) attn_unit(p, lq, a, lds, tidp); }
            }
            else { for (int u = bx - 32; u < 1024; u += G - 32) { if (u < 512) { P1PF pf; ssd_p1_issue(p, u, tidp, pf); ssd_p1_unit(p, lq, u, -1, lds, tidp, pf); } else { for (int r2 = 0; r2 < REP_ATT; ++r2) attn_unit(p, lq, u - 512, lds, tidp); } } } }
        }
        GSYNC();
        {
            PHASE_IDS();
            for (int vb = bx; vb < 256; vb += G) ssd_scan_all(p, vb, lds, tidp);
            gdn_post(p, lq, gwp, NGW, lanep);
        }
        GSYNC();
        {
            PHASE_IDS();
            for (int rep = 0; rep < REP_E; ++rep) {
                if (rep) GSYNC();
                for (int u = bx; u < 512; u += G) ssd_p3_unit(p, lq, u, lds, tidp);
            }
        }
        GSYNC();
        {
            pg8::Gemm g{MIX, (const bf16*)(p.ws + WS_WOUT), MTOK, DM, DM}; pg8::StaticOrder S; S.init(MTOK, DM, G, bx);
            pg8::EpiStoreBf16 E{TMP, DM};
            for (int rg_ = 0; rg_ < REP_GEMM; ++rg_) { if (rg_) GSYNC(); pg8::gemm_phase<pg8::EpiStoreBf16, pg8::StaticOrder, true, true>(lds, g, S, E); }
        }
        GSYNC();
        {
            PHASE_IDS();
            rowpass<1, false, true>(lq == 0 ? p.x : p.out, TMP, p.post_mix + (size_t)lq * DM, p.pre_ffn + (size_t)lq * DM, p.ws + WS_X1, XN, nullptr, wsT, gwp, NGW, lanep);
        }
        GSYNC();
        {
            pg8::Gemm g{XN, (const bf16*)(p.ws + WS_WGU), MTOK, 2 * FF, DM}; pg8::StaticOrder S; S.init(MTOK, 2 * FF, G, bx);
            pg8::EpiSwiGLU E{HB, FF};
            for (int rg_ = 0; rg_ < REP_GEMM; ++rg_) { if (rg_) GSYNC(); pg8::gemm_phase<pg8::EpiSwiGLU, pg8::StaticOrder, true, true>(lds, g, S, E); }
        }
        GSYNC();
        {
            pg8::Gemm g{HB, (const bf16*)(p.ws + WS_WDN), MTOK, DM, FF}; pg8::StaticOrder S; S.init(MTOK, DM, G, bx);
            pg8::EpiStoreBf16 E{TMP, DM};
            for (int rg_ = 0; rg_ < REP_GEMM; ++rg_) { if (rg_) GSYNC(); pg8::gemm_phase<pg8::EpiStoreBf16, pg8::StaticOrder, true, true>(lds, g, S, E); }
        }
        GSYNC();
        {
            PHASE_IDS();
            if (lq + 1 < DEPTH) {
                stage_small(p, lq + 1, wsT, tidp);
                __syncthreads();
                rowpass<2, true, false>(p.ws + WS_X1, TMP, p.post_ffn + (size_t)lq * DM, p.pre_mix + (size_t)(lq + 1) * DM, p.out, XN, SMALL, wsT, gwp, NGW, lanep);
                __syncthreads();
            } else {
                rowpass<3, true, false>(p.ws + WS_X1, TMP, p.post_ffn + (size_t)lq * DM, nullptr, p.out, nullptr, nullptr, wsT, gwp, NGW, lanep);
            }
        }
    }
}

extern "C" void kernel_launch(void* const* d_in, const int* in_sizes, int n_in, void* d_out, int out_size, void* d_ws, size_t ws_size, hipStream_t stream) {
    static int grid = 0;
    if (grid == 0) {
        if (n_in != 21 || out_size != MTOK * DM || ws_size < WS_END) { fprintf(stderr, "kernel_launch: unexpected shapes (n_in %d out %d ws %zu)\n", n_in, out_size, ws_size); grid = -1; return; }
        int dev = 0, cus = 0, per_cu = 0;
        hipGetDevice(&dev); hipDeviceGetAttribute(&cus, hipDeviceAttributeMultiprocessorCount, dev);
        if (hipFuncSetAttribute((const void*)fwd_megakernel, hipFuncAttributeMaxDynamicSharedMemorySize, LDS_BYTES) != hipSuccess) { fprintf(stderr, "kernel_launch: hipFuncSetAttribute failed\n"); grid = -1; return; }
        hipOccupancyMaxActiveBlocksPerMultiprocessor(&per_cu, (const void*)fwd_megakernel, 512, LDS_BYTES);
        if (per_cu < 1) { fprintf(stderr, "kernel_launch: occupancy query says %d blocks per CU\n", per_cu); per_cu = 1; }
        (void)hipGetLastError();
        grid = cus;
    }
    if (grid < 0) return;
    if (hipMemsetAsync(d_ws, 0, 16384, stream) != hipSuccess) { fprintf(stderr, "kernel_launch: memset of the barrier words failed\n"); return; }
    Params p{};
    const float** pp = (const float**)&p;
    for (int i = 0; i < 21; ++i) pp[i] = (const float*)d_in[i];
    p.out = (float*)d_out; p.ws = (unsigned char*)d_ws;
    void* args[] = {&p};
    hipError_t e = hipLaunchCooperativeKernel((const void*)fwd_megakernel, dim3(grid), dim3(512), args, LDS_BYTES, stream);
    if (e != hipSuccess) fprintf(stderr, "cooperative launch failed: %s (grid %d)\n", hipGetErrorString(e), grid);
}
```

```cpp
#include <hip/hip_runtime.h>
#include <hip/hip_cooperative_groups.h>
#include <cstdio>
#include <cstdint>
namespace cg = cooperative_groups;
namespace pg8 {
#define PG8_LAS __attribute__((address_space(3)))
typedef unsigned short bf16_t;
typedef short bf16x8 __attribute__((ext_vector_type(8)));
typedef float f32x4 __attribute__((ext_vector_type(4)));
typedef unsigned u32x4 __attribute__((ext_vector_type(4)));
constexpr int BM = 256, BK = 64, HALF = 128, HTB = HALF * BK * 2  , STAGE_BYTES = 8 * HTB, NXCD = 8, WGM = 8;

__host__ __device__ __forceinline__ int lds_byte(int r, int c) { const int st = (r >> 4) * 2 + (c >> 5), rr = r & 15, cc = c & 31, ob = rr * 64 + cc * 2; return st * 1024 + (ob ^ (((ob >> 9) & 1) << 5)); }
__host__ __device__ __forceinline__ void stage_rc(int b, int& R, int& C) { const int st = b / 1024, sb = b % 1024, swz = sb ^ (((sb >> 9) & 1) << 5); R = (st >> 1) * 16 + swz / 64; C = (st & 1) * 32 + (swz % 64) / 2; }
__host__ __device__ __forceinline__ int perm32(int rho) { const int n = rho >> 4, i = rho & 15; return 8 * (i >> 2) + 4 * n + (i & 3); }

struct Unit { int pm, pn; };
struct Gemm { const bf16_t* A; const bf16_t* Bt; int M, N, K; };

struct StaticOrder {
    int nM, nN, nwg, G, c;
    __host__ __device__ void init(int M, int N, int G_, int c_) { nM = M / BM; nN = N / BM; nwg = nM * nN; G = G_; c = c_; }
    __host__ __device__ bool next(int i, Unit& u) const {
        const long L = (long)i * G + c; if (L >= nwg) return false;
        int wgid = (int)L; { const int q = nwg / NXCD, r = nwg % NXCD, xcd = wgid % NXCD, off = wgid / NXCD; wgid = (xcd < r ? xcd * (q + 1) : r * (q + 1) + (xcd - r) * q) + off; }
        const int nig = WGM * nN, gid = wgid / nig, fm = gid * WGM, gsz = (nM - fm) < WGM ? (nM - fm) : WGM;
        u.pm = fm + ((wgid % nig) % gsz); u.pn = (wgid % nig) / gsz; return true;
    }
    __device__ __forceinline__ void a_ready(const Unit&) const {}
    __device__ __forceinline__ void done(const Unit&) const {}
};

typedef float f32x2c __attribute__((ext_vector_type(2))); typedef __bf16 bf16x2c __attribute__((ext_vector_type(2)));
__device__ __forceinline__ unsigned cvt_pk_bf16(float lo, float hi) { const f32x2c v = {lo, hi}; const bf16x2c b = __builtin_convertvector(v, bf16x2c); return __builtin_bit_cast(unsigned, b); }
typedef float f32x2 __attribute__((ext_vector_type(2)));
typedef unsigned u32x2 __attribute__((ext_vector_type(2)));
__device__ __forceinline__ float silu_f(float x) { return x * __builtin_amdgcn_rcpf(1.0f + __expf(-x)); }
struct EpiStoreBf16 {
    static constexpr bool PERM = true, AFTER_DRAIN = false;
    bf16_t* O; int ldc;
    __device__ __forceinline__ void operator()(const f32x4 (&acc)[2][2][4][2], const Unit& u, int wr, int wc, int fr, int fq) const {
        const int row0 = u.pm * BM + wr * 64 + fr, col0 = u.pn * BM + wc * 32 + 8 * fq;
#pragma unroll
        for (int ai = 0; ai < 2; ++ai)
#pragma unroll
            for (int m = 0; m < 4; ++m) { bf16_t* rowp = O + (size_t)(row0 + ai * HALF + m * 16) * ldc + col0;
#pragma unroll
                for (int bj = 0; bj < 2; ++bj) { const f32x4 v0 = acc[ai][bj][m][0], v1 = acc[ai][bj][m][1];
                    u32x4 w; w.x = cvt_pk_bf16(v0[0], v0[1]); w.y = cvt_pk_bf16(v0[2], v0[3]); w.z = cvt_pk_bf16(v1[0], v1[1]); w.w = cvt_pk_bf16(v1[2], v1[3]);
                    *(u32x4*)(rowp + bj * HALF) = w; } }
    }
};
struct EpiStoreF32 {
    static constexpr bool PERM = true, AFTER_DRAIN = false;
    float* O; int ldc;
    __device__ __forceinline__ void operator()(const f32x4 (&acc)[2][2][4][2], const Unit& u, int wr, int wc, int fr, int fq) const {
        const int row0 = u.pm * BM + wr * 64 + fr, col0 = u.pn * BM + wc * 32 + 8 * fq;
#pragma unroll
        for (int ai = 0; ai < 2; ++ai)
#pragma unroll
            for (int m = 0; m < 4; ++m) { float* rowp = O + (size_t)(row0 + ai * HALF + m * 16) * ldc + col0;
#pragma unroll
                for (int bj = 0; bj < 2; ++bj) { *(f32x4*)(rowp + bj * HALF) = acc[ai][bj][m][0]; *(f32x4*)(rowp + bj * HALF + 4) = acc[ai][bj][m][1]; } }
    }
};
struct EpiSwiGLU {
    static constexpr bool PERM = true, AFTER_DRAIN = false;
    bf16_t* H; int ldh;
    __device__ __forceinline__ void operator()(const f32x4 (&acc)[2][2][4][2], const Unit& u, int wr, int wc, int fr, int fq) const {
        const int row0 = u.pm * BM + wr * 64 + fr, col0 = u.pn * (BM / 2) + wc * 16 + 4 * fq;
#pragma unroll
        for (int ai = 0; ai < 2; ++ai)
#pragma unroll
            for (int m = 0; m < 4; ++m) { bf16_t* rowp = H + (size_t)(row0 + ai * HALF + m * 16) * ldh + col0;
#pragma unroll
                for (int bj = 0; bj < 2; ++bj) { const f32x4 v0 = acc[ai][bj][m][0], v1 = acc[ai][bj][m][1];
                    u32x2 w; w.x = cvt_pk_bf16(silu_f(v0[0]) * v0[1], silu_f(v0[2]) * v0[3]); w.y = cvt_pk_bf16(silu_f(v1[0]) * v1[1], silu_f(v1[2]) * v1[3]);
                    *(u32x2*)(rowp + bj * (HALF / 2)) = w; } }
    }
};
template <class Epi, class Sched, bool ALIGN_EPI = false, bool SP2 = false>
__device__ __forceinline__ void gemm_phase(PG8_LAS unsigned char* lds, const Gemm g, const Sched& S, const Epi& E) {
    int tid_l = threadIdx.x; asm volatile("" : "+v"(tid_l));
    const int tid = tid_l, wid = __builtin_amdgcn_readfirstlane(tid >> 6), lane = tid & 63, wr = wid >> 2, wc = wid & 3, fr = lane & 15, fq = lane >> 4;
    const int K = g.K, nt = K / BK;
    unsigned voffA[2], voffB[2];
#pragma unroll
    for (int i = 0; i < 2; ++i) { int R, C; stage_rc(tid * 16 + i * 8192, R, C); const int Rb = Epi::PERM ? ((R & ~31) + perm32(R & 31)) : R;
        voffA[i] = (unsigned)(R * K + C) * 2u; voffB[i] = (unsigned)(Rb * K + C) * 2u; }
    const size_t kstep = (size_t)(BK * 2);
    const size_t hstep = (size_t)HALF * K * 2;
    const size_t tstep = 2 * hstep;
    const unsigned ldsw = (unsigned)wid * 1024u;
    const int aoff = lds_byte(wr * 64 + fr, fq * 8), boff = lds_byte(wc * 32 + fr, fq * 8);
#define PG8_SA(b, h) (((b) * 2 + (h)) * HTB)
#define PG8_SB(b, h) ((4 + (b) * 2 + (h)) * HTB)
#define PG8_STAGE(bufoff, gbase, voff) do { _Pragma("unroll") for (int _i = 0; _i < 2; ++_i) \
        __builtin_amdgcn_global_load_lds((const unsigned*)((const char*)(gbase) + (voff)[_i]), (PG8_LAS unsigned*)(lds + (bufoff) + ldsw + _i * 8192), 16, 0, 0); } while (0)
#define PG8_LDA(dst, b, h) do { _Pragma("unroll") for (int m = 0; m < 4; ++m) _Pragma("unroll") for (int k = 0; k < 2; ++k) dst[m][k] = *(const PG8_LAS bf16x8*)(lds + PG8_SA(b, h) + aoff + m * 2048 + k * 1024); } while (0)
#define PG8_LDB(dst, b, h) do { _Pragma("unroll") for (int n = 0; n < 2; ++n) _Pragma("unroll") for (int k = 0; k < 2; ++k) dst[n][k] = *(const PG8_LAS bf16x8*)(lds + PG8_SB(b, h) + boff + n * 2048 + k * 1024); } while (0)
#define PG8_MMA(ai, bj, At, Bt) do { __builtin_amdgcn_s_setprio(1); _Pragma("unroll") for (int m = 0; m < 4; ++m) _Pragma("unroll") for (int n = 0; n < 2; ++n) _Pragma("unroll") for (int k = 0; k < 2; ++k) \
        acc[ai][bj][m][n] = __builtin_amdgcn_mfma_f32_16x16x32_bf16(Bt[n][k], At[m][k], acc[ai][bj][m][n], 0, 0, 0); __builtin_amdgcn_s_setprio(0); } while (0)
#define PG8_WAIT_V(n) asm volatile("s_waitcnt vmcnt(" #n ")" ::: "memory")
#define PG8_WAIT_L(n) asm volatile("s_waitcnt lgkmcnt(" #n ")" ::: "memory")
#define PG8_BAR __builtin_amdgcn_s_barrier()
#define PG8_SCHED __builtin_amdgcn_sched_barrier(0)
    Unit cur, nxt; int ui = 0;
    if (!S.next(0, cur)) return;
    f32x4 acc[2][2][4][2];
#pragma unroll
    for (int a = 0; a < 2; ++a)
#pragma unroll
        for (int b = 0; b < 2; ++b)
#pragma unroll
            for (int m = 0; m < 4; ++m)
#pragma unroll
                for (int n = 0; n < 2; ++n) acc[a][b][m][n] = (f32x4){0.f, 0.f, 0.f, 0.f};
    bf16x8 At[4][2], B0[2][2], B1[2][2];
    const char* cA = (const char*)g.A + (size_t)cur.pm * tstep; const char* cB = (const char*)g.Bt + (size_t)cur.pn * tstep;
    S.a_ready(cur);
    if constexpr (SP2) {
        PG8_STAGE(PG8_SB(0, 0), cB, voffB); PG8_STAGE(PG8_SB(0, 1), cB + hstep, voffB); PG8_STAGE(PG8_SA(0, 0), cA, voffA); PG8_STAGE(PG8_SA(0, 1), cA + hstep, voffA);
        if (wr == 1) PG8_BAR;
        PG8_WAIT_V(2); PG8_BAR;
        PG8_STAGE(PG8_SB(1, 0), cB + kstep, voffB); PG8_STAGE(PG8_SA(1, 0), cA + kstep, voffA); PG8_STAGE(PG8_SB(1, 1), cB + hstep + kstep, voffB);
        PG8_WAIT_V(6); PG8_BAR;
    } else {
        PG8_STAGE(PG8_SB(0, 0), cB, voffB); PG8_STAGE(PG8_SA(0, 0), cA, voffA); PG8_STAGE(PG8_SB(0, 1), cB + hstep, voffB); PG8_STAGE(PG8_SA(0, 1), cA + hstep, voffA);
        if (wr == 1) PG8_BAR;
        PG8_WAIT_V(4); PG8_BAR;
        PG8_STAGE(PG8_SB(1, 0), cB + kstep, voffB); PG8_STAGE(PG8_SA(1, 0), cA + kstep, voffA); PG8_STAGE(PG8_SB(1, 1), cB + hstep + kstep, voffB);
        PG8_WAIT_V(6); PG8_BAR;
    }
    for (;;) {
        const bool has_next = S.next(ui + 1, nxt);
        const char* nA = has_next ? (const char*)g.A + (size_t)nxt.pm * tstep : cA; const char* nB = has_next ? (const char*)g.Bt + (size_t)nxt.pn * tstep : cB;
        for (int t = 0; t < nt; t += 2) {
            const bool last = (t == nt - 2);
            const char* a1 = cA + (size_t)(t + 1) * kstep;
            const char* a2 = last ? nA : cA + (size_t)(t + 2) * kstep; const char* b2 = last ? nB : cB + (size_t)(t + 2) * kstep;
            const char* a3 = a2 + kstep; const char* b3 = b2 + kstep;
            if (last && has_next) S.a_ready(nxt);
            if constexpr (SP2) {
            PG8_LDB(B0, 0, 0); PG8_LDB(B1, 0, 1); PG8_SCHED; PG8_LDA(At, 0, 0); PG8_STAGE(PG8_SA(1, 1), a1 + hstep, voffA);
            PG8_WAIT_V(8); PG8_WAIT_L(0); PG8_BAR; PG8_MMA(0, 0, At, B0); PG8_MMA(0, 1, At, B1); PG8_BAR; PG8_SCHED;
            PG8_LDA(At, 0, 1); PG8_STAGE(PG8_SB(0, 0), b2, voffB); PG8_STAGE(PG8_SB(0, 1), b2 + hstep, voffB); PG8_STAGE(PG8_SA(0, 0), a2, voffA);
            PG8_WAIT_V(8); PG8_WAIT_L(0); PG8_BAR; PG8_MMA(1, 0, At, B0); PG8_MMA(1, 1, At, B1); PG8_BAR; PG8_SCHED;
            PG8_LDB(B0, 1, 0); PG8_LDB(B1, 1, 1); PG8_SCHED; PG8_LDA(At, 1, 0); PG8_STAGE(PG8_SA(0, 1), a2 + hstep, voffA);
            PG8_WAIT_V(8); PG8_WAIT_L(0); PG8_BAR; PG8_MMA(0, 0, At, B0); PG8_MMA(0, 1, At, B1); PG8_BAR; PG8_SCHED;
            PG8_LDA(At, 1, 1); PG8_STAGE(PG8_SB(1, 0), b3, voffB); PG8_STAGE(PG8_SB(1, 1), b3 + hstep, voffB); PG8_STAGE(PG8_SA(1, 0), a3, voffA);
            PG8_WAIT_V(8); PG8_WAIT_L(0); PG8_BAR; PG8_MMA(1, 0, At, B0); PG8_MMA(1, 1, At, B1); PG8_BAR; PG8_SCHED;
            } else {
            PG8_LDB(B0, 0, 0); PG8_SCHED; PG8_LDA(At, 0, 0); PG8_STAGE(PG8_SA(1, 1), a1 + hstep, voffA);
            PG8_WAIT_L(8); PG8_BAR; PG8_WAIT_L(0); PG8_MMA(0, 0, At, B0); PG8_BAR; PG8_SCHED;
            PG8_LDB(B1, 0, 1); PG8_STAGE(PG8_SB(0, 0), b2, voffB);
            PG8_BAR; PG8_WAIT_L(0); PG8_MMA(0, 1, At, B1); PG8_BAR;
            PG8_LDA(At, 0, 1); PG8_STAGE(PG8_SA(0, 0), a2, voffA);
            PG8_BAR; PG8_WAIT_L(0); PG8_MMA(1, 0, At, B0); PG8_BAR; PG8_SCHED;
            PG8_STAGE(PG8_SB(0, 1), b2 + hstep, voffB);
            PG8_WAIT_V(6); PG8_BAR; PG8_MMA(1, 1, At, B1); PG8_BAR;
            PG8_LDB(B0, 1, 0); PG8_SCHED; PG8_LDA(At, 1, 0); PG8_STAGE(PG8_SA(0, 1), a2 + hstep, voffA);
            PG8_WAIT_L(8); PG8_BAR; PG8_WAIT_L(0); PG8_MMA(0, 0, At, B0); PG8_BAR; PG8_SCHED;
            PG8_LDB(B1, 1, 1); PG8_STAGE(PG8_SB(1, 0), b3, voffB);
            PG8_BAR; PG8_WAIT_L(0); PG8_MMA(0, 1, At, B1); PG8_BAR;
            PG8_LDA(At, 1, 1); PG8_STAGE(PG8_SA(1, 0), a3, voffA);
            PG8_BAR; PG8_WAIT_L(0); PG8_MMA(1, 0, At, B0); PG8_BAR; PG8_SCHED;
            PG8_STAGE(PG8_SB(1, 1), b3 + hstep, voffB);
            PG8_WAIT_V(6); PG8_BAR; PG8_MMA(1, 1, At, B1); PG8_BAR;
            }
        }
        if constexpr (ALIGN_EPI) { if (wr == 0) PG8_BAR; }
        if constexpr (!Epi::AFTER_DRAIN) { E(acc, cur, wr, wc, fr, fq); S.done(cur); }
        if (!has_next) break;
#pragma unroll
        for (int a = 0; a < 2; ++a)
#pragma unroll
            for (int b = 0; b < 2; ++b)
#pragma unroll
                for (int m = 0; m < 4; ++m)
#pragma unroll
                    for (int n = 0; n < 2; ++n) acc[a][b][m][n] = (f32x4){0.f, 0.f, 0.f, 0.f};
        cur = nxt; cA = nA; cB = nB; ++ui;
        if constexpr (ALIGN_EPI) { if (wr == 1) PG8_BAR; }
    }
    PG8_WAIT_V(0);
    if constexpr (!ALIGN_EPI) { if (wr == 0) PG8_BAR; }
    PG8_BAR;
    if constexpr (Epi::AFTER_DRAIN) { E.fused(acc, cur, wr, wc, fr, fq, lds, wid, lane); S.done(cur); }
#undef PG8_SA
#undef PG8_SB
#undef PG8_STAGE
#undef PG8_LDA
#undef PG8_LDB
#undef PG8_MMA
#undef PG8_WAIT_V
#undef PG8_WAIT_L
#undef PG8_BAR
#undef PG8_SCHED
}
}
constexpr int BATCH = 4, SEQ = 4096, DM = 1024, NCH = 64, CH = 64, MTOK = BATCH * SEQ, DEPTH = 2;
constexpr int NPROJ = 3072, IN_COLS = 3088, FF = 2816;
constexpr float EPS = 1e-6f;
constexpr size_t MiB = 1u << 20;
constexpr size_t WS_SMALL = 1 * MiB, WS_ACS = 2 * MiB, WS_CDEC = 2 * MiB + 512 * 1024, WS_EGL = 2 * MiB + 768 * 1024;
constexpr size_t WS_WIN = 3 * MiB, WS_WOUT = 9 * MiB, WS_WGU = 11 * MiB, WS_WDN = 22 * MiB;
constexpr size_t WS_XN = 28 * MiB;
constexpr size_t WS_GU = 28 * MiB, WS_GW = 36 * MiB, WS_GQE = 44 * MiB, WS_GQK = 52 * MiB, WS_GKDT = 244 * MiB;
constexpr size_t WS_PROJ = 60 * MiB, WS_H = 60 * MiB;
constexpr size_t WS_MIX = 156 * MiB;
constexpr size_t WS_STATES = 188 * MiB, WS_YPART = 220 * MiB, WS_CCONV = 236 * MiB, WS_TMP = 188 * MiB;
constexpr size_t WS_X1 = 220 * MiB;
constexpr size_t WS_END = 252 * MiB;
constexpr int LDS_BYTES = 147456;
#ifndef REP_C
#define REP_C 1
#endif
#ifndef REP_P1
#define REP_P1 1
#endif
#ifndef REP_DS
#define REP_DS 1
#endif
#ifndef RP3_MMA
#define RP3_MMA 1
#endif
#ifndef REP_GEMM
#define REP_GEMM 1
#endif
#ifndef REP_ATT
#define REP_ATT 1
#endif
#ifndef RG_CONV
#define RG_CONV 1
#endif
#ifndef RG_KK
#define RG_KK 1
#endif
#ifndef RG_SOLVE
#define RG_SOLVE 1
#endif
#ifndef REP_C1
#define REP_C1 1
#endif
#ifndef REP_C2
#define REP_C2 1
#endif
#ifndef REP_D
#define REP_D 1
#endif
#ifndef REP_E
#define REP_E 1
#endif

#define LAS __attribute__((address_space(3)))
#define DEV __device__ __forceinline__
typedef unsigned short bf16;
typedef short bf16x8 __attribute__((ext_vector_type(8)));
typedef float f32x4 __attribute__((ext_vector_type(4)));
typedef unsigned u32x4 __attribute__((ext_vector_type(4)));
typedef unsigned u32x2 __attribute__((ext_vector_type(2)));

typedef float f32x2_t __attribute__((ext_vector_type(2)));
typedef __bf16 bf16x2_t __attribute__((ext_vector_type(2)));
DEV unsigned pk2(float lo, float hi) { const f32x2_t v = {lo, hi}; const bf16x2_t b = __builtin_convertvector(v, bf16x2_t); return __builtin_bit_cast(unsigned, b); }
DEV unsigned f2bf(float f) { return pk2(f, 0.f) & 0xffffu; }
DEV float bf2f(unsigned b) { return __builtin_bit_cast(float, b << 16); }
DEV float bflo(unsigned w) { return __builtin_bit_cast(float, w << 16); }
DEV float bfhi(unsigned w) { return __builtin_bit_cast(float, w & 0xffff0000u); }
DEV float silu(float x) { return x * __builtin_amdgcn_rcpf(1.0f + __expf(-x)); }
DEV float softplus(float x) { return fmaxf(x, 0.f) + log1pf(expf(-fabsf(x))); }
template <int CTRL> DEV float dpp_f(float v) { return __builtin_bit_cast(float, __builtin_amdgcn_update_dpp(0, __builtin_bit_cast(int, v), CTRL, 0xF, 0xF, true)); }
DEV float red4_sum(float v) { v += dpp_f<0xB1>(v); v += dpp_f<0x4E>(v); return v; }
DEV float red8_sum(float v) { v = red4_sum(v); v += dpp_f<0x141>(v); return v; }
DEV float red16_sum(float v) { v = red8_sum(v); v += dpp_f<0x140>(v); return v; }
DEV float red16_max(float v) { v = fmaxf(v, dpp_f<0xB1>(v)); v = fmaxf(v, dpp_f<0x4E>(v)); v = fmaxf(v, dpp_f<0x141>(v)); v = fmaxf(v, dpp_f<0x140>(v)); return v; }
DEV float rdlane(float v, int l) { return __builtin_bit_cast(float, __builtin_amdgcn_readlane(__builtin_bit_cast(int, v), l)); }
DEV float wave_sum(float v) { v = red16_sum(v); return (rdlane(v, 0) + rdlane(v, 16)) + (rdlane(v, 32) + rdlane(v, 48)); }
DEV float wave_incl_scan(float v, int lane) {
    v += dpp_f<0x111>(v); v += dpp_f<0x112>(v); v += dpp_f<0x114>(v); v += dpp_f<0x118>(v);
    const float t0 = rdlane(v, 15), t1 = rdlane(v, 31), t2 = rdlane(v, 47);
    const int r = lane >> 4;
    return v + (r > 0 ? t0 : 0.f) + (r > 1 ? t1 : 0.f) + (r > 2 ? t2 : 0.f);
}
DEV float frcp(float x) { return __builtin_amdgcn_rcpf(x); }
DEV f32x4 mma_tile(const LAS bf16* A, int lda, const LAS bf16* B, int ldb, int K, int lane, f32x4 acc) {
    const LAS bf16* ap = A + (lane & 15) * lda + (lane >> 4) * 8;
    const LAS bf16* bp = B + (lane & 15) * ldb + (lane >> 4) * 8;
    for (int k = 0; k < K; k += 32) {
        const bf16x8 a = *(const LAS bf16x8*)(ap + k), b = *(const LAS bf16x8*)(bp + k);
        acc = __builtin_amdgcn_mfma_f32_16x16x32_bf16(a, b, acc, 0, 0, 0);
    }
    return acc;
}

struct Params {
    const float *x, *pre_mix, *post_mix, *pre_ffn, *post_ffn, *w_in, *w_out, *sinks, *sconv_w, *sconv_b, *sdt_bias, *sA_log, *sD, *snorm_w,
                *gconv_w, *gdt_bias, *gA_log, *gnorm_w, *w_gate, *w_up, *w_down;
    float* out; unsigned char* ws;
};

DEV void tr_item(const float* W, int ldw, int col0, bf16* WT, int K, int drow0, int rs, LAS float* scr, int kb, int nb, int lane) {
    const int k0 = 64 * kb, n0 = 32 * nb;
    float wv[32];
#pragma unroll
    for (int i = 0; i < 32; ++i) { const int kk = 2 * i + (lane >> 5); wv[i] = W[(size_t)(k0 + kk) * ldw + col0 + n0 + (lane & 31)]; }
#pragma unroll
    for (int i = 0; i < 32; ++i) { const int kk = 2 * i + (lane >> 5); scr[kk * 33 + (lane & 31)] = wv[i]; }
    asm volatile("s_waitcnt lgkmcnt(0)" ::: "memory");
    const int c = lane & 7;
#pragma unroll
    for (int j = 0; j < 4; ++j) { const int n = (lane >> 3) + 8 * j; const LAS float* s = scr + (8 * c) * 33 + n;
        u32x4 o; o.x = pk2(s[0 * 33], s[1 * 33]); o.y = pk2(s[2 * 33], s[3 * 33]); o.z = pk2(s[4 * 33], s[5 * 33]); o.w = pk2(s[6 * 33], s[7 * 33]);
        *(u32x4*)(WT + (size_t)(drow0 + (n0 + n) * rs) * K + k0 + 8 * c) = o; }
    asm volatile("s_waitcnt lgkmcnt(0)" ::: "memory");
}
DEV void convert_weights(const Params& p, int l, LAS unsigned char* lds, int gw, int NGW, int wave, int lane) {
    LAS float* scr = (LAS float*)(lds + wave * 8448);
    const float* win = p.w_in + (size_t)l * DM * IN_COLS; const float* wout = p.w_out + (size_t)l * DM * DM;
    const float* wg = p.w_gate + (size_t)l * DM * FF; const float* wu = p.w_up + (size_t)l * DM * FF; const float* wd = p.w_down + (size_t)l * FF * DM;
    bf16* WIN = (bf16*)(p.ws + WS_WIN); bf16* WOUT = (bf16*)(p.ws + WS_WOUT); bf16* WGU = (bf16*)(p.ws + WS_WGU); bf16* WDN = (bf16*)(p.ws + WS_WDN);
    constexpr int I_IN = 16 * 96, I_OUT = 16 * 32, I_G = 16 * 88, I_D = 44 * 32;
    constexpr int NIT = I_IN + I_OUT + 2 * I_G + I_D;
    for (int it = gw; it < NIT; it += NGW) {
        int r = it;
        if (r < I_IN) { const int kb = r / 96, nb = r % 96;
            if (nb < 64) tr_item(win, IN_COLS, 0, WIN, DM, 0, 1, scr, kb, nb, lane); else tr_item(win, IN_COLS, 2056, WIN, DM, 2048, 1, scr, kb, nb - 64, lane);
            continue; } r -= I_IN;
        if (r < I_OUT) { tr_item(wout, DM, 0, WOUT, DM, 0, 1, scr, r / 32, r % 32, lane); continue; } r -= I_OUT;
        if (r < I_G) { tr_item(wg, FF, 0, WGU, DM, 0, 2, scr, r / 88, r % 88, lane); continue; } r -= I_G;
        if (r < I_G) { tr_item(wu, FF, 0, WGU, DM, 1, 2, scr, r / 88, r % 88, lane); continue; } r -= I_G;
        tr_item(wd, DM, 0, WDN, FF, 0, 1, scr, r / 32, r % 32, lane);
    }
}
DEV void stage_small(const Params& p, int l, LAS float* wsT, int tid) {
    const float* win = p.w_in + (size_t)l * DM * IN_COLS;
    for (int idx = tid; idx < 16 * DM; idx += 512) { const int k = idx >> 4, c = idx & 15; const int sc = c < 8 ? 2048 + c : 3072 + c; wsT[c * DM + k] = win[(size_t)k * IN_COLS + sc]; }
}
template <int MODE, bool RB = false, bool OB = false>
DEV void rowpass(const void* res_, const bf16* tmp, const float* wpost, const float* wnext, void* xout_, bf16* XN, float* SMALL, const LAS float* wsT, int gw, int NGW, int lane) {
    const float* res = (const float*)res_; const bf16* res16 = (const bf16*)res_; float* xout = (float*)xout_; bf16* xout16 = (bf16*)xout_;
    f32x4 wp[4], wn[4];
#pragma unroll
    for (int j = 0; j < 4; ++j) {
        if (MODE != 0) wp[j] = *((const f32x4*)wpost + lane + 64 * j);
        if (MODE != 3) wn[j] = *((const f32x4*)wnext + lane + 64 * j);
    }
    f32x4 nv[4]; u32x2 nv16[4]; u32x2 ntw[4];
#pragma unroll
    for (int j = 0; j < 4; ++j) { if (RB) nv16[j] = *((const u32x2*)(res16 + (size_t)gw * DM) + lane + 64 * j); else nv[j] = *((const f32x4*)(res + (size_t)gw * DM) + lane + 64 * j);
        if (MODE != 0) ntw[j] = *((const u32x2*)(tmp + (size_t)gw * DM) + lane + 64 * j); }
    for (int m = gw; m < MTOK; m += NGW) {
        f32x4 v[4]; u32x2 ctw[4];
#pragma unroll
        for (int j = 0; j < 4; ++j) { if (RB) v[j] = (f32x4){bflo(nv16[j].x), bfhi(nv16[j].x), bflo(nv16[j].y), bfhi(nv16[j].y)}; else v[j] = nv[j]; if (MODE != 0) ctw[j] = ntw[j]; }
        { const int mn = (m + NGW < MTOK) ? m + NGW : m;
#pragma unroll
            for (int j = 0; j < 4; ++j) { if (RB) nv16[j] = *((const u32x2*)(res16 + (size_t)mn * DM) + lane + 64 * j); else nv[j] = *((const f32x4*)(res + (size_t)mn * DM) + lane + 64 * j);
                if (MODE != 0) ntw[j] = *((const u32x2*)(tmp + (size_t)mn * DM) + lane + 64 * j); } }
        if (MODE != 0) {
            f32x4 t[4]; float ss = 0.f;
#pragma unroll
            for (int j = 0; j < 4; ++j) { const u32x2 tw = ctw[j]; t[j] = (f32x4){bflo(tw.x), bfhi(tw.x), bflo(tw.y), bfhi(tw.y)}; ss += (t[j].x * t[j].x + t[j].y * t[j].y) + (t[j].z * t[j].z + t[j].w * t[j].w); }
            const float rstd = rsqrtf(wave_sum(ss) * (1.0f / DM) + EPS);
#pragma unroll
            for (int j = 0; j < 4; ++j) { v[j] = v[j] + t[j] * rstd * wp[j];
                if (OB) { u32x2 o; o.x = pk2(v[j].x, v[j].y); o.y = pk2(v[j].z, v[j].w); *((u32x2*)(xout16 + (size_t)m * DM) + lane + 64 * j) = o; }
                else *((f32x4*)(xout + (size_t)m * DM) + lane + 64 * j) = v[j]; }
        }
        if (MODE != 3) {
            float ss = 0.f;
#pragma unroll
            for (int j = 0; j < 4; ++j) ss += (v[j].x * v[j].x + v[j].y * v[j].y) + (v[j].z * v[j].z + v[j].w * v[j].w);
            const float rstd = rsqrtf(wave_sum(ss) * (1.0f / DM) + EPS);
#pragma unroll
            for (int j = 0; j < 4; ++j) { v[j] = v[j] * rstd * wn[j];
                u32x2 o; o.x = pk2(v[j].x, v[j].y); o.y = pk2(v[j].z, v[j].w); *((u32x2*)(XN + (size_t)m * DM) + lane + 64 * j) = o; }
            if (MODE == 0 || MODE == 2) {
                float mine = 0.f;
#pragma unroll
                for (int c = 0; c < 16; ++c) { float s = 0.f; asm volatile("" ::: "memory");
#pragma unroll
                    for (int j = 0; j < 4; ++j) { const f32x4 w = *((const LAS f32x4*)(wsT + c * DM) + lane + 64 * j); s += (v[j].x * w.x + v[j].y * w.y) + (v[j].z * w.z + v[j].w * w.w); }
                    s = red16_sum(s); mine = ((lane & 15) == c) ? s : mine; }
                mine += __shfl_xor(mine, 16); mine += __shfl_xor(mine, 32);
                if (lane < 16) SMALL[(size_t)m * 16 + lane] = mine;
            }
        }
    }
}

DEV void attn_unit(const Params& p, int l, int u, LAS unsigned char* lds, int tid) {
    asm volatile("" : "+v"(tid));
    const int b = u >> 7, c = (u >> 1) & 63, kvh = u & 1, wave = tid >> 6, lane = tid & 63;
    const bf16* PROJ = (const bf16*)(p.ws + WS_PROJ); bf16* MIX = (bf16*)(p.ws + WS_MIX);
    LAS bf16* Qs = (LAS bf16*)lds;
    LAS bf16* Ks = Qs + 128 * 72;
    LAS bf16* Vt = Ks + 192 * 72;
    LAS bf16* Ps = Vt + 64 * 200;
    const size_t t0 = (size_t)b * SEQ + (size_t)c * CH;
    const float sink = p.sinks[l * 4 + kvh * 2 + (wave >> 2)];
    {
        u32x4 rq[2], rk[3], rv[3];
#pragma unroll
        for (int k = 0; k < 2; ++k) { const int idx = tid + k * 512, r = idx >> 3, v = idx & 7, g = r >> 6, i = r & 63;
            rq[k] = *(const u32x4*)(PROJ + (t0 + i) * NPROJ + kvh * 128 + g * 64 + v * 8); }
#pragma unroll
        for (int k = 0; k < 3; ++k) { const int idx = tid + k * 512, j = idx >> 3, v = idx & 7; const bool valid = (c - 2 + (j >> 6)) >= 0;
            rk[k] = (u32x4){0u, 0u, 0u, 0u}; rv[k] = rk[k];
            if (valid) { const bf16* rowp = PROJ + (size_t)((long)t0 - 128 + j) * NPROJ; rk[k] = *(const u32x4*)(rowp + 256 + kvh * 64 + v * 8); rv[k] = *(const u32x4*)(rowp + 384 + kvh * 64 + v * 8); } }
#pragma unroll
        for (int k = 0; k < 2; ++k) { const int idx = tid + k * 512, r = idx >> 3, v = idx & 7; *(LAS u32x4*)(Qs + r * 72 + v * 8) = rq[k]; }
#pragma unroll
        for (int k = 0; k < 3; ++k) { const int idx = tid + k * 512, j = idx >> 3, v = idx & 7; const u32x4 vv = rv[k];
            *(LAS u32x4*)(Ks + j * 72 + v * 8) = rk[k];
            LAS bf16* vt = Vt + (v * 8) * 200 + j;
            vt[0 * 200] = (bf16)(vv.x & 0xffffu); vt[1 * 200] = (bf16)(vv.x >> 16); vt[2 * 200] = (bf16)(vv.y & 0xffffu); vt[3 * 200] = (bf16)(vv.y >> 16);
            vt[4 * 200] = (bf16)(vv.z & 0xffffu); vt[5 * 200] = (bf16)(vv.z >> 16); vt[6 * 200] = (bf16)(vv.w & 0xffffu); vt[7 * 200] = (bf16)(vv.w >> 16); }
    }
    __syncthreads();
    {
        const int g = wave >> 2, h = kvh * 2 + g;
        const float slope = exp2f(-2.0f * (float)(h + 1));
        f32x4 s[12];
#pragma unroll
        for (int nt = 0; nt < 12; ++nt) s[nt] = mma_tile(Qs + wave * 16 * 72, 72, Ks + nt * 16 * 72, 72, 64, lane, (f32x4){0.f, 0.f, 0.f, 0.f});
#pragma unroll
        for (int j = 0; j < 4; ++j) {
            const int r = wave * 16 + (lane >> 4) * 4 + j, i = r & 63;
            float mx = sink;
#pragma unroll
            for (int nt = 0; nt < 12; ++nt) { const int jj = nt * 16 + (lane & 15);
                float val = s[nt][j] * 0.125f - slope * fabsf((float)(i + 128 - jj));
                if (c - 2 + (nt >> 2) < 0) val = -INFINITY;
                s[nt][j] = val; mx = fmaxf(mx, val); }
            mx = red16_max(mx);
            float sum = 0.f;
#pragma unroll
            for (int nt = 0; nt < 12; ++nt) { const float e = __expf(s[nt][j] - mx); s[nt][j] = e; sum += e; }
            sum = red16_sum(sum);
            sum += __expf(sink - mx);
            const float inv = frcp(sum);
#pragma unroll
            for (int nt = 0; nt < 12; ++nt) Ps[r * 200 + nt * 16 + (lane & 15)] = (bf16)f2bf(s[nt][j] * inv);
        }
    }
    __syncthreads();
#pragma unroll
    for (int nt = 0; nt < 4; ++nt) {
        const f32x4 acc = mma_tile(Vt + nt * 16 * 200, 200, Ps + wave * 16 * 200, 200, 192, lane, (f32x4){0.f, 0.f, 0.f, 0.f});
        const int r = wave * 16 + (lane & 15), g = r >> 6, i = r & 63, d0 = nt * 16 + (lane >> 4) * 4;
        u32x2 o; o.x = pk2(acc[0], acc[1]); o.y = pk2(acc[2], acc[3]);
        *(u32x2*)(MIX + (t0 + i) * DM + (kvh * 2 + g) * 64 + d0) = o;
    }
    __syncthreads();
}

template <int NCOLS> struct RawTile {
    static constexpr int VPR = NCOLS / 8, NV = 67 * VPR, NIT = (NV + 511) / 512;
    u32x4 r[NIT];
    DEV void issue(const bf16* PROJ, size_t t0, int c, int col0, int tid) {
#pragma unroll
        for (int k = 0; k < NIT; ++k) { const int idx = tid + k * 512, row = idx / VPR, v = idx % VPR;
            r[k] = (u32x4){0u, 0u, 0u, 0u};
            if (idx < NV && (c > 0 || row >= 3)) r[k] = *(const u32x4*)(PROJ + (size_t)((long)t0 - 3 + row) * NPROJ + col0 + v * 8); }
    }
    DEV void commit(LAS bf16* Raw, int rawld, int dcol0, int tid) const {
#pragma unroll
        for (int k = 0; k < NIT; ++k) { const int idx = tid + k * 512, row = idx / VPR, v = idx % VPR;
            if (idx < NV) *(LAS u32x4*)(Raw + row * rawld + dcol0 + v * 8) = r[k]; }
    }
};
struct P1PF { RawTile<256> R1; float sm; };
DEV void ssd_p1_issue(const Params& p, int u, int tid, P1PF& pf) {
    const int b = u >> 7, c = (u >> 1) & 63, g = u & 1, lane = tid & 63;
    const bf16* PROJ = (const bf16*)(p.ws + WS_PROJ); const float* SMALL = (const float*)(p.ws + WS_SMALL);
    const size_t t0 = (size_t)b * SEQ + (size_t)c * CH;
    pf.R1.issue(PROJ, t0, c, 1024 + g * 256, tid);
    pf.sm = 0.f; if (tid < 256) pf.sm = SMALL[(t0 + lane) * 16 + g * 4 + (tid >> 6)];
}
DEV void ssd_p1_unit(const Params& p, int l, int u, int unext, LAS unsigned char* lds, int tid, P1PF& pf) {
    asm volatile("" : "+v"(tid));
    const int b = u >> 7, c = (u >> 1) & 63, g = u & 1, wave = tid >> 6, lane = tid & 63;
    const bf16* PROJ = (const bf16*)(p.ws + WS_PROJ);
    const float* SMALL = (const float*)(p.ws + WS_SMALL);
    float* ACS = (float*)(p.ws + WS_ACS); float* CDEC = (float*)(p.ws + WS_CDEC);
    bf16* STATES = (bf16*)(p.ws + WS_STATES); bf16* YPART = (bf16*)(p.ws + WS_YPART); bf16* CCONV = (bf16*)(p.ws + WS_CCONV);
    LAS bf16* XsT = (LAS bf16*)lds;
    LAS bf16* Bm = XsT + 4 * 64 * 72;
    LAS bf16* Cm = Bm + 64 * 136;
    LAS bf16* BmT = Cm + 64 * 136;
    LAS bf16* Sc = BmT + 128 * 72;
    LAS bf16* Raw = Sc;
    LAS float* dtS = (LAS float*)(Sc + 4 * 64 * 72);
    LAS float* acsS = dtS + 256;
    LAS float* fS = acsS + 256;
    const size_t t0 = (size_t)b * SEQ + (size_t)c * CH;
    RawTile<128> R2b, R2c;
    R2b.issue(PROJ, t0, c, 1024 + 512 + g * 128, tid); R2c.issue(PROJ, t0, c, 1024 + 768 + g * 128, tid);
    float cw1[5], cw2[5];
    { const int ch = tid & 255, chg1 = g * 256 + ch, chg2 = 512 + (ch >> 7) * 256 + g * 128 + (ch & 127);
      const float* c1 = p.sconv_w + (size_t)l * 4096 + chg1; const float* c2 = p.sconv_w + (size_t)l * 4096 + chg2;
      cw1[0] = c1[0]; cw1[1] = c1[1024]; cw1[2] = c1[2048]; cw1[3] = c1[3072]; cw1[4] = p.sconv_b[l * 1024 + chg1];
      cw2[0] = c2[0]; cw2[1] = c2[1024]; cw2[2] = c2[2048]; cw2[3] = c2[3072]; cw2[4] = p.sconv_b[l * 1024 + chg2]; }
    const float Dh = p.sD[l * 8 + g * 4 + (wave >> 1)];
    if (tid < 256) {
        const int h = tid >> 6, hh = g * 4 + h;
        const float dt = softplus(pf.sm + p.sdt_bias[l * 8 + hh]);
        const float a = -expf(p.sA_log[l * 8 + hh]);
        const float acs = wave_incl_scan(dt * a, lane);
        const float alast = rdlane(acs, 63);
        dtS[tid] = dt; acsS[tid] = acs; fS[tid] = dt * expf(alast - acs);
        ACS[(t0 + lane) * 8 + hh] = acs;
        if (lane == 63) CDEC[((size_t)b * NCH + c) * 8 + hh] = expf(acs);
    }
    pf.R1.commit(Raw, 256, 0, tid);
    __syncthreads();
    {
        const int ch = tid & 255, half = tid >> 8, chg = g * 256 + ch, h = ch >> 6, pp = ch & 63;
        const float w0 = cw1[0], w1 = cw1[1], w2 = cw1[2], w3 = cw1[3], bias = cw1[4]; (void)chg;
        const int r0 = half * 32;
        float x0 = bf2f(Raw[(r0 + 0) * 256 + ch]), x1 = bf2f(Raw[(r0 + 1) * 256 + ch]), x2 = bf2f(Raw[(r0 + 2) * 256 + ch]);
        LAS bf16* dst = XsT + h * 64 * 72 + pp * 72 + r0;
#pragma unroll 8
        for (int r = 0; r < 32; ++r) { const float x3 = bf2f(Raw[(r0 + r + 3) * 256 + ch]);
            const float y = silu(w0 * x0 + w1 * x1 + w2 * x2 + w3 * x3 + bias);
            dst[r] = (bf16)f2bf(y); x0 = x1; x1 = x2; x2 = x3; }
    }
    __syncthreads();
    R2b.commit(Raw, 256, 0, tid); R2c.commit(Raw, 256, 128, tid);
    if (unext >= 0) ssd_p1_issue(p, unext, tid, pf);
    __syncthreads();
    {
        const int ch = tid & 255, half = tid >> 8, isC = ch >> 7, n = ch & 127, chg = 512 + isC * 256 + g * 128 + n;
        const float w0 = cw2[0], w1 = cw2[1], w2 = cw2[2], w3 = cw2[3], bias = cw2[4]; (void)chg;
        const int r0 = half * 32;
        float x0 = bf2f(Raw[(r0 + 0) * 256 + ch]), x1 = bf2f(Raw[(r0 + 1) * 256 + ch]), x2 = bf2f(Raw[(r0 + 2) * 256 + ch]);
#pragma unroll 8
        for (int r = 0; r < 32; ++r) { const float x3 = bf2f(Raw[(r0 + r + 3) * 256 + ch]);
            const bf16 y = (bf16)f2bf(silu(w0 * x0 + w1 * x1 + w2 * x2 + w3 * x3 + bias));
            if (isC) Cm[(r0 + r) * 136 + n] = y; else { Bm[(r0 + r) * 136 + n] = y; BmT[n * 72 + r0 + r] = y; }
            x0 = x1; x1 = x2; x2 = x3; }
    }
    __syncthreads();
    for (int idx = tid; idx < 1024; idx += 512) { const int r = idx >> 4, v = idx & 15; *(u32x4*)(CCONV + (t0 + r) * 256 + g * 128 + v * 8) = *(const LAS u32x4*)(Cm + r * 136 + v * 8); }
#pragma unroll
    for (int ti = 0; ti < 2; ++ti) {
        const int tt = wave * 2 + ti, mt = tt >> 2, nt = tt & 3;
        f32x4 acc = (f32x4){0.f, 0.f, 0.f, 0.f};
        if (nt <= mt) acc = mma_tile(Bm + nt * 16 * 136, 136, Cm + mt * 16 * 136, 136, 128, lane, acc);
        const int lr = mt * 16 + (lane & 15), s0 = nt * 16 + (lane >> 4) * 4;
#pragma unroll
        for (int h = 0; h < 4; ++h) { const f32x4 as = *(const LAS f32x4*)(acsS + h * 64 + s0), ds = *(const LAS f32x4*)(dtS + h * 64 + s0); const float al = acsS[h * 64 + lr];
            float v[4];
#pragma unroll
            for (int j = 0; j < 4; ++j) v[j] = (s0 + j <= lr) ? acc[j] * __expf(al - as[j]) * ds[j] : 0.f;
            u32x2 o; o.x = pk2(v[0], v[1]); o.y = pk2(v[2], v[3]);
            *(LAS u32x2*)(Sc + h * 64 * 72 + lr * 72 + s0) = o; }
    }
    __syncthreads();
    {
        const int h = wave >> 1, hh = g * 4 + h;
#pragma unroll 2
        for (int ti = 0; ti < 8; ++ti) { const int tt = (wave & 1) * 8 + ti, mt = tt >> 2, nt = tt & 3;
            const f32x4 acc = mma_tile(XsT + h * 64 * 72 + nt * 16 * 72, 72, Sc + h * 64 * 72 + mt * 16 * 72, 72, 64, lane, (f32x4){0.f, 0.f, 0.f, 0.f});
            const int lr = mt * 16 + (lane & 15), p0 = nt * 16 + (lane >> 4) * 4;
            const LAS bf16* xp = XsT + h * 64 * 72 + p0 * 72 + lr;
            u32x2 o; o.x = pk2(acc[0] + Dh * bf2f(xp[0]), acc[1] + Dh * bf2f(xp[72])); o.y = pk2(acc[2] + Dh * bf2f(xp[144]), acc[3] + Dh * bf2f(xp[216]));
            *(u32x2*)(YPART + (t0 + lr) * 512 + hh * 64 + p0) = o; }
#pragma unroll
        for (int pi = 0; pi < 2; ++pi) { const int pt = (wave & 1) * 2 + pi;
            bf16x8 xf[2];
#pragma unroll
            for (int k = 0; k < 2; ++k) { const int l0 = k * 32 + (lane >> 4) * 8;
                const u32x4 xw = *(const LAS u32x4*)(XsT + h * 64 * 72 + (pt * 16 + (lane & 15)) * 72 + l0);
                const f32x4 f0 = *(const LAS f32x4*)(fS + h * 64 + l0), f1 = *(const LAS f32x4*)(fS + h * 64 + l0 + 4);
                u32x4 o; o.x = pk2(bflo(xw.x) * f0.x, bfhi(xw.x) * f0.y); o.y = pk2(bflo(xw.y) * f0.z, bfhi(xw.y) * f0.w);
                o.z = pk2(bflo(xw.z) * f1.x, bfhi(xw.z) * f1.y); o.w = pk2(bflo(xw.w) * f1.z, bfhi(xw.w) * f1.w);
                xf[k] = __builtin_bit_cast(bf16x8, o); }
#pragma unroll 2
            for (int nt = 0; nt < 8; ++nt) {
                f32x4 acc = (f32x4){0.f, 0.f, 0.f, 0.f};
#pragma unroll
                for (int k = 0; k < 2; ++k) { const bf16x8 bfr = *(const LAS bf16x8*)(BmT + (nt * 16 + (lane & 15)) * 72 + k * 32 + (lane >> 4) * 8);
                    acc = __builtin_amdgcn_mfma_f32_16x16x32_bf16(bfr, xf[k], acc, 0, 0, 0); }
                u32x2 o; o.x = pk2(acc[0], acc[1]); o.y = pk2(acc[2], acc[3]);
                *(u32x2*)(STATES + ((((size_t)b * NCH + c) * 8 + hh) * 64 + pt * 16 + (lane & 15)) * 128 + nt * 16 + (lane >> 4) * 4) = o; } }
    }
    __syncthreads();
}
DEV void ssd_scan_all(const Params& p, int bx, LAS unsigned char* lds, int tid) {
    asm volatile("" : "+v"(tid));
    bf16* STATES = (bf16*)(p.ws + WS_STATES); const float* CDEC = (const float*)(p.ws + WS_CDEC);
    LAS float* decS = (LAS float*)lds;
    const int idx = bx * 512 + tid, b = idx >> 15, rem = idx & 32767, hh = rem >> 12, pn2 = rem & 4095;
    if (tid < 64) decS[tid] = CDEC[((size_t)b * NCH + tid) * 8 + hh];
    unsigned* base = (unsigned*)(STATES + ((size_t)b * NCH * 8 + hh) * 8192) + pn2;
    unsigned nw[NCH];
#pragma unroll
    for (int c = 0; c < NCH; ++c) nw[c] = base[(size_t)c * 8 * 4096];
    __syncthreads();
    float s0 = 0.f, s1 = 0.f;
#pragma unroll
    for (int c = 0; c < NCH; ++c) { const float d = decS[c];
        base[(size_t)c * 8 * 4096] = pk2(s0, s1);
        s0 = s0 * d + bflo(nw[c]); s1 = s1 * d + bfhi(nw[c]); }
    __syncthreads();
}
DEV void ssd_p3_unit(const Params& p, int l, int u, LAS unsigned char* lds, int tid) {
    asm volatile("" : "+v"(tid));
    const int b = u >> 7, c = (u >> 1) & 63, g = u & 1, wave = tid >> 6, lane = tid & 63;
    const bf16* PROJ = (const bf16*)(p.ws + WS_PROJ); const float* ACS = (const float*)(p.ws + WS_ACS);
    const bf16* STATES = (const bf16*)(p.ws + WS_STATES); const bf16* YPART = (const bf16*)(p.ws + WS_YPART); const bf16* CCONV = (const bf16*)(p.ws + WS_CCONV);
    bf16* MIX = (bf16*)(p.ws + WS_MIX);
    LAS bf16* Cm = (LAS bf16*)lds;
    LAS bf16* Prev = Cm + 64 * 136;
    LAS float* Gb = (LAS float*)Prev;
    LAS float* acsS = (LAS float*)(Prev + 4 * 64 * 136);
    const size_t t0 = (size_t)b * SEQ + (size_t)c * CH;
    const int h = wave >> 1, hh = g * 4 + h;
    u32x4 rc[2], rp[8]; u32x2 ry[8], rz[8]; float racs = 0.f;
    f32x4 nw[8];
    { const f32x4* nwp = (const f32x4*)(p.snorm_w + (size_t)l * 512 + g * 256 + (tid & 7) * 32);
#pragma unroll
        for (int k = 0; k < 8; ++k) nw[k] = nwp[k]; }
#pragma unroll
    for (int k = 0; k < 2; ++k) { const int idx = tid + k * 512, r = idx >> 4, v = idx & 15; rc[k] = *(const u32x4*)(CCONV + (t0 + r) * 256 + g * 128 + v * 8); }
#pragma unroll
    for (int k = 0; k < 8; ++k) { const int idx = tid + k * 512, hq = idx >> 10, r = (idx >> 4) & 63, v = idx & 15;
        rp[k] = *(const u32x4*)(STATES + ((((size_t)b * NCH + c) * 8 + g * 4 + hq) * 64 + r) * 128 + v * 8); }
    if (tid < 256) racs = ACS[(t0 + (tid & 63)) * 8 + g * 4 + (tid >> 6)];
#pragma unroll
    for (int ti = 0; ti < 8; ++ti) { const int tt = (wave & 1) * 8 + ti, mt = tt >> 2, nt = tt & 3, lr = mt * 16 + (lane & 15), p0 = nt * 16 + (lane >> 4) * 4;
        ry[ti] = *(const u32x2*)(YPART + (t0 + lr) * 512 + hh * 64 + p0); rz[ti] = *(const u32x2*)(PROJ + (t0 + lr) * NPROJ + 512 + hh * 64 + p0); }
#pragma unroll
    for (int k = 0; k < 2; ++k) { const int idx = tid + k * 512, r = idx >> 4, v = idx & 15; *(LAS u32x4*)(Cm + r * 136 + v * 8) = rc[k]; }
#pragma unroll
    for (int k = 0; k < 8; ++k) { const int idx = tid + k * 512, hq = idx >> 10, r = (idx >> 4) & 63, v = idx & 15; *(LAS u32x4*)(Prev + hq * 64 * 136 + r * 136 + v * 8) = rp[k]; }
    if (tid < 256) acsS[tid] = racs;
    __syncthreads();
    f32x4 acc[8];
    for (int rq_ = 0; rq_ < RP3_MMA; ++rq_) {
#pragma unroll
    for (int ti = 0; ti < 8; ++ti) { const int tt = (wave & 1) * 8 + ti, mt = tt >> 2, nt = tt & 3;
        acc[ti] = mma_tile(Prev + h * 64 * 136 + nt * 16 * 136, 136, Cm + mt * 16 * 136, 136, 128, lane, (f32x4){0.f, 0.f, 0.f, 0.f}); }
    asm volatile("" ::: "memory"); }
    __syncthreads();
#pragma unroll
    for (int ti = 0; ti < 8; ++ti) { const int tt = (wave & 1) * 8 + ti, mt = tt >> 2, nt = tt & 3, lr = mt * 16 + (lane & 15), p0 = nt * 16 + (lane >> 4) * 4;
        const float ea = __expf(acsS[h * 64 + lr]);
        f32x4 gv;
        gv.x = (bflo(ry[ti].x) + ea * acc[ti][0]) * silu(bflo(rz[ti].x)); gv.y = (bfhi(ry[ti].x) + ea * acc[ti][1]) * silu(bfhi(rz[ti].x));
        gv.z = (bflo(ry[ti].y) + ea * acc[ti][2]) * silu(bflo(rz[ti].y)); gv.w = (bfhi(ry[ti].y) + ea * acc[ti][3]) * silu(bfhi(rz[ti].y));
        *(LAS f32x4*)(Gb + lr * 260 + h * 64 + p0) = gv; }
    __syncthreads();
    {
        const int lr = tid >> 3, part = tid & 7;
        f32x4 v[8]; float ss = 0.f;
#pragma unroll
        for (int k = 0; k < 8; ++k) { v[k] = *(const LAS f32x4*)(Gb + lr * 260 + part * 32 + k * 4); ss += (v[k].x * v[k].x + v[k].y * v[k].y) + (v[k].z * v[k].z + v[k].w * v[k].w); }
        ss = red8_sum(ss);
        const float rstd = rsqrtf(ss * (1.0f / 256.0f) + EPS);
        bf16* dst = MIX + (t0 + lr) * DM + 256 + g * 256 + part * 32;
#pragma unroll
        for (int k = 0; k < 4; ++k) { const f32x4 a = v[2 * k] * rstd * nw[2 * k], bq = v[2 * k + 1] * rstd * nw[2 * k + 1];
            u32x4 o; o.x = pk2(a.x, a.y); o.y = pk2(a.z, a.w); o.z = pk2(bq.x, bq.y); o.w = pk2(bq.z, bq.w);
            *(u32x4*)(dst + 8 * k) = o; }
    }
    __syncthreads();
}

struct GdnPF { u32x4 rr[4]; float sb, sa; };
DEV void gdn_pre_issue(const Params& p, int u, int tid, GdnPF& pf) {
    const int b = u >> 8, c = (u >> 2) & 63, hg = u & 3, lane = tid & 63;
    const bf16* PROJ = (const bf16*)(p.ws + WS_PROJ); const float* SMALL = (const float*)(p.ws + WS_SMALL);
    const size_t t0 = (size_t)b * SEQ + (size_t)c * CH;
#pragma unroll
    for (int k = 0; k < 4; ++k) { const int idx = tid + k * 512, row = idx / 24, rem = idx % 24, seg = rem >> 3, v = rem & 7;
        pf.rr[k] = (u32x4){0u, 0u, 0u, 0u};
        if (idx < 67 * 24 && (c > 0 || row >= 3)) pf.rr[k] = *(const u32x4*)(PROJ + (size_t)((long)t0 - 3 + row) * NPROJ + 2048 + seg * 256 + hg * 64 + v * 8); }
    pf.sb = 0.f; pf.sa = 0.f;
    if ((tid >> 6) == 0) { pf.sb = SMALL[(t0 + lane) * 16 + 8 + hg]; pf.sa = SMALL[(t0 + lane) * 16 + 12 + hg]; }
}
DEV void gdn_pre_unit(const Params& p, int l, int u, int unext, LAS unsigned char* lds, int tid, GdnPF& pf) {
    asm volatile("" : "+v"(tid));
    const int b = u >> 8, c = (u >> 2) & 63, hg = u & 3, wave = tid >> 6, lane = tid & 63;
    const int ub = (b * 4 + hg) * 64 + c;
    const bf16* PROJ = (const bf16*)(p.ws + WS_PROJ); const float* SMALL = (const float*)(p.ws + WS_SMALL);
    bf16* GU = (bf16*)(p.ws + WS_GU) + (size_t)ub * 4096; bf16* GW = (bf16*)(p.ws + WS_GW) + (size_t)ub * 4096; bf16* GQE = (bf16*)(p.ws + WS_GQE) + (size_t)ub * 4096;
    bf16* GQK = (bf16*)(p.ws + WS_GQK) + (size_t)ub * 4096; bf16* GKDT = (bf16*)(p.ws + WS_GKDT) + (size_t)ub * 4096; float* EGL = (float*)(p.ws + WS_EGL);
    LAS bf16* Raw = (LAS bf16*)lds;
    LAS float* Xn = (LAS float*)lds;
    LAS float* Qs = (LAS float*)(lds + 25728);
    LAS float* Ks = Qs + 64 * 65;
    LAS float* Vs = Ks + 64 * 65;
    LAS float* Am = Vs + 64 * 65;
    LAS float* betaS = Am + 64 * 64;
    LAS float* gcS = betaS + 64;
    LAS float* scwS = gcS + 64;
    LAS float* egS = scwS + 64;
    LAS float* kdS = egS + 64;
    LAS float* R = kdS + 64;
    LAS float* At = R + 64 * 128;
    LAS float* Dv = At + 64 * 64;
    const size_t t0 = (size_t)b * SEQ + (size_t)c * CH;
    float cwv[3][4];
#pragma unroll
    for (int seg = 0; seg < 3; ++seg) { const float* cw = p.gconv_w + (size_t)l * 3072 + seg * 256 + hg * 64 + lane; cwv[seg][0] = cw[0]; cwv[seg][1] = cw[768]; cwv[seg][2] = cw[1536]; cwv[seg][3] = cw[2304]; }
    if (wave == 0) {
        const float beta = frcp(1.0f + expf(-pf.sb));
        const float gg = -expf(p.gA_log[l * 4 + hg]) * softplus(pf.sa + p.gdt_bias[l * 4 + hg]);
        const float gc = wave_incl_scan(gg, lane);
        const float glast = rdlane(gc, 63), eg = expf(gc);
        betaS[lane] = beta; gcS[lane] = gc; scwS[lane] = beta * eg; egS[lane] = eg; kdS[lane] = expf(glast - gc);
        if (lane == 63) EGL[ub] = eg;
    }
#pragma unroll
    for (int k = 0; k < 4; ++k) { const int idx = tid + k * 512, row = idx / 24, rem = idx % 24;
        if (idx < 67 * 24) *(LAS u32x4*)(Raw + row * 192 + rem * 8) = pf.rr[k]; }
    __syncthreads();
    for (int rq_ = 0; rq_ < RG_CONV; ++rq_)
#pragma unroll
    for (int seg = 0; seg < 3; ++seg) {
        const float w0 = cwv[seg][0], w1 = cwv[seg][1], w2 = cwv[seg][2], w3 = cwv[seg][3];
        LAS float* dst = seg == 0 ? Qs : (seg == 1 ? Ks : Vs);
        const int r0 = wave * 8;
        float x0 = bf2f(Raw[(r0 + 0) * 192 + seg * 64 + lane]), x1 = bf2f(Raw[(r0 + 1) * 192 + seg * 64 + lane]), x2 = bf2f(Raw[(r0 + 2) * 192 + seg * 64 + lane]);
#pragma unroll
        for (int r = 0; r < 8; ++r) { const float x3 = bf2f(Raw[(r0 + r + 3) * 192 + seg * 64 + lane]);
            float y = silu(w0 * x0 + w1 * x1 + w2 * x2 + w3 * x3);
            if (seg < 2) { const float ss = wave_sum(y * y); y *= rsqrtf(ss + EPS); if (seg == 0) y *= 0.125f; }
            dst[(r0 + r) * 65 + lane] = y; x0 = x1; x1 = x2; x2 = x3; }
    }
    __syncthreads();
    for (int rq_ = 0; rq_ < RG_KK; ++rq_)
    {
        for (int t = wave; t < 20; t += 8) {
            const bool isqk = t >= 10; const int idx = isqk ? t - 10 : t;
            const int mt = idx >= 6 ? 3 : (idx >= 3 ? 2 : (idx >= 1 ? 1 : 0)), nt = idx - mt * (mt + 1) / 2;
            const LAS float* ap = (isqk ? Qs : Ks) + (mt * 16 + (lane & 15)) * 65 + (lane >> 4);
            const LAS float* bp = Ks + (nt * 16 + (lane & 15)) * 65 + (lane >> 4);
            f32x4 acc = (f32x4){0.f, 0.f, 0.f, 0.f};
#pragma unroll
            for (int ks = 0; ks < 16; ++ks) acc = __builtin_amdgcn_mfma_f32_16x16x4f32(ap[ks * 4], bp[ks * 4], acc, 0, 0, 0);
            const int j = nt * 16 + (lane & 15), i0 = mt * 16 + (lane >> 4) * 4; const float gj = gcS[j];
            float v[4];
#pragma unroll
            for (int jj = 0; jj < 4; ++jj) { const int i = i0 + jj; const float dec = (j <= i) ? __expf(gcS[i] - gj) : 0.f;
                v[jj] = isqk ? acc[jj] * dec : ((j < i) ? betaS[i] * acc[jj] * dec : 0.f); }
            if (!isqk) {
#pragma unroll
                for (int jj = 0; jj < 4; ++jj) Am[(i0 + jj) * 64 + j] = v[jj];
                *(LAS f32x4*)(At + j * 64 + i0) = (f32x4){v[0], v[1], v[2], v[3]};
            } else {
#pragma unroll
                for (int jj = 0; jj < 4; ++jj) GQK[(i0 + jj) * 64 + j] = (bf16)f2bf(v[jj]);
            }
        }
        { const int e0 = tid * 8, i = e0 >> 6, j = e0 & 63; const unsigned zz = (unsigned)tid >> 31;
          if ((j >> 4) > (i >> 4)) *(u32x4*)(GQK + e0) = (u32x4){zz, zz, zz, zz}; }
    }
    __syncthreads();
    if (unext >= 0) gdn_pre_issue(p, unext, tid, pf);
    for (int rq_ = 0; rq_ < RG_SOLVE; ++rq_) {
    if (wave == 7) {
        const int bb = lane >> 4, cc = lane & 15;
        f32x4 ar[16][4];
#pragma unroll
        for (int i = 1; i < 16; ++i)
#pragma unroll
            for (int q4 = 0; q4 < 4; ++q4) if (q4 * 4 < i) ar[i][q4] = *(const LAS f32x4*)(Am + (bb * 16 + i) * 64 + bb * 16 + q4 * 4);
        float x[16];
#pragma unroll
        for (int i = 0; i < 16; ++i) {
            float acc = (i == cc) ? 1.f : 0.f;
#pragma unroll
            for (int q4 = 0; q4 < 4; ++q4) if (q4 * 4 < i) { const f32x4 a = ar[i][q4];
                if (q4 * 4 + 0 < i) acc -= a.x * x[q4 * 4 + 0];
                if (q4 * 4 + 1 < i) acc -= a.y * x[q4 * 4 + 1];
                if (q4 * 4 + 2 < i) acc -= a.z * x[q4 * 4 + 2];
                if (q4 * 4 + 3 < i) acc -= a.w * x[q4 * 4 + 3]; }
            x[i] = acc;
            Dv[bb * 256 + i * 16 + cc] = acc;
        }
    } else {
#pragma unroll 4
        for (int e = tid; e < 4096; e += 448) { const int r = e >> 6, d = e & 63;
            if (rq_ == 0) GQE[e] = (bf16)f2bf(Qs[r * 65 + d] * egS[r]);
            GKDT[e] = (bf16)f2bf(Ks[d * 65 + r] * kdS[d]); }
    }
    __syncthreads();
    {
        const int col = wave * 16 + (lane & 15), q = lane >> 4;
        bf16* dstg = (col >= 64 ? GW : GU) + (col & 63);
        const int fr = lane & 15;
#pragma unroll
        for (int rb = 0; rb < 4; ++rb) {
            LAS float* rp = R + (16 * rb + 4 * q) * 128 + col;
            float rh[4];
#pragma unroll
            for (int k = 0; k < 4; ++k) { const int i = 16 * rb + 4 * q + k; rh[k] = (col < 64) ? Vs[i * 65 + col] * betaS[i] : Ks[i * 65 + col - 64] * scwS[i]; }
            if (rb > 0) {
                float af[12], xf[12];
#pragma unroll
                for (int ks = 0; ks < 4 * rb; ++ks) { af[ks] = Am[(16 * rb + fr) * 64 + 4 * ks + q]; xf[ks] = Xn[(4 * ks + q) * 128 + col]; }
                f32x4 pacc = (f32x4){0.f, 0.f, 0.f, 0.f};
#pragma unroll
                for (int ks = 0; ks < 4 * rb; ++ks) pacc = __builtin_amdgcn_mfma_f32_16x16x4f32(af[ks], xf[ks], pacc, 0, 0, 0);
                rh[0] -= pacc[0]; rh[1] -= pacc[1]; rh[2] -= pacc[2]; rh[3] -= pacc[3];
            }
            rp[0] = rh[0]; rp[128] = rh[1]; rp[256] = rh[2]; rp[384] = rh[3];
            asm volatile("s_waitcnt lgkmcnt(0)" ::: "memory");
            float df[4], rf[4];
#pragma unroll
            for (int ks = 0; ks < 4; ++ks) { df[ks] = Dv[rb * 256 + fr * 16 + 4 * ks + q]; rf[ks] = R[(16 * rb + 4 * ks + q) * 128 + col]; }
            f32x4 xacc = (f32x4){0.f, 0.f, 0.f, 0.f};
#pragma unroll
            for (int ks = 0; ks < 4; ++ks) xacc = __builtin_amdgcn_mfma_f32_16x16x4f32(df[ks], rf[ks], xacc, 0, 0, 0);
#pragma unroll
            for (int k = 0; k < 4; ++k) { const int ii = 4 * q + k; Xn[(16 * rb + ii) * 128 + col] = xacc[k]; dstg[(16 * rb + ii) * 64] = (bf16)f2bf(xacc[k]); }
            asm volatile("s_waitcnt lgkmcnt(0)" ::: "memory");
        }
    }
    __syncthreads();
    }
}
DEV void gdn_scan_block(const Params& p, int bh2, LAS unsigned char* lds, int tid) {
    asm volatile("" : "+v"(tid));
    const int bh = bh2 >> 1, half = bh2 & 1;
    const int b = bh >> 2, hg = bh & 3, wave = tid >> 6, lane = tid & 63;
    const size_t ub0 = (size_t)bh * 64;
    const bf16* GM0 = (const bf16*)(p.ws + WS_GW) + ub0 * 4096; const bf16* GM1 = (const bf16*)(p.ws + WS_GQE) + ub0 * 4096;
    const bf16* GM2 = (const bf16*)(p.ws + WS_GQK) + ub0 * 4096; const bf16* GM3 = (const bf16*)(p.ws + WS_GKDT) + ub0 * 4096;
    const bf16* GM4 = (const bf16*)(p.ws + WS_GU) + ub0 * 4096;
    const float* EGL = (const float*)(p.ws + WS_EGL) + ub0;
    bf16* MIX = (bf16*)(p.ws + WS_MIX);
    LAS bf16* OPS = (LAS bf16*)lds;
    LAS bf16* PRV = OPS + 2 * 5 * 4608;
    LAS float* egS = (LAS float*)(PRV + 4 * 2 * 1152);
    if (tid < 64) egS[tid] = EGL[tid];
    if (wave >= 2 && wave < 4) {
        __syncthreads();
        for (int c = 0; c < NCH; ++c) __syncthreads();
    } else if (wave < 2) {
        const int es = half * 2 + wave, fr = lane & 15, fq = lane >> 4;
        LAS bf16* Stp = PRV + wave * 2304; LAS bf16* Vtp = Stp + 1152;
        for (int i = lane; i < 1152; i += 64) Stp[i] = 0;
        f32x4 Sacc[4];
#pragma unroll
        for (int mt = 0; mt < 4; ++mt) Sacc[mt] = (f32x4){0.f, 0.f, 0.f, 0.f};
        bf16* obase = MIX + ((size_t)b * SEQ + fr) * DM + 768 + hg * 64 + es * 16 + fq * 4;
        __syncthreads();
#pragma unroll 2
        for (int c = 0; c < NCH; ++c) {
            const LAS bf16* Wb = OPS + (c & 1) * 5 * 4608;
            const int fo = fr * 72 + fq * 8;
            const bf16x8 fS0 = *(const LAS bf16x8*)(Stp + fo), fS1 = *(const LAS bf16x8*)(Stp + fo + 32);
            bf16x8 fW[4][2], fQE[4][2], fQK[4][2], fKD[4][2]; u32x2 uw[4];
#pragma unroll
            for (int mt = 0; mt < 4; ++mt)
#pragma unroll
                for (int ks = 0; ks < 2; ++ks) fW[mt][ks] = *(const LAS bf16x8*)(Wb + mt * 16 * 72 + fo + ks * 32);
#pragma unroll
            for (int mt = 0; mt < 4; ++mt) uw[mt] = *(const LAS u32x2*)(Wb + 4 * 4608 + (mt * 16 + fr) * 72 + es * 16 + fq * 4);
#pragma unroll
            for (int mt = 0; mt < 4; ++mt)
#pragma unroll
                for (int ks = 0; ks < 2; ++ks) fQE[mt][ks] = *(const LAS bf16x8*)(Wb + 4608 + mt * 16 * 72 + fo + ks * 32);
#pragma unroll
            for (int mt = 0; mt < 4; ++mt)
#pragma unroll
                for (int ks = 0; ks < 2; ++ks) fKD[mt][ks] = *(const LAS bf16x8*)(Wb + 3 * 4608 + mt * 16 * 72 + fo + ks * 32);
#pragma unroll
            for (int mt = 0; mt < 4; ++mt)
#pragma unroll
                for (int ks = 0; ks < 2; ++ks) fQK[mt][ks] = *(const LAS bf16x8*)(Wb + 2 * 4608 + mt * 16 * 72 + fo + ks * 32);
            const float egl = egS[c];
            f32x4 av[4], ov[4];
#pragma unroll
            for (int mt = 0; mt < 4; ++mt) {
                av[mt] = __builtin_amdgcn_mfma_f32_16x16x32_bf16(fS0, fW[mt][0], (f32x4){0.f, 0.f, 0.f, 0.f}, 0, 0, 0);
                av[mt] = __builtin_amdgcn_mfma_f32_16x16x32_bf16(fS1, fW[mt][1], av[mt], 0, 0, 0); }
#pragma unroll
            for (int mt = 0; mt < 4; ++mt) {
                ov[mt] = __builtin_amdgcn_mfma_f32_16x16x32_bf16(fS0, fQE[mt][0], (f32x4){0.f, 0.f, 0.f, 0.f}, 0, 0, 0);
                ov[mt] = __builtin_amdgcn_mfma_f32_16x16x32_bf16(fS1, fQE[mt][1], ov[mt], 0, 0, 0); }
#pragma unroll
            for (int mt = 0; mt < 4; ++mt) {
                LAS bf16* vp = Vtp + (fq * 4) * 72 + mt * 16 + fr;
                vp[0] = (bf16)f2bf(bflo(uw[mt].x) - av[mt][0]); vp[72] = (bf16)f2bf(bfhi(uw[mt].x) - av[mt][1]);
                vp[144] = (bf16)f2bf(bflo(uw[mt].y) - av[mt][2]); vp[216] = (bf16)f2bf(bfhi(uw[mt].y) - av[mt][3]); }
            const bf16x8 fV0 = *(const LAS bf16x8*)(Vtp + fo), fV1 = *(const LAS bf16x8*)(Vtp + fo + 32);
#pragma unroll
            for (int mt = 0; mt < 4; ++mt) {
                f32x4 sa = Sacc[mt] * egl;
                sa = __builtin_amdgcn_mfma_f32_16x16x32_bf16(fKD[mt][0], fV0, sa, 0, 0, 0);
                sa = __builtin_amdgcn_mfma_f32_16x16x32_bf16(fKD[mt][1], fV1, sa, 0, 0, 0);
                Sacc[mt] = sa;
                u32x2 sw; sw.x = pk2(sa[0], sa[1]); sw.y = pk2(sa[2], sa[3]);
                *(LAS u32x2*)(Stp + fr * 72 + mt * 16 + fq * 4) = sw; }
#pragma unroll
            for (int mt = 0; mt < 4; ++mt) {
                f32x4 o = __builtin_amdgcn_mfma_f32_16x16x32_bf16(fV0, fQK[mt][0], ov[mt], 0, 0, 0);
                o = __builtin_amdgcn_mfma_f32_16x16x32_bf16(fV1, fQK[mt][1], o, 0, 0, 0);
                u32x2 ow; ow.x = pk2(o[0], o[1]); ow.y = pk2(o[2], o[3]);
                *(u32x2*)(obase + ((size_t)c * CH + mt * 16) * DM) = ow; }
            __syncthreads();
        }
    } else {
        const int lt = tid - 256;
        u32x4 rg[4][10];
#define GDN_ISSUE(k, ch) { const size_t co = (size_t)((ch) < NCH ? (ch) : NCH - 1) * 4096; \
            _Pragma("unroll") for (int h2 = 0; h2 < 2; ++h2) { const int idx = lt + h2 * 256, row = idx >> 3, v = idx & 7; \
                rg[k][0 + h2] = *(const u32x4*)(GM0 + co + row * 64 + v * 8); rg[k][2 + h2] = *(const u32x4*)(GM1 + co + row * 64 + v * 8); \
                rg[k][4 + h2] = *(const u32x4*)(GM2 + co + row * 64 + v * 8); rg[k][6 + h2] = *(const u32x4*)(GM3 + co + row * 64 + v * 8); \
                rg[k][8 + h2] = *(const u32x4*)(GM4 + co + row * 64 + v * 8); } }
#define GDN_COMMIT(k, set) { LAS bf16* sb = OPS + (set) * 5 * 4608; \
            _Pragma("unroll") for (int m = 0; m < 5; ++m) _Pragma("unroll") for (int h2 = 0; h2 < 2; ++h2) { const int idx = lt + h2 * 256, row = idx >> 3, v = idx & 7; \
                *(LAS u32x4*)(sb + m * 4608 + row * 72 + v * 8) = rg[k][m * 2 + h2]; } }
        GDN_ISSUE(0, 0) GDN_ISSUE(1, 1) GDN_ISSUE(2, 2) GDN_ISSUE(3, 3)
        GDN_COMMIT(0, 0)
        __syncthreads();
        for (int c = 0; c < NCH; c += 4) {
            GDN_COMMIT(1, 1) GDN_ISSUE(0, c + 4) __syncthreads();
            GDN_COMMIT(2, 0) GDN_ISSUE(1, c + 5) __syncthreads();
            GDN_COMMIT(3, 1) GDN_ISSUE(2, c + 6) __syncthreads();
            GDN_COMMIT(0, 0) GDN_ISSUE(3, c + 7) __syncthreads();
        }
#undef GDN_ISSUE
#undef GDN_COMMIT
    }
}
DEV void gdn_post(const Params& p, int l, int gw, int NGW, int lane) {
    bf16* MIX = (bf16*)(p.ws + WS_MIX); const bf16* PROJ = (const bf16*)(p.ws + WS_PROJ);
    const f32x4 nw = *((const f32x4*)(p.gnorm_w + (size_t)l * 64) + (lane & 15));
    for (int m = gw; m < MTOK; m += NGW) {
        bf16* op = MIX + (size_t)m * DM + 768 + lane * 4;
        const u32x2 ow = *(const u32x2*)op; const u32x2 zw = *(const u32x2*)(PROJ + (size_t)m * NPROJ + 2816 + lane * 4);
        const float o0 = bflo(ow.x), o1 = bfhi(ow.x), o2 = bflo(ow.y), o3 = bfhi(ow.y);
        float ss = (o0 * o0 + o1 * o1) + (o2 * o2 + o3 * o3);
        ss = red16_sum(ss);
        const float rstd = rsqrtf(ss * (1.0f / 64.0f) + EPS);
        u32x2 r; r.x = pk2(o0 * rstd * nw.x * silu(bflo(zw.x)), o1 * rstd * nw.y * silu(bfhi(zw.x))); r.y = pk2(o2 * rstd * nw.z * silu(bflo(zw.y)), o3 * rstd * nw.w * silu(bfhi(zw.y)));
        *(u32x2*)op = r;
    }
}

#define XB_TMO      128
#define XB_XCNT(j)  (256  + 64 * (j))
#define XB_XSUB(j)  (1280 + 64 * (j))
#define XB_XGEN(j)  (2304 + 64 * (j))
#define XB_TOP      3328
#define XB_TOPGEN   3392
#define XCD_BAR_WORDS 3456
#define XB_SPIN_CAP (1u << 18)

__device__ __forceinline__ unsigned xb_ld(unsigned* p)              { return __hip_atomic_load(p, __ATOMIC_RELAXED, __HIP_MEMORY_SCOPE_AGENT); }
__device__ __forceinline__ unsigned xb_add(unsigned* p, unsigned v) { return __hip_atomic_fetch_add(p, v, __ATOMIC_RELAXED, __HIP_MEMORY_SCOPE_AGENT); }
__device__ __forceinline__ unsigned xb_xcc_id() { return (unsigned)__builtin_amdgcn_s_getreg((3 << 11) | 20) & 0xFu; }
#define XB_SPIN(cond, bar) do { unsigned _sp = 0; while (cond) { __builtin_amdgcn_s_sleep(1); \
    if ((++_sp & 255u) == 0u) { if (xb_ld(&(bar)[XB_TMO])) break; if (_sp > XB_SPIN_CAP) { atomicAdd(&(bar)[XB_TMO], 1u); break; } } } } while (0)

struct XcdBarrier {
    unsigned* bar; unsigned x;
    volatile LAS unsigned* st;
};

__device__ __forceinline__ XcdBarrier xcd_barrier_post(unsigned* bar, volatile LAS unsigned* st) {
    XcdBarrier b; b.bar = bar; b.x = xb_xcc_id(); b.st = st;
    if (threadIdx.x == 0) (void)xb_add(&bar[XB_XCNT(b.x)], 1u);
    return b;
}
__device__ __forceinline__ void xcd_barrier_complete(unsigned* bar, unsigned x, unsigned& nloc, unsigned& nx) {
    const unsigned G = gridDim.x * gridDim.y * gridDim.z;
    unsigned sum, cnt, mine, sp = 0u;
    for (;;) {
        sum = 0u; cnt = 0u; mine = 0u;
#pragma unroll
        for (unsigned j = 0; j < 16; ++j) { const unsigned c = xb_ld(&bar[XB_XCNT(j)]); sum += c; cnt += (c > 0u) ? 1u : 0u; mine = (j == x) ? c : mine; }
        if (sum == G) break;
        __builtin_amdgcn_s_sleep(1);
        if ((++sp & 255u) == 0u) { if (xb_ld(&bar[XB_TMO])) break; if (sp > XB_SPIN_CAP) { atomicAdd(&bar[XB_TMO], 1u); break; } }
    }
    nloc = mine > 0u ? mine : 1u; nx = cnt > 0u ? cnt : 1u;
}

__device__ __forceinline__ void xcd_barrier(const XcdBarrier& b) {
    asm volatile("s_waitcnt vmcnt(0)" ::: "memory");
    __syncthreads();
    if (threadIdx.x == 0) {
        unsigned* bar = b.bar;
        __builtin_amdgcn_s_waitcnt(0);
        unsigned nloc = b.st[0], nx = b.st[1];
        if (nloc == 0u) { xcd_barrier_complete(bar, b.x, nloc, nx); b.st[0] = nloc; b.st[1] = nx; }
        const unsigned old = xb_add(&bar[XB_XSUB(b.x)], 1u);
        const unsigned gen = old / nloc;
        if (old + 1u == (gen + 1u) * nloc) {
            __builtin_amdgcn_fence(__ATOMIC_RELEASE, "agent");
            asm volatile("s_waitcnt vmcnt(0)" ::: "memory");
            const unsigned og = xb_add(&bar[XB_TOP], 1u);
            const unsigned tg = og / nx;
            if (og + 1u == (tg + 1u) * nx) xb_add(&bar[XB_TOPGEN], 1u);
            else XB_SPIN(xb_ld(&bar[XB_TOPGEN]) == tg, bar);
            __builtin_amdgcn_fence(__ATOMIC_ACQUIRE, "agent");
            xb_add(&bar[XB_XGEN(b.x)], 1u);
            asm volatile("s_waitcnt vmcnt(0)" ::: "memory");
        } else {
            XB_SPIN(xb_ld(&bar[XB_XGEN(b.x)]) == gen, bar);
            __builtin_amdgcn_fence(__ATOMIC_ACQUIRE, "agent");
            asm volatile("s_waitcnt vmcnt(0)" ::: "memory");
        }
    }
    __syncthreads();
}
__global__ void __launch_bounds__(512, 2) fwd_megakernel(Params p) {
    extern __shared__ __attribute__((aligned(16))) unsigned char lds_raw[];
    cg::grid_group grid = cg::this_grid();
    LAS unsigned char* lds = (LAS unsigned char*)lds_raw;
    const int tid = threadIdx.x, lane = tid & 63, wave = __builtin_amdgcn_readfirstlane(tid >> 6);
    const int G = gridDim.x, bx = blockIdx.x, gw = bx * 8 + wave, NGW = G * 8;
    bf16* XN = (bf16*)(p.ws + WS_XN); float* SMALL = (float*)(p.ws + WS_SMALL); bf16* TMP = (bf16*)(p.ws + WS_TMP);
    bf16* PROJ = (bf16*)(p.ws + WS_PROJ); bf16* MIX = (bf16*)(p.ws + WS_MIX); bf16* HB = (bf16*)(p.ws + WS_H);
    LAS float* wsT = (LAS float*)(lds + 69632);
    volatile LAS unsigned* misc = (volatile LAS unsigned*)(lds + 147200);
    if (tid < 4) misc[tid] = 0u;
    __syncthreads();
    if (bx == 0) { for (int i = tid; i < 4096; i += 512) __hip_atomic_store((unsigned*)p.ws + i, 0u, __ATOMIC_RELAXED, __HIP_MEMORY_SCOPE_AGENT); }
    XcdBarrier xbar; xbar.bar = (unsigned*)p.ws; xbar.x = 0; xbar.st = misc;
#define GSYNC() xcd_barrier(xbar)

#define PHASE_IDS() int tidp = threadIdx.x; int lq = l; asm volatile("" : "+v"(tidp), "+s"(lq)); const int lanep = tidp & 63; const int wavep = __builtin_amdgcn_readfirstlane(tidp >> 6); const int gwp = bx * 8 + wavep; (void)lanep; (void)gwp; (void)lq
#pragma unroll 1
    for (int l = 0; l < DEPTH; ++l) {
        {
            PHASE_IDS();
            convert_weights(p, lq, lds, gwp, NGW, wavep, lanep);
            if (lq == 0) {
                stage_small(p, 0, wsT, tidp);
                __syncthreads();
                rowpass<0>(p.x, nullptr, nullptr, p.pre_mix, nullptr, XN, SMALL, wsT, gwp, NGW, lanep);
            }
        }
        if (l == 0) { grid.sync(); xbar = xcd_barrier_post((unsigned*)p.ws, misc); } else GSYNC();
#ifdef REP_SYNC
        for (int rep = 0; rep < REP_SYNC; ++rep) GSYNC();
#endif
        {
            pg8::Gemm g{XN, (const bf16*)(p.ws + WS_WIN), MTOK, NPROJ, DM}; pg8::StaticOrder S; S.init(MTOK, NPROJ, G, bx);
            pg8::EpiStoreBf16 E{PROJ, NPROJ};
            for (int rg_ = 0; rg_ < REP_GEMM; ++rg_) { if (rg_) GSYNC(); pg8::gemm_phase<pg8::EpiStoreBf16, pg8::StaticOrder, true, true>(lds, g, S, E); }
        }
        GSYNC();
        {
            PHASE_IDS();
            for (int rep = 0; rep < REP_C; ++rep) { if (rep) GSYNC();
            GdnPF pf; if (bx < 1024) gdn_pre_issue(p, bx, tidp, pf);
            for (int u = bx; u < 1024; u += G) gdn_pre_unit(p, lq, u, (u + G < 1024) ? u + G : -1, lds, tidp, pf); }
        }
        GSYNC();
        {
            PHASE_IDS();
            for (int rep = 0; rep < REP_D; ++rep) { if (rep) GSYNC();
            if (bx < 32) { for (int r2 = 0; r2 < REP_DS; ++r2) gdn_scan_block(p, bx, lds, tidp); }
            else if (G == 256) {
                const int vb = bx - 32;
                { P1PF pf; ssd_p1_issue(p, vb, tidp, pf);
                  for (int u = vb; u < 512; u += 224) ssd_p1_unit(p, lq, u, (u + 224 < 512) ? u + 224 : -1, lds, tidp, pf); }
                if (vb < 64) attn_unit(p, lq, vb, lds, tidp);
                else { for (int a = vb; a < 512; a += 160) attn_unit(p, lq, a, lds, tidp); }
            }
            else { for (int u = bx - 32; u < 1024; u += G - 32) { if (u < 512) { P1PF pf; ssd_p1_issue(p, u, tidp, pf); ssd_p1_unit(p, lq, u, -1, lds, tidp, pf); } else { for (int r2 = 0; r2 < REP_ATT; ++r2) attn_unit(p, lq, u - 512, lds, tidp); } } } }
        }
        GSYNC();
        {
            PHASE_IDS();
            for (int vb = bx; vb < 256; vb += G) ssd_scan_all(p, vb, lds, tidp);
            gdn_post(p, lq, gwp, NGW, lanep);
        }
        GSYNC();
        {
            PHASE_IDS();
            for (int rep = 0; rep < REP_E; ++rep) {
                if (rep) GSYNC();
                for (int u = bx; u < 512; u += G) ssd_p3_unit(p, lq, u, lds, tidp);
            }
        }
        GSYNC();
        {
            pg8::Gemm g{MIX, (const bf16*)(p.ws + WS_WOUT), MTOK, DM, DM}; pg8::StaticOrder S; S.init(MTOK, DM, G, bx);
            pg8::EpiStoreBf16 E{TMP, DM};
            for (int rg_ = 0; rg_ < REP_GEMM; ++rg_) { if (rg_) GSYNC(); pg8::gemm_phase<pg8::EpiStoreBf16, pg8::StaticOrder, true, true>(lds, g, S, E); }
        }
        GSYNC();
        {
            PHASE_IDS();
            rowpass<1, false, true>(lq == 0 ? p.x : p.out, TMP, p.post_mix + (size_t)lq * DM, p.pre_ffn + (size_t)lq * DM, p.ws + WS_X1, XN, nullptr, wsT, gwp, NGW, lanep);
        }
        GSYNC();
        {
            pg8::Gemm g{XN, (const bf16*)(p.ws + WS_WGU), MTOK, 2 * FF, DM}; pg8::StaticOrder S; S.init(MTOK, 2 * FF, G, bx);
            pg8::EpiSwiGLU E{HB, FF};
            for (int rg_ = 0; rg_ < REP_GEMM; ++rg_) { if (rg_) GSYNC(); pg8::gemm_phase<pg8::EpiSwiGLU, pg8::StaticOrder, true, true>(lds, g, S, E); }
        }
        GSYNC();
        {
            pg8::Gemm g{HB, (const bf16*)(p.ws + WS_WDN), MTOK, DM, FF}; pg8::StaticOrder S; S.init(MTOK, DM, G, bx);
            pg8::EpiStoreBf16 E{TMP, DM};
            for (int rg_ = 0; rg_ < REP_GEMM; ++rg_) { if (rg_) GSYNC(); pg8::gemm_phase<pg8::EpiStoreBf16, pg8::StaticOrder, true, true>(lds, g, S, E); }
        }
        GSYNC();
        {
            PHASE_IDS();
            if (lq + 1 < DEPTH) {
                stage_small(p, lq + 1, wsT, tidp);
                __syncthreads();
                rowpass<2, true, false>(p.ws + WS_X1, TMP, p.post_ffn + (size_t)lq * DM, p.pre_mix + (size_t)(lq + 1) * DM, p.out, XN, SMALL, wsT, gwp, NGW, lanep);
                __syncthreads();
            } else {
                rowpass<3, true, false>(p.ws + WS_X1, TMP, p.post_ffn + (size_t)lq * DM, nullptr, p.out, nullptr, nullptr, wsT, gwp, NGW, lanep);
            }
        }
    }
}

extern "C" void kernel_launch(void* const* d_in, const int* in_sizes, int n_in, void* d_out, int out_size, void* d_ws, size_t ws_size, hipStream_t stream) {
    static int grid = 0;
    if (grid == 0) {
        if (n_in != 21 || out_size != MTOK * DM || ws_size < WS_END) { fprintf(stderr, "kernel_launch: unexpected shapes (n_in %d out %d ws %zu)\n", n_in, out_size, ws_size); grid = -1; return; }
        int dev = 0, cus = 0, per_cu = 0;
        hipGetDevice(&dev); hipDeviceGetAttribute(&cus, hipDeviceAttributeMultiprocessorCount, dev);
        if (hipFuncSetAttribute((const void*)fwd_megakernel, hipFuncAttributeMaxDynamicSharedMemorySize, LDS_BYTES) != hipSuccess) { fprintf(stderr, "kernel_launch: hipFuncSetAttribute failed\n"); grid = -1; return; }
        hipOccupancyMaxActiveBlocksPerMultiprocessor(&per_cu, (const void*)fwd_megakernel, 512, LDS_BYTES);
        if (per_cu < 1) { fprintf(stderr, "kernel_launch: occupancy query says %d blocks per CU\n", per_cu); per_cu = 1; }
        (void)hipGetLastError();
        grid = cus;
    }
    if (grid < 0) return;
    Params p{};
    const float** pp = (const float**)&p;
    for (int i = 0; i < 21; ++i) pp[i] = (const float*)d_in[i];
    p.out = (float*)d_out; p.ws = (unsigned char*)d_ws;
    void* args[] = {&p};
    hipError_t e = hipLaunchCooperativeKernel((const void*)fwd_megakernel, dim3(grid), dim3(512), args, LDS_BYTES, stream);
    if (e != hipSuccess) fprintf(stderr, "cooperative launch failed: %s (grid %d)\n", hipGetErrorString(e), grid);
}
```
